# Optimizing an MI355X kernel written in HIP

```python
import math
import jax, jax.numpy as jnp
from jax import lax
import numpy as np

D_MODEL = 2048
BATCH = 4
SEQ = 2048
DEPTH = 4

GRID_W = 64
CTX_LEN = 256
N_MIXERS = 3
N_HEADS = 16
HEAD_DIM = 64
V_HEAD_DIM = 2 * HEAD_DIM
ROPE_BASE = 10000.0
AXIS_ROT = HEAD_DIM // 2
Q_BLOCK = 128
SUBLN_EPS = 1e-5
N_FFT_GROUPS = 4
POOL_WINDOWS = (2, 4, 8, 16)
N_POOL_GROUPS = len(POOL_WINDOWS)
D_FF = 4 * D_MODEL
NORM_EPS = 1e-6
N_MOD = 6
N_A = len(range(0, DEPTH, N_MIXERS))
N_B = len(range(1, DEPTH, N_MIXERS))
N_C = len(range(2, DEPTH, N_MIXERS))

kernel_name = 'hybrid_diffattn_fourier_pool_dit'

F32 = jnp.float32


def rmsnorm(x, g, eps=NORM_EPS):
    x32 = x.astype(F32)
    y = x32 * lax.rsqrt(jnp.mean(x32 * x32, axis=-1, keepdims=True) + eps)
    return y.astype(x.dtype) * g


def ada_mod(cond, w, b):
    m = jax.nn.silu(cond) @ w + b
    m = m.reshape(m.shape[:-1] + (N_MOD, 1, D_MODEL))
    return [m[..., k, :, :] for k in range(N_MOD)]


def axial_rope_tables(seq_len):
    rows = seq_len // GRID_W
    row = jnp.repeat(jnp.arange(rows), GRID_W).astype(F32)
    col = jnp.tile(jnp.arange(GRID_W), rows).astype(F32)
    n_freq = AXIS_ROT // 2
    inv = 1.0 / (ROPE_BASE ** (jnp.arange(n_freq, dtype=F32) / n_freq))
    ang = jnp.stack([row[:, None] * inv, col[:, None] * inv], axis=1)
    return jnp.cos(ang), jnp.sin(ang)


def apply_axial_rope(x, cos, sin):
    xs = x.reshape(x.shape[:-1] + (2, 2, AXIS_ROT // 2))
    a = xs[..., 0, :]
    b = xs[..., 1, :]
    cs = cos[None, :, None, None].astype(x.dtype)
    sn = sin[None, :, None, None].astype(x.dtype)
    out = jnp.stack([a * cs - b * sn, a * sn + b * cs], axis=-2)
    return out.reshape(x.shape)


def diff_attention(ul, uc, cos, sin, w_qkv, w_o, lq1, lk1, lq2, lk2, g_subln, lambda_init, with_ctx_out):
    B, L, _ = ul.shape

    def proj(u):
        q, k, v = jnp.split(u @ w_qkv, 3, axis=-1)
        sh = u.shape[:2]
        return (q.reshape(sh + (N_HEADS, 2, HEAD_DIM)),
                k.reshape(sh + (N_HEADS, 2, HEAD_DIM)),
                v.reshape(sh + (N_HEADS, V_HEAD_DIM)))

    ql, kl, vl = proj(ul)
    qc, kc, vc = proj(uc)
    ql = apply_axial_rope(ql, cos, sin)
    kl = apply_axial_rope(kl, cos, sin)
    lam = (jnp.exp(jnp.sum(lq1.astype(F32) * lk1.astype(F32)))
           - jnp.exp(jnp.sum(lq2.astype(F32) * lk2.astype(F32))) + lambda_init)
    scale = 1.0 / math.sqrt(HEAD_DIM)

    def attend(q, k, v):
        s = jnp.einsum('bqhcd,bkhcd->bhcqk', q, k).astype(F32) * scale
        p = jax.nn.softmax(s, axis=-1)
        a = (p[:, :, 0] - lam * p[:, :, 1]).astype(v.dtype)
        return jnp.einsum('bhqk,bkhe->bqhe', a, v)

    k_all = jnp.concatenate([kl, kc], axis=1)
    v_all = jnp.concatenate([vl, vc], axis=1)
    nb = L // Q_BLOCK
    qb = ql.reshape(B, nb, Q_BLOCK, N_HEADS, 2, HEAD_DIM).swapaxes(0, 1)
    ol = lax.map(lambda q: attend(q, k_all, v_all), qb)
    ol = ol.swapaxes(0, 1).reshape(B, L, N_HEADS, V_HEAD_DIM)

    def finish(o):
        o = rmsnorm(o, g_subln, SUBLN_EPS) * (1.0 - lambda_init)
        return o.reshape(o.shape[:2] + (N_HEADS * V_HEAD_DIM,)) @ w_o

    yl = finish(ol)
    yc = finish(attend(qc, kc, vc)) if with_ctx_out else None
    return yl, yc


def fourier_mix(u, w_out):
    B, L, D = u.shape
    ug = u.reshape(B, L, N_FFT_GROUPS, D // N_FFT_GROUPS).astype(F32)
    f = jnp.fft.fft2(ug, axes=(1, 3), norm='ortho').real
    return f.astype(u.dtype).reshape(B, L, D) @ w_out


def pool_mix(u, w_pool, pool_scale):
    L = u.shape[1]
    cg = D_MODEL // N_POOL_GROUPS
    t = jnp.arange(L)
    outs = []
    for g, w in enumerate(POOL_WINDOWS):
        ug = u[..., g * cg:(g + 1) * cg]
        cs = jnp.cumsum(ug.astype(F32), axis=1)
        cs = jnp.concatenate([jnp.zeros_like(cs[:, :1]), cs], axis=1)
        lo = jnp.clip(t - w // 2, 0, L)
        hi = jnp.clip(t - w // 2 + w, 0, L)
        cnt = (hi - lo).astype(F32)[None, :, None]
        mean = (jnp.take(cs, hi, axis=1) - jnp.take(cs, lo, axis=1)) / cnt
        outs.append((mean.astype(u.dtype) - ug) @ w_pool[g])
    return jnp.concatenate(outs, axis=-1) * pool_scale


def sq_relu_mlp(u, w1, w2):
    h = jax.nn.relu(u @ w1)
    return (h * h) @ w2


def setup_inputs(seed: int = 0) -> dict:
    key = jax.random.key(seed)
    ks = jax.random.split(key, 24)
    D = D_MODEL
    cg = D // N_POOL_GROUPS
    nrm = lambda k, shape, s: jax.random.normal(k, shape, F32) * s
    return {
        'x': nrm(ks[0], (BATCH, SEQ, D), 1.0),
        'c': nrm(ks[1], (BATCH, D), 1.0),
        'ctx': nrm(ks[2], (BATCH, CTX_LEN, D), 1.0),
        'c_ctx': nrm(ks[3], (D,), 1.0),
        'w_mod': nrm(ks[4], (DEPTH, D, N_MOD * D), 0.5 * D ** -0.5),
        'b_mod': nrm(ks[5], (DEPTH, N_MOD * D), 0.01),
        'g_mix_pre': 1.0 + nrm(ks[6], (DEPTH, D), 0.02),
        'g_mix_post': 1.0 + nrm(ks[7], (DEPTH, D), 0.02),
        'g_mlp_pre': 1.0 + nrm(ks[8], (DEPTH, D), 0.02),
        'g_mlp_post': 1.0 + nrm(ks[9], (DEPTH, D), 0.02),
        'w_qkv': nrm(ks[10], (N_A, D, 3 * D), D ** -0.5),
        'w_attn_out': nrm(ks[11], (N_A, N_HEADS * V_HEAD_DIM, D), (N_HEADS * V_HEAD_DIM) ** -0.5),
        'lambda_q1': nrm(ks[12], (N_A, HEAD_DIM), 0.1),
        'lambda_k1': nrm(ks[13], (N_A, HEAD_DIM), 0.1),
        'lambda_q2': nrm(ks[14], (N_A, HEAD_DIM), 0.1),
        'lambda_k2': nrm(ks[15], (N_A, HEAD_DIM), 0.1),
        'g_subln': 1.0 + nrm(ks[16], (N_A, V_HEAD_DIM), 0.02),
        'w_fourier_out': nrm(ks[17], (N_B, D, D), D ** -0.5),
        'w_pool': nrm(ks[18], (N_C, N_POOL_GROUPS, cg, cg), cg ** -0.5),
        'pool_scale': 1.0 + nrm(ks[19], (N_C, D), 0.1),
        'w_mlp_in': nrm(ks[20], (DEPTH, D, D_FF), D ** -0.5),
        'w_mlp_out': nrm(ks[21], (DEPTH, D_FF, D), D_FF ** -0.5),
    }


def reference(x, c, ctx, c_ctx, w_mod, b_mod, g_mix_pre, g_mix_post, g_mlp_pre, g_mlp_post,
              w_qkv, w_attn_out, lambda_q1, lambda_k1, lambda_q2, lambda_k2, g_subln,
              w_fourier_out, w_pool, pool_scale, w_mlp_in, w_mlp_out):
    xl, xc = x, ctx
    cos, sin = axial_rope_tables(xl.shape[1])
    ia = ib = ic = 0
    for i in range(DEPTH):
        last = i == DEPTH - 1
        kind = i % N_MIXERS
        need_ctx_in = (not last) or kind == 0
        sh1, sc1, gt1, sh2, sc2, gt2 = ada_mod(c, w_mod[i], b_mod[i])
        csh1, csc1, cgt1, csh2, csc2, cgt2 = ada_mod(c_ctx, w_mod[i], b_mod[i])

        ul = rmsnorm(xl, g_mix_pre[i]) * (1.0 + sc1) + sh1
        uc = rmsnorm(xc, g_mix_pre[i]) * (1.0 + csc1) + csh1 if need_ctx_in else None
        if kind == 0:
            lambda_init = 0.8 - 0.6 * math.exp(-0.3 * i)
            yl, yc = diff_attention(ul, uc, cos, sin, w_qkv[ia], w_attn_out[ia],
                                    lambda_q1[ia], lambda_k1[ia], lambda_q2[ia], lambda_k2[ia],
                                    g_subln[ia], lambda_init, not last)
            ia += 1
        elif kind == 1:
            yl = fourier_mix(ul, w_fourier_out[ib])
            yc = None if last else fourier_mix(uc, w_fourier_out[ib])
            ib += 1
        else:
            yl = pool_mix(ul, w_pool[ic], pool_scale[ic])
            yc = None if last else pool_mix(uc, w_pool[ic], pool_scale[ic])
            ic += 1
        xl = xl + gt1 * rmsnorm(yl, g_mix_post[i])

        vl = rmsnorm(xl, g_mlp_pre[i]) * (1.0 + sc2) + sh2
        xl = xl + gt2 * rmsnorm(sq_relu_mlp(vl, w_mlp_in[i], w_mlp_out[i]), g_mlp_post[i])

        if not last:
            xc = xc + cgt1 * rmsnorm(yc, g_mix_post[i])
            vc = rmsnorm(xc, g_mlp_pre[i]) * (1.0 + csc2) + csh2
            xc = xc + cgt2 * rmsnorm(sq_relu_mlp(vc, w_mlp_in[i], w_mlp_out[i]), g_mlp_post[i])
    return xl
```

```cpp
#include <hip/hip_runtime.h>
#include <cstdio>
#include <cstdint>
#include <cmath>

#ifndef MK_MULTI
#define MK_MULTI 0
#endif

#define LAS __attribute__((address_space(3)))
#define GAS __attribute__((address_space(1)))
typedef unsigned short bf16_t;
typedef short bf16x8 __attribute__((ext_vector_type(8)));
typedef short s16x4 __attribute__((ext_vector_type(4)));
typedef float f32x4 __attribute__((ext_vector_type(4)));
typedef float f32x2 __attribute__((ext_vector_type(2)));
typedef float f32x16 __attribute__((ext_vector_type(16)));
typedef unsigned u32x4 __attribute__((ext_vector_type(4)));
typedef unsigned u32x2 __attribute__((ext_vector_type(2)));

constexpr int D = 2048, NB = 4, SEQ = 2048, CL = 256, ML = NB * SEQ, MC = NB * CL, MT = ML + MC, FF = 8192, NH = 16, NMOD = 6, MODROW = NMOD * D;
constexpr int NWAVES = 8, NTHR = 512;
constexpr float NORM_EPS = 1e-6f, SUBLN_EPS = 1e-5f;
constexpr float QSCALE = 0.125f * 1.4426950408889634f;

constexpr size_t MiB = 1u << 20;
constexpr size_t WS_CTL = 0, CTL_BYTES = 1 * MiB;
constexpr size_t WS_MOD = 1 * MiB;
constexpr size_t WS_ROPE = 2 * MiB;
constexpr size_t WS_T1 = 3 * MiB;
constexpr size_t WS_A2C = 4 * MiB;
constexpr size_t WS_A2 = 5 * MiB;
constexpr size_t WS_WQKV = 22 * MiB;
constexpr size_t WS_WO = 70 * MiB;
constexpr size_t WS_WF = 86 * MiB;
constexpr size_t WS_WPOOL = 94 * MiB;
constexpr size_t WS_W1 = 96 * MiB;
constexpr size_t WS_W2 = 224 * MiB;
constexpr size_t WS_X = 352 * MiB;
constexpr size_t WS_Y = 424 * MiB;
constexpr size_t WS_U = 496 * MiB;
constexpr size_t WS_Q = 532 * MiB, WS_K = 568 * MiB, WS_V = 604 * MiB, WS_O = 640 * MiB;
constexpr size_t WS_H = 676 * MiB;
constexpr size_t WS_YT = 820 * MiB;
constexpr size_t WS_YTC = 884 * MiB;
constexpr size_t WS_END = 892 * MiB;

constexpr int RING_BYTES = 131072, LDSCTL_OFF = 139264  , MISC_OFF = LDSCTL_OFF + 320, LDS_BYTES = 147456;

__device__ __forceinline__ unsigned cvt_pk_bf16(float lo, float hi) { unsigned r; asm volatile("v_cvt_pk_bf16_f32 %0, %1, %2" : "=v"(r) : "v"(lo), "v"(hi)); return r; }
__device__ __forceinline__ float bf2f(unsigned short b) { return __uint_as_float(((unsigned)b) << 16); }
__device__ __forceinline__ float wave_sum(float v) {
#pragma unroll
    for (int o = 1; o < 64; o <<= 1) v += __shfl_xor(v, o);
    return v;
}

#define XB_TMO      128
#define XB_XCNT(j)  (256  + 64 * (j))
#define XB_XSUB(j)  (1280 + 64 * (j))
#define XB_XGEN(j)  (2304 + 64 * (j))
#define XB_TOP      3328
#define XB_TOPGEN   3392
#define XCD_BAR_WORDS 3456
#define XB_SPIN_CAP (1u << 18)
constexpr int CW_BAR = 4096;

__device__ __forceinline__ unsigned xb_ld(unsigned* p)              { return __hip_atomic_load(p, __ATOMIC_RELAXED, __HIP_MEMORY_SCOPE_AGENT); }
__device__ __forceinline__ unsigned xb_add(unsigned* p, unsigned v) { return __hip_atomic_fetch_add(p, v, __ATOMIC_RELAXED, __HIP_MEMORY_SCOPE_AGENT); }
__device__ __forceinline__ unsigned xb_xcc_id() { return (unsigned)__builtin_amdgcn_s_getreg((3 << 11) | 20) & 0xFu; }
#define XB_SPIN(cond, bar) do { unsigned _sp = 0; while (cond) { __builtin_amdgcn_s_sleep(1); \
    if ((++_sp & 255u) == 0u) { if (xb_ld(&(bar)[XB_TMO])) break; if (_sp > XB_SPIN_CAP) { atomicAdd(&(bar)[XB_TMO], 1u); break; } } } } while (0)

struct XcdBarrier { unsigned* bar; unsigned x; volatile LAS unsigned* st; };

__device__ __forceinline__ XcdBarrier xcd_barrier_post(unsigned* bar, volatile LAS unsigned* st) {
    XcdBarrier b; b.bar = bar; b.x = xb_xcc_id(); b.st = st;
    if (threadIdx.x == 0) (void)xb_add(&bar[XB_XCNT(b.x)], 1u);
    return b;
}
__device__ __forceinline__ void xcd_barrier_complete(unsigned* bar, unsigned x, unsigned& nloc, unsigned& nx) {
    const unsigned G = gridDim.x * gridDim.y * gridDim.z;
    unsigned sum, cnt, mine, sp = 0u;
    for (;;) {
        sum = 0u; cnt = 0u; mine = 0u;
#pragma unroll
        for (unsigned j = 0; j < 16; ++j) { const unsigned c = xb_ld(&bar[XB_XCNT(j)]); sum += c; cnt += (c > 0u) ? 1u : 0u; mine = (j == x) ? c : mine; }
        if (sum == G) break;
        __builtin_amdgcn_s_sleep(1);
        if ((++sp & 255u) == 0u) { if (xb_ld(&bar[XB_TMO])) break; if (sp > XB_SPIN_CAP) { atomicAdd(&bar[XB_TMO], 1u); break; } }
    }
    nloc = mine > 0u ? mine : 1u; nx = cnt > 0u ? cnt : 1u;
}
__device__ __forceinline__ void xcd_barrier(const XcdBarrier& b) {
    asm volatile("s_waitcnt vmcnt(0)" ::: "memory");
    __syncthreads();
    if (threadIdx.x == 0) {
        unsigned* bar = b.bar;
        __builtin_amdgcn_s_waitcnt(0);
        unsigned nloc = b.st[0], nx = b.st[1];
        if (nloc == 0u) { xcd_barrier_complete(bar, b.x, nloc, nx); b.st[0] = nloc; b.st[1] = nx; }
        const unsigned old = xb_add(&bar[XB_XSUB(b.x)], 1u);
        const unsigned gen = old / nloc;
        if (old + 1u == (gen + 1u) * nloc) {
            __builtin_amdgcn_fence(__ATOMIC_RELEASE, "agent");
            asm volatile("s_waitcnt vmcnt(0)" ::: "memory");
            const unsigned og = xb_add(&bar[XB_TOP], 1u);
            const unsigned tg = og / nx;
            if (og + 1u == (tg + 1u) * nx) xb_add(&bar[XB_TOPGEN], 1u);
            else XB_SPIN(xb_ld(&bar[XB_TOPGEN]) == tg, bar);
            __builtin_amdgcn_fence(__ATOMIC_ACQUIRE, "agent");
            xb_add(&bar[XB_XGEN(b.x)], 1u);
            asm volatile("s_waitcnt vmcnt(0)" ::: "memory");
        } else {
            XB_SPIN(xb_ld(&bar[XB_XGEN(b.x)]) == gen, bar);
            __builtin_amdgcn_fence(__ATOMIC_ACQUIRE, "agent");
            asm volatile("s_waitcnt vmcnt(0)" ::: "memory");
        }
    }
    __syncthreads();
}

namespace pg8 {
constexpr int BM = 256, BK = 64, HALF = 128, HTB = HALF * BK * 2, STAGE_BYTES = 8 * HTB, NXCD = 8, WGM = 8;
__device__ __forceinline__ int lds_byte(int r, int c) { const int st = (r >> 4) * 2 + (c >> 5), rr = r & 15, cc = c & 31, ob = rr * 64 + cc * 2; return st * 1024 + (ob ^ (((ob >> 9) & 1) << 5)); }
__device__ __forceinline__ void stage_rc(int b, int& R, int& C) { const int st = b / 1024, sb = b % 1024, swz = sb ^ (((sb >> 9) & 1) << 5); R = (st >> 1) * 16 + swz / 64; C = (st & 1) * 32 + (swz % 64) / 2; }
__device__ __forceinline__ int perm32(int rho) { const int n = rho >> 4, i = rho & 15; return 8 * (i >> 2) + 4 * n + (i & 3); }

struct Unit { const char* A; const char* B; int g, pm, pn; };

struct Sched {
    const char* A; const char* B; unsigned lda, ldb; int nt;
    int nM, nN, ngroups; long long a_g, b_g;
    int G, c;
    __device__ __forceinline__ bool next(int i, Unit& u) const {
        const int per = nM * nN, nwg = per * ngroups;
        const long L = (long)i * G + c; if (L >= nwg) return false;
        int wgid = (int)L; { const int q = nwg / NXCD, r = nwg % NXCD, xcd = wgid % NXCD, off = wgid / NXCD; wgid = (xcd < r ? xcd * (q + 1) : r * (q + 1) + (xcd - r) * q) + off; }
        const int g = wgid / per, w = wgid % per;
        const int nig = WGM * nN, gid = w / nig, fm = gid * WGM, gsz = (nM - fm) < WGM ? (nM - fm) : WGM;
        u.g = g; u.pm = fm + ((w % nig) % gsz); u.pn = (w % nig) / gsz;
        u.A = A + (long long)g * a_g + (size_t)u.pm * BM * lda; u.B = B + (long long)g * b_g + (size_t)u.pn * BM * ldb;
        return true;
    }
};

template <class Epi>
__device__ __forceinline__ void gemm_phase(LAS unsigned char* lds, const Sched& S, const Epi& E) {
    const int tid = threadIdx.x, wid = __builtin_amdgcn_readfirstlane(tid >> 6), lane = tid & 63, wr = wid >> 2, wc = wid & 3, fr = lane & 15, fq = lane >> 4;
    const int nt = S.nt;
    unsigned voffA[2], voffB[2];
#pragma unroll
    for (int i = 0; i < 2; ++i) { int R, C; stage_rc(tid * 16 + i * 8192, R, C); const int Rb = (R & ~31) + perm32(R & 31);
        voffA[i] = (unsigned)R * S.lda + (unsigned)C * 2u; voffB[i] = (unsigned)Rb * S.ldb + (unsigned)C * 2u; }
    const size_t kstep = (size_t)(BK * 2);
    const size_t hA = (size_t)HALF * S.lda, hB = (size_t)HALF * S.ldb;
    const unsigned ldsw = (unsigned)wid * 1024u;
    const int aoff = lds_byte(wr * 64 + fr, fq * 8), boff = lds_byte(wc * 32 + fr, fq * 8);
#define PG8_SA(b, h) (((b) * 2 + (h)) * HTB)
#define PG8_SB(b, h) ((4 + (b) * 2 + (h)) * HTB)
#define PG8_STAGE(bufoff, gbase, voff) do { _Pragma("unroll") for (int _i = 0; _i < 2; ++_i) \
        __builtin_amdgcn_global_load_lds((const unsigned*)((const char*)(gbase) + (voff)[_i]), (LAS unsigned*)(lds + (bufoff) + ldsw + _i * 8192), 16, 0, 0); } while (0)
#define PG8_LDA(dst, b, h) do { _Pragma("unroll") for (int m = 0; m < 4; ++m) _Pragma("unroll") for (int k = 0; k < 2; ++k) dst[m][k] = *(const LAS bf16x8*)(lds + PG8_SA(b, h) + aoff + m * 2048 + k * 1024); } while (0)
#define PG8_LDB(dst, b, h) do { _Pragma("unroll") for (int n = 0; n < 2; ++n) _Pragma("unroll") for (int k = 0; k < 2; ++k) dst[n][k] = *(const LAS bf16x8*)(lds + PG8_SB(b, h) + boff + n * 2048 + k * 1024); } while (0)
#define PG8_MMA(ai, bj, At, Bt) do { __builtin_amdgcn_s_setprio(1); _Pragma("unroll") for (int m = 0; m < 4; ++m) _Pragma("unroll") for (int n = 0; n < 2; ++n) _Pragma("unroll") for (int k = 0; k < 2; ++k) \
        acc[ai][bj][m][n] = __builtin_amdgcn_mfma_f32_16x16x32_bf16(Bt[n][k], At[m][k], acc[ai][bj][m][n], 0, 0, 0); __builtin_amdgcn_s_setprio(0); } while (0)
#define PG8_WAIT_V(n) asm volatile("s_waitcnt vmcnt(" #n ")" ::: "memory")
#define PG8_WAIT_L(n) asm volatile("s_waitcnt lgkmcnt(" #n ")" ::: "memory")
#define PG8_BAR __builtin_amdgcn_s_barrier()
#define PG8_SCHED __builtin_amdgcn_sched_barrier(0)
    Unit cur, nxt; int ui = 0;
    if (!S.next(0, cur)) return;
    f32x4 acc[2][2][4][2];
#pragma unroll
    for (int a = 0; a < 2; ++a)
#pragma unroll
        for (int b = 0; b < 2; ++b)
#pragma unroll
            for (int m = 0; m < 4; ++m)
#pragma unroll
                for (int n = 0; n < 2; ++n) acc[a][b][m][n] = (f32x4){0.f, 0.f, 0.f, 0.f};
    bf16x8 At[4][2], B0[2][2], B1[2][2];
    const char* cA = cur.A; const char* cB = cur.B;
    PG8_STAGE(PG8_SB(0, 0), cB, voffB); PG8_STAGE(PG8_SB(0, 1), cB + hB, voffB); PG8_STAGE(PG8_SA(0, 0), cA, voffA); PG8_STAGE(PG8_SA(0, 1), cA + hA, voffA);
    if (wr == 1) PG8_BAR;
    PG8_WAIT_V(2); PG8_BAR;
    PG8_STAGE(PG8_SB(1, 0), cB + kstep, voffB); PG8_STAGE(PG8_SA(1, 0), cA + kstep, voffA); PG8_STAGE(PG8_SB(1, 1), cB + hB + kstep, voffB);
    PG8_WAIT_V(6); PG8_BAR;
    for (;;) {
        const bool has_next = S.next(ui + 1, nxt);
        const char* nA = has_next ? nxt.A : cA; const char* nB = has_next ? nxt.B : cB;
        for (int t = 0; t < nt; t += 2) {
            const bool last = (t == nt - 2);
            const char* a1 = cA + (size_t)(t + 1) * kstep;
            const char* a2 = last ? nA : cA + (size_t)(t + 2) * kstep; const char* b2 = last ? nB : cB + (size_t)(t + 2) * kstep;
            const char* a3 = a2 + kstep; const char* b3 = b2 + kstep;
            PG8_LDB(B0, 0, 0); PG8_LDB(B1, 0, 1); PG8_SCHED; PG8_LDA(At, 0, 0); PG8_STAGE(PG8_SA(1, 1), a1 + hA, voffA);
            PG8_WAIT_V(8); PG8_WAIT_L(0); PG8_BAR; PG8_MMA(0, 0, At, B0); PG8_MMA(0, 1, At, B1); PG8_BAR; PG8_SCHED;
            PG8_LDA(At, 0, 1); PG8_STAGE(PG8_SB(0, 0), b2, voffB); PG8_STAGE(PG8_SB(0, 1), b2 + hB, voffB); PG8_STAGE(PG8_SA(0, 0), a2, voffA);
            PG8_WAIT_V(8); PG8_WAIT_L(0); PG8_BAR; PG8_MMA(1, 0, At, B0); PG8_MMA(1, 1, At, B1); PG8_BAR; PG8_SCHED;
            PG8_LDB(B0, 1, 0); PG8_LDB(B1, 1, 1); PG8_SCHED; PG8_LDA(At, 1, 0); PG8_STAGE(PG8_SA(0, 1), a2 + hA, voffA);
            PG8_WAIT_V(8); PG8_WAIT_L(0); PG8_BAR; PG8_MMA(0, 0, At, B0); PG8_MMA(0, 1, At, B1); PG8_BAR; PG8_SCHED;
            PG8_LDA(At, 1, 1); PG8_STAGE(PG8_SB(1, 0), b3, voffB); PG8_STAGE(PG8_SB(1, 1), b3 + hB, voffB); PG8_STAGE(PG8_SA(1, 0), a3, voffA);
            PG8_WAIT_V(8); PG8_WAIT_L(0); PG8_BAR; PG8_MMA(1, 0, At, B0); PG8_MMA(1, 1, At, B1); PG8_BAR; PG8_SCHED;
        }
        if (wr == 0) PG8_BAR;
        E(acc, cur, wr, wc, fr, fq);
        if (!has_next) break;
#pragma unroll
        for (int a = 0; a < 2; ++a)
#pragma unroll
            for (int b = 0; b < 2; ++b)
#pragma unroll
                for (int m = 0; m < 4; ++m)
#pragma unroll
                    for (int n = 0; n < 2; ++n) acc[a][b][m][n] = (f32x4){0.f, 0.f, 0.f, 0.f};
        cur = nxt; cA = nA; cB = nB; ++ui;
        if (wr == 1) PG8_BAR;
    }
    PG8_WAIT_V(0);
    PG8_BAR;
#undef PG8_SA
#undef PG8_SB
#undef PG8_STAGE
#undef PG8_LDA
#undef PG8_LDB
#undef PG8_MMA
#undef PG8_WAIT_V
#undef PG8_WAIT_L
#undef PG8_BAR
#undef PG8_SCHED
}

struct EpiF32 {
    float* C; unsigned ldc; const float* colscale; int c_g;
    __device__ __forceinline__ void operator()(const f32x4 (&acc)[2][2][4][2], const Unit& u, int wr, int wc, int fr, int fq) const {
        const int row0 = u.pm * BM + wr * 64 + fr, col0 = u.g * c_g + u.pn * BM + wc * 32 + 8 * fq;
        f32x4 sv[2][2];
#pragma unroll
        for (int bj = 0; bj < 2; ++bj)
#pragma unroll
            for (int n = 0; n < 2; ++n) sv[bj][n] = colscale ? *(const f32x4*)(colscale + col0 + bj * HALF + 4 * n) : (f32x4){1.f, 1.f, 1.f, 1.f};
#pragma unroll
        for (int ai = 0; ai < 2; ++ai)
#pragma unroll
            for (int m = 0; m < 4; ++m) { float* rowp = C + (size_t)(row0 + ai * HALF + m * 16) * ldc + col0;
#pragma unroll
                for (int bj = 0; bj < 2; ++bj) { *(f32x4*)(rowp + bj * HALF) = acc[ai][bj][m][0] * sv[bj][0]; *(f32x4*)(rowp + bj * HALF + 4) = acc[ai][bj][m][1] * sv[bj][1]; } }
    }
};
template <int ACT> struct EpiBf16 {
    bf16_t* C; unsigned ldc; int row_g;
    __device__ __forceinline__ void operator()(const f32x4 (&acc)[2][2][4][2], const Unit& u, int wr, int wc, int fr, int fq) const {
        const int row0 = u.g * row_g + u.pm * BM + wr * 64 + fr, col0 = u.pn * BM + wc * 32 + 8 * fq;
#pragma unroll
        for (int ai = 0; ai < 2; ++ai)
#pragma unroll
            for (int m = 0; m < 4; ++m) { bf16_t* rowp = C + (size_t)(row0 + ai * HALF + m * 16) * ldc + col0;
#pragma unroll
                for (int bj = 0; bj < 2; ++bj) { f32x4 v0 = acc[ai][bj][m][0], v1 = acc[ai][bj][m][1];
                    if (ACT == 1) {
#pragma unroll
                        for (int e = 0; e < 4; ++e) { const float a = fmaxf(v0[e], 0.f), b = fmaxf(v1[e], 0.f); v0[e] = a * a; v1[e] = b * b; } }
                    u32x4 w; w.x = cvt_pk_bf16(v0[0], v0[1]); w.y = cvt_pk_bf16(v0[2], v0[3]); w.z = cvt_pk_bf16(v1[0], v1[1]); w.w = cvt_pk_bf16(v1[2], v1[3]);
                    *(u32x4*)(rowp + bj * HALF) = w; } }
    }
};
struct EpiFA {
    bf16_t* YT; bf16_t* YTC;
    __device__ __forceinline__ void operator()(const f32x4 (&acc)[2][2][4][2], const Unit& u, int wr, int wc, int fr, int fq) const {
        const int cs = u.pm >> 1, k2b = (u.pm & 1) * 256;
        bf16_t* base; size_t pitch;
        if (u.pn < 32) { const int b = u.pn >> 3; base = YT + (size_t)(u.g * 512 + k2b) * 16384 + b * 4096 + cs * 2048 + (u.pn & 7) * 256; pitch = 16384; }
        else { const int b = u.pn - 32; base = YTC + (size_t)(u.g * 512 + k2b) * 2048 + b * 512 + cs * 256; pitch = 2048; }
        const int row0 = wr * 64 + fr, col0 = wc * 32 + 8 * fq;
#pragma unroll
        for (int ai = 0; ai < 2; ++ai)
#pragma unroll
            for (int m = 0; m < 4; ++m) { bf16_t* rowp = base + (size_t)(row0 + ai * HALF + m * 16) * pitch + col0;
#pragma unroll
                for (int bj = 0; bj < 2; ++bj) { const f32x4 v0 = acc[ai][bj][m][0], v1 = acc[ai][bj][m][1];
                    u32x4 w; w.x = cvt_pk_bf16(v0[0], v0[1]); w.y = cvt_pk_bf16(v0[2], v0[3]); w.z = cvt_pk_bf16(v1[0], v1[1]); w.w = cvt_pk_bf16(v1[2], v1[3]);
                    *(u32x4*)(rowp + bj * HALF) = w; } }
    }
};
struct EpiQKV {
    bf16_t* Q; const float* rope;
    __device__ __forceinline__ void operator()(const f32x4 (&acc)[2][2][4][2], const Unit& u, int wr, int wc, int fr, int fq) const {
        const int part = u.pn >> 3;
        bf16_t* dst = Q + (size_t)part * ((WS_K - WS_Q) / 2);
        const int row0 = u.pm * BM + wr * 64 + fr, colp = (u.pn & 7) * BM + wc * 32 + 8 * fq;
        const bool dorope = (part < 2) && (u.pm < 32);
        const float sc = part == 0 ? QSCALE : 1.f;
#pragma unroll
        for (int ai = 0; ai < 2; ++ai)
#pragma unroll
            for (int m = 0; m < 4; ++m) { const int row = row0 + ai * HALF + m * 16; bf16_t* rowp = dst + (size_t)row * D + colp;
                const int t = row & 2047, prow = t >> 6, pcol = t & 63;
#pragma unroll
                for (int bj = 0; bj < 2; ++bj) { f32x4 v0 = acc[ai][bj][m][0], v1 = acc[ai][bj][m][1];
                    if (dorope) { const int c = colp + bj * HALF, j0 = (c & 63) >> 1, ax = j0 >> 4, f0 = j0 & 15;
                        const float* cs = rope + ((ax ? pcol : prow) * 16 + f0) * 2;
                        const f32x4 cs0 = *(const f32x4*)cs, cs1 = *(const f32x4*)(cs + 4);
                        f32x4 r0, r1;
                        r0[0] = v0[0] * cs0[0] - v0[1] * cs0[1]; r0[1] = v0[0] * cs0[1] + v0[1] * cs0[0];
                        r0[2] = v0[2] * cs0[2] - v0[3] * cs0[3]; r0[3] = v0[2] * cs0[3] + v0[3] * cs0[2];
                        r1[0] = v1[0] * cs1[0] - v1[1] * cs1[1]; r1[1] = v1[0] * cs1[1] + v1[1] * cs1[0];
                        r1[2] = v1[2] * cs1[2] - v1[3] * cs1[3]; r1[3] = v1[2] * cs1[3] + v1[3] * cs1[2];
                        v0 = r0; v1 = r1; }
                    v0 = v0 * sc; v1 = v1 * sc;
                    u32x4 w; w.x = cvt_pk_bf16(v0[0], v0[1]); w.y = cvt_pk_bf16(v0[2], v0[3]); w.z = cvt_pk_bf16(v1[0], v1[1]); w.w = cvt_pk_bf16(v1[2], v1[3]);
                    *(u32x4*)(rowp + bj * HALF) = w; } }
    }
};
}


namespace att {
__device__ __forceinline__ unsigned off_a(unsigned row, unsigned ch) { return 2048u * (row >> 3) + 512u * (ch >> 2) + 64u * (row & 7) + 16u * ((ch & 3) ^ ((row >> 2) & 3)); }
constexpr int KBUF = 0, VBUF = 32768, QOFF = 65536, WSF_OFF = LDSCTL_OFF + 1024;
constexpr float THR = 6.0f;
struct Args { const bf16_t* Q; const bf16_t* K; const bf16_t* V; bf16_t* O; const float* gsub; float lam, post; };
__device__ __forceinline__ s16x4 vtr(const LAS unsigned char* p) { return __builtin_bit_cast(s16x4, __builtin_amdgcn_ds_read_tr16_b64_v4i16((LAS s16x4*)p)); }
__device__ __forceinline__ float half_max(float v) { auto rr = __builtin_amdgcn_permlane32_swap(__float_as_uint(v), __float_as_uint(v), false, false); return fmaxf(__uint_as_float(rr[0]), __uint_as_float(rr[1])); }
__device__ __forceinline__ float half_sum(float v) { auto rr = __builtin_amdgcn_permlane32_swap(__float_as_uint(v), __float_as_uint(v), false, false); return __uint_as_float(rr[0]) + __uint_as_float(rr[1]); }

__device__ __forceinline__ void unit(LAS unsigned char* lds, const Args& P, int b, int h, int q0, int nlat) {
    const int tid = threadIdx.x, lane = tid & 63, r32 = lane & 31, hi = lane >> 5; const int wid = __builtin_amdgcn_readfirstlane(tid >> 6);
    const int nt = nlat + 4;
    LAS unsigned char* Qs = lds + QOFF + wid * 8192;
    LAS float* wsf = (LAS float*)(lds + WSF_OFF + wid * 256);
    {   const bf16_t* qrow = P.Q + (size_t)(q0 + wid * 32 + r32) * D + h * 128 + hi * 8;
#pragma unroll
        for (int c = 0; c < 2; ++c)
#pragma unroll
            for (int d0 = 0; d0 < 4; ++d0) { const u32x4 v = *(const u32x4*)(qrow + c * 64 + d0 * 16); *(LAS u32x4*)(Qs + ((c * 4 + d0) * 2 + hi) * 512 + r32 * 16) = v; } }
    unsigned goff[2];
#pragma unroll
    for (int i = 0; i < 2; ++i) { const unsigned p = 2 * wid + i, rg = p >> 1, chq = (p & 1) * 2 + (lane >> 5), r7 = (lane >> 2) & 7, x = lane & 3, rsw = (r7 >> 2) | ((rg & 1) << 1);
        goff[i] = ((8 * rg + r7) * D + h * 128 + (4 * chq + (x ^ rsw)) * 8) * 2; }
#define ATT_GROW(t) ((t) < nlat ? b * SEQ + 64 * (t) : ML + b * CL + 64 * ((t) - nlat))
#define ATT_DMA(t, buf) do { const size_t g_ = (size_t)ATT_GROW(t) * D * 2; _Pragma("unroll") for (int i_ = 0; i_ < 2; ++i_) { \
        __builtin_amdgcn_global_load_lds((const unsigned*)((const char*)P.K + g_ + goff[i_]), (LAS unsigned*)(lds + KBUF + (buf) * 16384 + (2 * wid + i_) * 1024), 16, 0, 0); \
        __builtin_amdgcn_global_load_lds((const unsigned*)((const char*)P.V + g_ + goff[i_]), (LAS unsigned*)(lds + VBUF + (buf) * 16384 + (2 * wid + i_) * 1024), 16, 0, 0); } } while (0)
    ATT_DMA(0, 0);
    unsigned kb[2];
#pragma unroll
    for (int e = 0; e < 2; ++e) kb[e] = 2048u * (r32 >> 3) + 64u * (r32 & 7) + 16u * ((unsigned)(2 * e + hi) ^ ((r32 >> 2) & 3));
    const unsigned blk = (lane >> 4) & 1, q_ = (lane & 15) >> 2, p_ = lane & 3;
    unsigned vb[2];
#pragma unroll
    for (int t = 0; t < 2; ++t) vb[t] = 2048u * t + 64u * (4 * hi + q_) + 16u * ((2 * blk + (p_ >> 1)) ^ ((2 * t + hi) & 3)) + 8u * (p_ & 1);
    float m0 = -1e30f, m1 = -1e30f, l0 = 0.f, l1 = 0.f;
    f32x16 o[2][4];
#pragma unroll
    for (int c = 0; c < 2; ++c)
#pragma unroll
        for (int d = 0; d < 4; ++d) o[c][d] = f32x16{};
    asm volatile("s_waitcnt vmcnt(0)" ::: "memory");
    __syncthreads();
#pragma unroll 1
    for (int t = 0; t < nt; ++t) {
        const int buf = t & 1;
        if (t + 1 < nt) ATT_DMA(t + 1, buf ^ 1);
        const LAS unsigned char* Kb = lds + KBUF + buf * 16384; const LAS unsigned char* Vb = lds + VBUF + buf * 16384;
#pragma unroll
        for (int c = 0; c < 2; ++c) {
            u32x4 pw[4];
            f32x16 s0 = f32x16{}, s1 = f32x16{};
            __builtin_amdgcn_sched_barrier(0);
#pragma unroll
            for (int dp = 0; dp < 2; ++dp) {
                bf16x8 qf[2], k0[2], k1[2];
#pragma unroll
                for (int e = 0; e < 2; ++e) { const int d0 = 2 * dp + e;
                    qf[e] = *(const LAS bf16x8*)(Qs + ((c * 4 + d0) * 2 + hi) * 512 + r32 * 16);
                    k0[e] = *(const LAS bf16x8*)(Kb + kb[e] + 512 * (2 * c + dp));
                    k1[e] = *(const LAS bf16x8*)(Kb + kb[e] + 512 * (2 * c + dp) + 8192); }
#pragma unroll
                for (int e = 0; e < 2; ++e) { s0 = __builtin_amdgcn_mfma_f32_32x32x16_bf16(k0[e], qf[e], s0, 0, 0, 0); s1 = __builtin_amdgcn_mfma_f32_32x32x16_bf16(k1[e], qf[e], s1, 0, 0, 0); }
                __builtin_amdgcn_sched_barrier(0);
            }
            float mx = fmaxf(s0[0], s1[0]);
#pragma unroll
            for (int r = 1; r < 16; ++r) mx = fmaxf(mx, fmaxf(s0[r], s1[r]));
            mx = half_max(mx);
            float mc = c == 0 ? m0 : m1, lc = c == 0 ? l0 : l1;
            if (__any(mx - mc > THR)) {
                const float mn = fmaxf(mc, mx), al = __builtin_amdgcn_exp2f(mc - mn);
                mc = mn; lc *= al;
                if (hi == 0) wsf[r32] = al;
#pragma unroll
                for (int g4 = 0; g4 < 4; ++g4) { const f32x4 a4 = *(const LAS f32x4*)(wsf + 8 * g4 + 4 * hi);
#pragma unroll
                    for (int d = 0; d < 4; ++d) { o[c][d][4 * g4 + 0] *= a4[0]; o[c][d][4 * g4 + 1] *= a4[1]; o[c][d][4 * g4 + 2] *= a4[2]; o[c][d][4 * g4 + 3] *= a4[3]; } }
            }
            float sum = 0.f;
#pragma unroll
            for (int r = 0; r < 16; ++r) { s0[r] = __builtin_amdgcn_exp2f(s0[r] - mc); s1[r] = __builtin_amdgcn_exp2f(s1[r] - mc); sum += s0[r] + s1[r]; }
            lc += sum;
            if (c == 0) { m0 = mc; l0 = lc; } else { m1 = mc; l1 = lc; }
#pragma unroll
            for (int ks = 0; ks < 2; ++ks) {
                pw[ks]     = (u32x4){cvt_pk_bf16(s0[8 * ks + 0], s0[8 * ks + 1]), cvt_pk_bf16(s0[8 * ks + 2], s0[8 * ks + 3]), cvt_pk_bf16(s0[8 * ks + 4], s0[8 * ks + 5]), cvt_pk_bf16(s0[8 * ks + 6], s0[8 * ks + 7])};
                pw[2 + ks] = (u32x4){cvt_pk_bf16(s1[8 * ks + 0], s1[8 * ks + 1]), cvt_pk_bf16(s1[8 * ks + 2], s1[8 * ks + 3]), cvt_pk_bf16(s1[8 * ks + 4], s1[8 * ks + 5]), cvt_pk_bf16(s1[8 * ks + 6], s1[8 * ks + 7])};
            }
            __builtin_amdgcn_sched_barrier(0);
#pragma unroll
            for (int ks = 0; ks < 4; ++ks) {
                s16x4 lo[4], hh[4];
#pragma unroll
                for (int d = 0; d < 4; ++d) { lo[d] = vtr(Vb + vb[0] + 4096 * ks + 512 * d); hh[d] = vtr(Vb + vb[1] + 4096 * ks + 512 * d); }
#pragma unroll
                for (int d = 0; d < 4; ++d) {
                    const bf16x8 vf = (bf16x8){lo[d][0], lo[d][1], lo[d][2], lo[d][3], hh[d][0], hh[d][1], hh[d][2], hh[d][3]};
                    o[c][d] = __builtin_amdgcn_mfma_f32_32x32x16_bf16(__builtin_bit_cast(bf16x8, pw[ks]), vf, o[c][d], 0, 0, 0);
                }
                __builtin_amdgcn_sched_barrier(0);
            }
        }
        asm volatile("s_waitcnt vmcnt(0)" ::: "memory");
        __syncthreads();
    }
#undef ATT_GROW
#undef ATT_DMA
    l0 = half_sum(l0); l1 = half_sum(l1);
    if (hi == 0) { wsf[r32] = 1.0f / l0; wsf[32 + r32] = P.lam / l1; }
    float ss[16];
#pragma unroll
    for (int r = 0; r < 16; ++r) ss[r] = 0.f;
#pragma unroll
    for (int g4 = 0; g4 < 4; ++g4) { const f32x4 a4 = *(const LAS f32x4*)(wsf + 8 * g4 + 4 * hi), b4 = *(const LAS f32x4*)(wsf + 32 + 8 * g4 + 4 * hi);
#pragma unroll
        for (int d = 0; d < 4; ++d)
#pragma unroll
            for (int e = 0; e < 4; ++e) { const float v = o[0][d][4 * g4 + e] * a4[e] - o[1][d][4 * g4 + e] * b4[e]; o[0][d][4 * g4 + e] = v; ss[4 * g4 + e] += v * v; } }
#pragma unroll
    for (int r = 0; r < 16; ++r) {
        float v = ss[r];
#pragma unroll
        for (int s = 1; s < 32; s <<= 1) v += __shfl_xor(v, s);
        ss[r] = (1.0f / sqrtf(v * (1.0f / 128.0f) + SUBLN_EPS)) * P.post;
    }
    bf16_t* Ow = P.O + (size_t)(q0 + wid * 32) * D + h * 128 + r32;
#pragma unroll
    for (int d = 0; d < 4; ++d) { const float gs = P.gsub[32 * d + r32];
#pragma unroll
        for (int r = 0; r < 16; ++r) { const int row = (r & 3) + 8 * (r >> 2) + 4 * hi; const float v = o[0][d][r] * ss[r] * gs;
            Ow[(size_t)row * D + 32 * d] = (bf16_t)(cvt_pk_bf16(v, 0.f) & 0xffffu); } }
    __syncthreads();
}
}

struct ThinArgs {
    const float* xin_lat; const float* xin_ctx;
    const float* y;
    float* xout_lat; float* xout_ctx;
    const float* g_post; const float* gate;
    bf16_t* uout;
    const float* g_pre; const float* sc; const float* sh;
    int nrows;
};
__device__ __forceinline__ void thin_phase(const ThinArgs& T, int gw, int ngw, int lane) {
    for (int row = gw; row < T.nrows; row += ngw) {
        const int mrow = row < ML ? (row >> 11) : 4;
        const float* xr = row < ML ? T.xin_lat + (size_t)row * D : T.xin_ctx + (size_t)(row - ML) * D;
        f32x4 xv[8];
#pragma unroll
        for (int j = 0; j < 8; ++j) xv[j] = *(const f32x4*)(xr + 256 * j + 4 * lane);
        if (T.y) {
            const float* yr = T.y + (size_t)row * D; f32x4 yv[8]; float s = 0.f;
#pragma unroll
            for (int j = 0; j < 8; ++j) { yv[j] = *(const f32x4*)(yr + 256 * j + 4 * lane); s += (yv[j][0] * yv[j][0] + yv[j][1] * yv[j][1]) + (yv[j][2] * yv[j][2] + yv[j][3] * yv[j][3]); }
            const float rs = 1.0f / sqrtf(wave_sum(s) * (1.0f / D) + NORM_EPS);
            const float* gt = T.gate + (size_t)mrow * MODROW;
#pragma unroll
            for (int j = 0; j < 8; ++j) { const f32x4 g = *(const f32x4*)(T.g_post + 256 * j + 4 * lane), a = *(const f32x4*)(gt + 256 * j + 4 * lane); xv[j] = xv[j] + a * ((yv[j] * rs) * g); }
            float* xo = row < ML ? (T.xout_lat ? T.xout_lat + (size_t)row * D : nullptr) : (T.xout_ctx ? T.xout_ctx + (size_t)(row - ML) * D : nullptr);
            if (xo) {
#pragma unroll
                for (int j = 0; j < 8; ++j) *(f32x4*)(xo + 256 * j + 4 * lane) = xv[j]; }
        }
        if (T.uout) {
            float s = 0.f;
#pragma unroll
            for (int j = 0; j < 8; ++j) s += (xv[j][0] * xv[j][0] + xv[j][1] * xv[j][1]) + (xv[j][2] * xv[j][2] + xv[j][3] * xv[j][3]);
            const float rs = 1.0f / sqrtf(wave_sum(s) * (1.0f / D) + NORM_EPS);
            const float* scp = T.sc + (size_t)mrow * MODROW; const float* shp = T.sh + (size_t)mrow * MODROW;
            bf16_t* uo = T.uout + (size_t)row * D;
#pragma unroll
            for (int j = 0; j < 8; ++j) { const f32x4 g = *(const f32x4*)(T.g_pre + 256 * j + 4 * lane), a = *(const f32x4*)(scp + 256 * j + 4 * lane), c = *(const f32x4*)(shp + 256 * j + 4 * lane);
                const f32x4 u = ((xv[j] * rs) * g) * (a + 1.0f) + c;
                u32x2 w; w.x = cvt_pk_bf16(u[0], u[1]); w.y = cvt_pk_bf16(u[2], u[3]); *(u32x2*)(uo + 256 * j + 4 * lane) = w; }
        }
    }
}
__device__ __forceinline__ void pool_phase(const bf16_t* U, bf16_t* Dm, int nrows, int gw, int ngw, int lane) {
    for (int row = gw; row < nrows; row += ngw) {
        int base, t, Ls;
        if (row < ML) { base = row & ~2047; t = row & 2047; Ls = SEQ; } else { const int i = row - ML; base = ML + (i & ~255); t = i & 255; Ls = CL; }
#pragma unroll
        for (int j = 0; j < 8; ++j) {
            const int w = 2 << (j >> 1); int lo = t - (w >> 1), hi = lo + w; lo = lo < 0 ? 0 : lo; hi = hi > Ls ? Ls : hi;
            const bf16_t* p = U + (size_t)base * D + 256 * j + 4 * lane;
            f32x4 s = {0.f, 0.f, 0.f, 0.f};
            for (int tt = lo; tt < hi; ++tt) { const u32x2 v = *(const u32x2*)(p + (size_t)tt * D);
                s[0] += __uint_as_float(v.x << 16); s[1] += __uint_as_float(v.x & 0xffff0000u); s[2] += __uint_as_float(v.y << 16); s[3] += __uint_as_float(v.y & 0xffff0000u); }
            const u32x2 cv = *(const u32x2*)(p + (size_t)t * D);
            const float inv = 1.0f / (float)(hi - lo);
            f32x4 d; d[0] = s[0] * inv - __uint_as_float(cv.x << 16); d[1] = s[1] * inv - __uint_as_float(cv.x & 0xffff0000u); d[2] = s[2] * inv - __uint_as_float(cv.y << 16); d[3] = s[3] * inv - __uint_as_float(cv.y & 0xffff0000u);
            u32x2 o; o.x = cvt_pk_bf16(d[0], d[1]); o.y = cvt_pk_bf16(d[2], d[3]);
            *(u32x2*)(Dm + (size_t)row * D + 256 * j + 4 * lane) = o;
        }
    }
}

__device__ __forceinline__ void transpose_item(const float* W, int K, int N, bf16_t* WT, int row_off, LAS float* scr, int item, int lane, bool qkperm) {
    const int nblk = N / 64, kb = item / nblk, nb = item % nblk, k0 = 64 * kb, n0 = 64 * nb;
    const int kq = lane >> 4, n4 = lane & 15;
    f32x4 v[16];
#pragma unroll
    for (int i = 0; i < 16; ++i) v[i] = *(const f32x4*)(W + (size_t)(k0 + 4 * i + kq) * N + n0 + 4 * n4);
#pragma unroll
    for (int i = 0; i < 16; ++i) { LAS float* s = scr + (4 * i + kq) * 65 + 4 * n4; s[0] = v[i][0]; s[1] = v[i][1]; s[2] = v[i][2]; s[3] = v[i][3]; }
    asm volatile("s_waitcnt lgkmcnt(0)" ::: "memory");
    const int c = lane & 7;
#pragma unroll
    for (int j = 0; j < 8; ++j) { const int n = (lane >> 3) + 8 * j; int sc = n;
        if (qkperm) { const int jj = n >> 1, which = n & 1, ax = jj >> 4, f = jj & 15; sc = ax * 32 + which * 16 + f; }
        const LAS float* s = scr + (8 * c) * 65 + sc;
        u32x4 o; o.x = cvt_pk_bf16(s[0 * 65], s[1 * 65]); o.y = cvt_pk_bf16(s[2 * 65], s[3 * 65]); o.z = cvt_pk_bf16(s[4 * 65], s[5 * 65]); o.w = cvt_pk_bf16(s[6 * 65], s[7 * 65]);
        *(u32x4*)(WT + (size_t)(row_off + n0 + n) * K + k0 + 8 * c) = o; }
    asm volatile("s_waitcnt lgkmcnt(0)" ::: "memory");
}

struct Params {
    const float* in[22];
    float* out; unsigned char* ws;
    float lam_init0, lam_init3;
    int ph_lo, ph_hi;
};

__device__ __forceinline__ void prologue(const Params& P, LAS unsigned char* lds, int tid, int wave, int lane, int vcu, int G) {
    unsigned char* ws = P.ws;
    const float* c_in = P.in[1]; const float* cctx = P.in[3]; const float* w_mod = P.in[4]; const float* b_mod = P.in[5];
    LAS float* sil = (LAS float*)lds;
    LAS float* red = (LAS float*)(lds + 65536);
    for (int i = tid; i < 5 * D; i += NTHR) { const int r = i / D, k = i % D; const float x = r < 4 ? c_in[r * D + k] : cctx[k]; sil[k * 8 + r] = x / (1.0f + __expf(-x)); }
    __syncthreads();
    float* mod = (float*)(ws + WS_MOD);
    for (int item = blockIdx.x; item < 4 * 192; item += G) {
        const int l = item / 192, col = (item % 192) * 64 + lane;
        const float* W = w_mod + (size_t)l * D * MODROW + col;
        float a0 = 0.f, a1 = 0.f, a2 = 0.f, a3 = 0.f, a4 = 0.f;
        const int k0 = wave * 256;
        for (int kk = 0; kk < 256; kk += 16) {
            float w[16];
#pragma unroll
            for (int j = 0; j < 16; ++j) w[j] = W[(size_t)(k0 + kk + j) * MODROW];
#pragma unroll
            for (int j = 0; j < 16; ++j) { const f32x4 s4 = *(const LAS f32x4*)(sil + (k0 + kk + j) * 8); const float s5 = sil[(k0 + kk + j) * 8 + 4];
                a0 += s4[0] * w[j]; a1 += s4[1] * w[j]; a2 += s4[2] * w[j]; a3 += s4[3] * w[j]; a4 += s5 * w[j]; }
        }
        red[(wave * 5 + 0) * 64 + lane] = a0; red[(wave * 5 + 1) * 64 + lane] = a1; red[(wave * 5 + 2) * 64 + lane] = a2; red[(wave * 5 + 3) * 64 + lane] = a3; red[(wave * 5 + 4) * 64 + lane] = a4;
        __syncthreads();
        if (wave < 5) { float s = b_mod[l * MODROW + col];
#pragma unroll
            for (int w8 = 0; w8 < 8; ++w8) s += red[(w8 * 5 + wave) * 64 + lane];
            mod[((size_t)l * 5 + wave) * MODROW + col] = s; }
        __syncthreads();
    }
    LAS float* scr = (LAS float*)(lds + wave * 16640);
    const int gw = vcu * NWAVES + wave, NGW = G * NWAVES;
    bf16_t* Wqkv = (bf16_t*)(ws + WS_WQKV); bf16_t* Wo = (bf16_t*)(ws + WS_WO); bf16_t* Wf = (bf16_t*)(ws + WS_WF); bf16_t* Wp = (bf16_t*)(ws + WS_WPOOL);
    bf16_t* W1 = (bf16_t*)(ws + WS_W1); bf16_t* W2 = (bf16_t*)(ws + WS_W2);
    constexpr int I_QKV = (D / 64) * (3 * D / 64), I_O = (D / 64) * (D / 64), I_P = 8 * 8, I_1 = (D / 64) * (FF / 64), I_2 = (FF / 64) * (D / 64);
    constexpr int NITEMS = 2 * I_QKV + 2 * I_O + I_O + 4 * I_P + 4 * I_1 + 4 * I_2;
    for (int it = gw; it < NITEMS; it += NGW) {
        int r = it;
        if (r < 2 * I_QKV) { const int ia = r / I_QKV; r %= I_QKV; const int nb = r % (3 * D / 64);
            transpose_item(P.in[10] + (size_t)ia * D * 3 * D, D, 3 * D, Wqkv + (size_t)ia * 3 * D * D, 0, scr, r, lane, nb < 2 * D / 64); continue; } r -= 2 * I_QKV;
        if (r < 2 * I_O) { const int ia = r / I_O; r %= I_O; transpose_item(P.in[11] + (size_t)ia * D * D, D, D, Wo + (size_t)ia * D * D, 0, scr, r, lane, false); continue; } r -= 2 * I_O;
        if (r < I_O) { transpose_item(P.in[17], D, D, Wf, 0, scr, r, lane, false); continue; } r -= I_O;
        if (r < 4 * I_P) { const int g = r / I_P; r %= I_P; transpose_item(P.in[18] + (size_t)g * 512 * 512, 512, 512, Wp + (size_t)g * 512 * 512, 0, scr, r, lane, false); continue; } r -= 4 * I_P;
        if (r < 4 * I_1) { const int l = r / I_1; r %= I_1; transpose_item(P.in[20] + (size_t)l * D * FF, D, FF, W1 + (size_t)l * FF * D, 0, scr, r, lane, false); continue; } r -= 4 * I_1;
        { const int l = r / I_2; r %= I_2; transpose_item(P.in[21] + (size_t)l * FF * D, FF, D, W2 + (size_t)l * D * FF, 0, scr, r, lane, false); }
    }
    {   bf16_t* T1 = (bf16_t*)(ws + WS_T1); bf16_t* A2 = (bf16_t*)(ws + WS_A2); bf16_t* A2C = (bf16_t*)(ws + WS_A2C);
        constexpr int C_T1 = 1024 * 512 / 8, C_A2 = 2048 * 4096 / 8, C_A2C = 256 * 512 / 8;
        const int gt = gw * 64 + lane, NGT = NGW * 64;
        for (int ch = gt; ch < C_T1 + C_A2 + C_A2C; ch += NGT) {
            int r = ch; bf16_t* dst; int row, col0, N, ncol; float scale; bool negsin;
            if (r < C_T1) { row = r / 64; col0 = (r % 64) * 8; dst = T1 + (size_t)row * 512 + col0; N = 512; scale = 0.04419417382415922f; negsin = false;
                const int cs = row >> 9, k2 = row & 511; float vals[8];
#pragma unroll
                for (int e = 0; e < 8; ++e) { const int idx = (k2 * (col0 + e)) & 511; const float a = (float)idx * (1.0f / 256.0f); vals[e] = (cs ? sinpif(a) : cospif(a)) * scale; }
                u32x4 o; o.x = cvt_pk_bf16(vals[0], vals[1]); o.y = cvt_pk_bf16(vals[2], vals[3]); o.z = cvt_pk_bf16(vals[4], vals[5]); o.w = cvt_pk_bf16(vals[6], vals[7]); *(u32x4*)dst = o; continue; }
            r -= C_T1;
            if (r < C_A2) { row = r / 512; col0 = (r % 512) * 8; dst = A2 + (size_t)row * 4096 + col0; N = 2048; scale = 0.022097086912079608f; }
            else { r -= C_A2; row = r / 64; col0 = (r % 64) * 8; dst = A2C + (size_t)row * 512 + col0; N = 256; scale = 0.0625f; }
            (void)ncol; (void)negsin;
            { const int cs = col0 / N, n0 = col0 % N; float vals[8];
#pragma unroll
              for (int e = 0; e < 8; ++e) { const int idx = (row * (n0 + e)) & (N - 1); const float a = (float)idx * (2.0f / (float)N); vals[e] = (cs ? -sinpif(a) : cospif(a)) * scale; }
              u32x4 o; o.x = cvt_pk_bf16(vals[0], vals[1]); o.y = cvt_pk_bf16(vals[2], vals[3]); o.z = cvt_pk_bf16(vals[4], vals[5]); o.w = cvt_pk_bf16(vals[6], vals[7]); *(u32x4*)dst = o; }
        }
        float* rope = (float*)(ws + WS_ROPE);
        for (int i = gt; i < 64 * 16; i += NGT) { const int pos = i >> 4, f = i & 15; const float inv = 1.0f / powf(10000.0f, (float)f * (1.0f / 16.0f)); const float ang = (float)pos * inv;
            rope[2 * i] = cosf(ang); rope[2 * i + 1] = sinf(ang); }
    }
}

struct Ctx { LAS unsigned char* lds; int tid, lane, wave, G, bx, vcu, gw, NGW; };
#if MK_MULTI
#define GRID_BAR() do { } while (0)
#else
#define GRID_BAR() xcd_barrier(bar)
#endif
#define PH_BEGIN(k) if ((k) >= P.ph_lo && (k) < P.ph_hi) {
#define PH_END(k)   if ((k) + 1 < P.ph_hi) GRID_BAR(); }
#define WSP(T, off) ((T*)(P.ws + (off)))

template <int L, int PH0>
__device__ __forceinline__ void layer(const Params& P, const Ctx& C, const XcdBarrier& bar) {
    constexpr int kind = L % 3; constexpr bool lastl = (L == 3);
    constexpr int Mact = lastl ? ML : MT;
    constexpr int NMIX = (kind == 2) ? 1 : 2;
    LAS unsigned char* lds = C.lds;
    if constexpr (kind == 0) {
        constexpr int ia = L / 3;
        PH_BEGIN(PH0)
        { pg8::Sched S{}; S.A = (const char*)WSP(bf16_t, WS_U); S.B = (const char*)(WSP(bf16_t, WS_WQKV) + (size_t)ia * 3 * D * D); S.lda = D * 2; S.ldb = D * 2; S.nt = D / 64;
          S.nM = MT / 256; S.nN = 3 * D / 256; S.ngroups = 1; S.a_g = 0; S.b_g = 0; S.G = C.G; S.c = C.bx;
          pg8::EpiQKV E{WSP(bf16_t, WS_Q), WSP(const float, WS_ROPE)};
          pg8::gemm_phase(lds, S, E); }
        PH_END(PH0)
        PH_BEGIN(PH0 + 1)
        { const float* lq1 = P.in[12] + ia * 64; const float* lk1 = P.in[13] + ia * 64; const float* lq2 = P.in[14] + ia * 64; const float* lk2 = P.in[15] + ia * 64;
          const float d1 = wave_sum(lq1[C.lane] * lk1[C.lane]), d2 = wave_sum(lq2[C.lane] * lk2[C.lane]);
          const float li = (L == 0) ? P.lam_init0 : P.lam_init3;
          att::Args A{WSP(bf16_t, WS_Q), WSP(bf16_t, WS_K), WSP(bf16_t, WS_V), WSP(bf16_t, WS_O), P.in[16] + ia * 128, expf(d1) - expf(d2) + li, 1.0f - li};
          constexpr int nlat_units = NB * NH * (SEQ / 256);
          const int per = (nlat_units + C.G - 1) / C.G;
          for (int i = 0; i < per; ++i) { const int uu = C.vcu * per + i; if (uu < nlat_units) { const int bh = uu >> 3, qb = uu & 7; att::unit(lds, A, bh >> 4, bh & 15, (bh >> 4) * SEQ + qb * 256, SEQ / 64); } }
          if constexpr (!lastl) { for (int uc = C.bx; uc < NB * NH; uc += C.G) { const int b = uc >> 4, h = uc & 15; att::unit(lds, A, b, h, ML + b * CL, 0); } } }
        PH_END(PH0 + 1)
    } else if constexpr (kind == 1) {
        PH_BEGIN(PH0)
        { pg8::Sched S{}; S.A = (const char*)WSP(bf16_t, WS_T1); S.B = (const char*)WSP(bf16_t, WS_U); S.lda = 512 * 2; S.ldb = D * 2; S.nt = 8; S.nM = 4; S.nN = Mact / 256; S.ngroups = 4; S.a_g = 0; S.b_g = 512 * 2; S.G = C.G; S.c = C.bx;
          pg8::EpiFA E{WSP(bf16_t, WS_YT), WSP(bf16_t, WS_YTC)};
          pg8::gemm_phase(lds, S, E); }
        PH_END(PH0)
        PH_BEGIN(PH0 + 1)
        { pg8::Sched S{}; S.A = (const char*)WSP(bf16_t, WS_A2); S.B = (const char*)WSP(bf16_t, WS_YT); S.lda = 4096 * 2; S.ldb = 16384 * 2; S.nt = 64; S.nM = 8; S.nN = 8; S.ngroups = 4; S.a_g = 0; S.b_g = 4096 * 2; S.G = C.G; S.c = C.bx;
          pg8::EpiBf16<0> E{WSP(bf16_t, WS_O), (unsigned)D, SEQ};
          pg8::gemm_phase(lds, S, E);
          if constexpr (!lastl) { pg8::Sched S2{}; S2.A = (const char*)WSP(bf16_t, WS_A2C); S2.B = (const char*)WSP(bf16_t, WS_YTC); S2.lda = 512 * 2; S2.ldb = 2048 * 2; S2.nt = 8; S2.nM = 1; S2.nN = 8; S2.ngroups = 4; S2.a_g = 0; S2.b_g = 512 * 2; S2.G = C.G; S2.c = C.bx;
            pg8::EpiBf16<0> E2{WSP(bf16_t, WS_O) + (size_t)ML * D, (unsigned)D, CL};
            pg8::gemm_phase(lds, S2, E2); } }
        PH_END(PH0 + 1)
    } else {
        PH_BEGIN(PH0) pool_phase(WSP(bf16_t, WS_U), WSP(bf16_t, WS_O), Mact, C.gw, C.NGW, C.lane); PH_END(PH0)
    }
    PH_BEGIN(PH0 + NMIX)
    { pg8::Sched S{}; S.A = (const char*)WSP(bf16_t, WS_O); S.lda = D * 2; S.nM = Mact / 256; S.G = C.G; S.c = C.bx;
      const float* colscale = nullptr; int cg = 0;
      if constexpr (kind == 0) { S.B = (const char*)(WSP(bf16_t, WS_WO) + (size_t)(L / 3) * D * D); S.ldb = D * 2; S.nt = D / 64; S.nN = D / 256; S.ngroups = 1; }
      else if constexpr (kind == 1) { S.B = (const char*)WSP(bf16_t, WS_WF); S.ldb = D * 2; S.nt = D / 64; S.nN = D / 256; S.ngroups = 1; }
      else { S.B = (const char*)WSP(bf16_t, WS_WPOOL); S.ldb = 512 * 2; S.nt = 8; S.nN = 2; S.ngroups = 4; S.a_g = 512 * 2; S.b_g = 512 * 512 * 2; colscale = P.in[19]; cg = 512; }
      pg8::EpiF32 E{WSP(float, WS_Y), (unsigned)D, colscale, cg}; pg8::gemm_phase(lds, S, E); }
    PH_END(PH0 + NMIX)
    PH_BEGIN(PH0 + NMIX + 1)
    { const float* modl = WSP(const float, WS_MOD) + (size_t)L * 5 * MODROW; float* X = WSP(float, WS_X);
      ThinArgs T{}; T.xin_lat = L == 0 ? P.in[0] : X; T.xin_ctx = L == 0 ? P.in[2] : X + (size_t)ML * D; T.y = WSP(const float, WS_Y); T.xout_lat = X; T.xout_ctx = X + (size_t)ML * D;
      T.g_post = P.in[7] + L * D; T.gate = modl + 2 * D; T.uout = WSP(bf16_t, WS_U); T.g_pre = P.in[8] + L * D; T.sc = modl + 4 * D; T.sh = modl + 3 * D; T.nrows = Mact;
      thin_phase(T, C.gw, C.NGW, C.lane); }
    PH_END(PH0 + NMIX + 1)
    PH_BEGIN(PH0 + NMIX + 2)
    { pg8::Sched S{}; S.A = (const char*)WSP(bf16_t, WS_U); S.B = (const char*)(WSP(bf16_t, WS_W1) + (size_t)L * FF * D); S.lda = D * 2; S.ldb = D * 2; S.nt = D / 64; S.nM = Mact / 256; S.nN = FF / 256; S.ngroups = 1; S.G = C.G; S.c = C.bx;
      pg8::EpiBf16<1> E{WSP(bf16_t, WS_H), (unsigned)FF, 0}; pg8::gemm_phase(lds, S, E); }
    PH_END(PH0 + NMIX + 2)
    PH_BEGIN(PH0 + NMIX + 3)
    { pg8::Sched S{}; S.A = (const char*)WSP(bf16_t, WS_H); S.B = (const char*)(WSP(bf16_t, WS_W2) + (size_t)L * D * FF); S.lda = FF * 2; S.ldb = FF * 2; S.nt = FF / 64; S.nM = Mact / 256; S.nN = D / 256; S.ngroups = 1; S.G = C.G; S.c = C.bx;
      pg8::EpiF32 E{WSP(float, WS_Y), (unsigned)D, nullptr, 0}; pg8::gemm_phase(lds, S, E); }
    PH_END(PH0 + NMIX + 3)
    PH_BEGIN(PH0 + NMIX + 4)
    { const float* modl = WSP(const float, WS_MOD) + (size_t)L * 5 * MODROW; float* X = WSP(float, WS_X);
      ThinArgs T{}; T.xin_lat = X; T.xin_ctx = X + (size_t)ML * D; T.y = WSP(const float, WS_Y); T.xout_lat = lastl ? P.out : X; T.xout_ctx = X + (size_t)ML * D;
      T.g_post = P.in[9] + L * D; T.gate = modl + 5 * D; T.nrows = Mact;
      if constexpr (!lastl) { const float* modn = modl + 5 * MODROW; T.uout = WSP(bf16_t, WS_U); T.g_pre = P.in[6] + (L + 1) * D; T.sc = modn + 1 * D; T.sh = modn + 0 * D; }
      thin_phase(T, C.gw, C.NGW, C.lane); }
    PH_END(PH0 + NMIX + 4)
}
constexpr int PH_L0 = 2, PH_L1 = PH_L0 + 7, PH_L2 = PH_L1 + 7, PH_L3 = PH_L2 + 6, N_PHASES = PH_L3 + 7;

__global__ void __launch_bounds__(NTHR, 2) fwd_kernel(Params P) {
    extern __shared__ __attribute__((aligned(16))) unsigned char lds_raw[];
    Ctx C; C.lds = (LAS unsigned char*)lds_raw;
    C.tid = threadIdx.x; C.lane = C.tid & 63; C.wave = __builtin_amdgcn_readfirstlane(C.tid >> 6);
    C.G = gridDim.x; C.bx = blockIdx.x; C.vcu = (C.G % 8 == 0) ? (C.bx % 8) * (C.G / 8) + C.bx / 8 : C.bx;
    C.gw = C.vcu * NWAVES + C.wave; C.NGW = C.G * NWAVES;
    for (int u = C.tid; u < (LDS_BYTES - LDSCTL_OFF) / 4; u += NTHR) ((LAS unsigned*)(C.lds + LDSCTL_OFF))[u] = 0u;
    __syncthreads();
#if MK_MULTI
    XcdBarrier bar{};
#else
    XcdBarrier bar = xcd_barrier_post(WSP(unsigned, WS_CTL) + CW_BAR, (volatile LAS unsigned*)(C.lds + MISC_OFF) + 8);
#endif
    PH_BEGIN(0) prologue(P, C.lds, C.tid, C.wave, C.lane, C.vcu, C.G); PH_END(0)
    PH_BEGIN(1)
    { const float* mod = WSP(const float, WS_MOD);
      ThinArgs T{}; T.xin_lat = P.in[0]; T.xin_ctx = P.in[2]; T.y = nullptr; T.uout = WSP(bf16_t, WS_U); T.g_pre = P.in[6]; T.sc = mod + 1 * D; T.sh = mod + 0 * D; T.nrows = MT;
      thin_phase(T, C.gw, C.NGW, C.lane); }
    PH_END(1)
    layer<0, PH_L0>(P, C, bar);
    layer<1, PH_L1>(P, C, bar);
    layer<2, PH_L2>(P, C, bar);
    layer<3, PH_L3>(P, C, bar);
}
#undef PH_BEGIN
#undef PH_END
#undef GRID_BAR

extern "C" void kernel_launch(void* const* d_in, const int* in_sizes, int n_in, void* d_out, int out_size, void* d_ws, size_t ws_size, hipStream_t stream) {
    static int grid = 0;
    if (grid == 0) {
        if (n_in != 22 || out_size != ML * D || ws_size < WS_END) { fprintf(stderr, "kernel_launch: unexpected problem: n_in %d out %d ws %zu (need %zu)\n", n_in, out_size, ws_size, (size_t)WS_END); grid = -1; return; }
        int dev = 0, cus = 0, per_cu = 0;
        if (hipGetDevice(&dev) != hipSuccess || hipDeviceGetAttribute(&cus, hipDeviceAttributeMultiprocessorCount, dev) != hipSuccess) { grid = -1; return; }
        if (hipFuncSetAttribute((const void*)fwd_kernel, hipFuncAttributeMaxDynamicSharedMemorySize, LDS_BYTES) != hipSuccess) { fprintf(stderr, "kernel_launch: hipFuncSetAttribute failed\n"); grid = -1; return; }
        if (hipOccupancyMaxActiveBlocksPerMultiprocessor(&per_cu, (const void*)fwd_kernel, NTHR, LDS_BYTES) != hipSuccess || per_cu < 1) fprintf(stderr, "kernel_launch: occupancy query says %d\n", per_cu);
        (void)hipGetLastError();
        grid = cus;
    }
    if (grid < 0) return;
    (void)in_sizes;
    hipMemsetAsync((char*)d_ws + WS_CTL, 0, CTL_BYTES, stream);
    Params p{};
    for (int i = 0; i < 22; ++i) p.in[i] = (const float*)d_in[i];
    p.out = (float*)d_out; p.ws = (unsigned char*)d_ws;
    p.lam_init0 = (float)(0.8 - 0.6 * exp(-0.3 * 0.0)); p.lam_init3 = (float)(0.8 - 0.6 * exp(-0.3 * 3.0));
#if MK_MULTI
    for (int ph = 0; ph < N_PHASES; ++ph) { p.ph_lo = ph; p.ph_hi = ph + 1; hipLaunchKernelGGL(fwd_kernel, dim3(grid), dim3(NTHR), LDS_BYTES, stream, p); }
#else
    p.ph_lo = 0; p.ph_hi = N_PHASES;
    hipLaunchKernelGGL(fwd_kernel, dim3(grid), dim3(NTHR), LDS_BYTES, stream, p);
#endif
    const hipError_t le = hipPeekAtLastError();
    if (le != hipSuccess) fprintf(stderr, "kernel_launch: launch failed: %s\n", hipGetErrorName(le));
}
```

```cpp
#include <hip/hip_runtime.h>
#include <cstdio>
#include <cstdint>
#include <cmath>

#ifndef MK_MULTI
#define MK_MULTI 0
#endif

#define LAS __attribute__((address_space(3)))
#define GAS __attribute__((address_space(1)))
typedef unsigned short bf16_t;
typedef short bf16x8 __attribute__((ext_vector_type(8)));
typedef short s16x4 __attribute__((ext_vector_type(4)));
typedef float f32x4 __attribute__((ext_vector_type(4)));
typedef float f32x2 __attribute__((ext_vector_type(2)));
typedef float f32x16 __attribute__((ext_vector_type(16)));
typedef unsigned u32x4 __attribute__((ext_vector_type(4)));
typedef unsigned u32x2 __attribute__((ext_vector_type(2)));

constexpr int D = 2048, NB = 4, SEQ = 2048, CL = 256, ML = NB * SEQ, MC = NB * CL, MT = ML + MC, FF = 8192, NH = 16, NMOD = 6, MODROW = NMOD * D;
constexpr int NWAVES = 8, NTHR = 512;
constexpr float NORM_EPS = 1e-6f, SUBLN_EPS = 1e-5f;
constexpr float QSCALE = 0.125f * 1.4426950408889634f;

constexpr size_t MiB = 1u << 20;
constexpr size_t WS_CTL = 0, CTL_BYTES = 1 * MiB;
constexpr size_t WS_MOD = 1 * MiB;
constexpr size_t WS_ROPE = 2 * MiB;
constexpr size_t WS_T1 = 3 * MiB;
constexpr size_t WS_A2C = 4 * MiB;
constexpr size_t WS_A2 = 5 * MiB;
constexpr size_t WS_WQKV = 22 * MiB;
constexpr size_t WS_WO = 70 * MiB;
constexpr size_t WS_WF = 86 * MiB;
constexpr size_t WS_WPOOL = 94 * MiB;
constexpr size_t WS_W1 = 96 * MiB;
constexpr size_t WS_W2 = 224 * MiB;
constexpr size_t WS_X = 352 * MiB;
constexpr size_t WS_Y = 424 * MiB;
constexpr size_t WS_U = 496 * MiB;
constexpr size_t WS_Q = 532 * MiB, WS_K = 568 * MiB, WS_V = 604 * MiB, WS_O = 640 * MiB;
constexpr size_t WS_H = 676 * MiB;
constexpr size_t WS_YT = 820 * MiB;
constexpr size_t WS_YTC = 884 * MiB;
constexpr size_t WS_YC = 892 * MiB;
constexpr size_t WS_END = 956 * MiB;
constexpr int NSPLIT = 8;

constexpr int RING_BYTES = 131072, LDSCTL_OFF = 139264  , MISC_OFF = LDSCTL_OFF + 320, LDS_BYTES = 147456;

__device__ __forceinline__ unsigned cvt_pk_bf16(float lo, float hi) { unsigned r; asm volatile("v_cvt_pk_bf16_f32 %0, %1, %2" : "=v"(r) : "v"(lo), "v"(hi)); return r; }
__device__ __forceinline__ float bf2f(unsigned short b) { return __uint_as_float(((unsigned)b) << 16); }
__device__ __forceinline__ float wave_sum(float v) {
#pragma unroll
    for (int o = 1; o < 64; o <<= 1) v += __shfl_xor(v, o);
    return v;
}

#define XB_TMO      128
#define XB_XCNT(j)  (256  + 64 * (j))
#define XB_XSUB(j)  (1280 + 64 * (j))
#define XB_XGEN(j)  (2304 + 64 * (j))
#define XB_TOP      3328
#define XB_TOPGEN   3392
#define XCD_BAR_WORDS 3456
#define XB_SPIN_CAP (1u << 18)
constexpr int CW_BAR = 4096;

__device__ __forceinline__ unsigned xb_ld(unsigned* p)              { return __hip_atomic_load(p, __ATOMIC_RELAXED, __HIP_MEMORY_SCOPE_AGENT); }
__device__ __forceinline__ unsigned xb_add(unsigned* p, unsigned v) { return __hip_atomic_fetch_add(p, v, __ATOMIC_RELAXED, __HIP_MEMORY_SCOPE_AGENT); }
__device__ __forceinline__ unsigned xb_xcc_id() { return (unsigned)__builtin_amdgcn_s_getreg((3 << 11) | 20) & 0xFu; }
#define XB_SPIN(cond, bar) do { unsigned _sp = 0; while (cond) { __builtin_amdgcn_s_sleep(1); \
    if ((++_sp & 255u) == 0u) { if (xb_ld(&(bar)[XB_TMO])) break; if (_sp > XB_SPIN_CAP) { atomicAdd(&(bar)[XB_TMO], 1u); break; } } } } while (0)

struct XcdBarrier { unsigned* bar; unsigned x; volatile LAS unsigned* st; };

__device__ __forceinline__ XcdBarrier xcd_barrier_post(unsigned* bar, volatile LAS unsigned* st) {
    XcdBarrier b; b.bar = bar; b.x = xb_xcc_id(); b.st = st;
    if (threadIdx.x == 0) (void)xb_add(&bar[XB_XCNT(b.x)], 1u);
    return b;
}
__device__ __forceinline__ void xcd_barrier_complete(unsigned* bar, unsigned x, unsigned& nloc, unsigned& nx) {
    const unsigned G = gridDim.x * gridDim.y * gridDim.z;
    unsigned sum, cnt, mine, sp = 0u;
    for (;;) {
        sum = 0u; cnt = 0u; mine = 0u;
#pragma unroll
        for (unsigned j = 0; j < 16; ++j) { const unsigned c = xb_ld(&bar[XB_XCNT(j)]); sum += c; cnt += (c > 0u) ? 1u : 0u; mine = (j == x) ? c : mine; }
        if (sum == G) break;
        __builtin_amdgcn_s_sleep(1);
        if ((++sp & 255u) == 0u) { if (xb_ld(&bar[XB_TMO])) break; if (sp > XB_SPIN_CAP) { atomicAdd(&bar[XB_TMO], 1u); break; } }
    }
    nloc = mine > 0u ? mine : 1u; nx = cnt > 0u ? cnt : 1u;
}
__device__ __forceinline__ void xcd_barrier(const XcdBarrier& b) {
    asm volatile("s_waitcnt vmcnt(0)" ::: "memory");
    __syncthreads();
    if (threadIdx.x == 0) {
        unsigned* bar = b.bar;
        __builtin_amdgcn_s_waitcnt(0);
        unsigned nloc = b.st[0], nx = b.st[1];
        if (nloc == 0u) { xcd_barrier_complete(bar, b.x, nloc, nx); b.st[0] = nloc; b.st[1] = nx; }
        const unsigned old = xb_add(&bar[XB_XSUB(b.x)], 1u);
        const unsigned gen = old / nloc;
        if (old + 1u == (gen + 1u) * nloc) {
            __builtin_amdgcn_fence(__ATOMIC_RELEASE, "agent");
            asm volatile("s_waitcnt vmcnt(0)" ::: "memory");
            const unsigned og = xb_add(&bar[XB_TOP], 1u);
            const unsigned tg = og / nx;
            if (og + 1u == (tg + 1u) * nx) xb_add(&bar[XB_TOPGEN], 1u);
            else XB_SPIN(xb_ld(&bar[XB_TOPGEN]) == tg, bar);
            __builtin_amdgcn_fence(__ATOMIC_ACQUIRE, "agent");
            xb_add(&bar[XB_XGEN(b.x)], 1u);
            asm volatile("s_waitcnt vmcnt(0)" ::: "memory");
        } else {
            XB_SPIN(xb_ld(&bar[XB_XGEN(b.x)]) == gen, bar);
            __builtin_amdgcn_fence(__ATOMIC_ACQUIRE, "agent");
            asm volatile("s_waitcnt vmcnt(0)" ::: "memory");
        }
    }
    __syncthreads();
}

namespace pg8 {
constexpr int BM = 256, BK = 64, HALF = 128, HTB = HALF * BK * 2, STAGE_BYTES = 8 * HTB, NXCD = 8, WGM = 8;
__device__ __forceinline__ int lds_byte(int r, int c) { const int st = (r >> 4) * 2 + (c >> 5), rr = r & 15, cc = c & 31, ob = rr * 64 + cc * 2; return st * 1024 + (ob ^ (((ob >> 9) & 1) << 5)); }
__device__ __forceinline__ void stage_rc(int b, int& R, int& C) { const int st = b / 1024, sb = b % 1024, swz = sb ^ (((sb >> 9) & 1) << 5); R = (st >> 1) * 16 + swz / 64; C = (st & 1) * 32 + (swz % 64) / 2; }
__device__ __forceinline__ int perm32(int rho) { const int n = rho >> 4, i = rho & 15; return 8 * (i >> 2) + 4 * n + (i & 3); }

struct Unit { const char* A; const char* B; int g, pm, pn; };

struct Sched {
    const char* A; const char* B; unsigned lda, ldb; int nt;
    int nM, nN, ngroups; long long a_g, b_g;
    int G, c;
    __device__ __forceinline__ bool next(int i, Unit& u) const {
        const int per = nM * nN, nwg = per * ngroups;
        const long L = (long)i * G + c; if (L >= nwg) return false;
        int wgid = (int)L; { const int q = nwg / NXCD, r = nwg % NXCD, xcd = wgid % NXCD, off = wgid / NXCD; wgid = (xcd < r ? xcd * (q + 1) : r * (q + 1) + (xcd - r) * q) + off; }
        const int g = wgid / per, w = wgid % per;
        const int nig = WGM * nN, gid = w / nig, fm = gid * WGM, gsz = (nM - fm) < WGM ? (nM - fm) : WGM;
        u.g = g; u.pm = fm + ((w % nig) % gsz); u.pn = (w % nig) / gsz;
        u.A = A + (long long)g * a_g + (size_t)u.pm * BM * lda; u.B = B + (long long)g * b_g + (size_t)u.pn * BM * ldb;
        return true;
    }
};

template <class Epi>
__device__ __forceinline__ void gemm_phase(LAS unsigned char* lds, const Sched& S, const Epi& E) {
    const int tid = threadIdx.x, wid = __builtin_amdgcn_readfirstlane(tid >> 6), lane = tid & 63, wr = wid >> 2, wc = wid & 3, fr = lane & 15, fq = lane >> 4;
    const int nt = S.nt;
    unsigned voffA[2], voffB[2];
#pragma unroll
    for (int i = 0; i < 2; ++i) { int R, C; stage_rc(tid * 16 + i * 8192, R, C); const int Rb = (R & ~31) + perm32(R & 31);
        voffA[i] = (unsigned)R * S.lda + (unsigned)C * 2u; voffB[i] = (unsigned)Rb * S.ldb + (unsigned)C * 2u; }
    const size_t kstep = (size_t)(BK * 2);
    const size_t hA = (size_t)HALF * S.lda, hB = (size_t)HALF * S.ldb;
    const unsigned ldsw = (unsigned)wid * 1024u;
    const int aoff = lds_byte(wr * 64 + fr, fq * 8), boff = lds_byte(wc * 32 + fr, fq * 8);
#define PG8_SA(b, h) (((b) * 2 + (h)) * HTB)
#define PG8_SB(b, h) ((4 + (b) * 2 + (h)) * HTB)
#define PG8_STAGE(bufoff, gbase, voff) do { _Pragma("unroll") for (int _i = 0; _i < 2; ++_i) \
        __builtin_amdgcn_global_load_lds((const unsigned*)((const char*)(gbase) + (voff)[_i]), (LAS unsigned*)(lds + (bufoff) + ldsw + _i * 8192), 16, 0, 0); } while (0)
#define PG8_LDA(dst, b, h) do { _Pragma("unroll") for (int m = 0; m < 4; ++m) _Pragma("unroll") for (int k = 0; k < 2; ++k) dst[m][k] = *(const LAS bf16x8*)(lds + PG8_SA(b, h) + aoff + m * 2048 + k * 1024); } while (0)
#define PG8_LDB(dst, b, h) do { _Pragma("unroll") for (int n = 0; n < 2; ++n) _Pragma("unroll") for (int k = 0; k < 2; ++k) dst[n][k] = *(const LAS bf16x8*)(lds + PG8_SB(b, h) + boff + n * 2048 + k * 1024); } while (0)
#define PG8_MMA(ai, bj, At, Bt) do { __builtin_amdgcn_s_setprio(1); _Pragma("unroll") for (int m = 0; m < 4; ++m) _Pragma("unroll") for (int n = 0; n < 2; ++n) _Pragma("unroll") for (int k = 0; k < 2; ++k) \
        acc[ai][bj][m][n] = __builtin_amdgcn_mfma_f32_16x16x32_bf16(Bt[n][k], At[m][k], acc[ai][bj][m][n], 0, 0, 0); __builtin_amdgcn_s_setprio(0); } while (0)
#define PG8_WAIT_V(n) asm volatile("s_waitcnt vmcnt(" #n ")" ::: "memory")
#define PG8_WAIT_L(n) asm volatile("s_waitcnt lgkmcnt(" #n ")" ::: "memory")
#define PG8_BAR __builtin_amdgcn_s_barrier()
#define PG8_SCHED __builtin_amdgcn_sched_barrier(0)
    Unit cur, nxt; int ui = 0;
    if (!S.next(0, cur)) return;
    f32x4 acc[2][2][4][2];
#pragma unroll
    for (int a = 0; a < 2; ++a)
#pragma unroll
        for (int b = 0; b < 2; ++b)
#pragma unroll
            for (int m = 0; m < 4; ++m)
#pragma unroll
                for (int n = 0; n < 2; ++n) acc[a][b][m][n] = (f32x4){0.f, 0.f, 0.f, 0.f};
    bf16x8 At[4][2], B0[2][2], B1[2][2];
    const char* cA = cur.A; const char* cB = cur.B;
    PG8_STAGE(PG8_SB(0, 0), cB, voffB); PG8_STAGE(PG8_SB(0, 1), cB + hB, voffB); PG8_STAGE(PG8_SA(0, 0), cA, voffA); PG8_STAGE(PG8_SA(0, 1), cA + hA, voffA);
    if (wr == 1) PG8_BAR;
    PG8_WAIT_V(2); PG8_BAR;
    PG8_STAGE(PG8_SB(1, 0), cB + kstep, voffB); PG8_STAGE(PG8_SA(1, 0), cA + kstep, voffA); PG8_STAGE(PG8_SB(1, 1), cB + hB + kstep, voffB);
    PG8_WAIT_V(6); PG8_BAR;
    for (;;) {
        const bool has_next = S.next(ui + 1, nxt);
        const char* nA = has_next ? nxt.A : cA; const char* nB = has_next ? nxt.B : cB;
        for (int t = 0; t < nt; t += 2) {
            const bool last = (t == nt - 2);
            const char* a1 = cA + (size_t)(t + 1) * kstep;
            const char* a2 = last ? nA : cA + (size_t)(t + 2) * kstep; const char* b2 = last ? nB : cB + (size_t)(t + 2) * kstep;
            const char* a3 = a2 + kstep; const char* b3 = b2 + kstep;
            PG8_LDB(B0, 0, 0); PG8_LDB(B1, 0, 1); PG8_SCHED; PG8_LDA(At, 0, 0); PG8_STAGE(PG8_SA(1, 1), a1 + hA, voffA);
            PG8_WAIT_V(8); PG8_WAIT_L(0); PG8_BAR; PG8_MMA(0, 0, At, B0); PG8_MMA(0, 1, At, B1); PG8_BAR; PG8_SCHED;
            PG8_LDA(At, 0, 1); PG8_STAGE(PG8_SB(0, 0), b2, voffB); PG8_STAGE(PG8_SB(0, 1), b2 + hB, voffB); PG8_STAGE(PG8_SA(0, 0), a2, voffA);
            PG8_WAIT_V(8); PG8_WAIT_L(0); PG8_BAR; PG8_MMA(1, 0, At, B0); PG8_MMA(1, 1, At, B1); PG8_BAR; PG8_SCHED;
            PG8_LDB(B0, 1, 0); PG8_LDB(B1, 1, 1); PG8_SCHED; PG8_LDA(At, 1, 0); PG8_STAGE(PG8_SA(0, 1), a2 + hA, voffA);
            PG8_WAIT_V(8); PG8_WAIT_L(0); PG8_BAR; PG8_MMA(0, 0, At, B0); PG8_MMA(0, 1, At, B1); PG8_BAR; PG8_SCHED;
            PG8_LDA(At, 1, 1); PG8_STAGE(PG8_SB(1, 0), b3, voffB); PG8_STAGE(PG8_SB(1, 1), b3 + hB, voffB); PG8_STAGE(PG8_SA(1, 0), a3, voffA);
            PG8_WAIT_V(8); PG8_WAIT_L(0); PG8_BAR; PG8_MMA(1, 0, At, B0); PG8_MMA(1, 1, At, B1); PG8_BAR; PG8_SCHED;
        }
        if (wr == 0) PG8_BAR;
        E(acc, cur, wr, wc, fr, fq);
        if (!has_next) break;
#pragma unroll
        for (int a = 0; a < 2; ++a)
#pragma unroll
            for (int b = 0; b < 2; ++b)
#pragma unroll
                for (int m = 0; m < 4; ++m)
#pragma unroll
                    for (int n = 0; n < 2; ++n) acc[a][b][m][n] = (f32x4){0.f, 0.f, 0.f, 0.f};
        cur = nxt; cA = nA; cB = nB; ++ui;
        if (wr == 1) PG8_BAR;
    }
    PG8_WAIT_V(0);
    PG8_BAR;
#undef PG8_SA
#undef PG8_SB
#undef PG8_STAGE
#undef PG8_LDA
#undef PG8_LDB
#undef PG8_MMA
#undef PG8_WAIT_V
#undef PG8_WAIT_L
#undef PG8_BAR
#undef PG8_SCHED
}

struct EpiF32 {
    float* C; unsigned ldc; const float* colscale; int c_g; size_t slab_g;
    __device__ __forceinline__ void operator()(const f32x4 (&acc)[2][2][4][2], const Unit& u, int wr, int wc, int fr, int fq) const {
        const int row0 = u.pm * BM + wr * 64 + fr, col0 = u.g * c_g + u.pn * BM + wc * 32 + 8 * fq;
        f32x4 sv[2][2];
#pragma unroll
        for (int bj = 0; bj < 2; ++bj)
#pragma unroll
            for (int n = 0; n < 2; ++n) sv[bj][n] = colscale ? *(const f32x4*)(colscale + col0 + bj * HALF + 4 * n) : (f32x4){1.f, 1.f, 1.f, 1.f};
#pragma unroll
        for (int ai = 0; ai < 2; ++ai)
#pragma unroll
            for (int m = 0; m < 4; ++m) { float* rowp = C + (size_t)u.g * slab_g + (size_t)(row0 + ai * HALF + m * 16) * ldc + col0;
#pragma unroll
                for (int bj = 0; bj < 2; ++bj) { *(f32x4*)(rowp + bj * HALF) = acc[ai][bj][m][0] * sv[bj][0]; *(f32x4*)(rowp + bj * HALF + 4) = acc[ai][bj][m][1] * sv[bj][1]; } }
    }
};
template <int ACT> struct EpiBf16 {
    bf16_t* C; unsigned ldc; int row_g;
    __device__ __forceinline__ void operator()(const f32x4 (&acc)[2][2][4][2], const Unit& u, int wr, int wc, int fr, int fq) const {
        const int row0 = u.g * row_g + u.pm * BM + wr * 64 + fr, col0 = u.pn * BM + wc * 32 + 8 * fq;
#pragma unroll
        for (int ai = 0; ai < 2; ++ai)
#pragma unroll
            for (int m = 0; m < 4; ++m) { bf16_t* rowp = C + (size_t)(row0 + ai * HALF + m * 16) * ldc + col0;
#pragma unroll
                for (int bj = 0; bj < 2; ++bj) { f32x4 v0 = acc[ai][bj][m][0], v1 = acc[ai][bj][m][1];
                    if (ACT == 1) {
#pragma unroll
                        for (int e = 0; e < 4; ++e) { const float a = fmaxf(v0[e], 0.f), b = fmaxf(v1[e], 0.f); v0[e] = a * a; v1[e] = b * b; } }
                    u32x4 w; w.x = cvt_pk_bf16(v0[0], v0[1]); w.y = cvt_pk_bf16(v0[2], v0[3]); w.z = cvt_pk_bf16(v1[0], v1[1]); w.w = cvt_pk_bf16(v1[2], v1[3]);
                    *(u32x4*)(rowp + bj * HALF) = w; } }
    }
};
struct EpiFA {
    bf16_t* YT; bf16_t* YTC;
    __device__ __forceinline__ void operator()(const f32x4 (&acc)[2][2][4][2], const Unit& u, int wr, int wc, int fr, int fq) const {
        const int cs = u.pm >> 1, k2b = (u.pm & 1) * 256;
        bf16_t* base; size_t pitch;
        if (u.pn < 32) { const int b = u.pn >> 3; base = YT + (size_t)(u.g * 512 + k2b) * 16384 + b * 4096 + cs * 2048 + (u.pn & 7) * 256; pitch = 16384; }
        else { const int b = u.pn - 32; base = YTC + (size_t)(u.g * 512 + k2b) * 2048 + b * 512 + cs * 256; pitch = 2048; }
        const int row0 = wr * 64 + fr, col0 = wc * 32 + 8 * fq;
#pragma unroll
        for (int ai = 0; ai < 2; ++ai)
#pragma unroll
            for (int m = 0; m < 4; ++m) { bf16_t* rowp = base + (size_t)(row0 + ai * HALF + m * 16) * pitch + col0;
#pragma unroll
                for (int bj = 0; bj < 2; ++bj) { const f32x4 v0 = acc[ai][bj][m][0], v1 = acc[ai][bj][m][1];
                    u32x4 w; w.x = cvt_pk_bf16(v0[0], v0[1]); w.y = cvt_pk_bf16(v0[2], v0[3]); w.z = cvt_pk_bf16(v1[0], v1[1]); w.w = cvt_pk_bf16(v1[2], v1[3]);
                    *(u32x4*)(rowp + bj * HALF) = w; } }
    }
};
struct EpiQKV {
    bf16_t* Q; const float* rope;
    __device__ __forceinline__ void operator()(const f32x4 (&acc)[2][2][4][2], const Unit& u, int wr, int wc, int fr, int fq) const {
        const int part = u.pn >> 3;
        bf16_t* dst = Q + (size_t)part * ((WS_K - WS_Q) / 2);
        const int row0 = u.pm * BM + wr * 64 + fr, colp = (u.pn & 7) * BM + wc * 32 + 8 * fq;
        const bool dorope = (part < 2) && (u.pm < 32);
        const float sc = part == 0 ? QSCALE : 1.f;
#pragma unroll
        for (int ai = 0; ai < 2; ++ai)
#pragma unroll
            for (int m = 0; m < 4; ++m) { const int row = row0 + ai * HALF + m * 16; bf16_t* rowp = dst + (size_t)row * D + colp;
                const int t = row & 2047, prow = t >> 6, pcol = t & 63;
#pragma unroll
                for (int bj = 0; bj < 2; ++bj) { f32x4 v0 = acc[ai][bj][m][0], v1 = acc[ai][bj][m][1];
                    if (dorope) { const int c = colp + bj * HALF, j0 = (c & 63) >> 1, ax = j0 >> 4, f0 = j0 & 15;
                        const float* cs = rope + ((ax ? pcol : prow) * 16 + f0) * 2;
                        const f32x4 cs0 = *(const f32x4*)cs, cs1 = *(const f32x4*)(cs + 4);
                        f32x4 r0, r1;
                        r0[0] = v0[0] * cs0[0] - v0[1] * cs0[1]; r0[1] = v0[0] * cs0[1] + v0[1] * cs0[0];
                        r0[2] = v0[2] * cs0[2] - v0[3] * cs0[3]; r0[3] = v0[2] * cs0[3] + v0[3] * cs0[2];
                        r1[0] = v1[0] * cs1[0] - v1[1] * cs1[1]; r1[1] = v1[0] * cs1[1] + v1[1] * cs1[0];
                        r1[2] = v1[2] * cs1[2] - v1[3] * cs1[3]; r1[3] = v1[2] * cs1[3] + v1[3] * cs1[2];
                        v0 = r0; v1 = r1; }
                    v0 = v0 * sc; v1 = v1 * sc;
                    u32x4 w; w.x = cvt_pk_bf16(v0[0], v0[1]); w.y = cvt_pk_bf16(v0[2], v0[3]); w.z = cvt_pk_bf16(v1[0], v1[1]); w.w = cvt_pk_bf16(v1[2], v1[3]);
                    *(u32x4*)(rowp + bj * HALF) = w; } }
    }
};
}


namespace att {
__device__ __forceinline__ unsigned off_a(unsigned row, unsigned ch) { return 2048u * (row >> 3) + 512u * (ch >> 2) + 64u * (row & 7) + 16u * ((ch & 3) ^ ((row >> 2) & 3)); }
constexpr int KBUF = 0, VBUF = 32768, QOFF = 65536, WSF_OFF = LDSCTL_OFF + 1024;
constexpr float THR = 6.0f;
struct Args { const bf16_t* Q; const bf16_t* K; const bf16_t* V; bf16_t* O; const float* gsub; float lam, post; };
__device__ __forceinline__ s16x4 vtr(const LAS unsigned char* p) { return __builtin_bit_cast(s16x4, __builtin_amdgcn_ds_read_tr16_b64_v4i16((LAS s16x4*)p)); }
__device__ __forceinline__ float half_max(float v) { auto rr = __builtin_amdgcn_permlane32_swap(__float_as_uint(v), __float_as_uint(v), false, false); return fmaxf(__uint_as_float(rr[0]), __uint_as_float(rr[1])); }
__device__ __forceinline__ float half_sum(float v) { auto rr = __builtin_amdgcn_permlane32_swap(__float_as_uint(v), __float_as_uint(v), false, false); return __uint_as_float(rr[0]) + __uint_as_float(rr[1]); }

__device__ __forceinline__ void unit(LAS unsigned char* lds, const Args& P, int b, int h, int q0, int nlat) {
    const int tid = threadIdx.x, lane = tid & 63, r32 = lane & 31, hi = lane >> 5; const int wid = __builtin_amdgcn_readfirstlane(tid >> 6);
    const int nt = nlat + 4;
    LAS unsigned char* Qs = lds + QOFF + wid * 8192;
    LAS float* wsf = (LAS float*)(lds + WSF_OFF + wid * 256);
    {   const bf16_t* qrow = P.Q + (size_t)(q0 + wid * 32 + r32) * D + h * 128 + hi * 8;
#pragma unroll
        for (int c = 0; c < 2; ++c)
#pragma unroll
            for (int d0 = 0; d0 < 4; ++d0) { const u32x4 v = *(const u32x4*)(qrow + c * 64 + d0 * 16); *(LAS u32x4*)(Qs + ((c * 4 + d0) * 2 + hi) * 512 + r32 * 16) = v; } }
    unsigned goff[2];
#pragma unroll
    for (int i = 0; i < 2; ++i) { const unsigned p = 2 * wid + i, rg = p >> 1, chq = (p & 1) * 2 + (lane >> 5), r7 = (lane >> 2) & 7, x = lane & 3, rsw = (r7 >> 2) | ((rg & 1) << 1);
        goff[i] = ((8 * rg + r7) * D + h * 128 + (4 * chq + (x ^ rsw)) * 8) * 2; }
#define ATT_GROW(t) ((t) < nlat ? b * SEQ + 64 * (t) : ML + b * CL + 64 * ((t) - nlat))
#define ATT_DMA(t, buf) do { const size_t g_ = (size_t)ATT_GROW(t) * D * 2; _Pragma("unroll") for (int i_ = 0; i_ < 2; ++i_) { \
        __builtin_amdgcn_global_load_lds((const unsigned*)((const char*)P.K + g_ + goff[i_]), (LAS unsigned*)(lds + KBUF + (buf) * 16384 + (2 * wid + i_) * 1024), 16, 0, 0); \
        __builtin_amdgcn_global_load_lds((const unsigned*)((const char*)P.V + g_ + goff[i_]), (LAS unsigned*)(lds + VBUF + (buf) * 16384 + (2 * wid + i_) * 1024), 16, 0, 0); } } while (0)
    ATT_DMA(0, 0);
    unsigned kb[2];
#pragma unroll
    for (int e = 0; e < 2; ++e) kb[e] = 2048u * (r32 >> 3) + 64u * (r32 & 7) + 16u * ((unsigned)(2 * e + hi) ^ ((r32 >> 2) & 3));
    const unsigned blk = (lane >> 4) & 1, q_ = (lane & 15) >> 2, p_ = lane & 3;
    unsigned vb[2];
#pragma unroll
    for (int t = 0; t < 2; ++t) vb[t] = 2048u * t + 64u * (4 * hi + q_) + 16u * ((2 * blk + (p_ >> 1)) ^ ((2 * t + hi) & 3)) + 8u * (p_ & 1);
    float m0 = -1e30f, m1 = -1e30f, l0 = 0.f, l1 = 0.f;
    f32x16 o[2][4];
#pragma unroll
    for (int c = 0; c < 2; ++c)
#pragma unroll
        for (int d = 0; d < 4; ++d) o[c][d] = f32x16{};
    asm volatile("s_waitcnt vmcnt(0)" ::: "memory");
    __syncthreads();
#pragma unroll 1
    for (int t = 0; t < nt; ++t) {
        const int buf = t & 1;
        if (t + 1 < nt) ATT_DMA(t + 1, buf ^ 1);
        const LAS unsigned char* Kb = lds + KBUF + buf * 16384; const LAS unsigned char* Vb = lds + VBUF + buf * 16384;
#pragma unroll
        for (int c = 0; c < 2; ++c) {
            u32x4 pw[4];
            f32x16 s0 = f32x16{}, s1 = f32x16{};
            __builtin_amdgcn_sched_barrier(0);
#pragma unroll
            for (int dp = 0; dp < 2; ++dp) {
                bf16x8 qf[2], k0[2], k1[2];
#pragma unroll
                for (int e = 0; e < 2; ++e) { const int d0 = 2 * dp + e;
                    qf[e] = *(const LAS bf16x8*)(Qs + ((c * 4 + d0) * 2 + hi) * 512 + r32 * 16);
                    k0[e] = *(const LAS bf16x8*)(Kb + kb[e] + 512 * (2 * c + dp));
                    k1[e] = *(const LAS bf16x8*)(Kb + kb[e] + 512 * (2 * c + dp) + 8192); }
#pragma unroll
                for (int e = 0; e < 2; ++e) { s0 = __builtin_amdgcn_mfma_f32_32x32x16_bf16(k0[e], qf[e], s0, 0, 0, 0); s1 = __builtin_amdgcn_mfma_f32_32x32x16_bf16(k1[e], qf[e], s1, 0, 0, 0); }
                __builtin_amdgcn_sched_barrier(0);
            }
            float mx = fmaxf(s0[0], s1[0]);
#pragma unroll
            for (int r = 1; r < 16; ++r) mx = fmaxf(mx, fmaxf(s0[r], s1[r]));
            mx = half_max(mx);
            float mc = c == 0 ? m0 : m1, lc = c == 0 ? l0 : l1;
            if (__any(mx - mc > THR)) {
                const float mn = fmaxf(mc, mx), al = __builtin_amdgcn_exp2f(mc - mn);
                mc = mn; lc *= al;
                if (hi == 0) wsf[r32] = al;
#pragma unroll
                for (int g4 = 0; g4 < 4; ++g4) { const f32x4 a4 = *(const LAS f32x4*)(wsf + 8 * g4 + 4 * hi);
#pragma unroll
                    for (int d = 0; d < 4; ++d) { o[c][d][4 * g4 + 0] *= a4[0]; o[c][d][4 * g4 + 1] *= a4[1]; o[c][d][4 * g4 + 2] *= a4[2]; o[c][d][4 * g4 + 3] *= a4[3]; } }
            }
            float sum = 0.f;
#pragma unroll
            for (int r = 0; r < 16; ++r) { s0[r] = __builtin_amdgcn_exp2f(s0[r] - mc); s1[r] = __builtin_amdgcn_exp2f(s1[r] - mc); sum += s0[r] + s1[r]; }
            lc += sum;
            if (c == 0) { m0 = mc; l0 = lc; } else { m1 = mc; l1 = lc; }
#pragma unroll
            for (int ks = 0; ks < 2; ++ks) {
                pw[ks]     = (u32x4){cvt_pk_bf16(s0[8 * ks + 0], s0[8 * ks + 1]), cvt_pk_bf16(s0[8 * ks + 2], s0[8 * ks + 3]), cvt_pk_bf16(s0[8 * ks + 4], s0[8 * ks + 5]), cvt_pk_bf16(s0[8 * ks + 6], s0[8 * ks + 7])};
                pw[2 + ks] = (u32x4){cvt_pk_bf16(s1[8 * ks + 0], s1[8 * ks + 1]), cvt_pk_bf16(s1[8 * ks + 2], s1[8 * ks + 3]), cvt_pk_bf16(s1[8 * ks + 4], s1[8 * ks + 5]), cvt_pk_bf16(s1[8 * ks + 6], s1[8 * ks + 7])};
            }
            __builtin_amdgcn_sched_barrier(0);
#pragma unroll
            for (int ks = 0; ks < 4; ++ks) {
                s16x4 lo[4], hh[4];
#pragma unroll
                for (int d = 0; d < 4; ++d) { lo[d] = vtr(Vb + vb[0] + 4096 * ks + 512 * d); hh[d] = vtr(Vb + vb[1] + 4096 * ks + 512 * d); }
#pragma unroll
                for (int d = 0; d < 4; ++d) {
                    const bf16x8 vf = (bf16x8){lo[d][0], lo[d][1], lo[d][2], lo[d][3], hh[d][0], hh[d][1], hh[d][2], hh[d][3]};
                    o[c][d] = __builtin_amdgcn_mfma_f32_32x32x16_bf16(__builtin_bit_cast(bf16x8, pw[ks]), vf, o[c][d], 0, 0, 0);
                }
                __builtin_amdgcn_sched_barrier(0);
            }
        }
        asm volatile("s_waitcnt vmcnt(0)" ::: "memory");
        __syncthreads();
    }
#undef ATT_GROW
#undef ATT_DMA
    l0 = half_sum(l0); l1 = half_sum(l1);
    if (hi == 0) { wsf[r32] = 1.0f / l0; wsf[32 + r32] = P.lam / l1; }
    float ss[16];
#pragma unroll
    for (int r = 0; r < 16; ++r) ss[r] = 0.f;
#pragma unroll
    for (int g4 = 0; g4 < 4; ++g4) { const f32x4 a4 = *(const LAS f32x4*)(wsf + 8 * g4 + 4 * hi), b4 = *(const LAS f32x4*)(wsf + 32 + 8 * g4 + 4 * hi);
#pragma unroll
        for (int d = 0; d < 4; ++d)
#pragma unroll
            for (int e = 0; e < 4; ++e) { const float v = o[0][d][4 * g4 + e] * a4[e] - o[1][d][4 * g4 + e] * b4[e]; o[0][d][4 * g4 + e] = v; ss[4 * g4 + e] += v * v; } }
#pragma unroll
    for (int r = 0; r < 16; ++r) {
        float v = ss[r];
#pragma unroll
        for (int s = 1; s < 32; s <<= 1) v += __shfl_xor(v, s);
        ss[r] = (1.0f / sqrtf(v * (1.0f / 128.0f) + SUBLN_EPS)) * P.post;
    }
    bf16_t* Ow = P.O + (size_t)(q0 + wid * 32) * D + h * 128 + r32;
#pragma unroll
    for (int d = 0; d < 4; ++d) { const float gs = P.gsub[32 * d + r32];
#pragma unroll
        for (int r = 0; r < 16; ++r) { const int row = (r & 3) + 8 * (r >> 2) + 4 * hi; const float v = o[0][d][r] * ss[r] * gs;
            Ow[(size_t)row * D + 32 * d] = (bf16_t)(cvt_pk_bf16(v, 0.f) & 0xffffu); } }
    __syncthreads();
}
}

struct ThinArgs {
    const float* xin_lat; const float* xin_ctx;
    const float* y;
    float* xout_lat; float* xout_ctx;
    const float* g_post; const float* gate;
    bf16_t* uout;
    const float* g_pre; const float* sc; const float* sh;
    const float* yc; int nslab;
    int nrows;
};
__device__ __forceinline__ void thin_phase(const ThinArgs& T, int gw, int ngw, int lane) {
    for (int row = gw; row < T.nrows; row += ngw) {
        const int mrow = row < ML ? (row >> 11) : 4;
        const float* xr = row < ML ? T.xin_lat + (size_t)row * D : T.xin_ctx + (size_t)(row - ML) * D;
        f32x4 xv[8];
#pragma unroll
        for (int j = 0; j < 8; ++j) xv[j] = *(const f32x4*)(xr + 256 * j + 4 * lane);
        if (T.y) {
            f32x4 yv[8]; float s = 0.f;
            if (row >= ML && T.nslab > 0) {
                const float* yr = T.yc + (size_t)(row - ML) * D;
#pragma unroll
                for (int j = 0; j < 8; ++j) yv[j] = *(const f32x4*)(yr + 256 * j + 4 * lane);
                for (int sl = 1; sl < T.nslab; ++sl) { yr += (size_t)MC * D;
#pragma unroll
                    for (int j = 0; j < 8; ++j) yv[j] = yv[j] + *(const f32x4*)(yr + 256 * j + 4 * lane); }
            } else {
                const float* yr = T.y + (size_t)row * D;
#pragma unroll
                for (int j = 0; j < 8; ++j) yv[j] = *(const f32x4*)(yr + 256 * j + 4 * lane);
            }
#pragma unroll
            for (int j = 0; j < 8; ++j) s += (yv[j][0] * yv[j][0] + yv[j][1] * yv[j][1]) + (yv[j][2] * yv[j][2] + yv[j][3] * yv[j][3]);
            const float rs = 1.0f / sqrtf(wave_sum(s) * (1.0f / D) + NORM_EPS);
            const float* gt = T.gate + (size_t)mrow * MODROW;
#pragma unroll
            for (int j = 0; j < 8; ++j) { const f32x4 g = *(const f32x4*)(T.g_post + 256 * j + 4 * lane), a = *(const f32x4*)(gt + 256 * j + 4 * lane); xv[j] = xv[j] + a * ((yv[j] * rs) * g); }
            float* xo = row < ML ? (T.xout_lat ? T.xout_lat + (size_t)row * D : nullptr) : (T.xout_ctx ? T.xout_ctx + (size_t)(row - ML) * D : nullptr);
            if (xo) {
#pragma unroll
                for (int j = 0; j < 8; ++j) *(f32x4*)(xo + 256 * j + 4 * lane) = xv[j]; }
        }
        if (T.uout) {
            float s = 0.f;
#pragma unroll
            for (int j = 0; j < 8; ++j) s += (xv[j][0] * xv[j][0] + xv[j][1] * xv[j][1]) + (xv[j][2] * xv[j][2] + xv[j][3] * xv[j][3]);
            const float rs = 1.0f / sqrtf(wave_sum(s) * (1.0f / D) + NORM_EPS);
            const float* scp = T.sc + (size_t)mrow * MODROW; const float* shp = T.sh + (size_t)mrow * MODROW;
            bf16_t* uo = T.uout + (size_t)row * D;
#pragma unroll
            for (int j = 0; j < 8; ++j) { const f32x4 g = *(const f32x4*)(T.g_pre + 256 * j + 4 * lane), a = *(const f32x4*)(scp + 256 * j + 4 * lane), c = *(const f32x4*)(shp + 256 * j + 4 * lane);
                const f32x4 u = ((xv[j] * rs) * g) * (a + 1.0f) + c;
                u32x2 w; w.x = cvt_pk_bf16(u[0], u[1]); w.y = cvt_pk_bf16(u[2], u[3]); *(u32x2*)(uo + 256 * j + 4 * lane) = w; }
        }
    }
}
__device__ __forceinline__ void pool_phase(const bf16_t* U, bf16_t* Dm, int nrows, int gw, int ngw, int lane) {
    for (int row = gw; row < nrows; row += ngw) {
        int base, t, Ls;
        if (row < ML) { base = row & ~2047; t = row & 2047; Ls = SEQ; } else { const int i = row - ML; base = ML + (i & ~255); t = i & 255; Ls = CL; }
#pragma unroll
        for (int j = 0; j < 8; ++j) {
            const int w = 2 << (j >> 1); int lo = t - (w >> 1), hi = lo + w; lo = lo < 0 ? 0 : lo; hi = hi > Ls ? Ls : hi;
            const bf16_t* p = U + (size_t)base * D + 256 * j + 4 * lane;
            f32x4 s = {0.f, 0.f, 0.f, 0.f};
            for (int tt = lo; tt < hi; ++tt) { const u32x2 v = *(const u32x2*)(p + (size_t)tt * D);
                s[0] += __uint_as_float(v.x << 16); s[1] += __uint_as_float(v.x & 0xffff0000u); s[2] += __uint_as_float(v.y << 16); s[3] += __uint_as_float(v.y & 0xffff0000u); }
            const u32x2 cv = *(const u32x2*)(p + (size_t)t * D);
            const float inv = 1.0f / (float)(hi - lo);
            f32x4 d; d[0] = s[0] * inv - __uint_as_float(cv.x << 16); d[1] = s[1] * inv - __uint_as_float(cv.x & 0xffff0000u); d[2] = s[2] * inv - __uint_as_float(cv.y << 16); d[3] = s[3] * inv - __uint_as_float(cv.y & 0xffff0000u);
            u32x2 o; o.x = cvt_pk_bf16(d[0], d[1]); o.y = cvt_pk_bf16(d[2], d[3]);
            *(u32x2*)(Dm + (size_t)row * D + 256 * j + 4 * lane) = o;
        }
    }
}

__device__ __forceinline__ void transpose_item(const float* W, int K, int N, bf16_t* WT, int row_off, LAS float* scr, int item, int lane, bool qkperm) {
    const int nblk = N / 64, kb = item / nblk, nb = item % nblk, k0 = 64 * kb, n0 = 64 * nb;
    const int kq = lane >> 4, n4 = lane & 15;
    f32x4 v[16];
#pragma unroll
    for (int i = 0; i < 16; ++i) v[i] = *(const f32x4*)(W + (size_t)(k0 + 4 * i + kq) * N + n0 + 4 * n4);
#pragma unroll
    for (int i = 0; i < 16; ++i) { LAS float* s = scr + (4 * i + kq) * 65 + 4 * n4; s[0] = v[i][0]; s[1] = v[i][1]; s[2] = v[i][2]; s[3] = v[i][3]; }
    asm volatile("s_waitcnt lgkmcnt(0)" ::: "memory");
    const int c = lane & 7;
#pragma unroll
    for (int j = 0; j < 8; ++j) { const int n = (lane >> 3) + 8 * j; int sc = n;
        if (qkperm) { const int jj = n >> 1, which = n & 1, ax = jj >> 4, f = jj & 15; sc = ax * 32 + which * 16 + f; }
        const LAS float* s = scr + (8 * c) * 65 + sc;
        u32x4 o; o.x = cvt_pk_bf16(s[0 * 65], s[1 * 65]); o.y = cvt_pk_bf16(s[2 * 65], s[3 * 65]); o.z = cvt_pk_bf16(s[4 * 65], s[5 * 65]); o.w = cvt_pk_bf16(s[6 * 65], s[7 * 65]);
        *(u32x4*)(WT + (size_t)(row_off + n0 + n) * K + k0 + 8 * c) = o; }
    asm volatile("s_waitcnt lgkmcnt(0)" ::: "memory");
}

struct Params {
    const float* in[22];
    float* out; unsigned char* ws;
    float lam_init0, lam_init3;
    int ph_lo, ph_hi;
};

__device__ __forceinline__ void prologue(const Params& P, LAS unsigned char* lds, int tid, int wave, int lane, int vcu, int G) {
    unsigned char* ws = P.ws;
    const float* c_in = P.in[1]; const float* cctx = P.in[3]; const float* w_mod = P.in[4]; const float* b_mod = P.in[5];
    LAS float* sil = (LAS float*)lds;
    LAS float* red = (LAS float*)(lds + 65536);
    for (int i = tid; i < 5 * D; i += NTHR) { const int r = i / D, k = i % D; const float x = r < 4 ? c_in[r * D + k] : cctx[k]; sil[k * 8 + r] = x / (1.0f + __expf(-x)); }
    __syncthreads();
    float* mod = (float*)(ws + WS_MOD);
    for (int item = blockIdx.x; item < 4 * 192; item += G) {
        const int l = item / 192, col = (item % 192) * 64 + lane;
        const float* W = w_mod + (size_t)l * D * MODROW + col;
        float a0 = 0.f, a1 = 0.f, a2 = 0.f, a3 = 0.f, a4 = 0.f;
        const int k0 = wave * 256;
        for (int kk = 0; kk < 256; kk += 16) {
            float w[16];
#pragma unroll
            for (int j = 0; j < 16; ++j) w[j] = W[(size_t)(k0 + kk + j) * MODROW];
#pragma unroll
            for (int j = 0; j < 16; ++j) { const f32x4 s4 = *(const LAS f32x4*)(sil + (k0 + kk + j) * 8); const float s5 = sil[(k0 + kk + j) * 8 + 4];
                a0 += s4[0] * w[j]; a1 += s4[1] * w[j]; a2 += s4[2] * w[j]; a3 += s4[3] * w[j]; a4 += s5 * w[j]; }
        }
        red[(wave * 5 + 0) * 64 + lane] = a0; red[(wave * 5 + 1) * 64 + lane] = a1; red[(wave * 5 + 2) * 64 + lane] = a2; red[(wave * 5 + 3) * 64 + lane] = a3; red[(wave * 5 + 4) * 64 + lane] = a4;
        __syncthreads();
        if (wave < 5) { float s = b_mod[l * MODROW + col];
#pragma unroll
            for (int w8 = 0; w8 < 8; ++w8) s += red[(w8 * 5 + wave) * 64 + lane];
            mod[((size_t)l * 5 + wave) * MODROW + col] = s; }
        __syncthreads();
    }
    LAS float* scr = (LAS float*)(lds + wave * 16640);
    const int gw = vcu * NWAVES + wave, NGW = G * NWAVES;
    bf16_t* Wqkv = (bf16_t*)(ws + WS_WQKV); bf16_t* Wo = (bf16_t*)(ws + WS_WO); bf16_t* Wf = (bf16_t*)(ws + WS_WF); bf16_t* Wp = (bf16_t*)(ws + WS_WPOOL);
    bf16_t* W1 = (bf16_t*)(ws + WS_W1); bf16_t* W2 = (bf16_t*)(ws + WS_W2);
    constexpr int I_QKV = (D / 64) * (3 * D / 64), I_O = (D / 64) * (D / 64), I_P = 8 * 8, I_1 = (D / 64) * (FF / 64), I_2 = (FF / 64) * (D / 64);
    constexpr int NITEMS = 2 * I_QKV + 2 * I_O + I_O + 4 * I_P + 4 * I_1 + 4 * I_2;
    for (int it = gw; it < NITEMS; it += NGW) {
        int r = it;
        if (r < 2 * I_QKV) { const int ia = r / I_QKV; r %= I_QKV; const int nb = r % (3 * D / 64);
            transpose_item(P.in[10] + (size_t)ia * D * 3 * D, D, 3 * D, Wqkv + (size_t)ia * 3 * D * D, 0, scr, r, lane, nb < 2 * D / 64); continue; } r -= 2 * I_QKV;
        if (r < 2 * I_O) { const int ia = r / I_O; r %= I_O; transpose_item(P.in[11] + (size_t)ia * D * D, D, D, Wo + (size_t)ia * D * D, 0, scr, r, lane, false); continue; } r -= 2 * I_O;
        if (r < I_O) { transpose_item(P.in[17], D, D, Wf, 0, scr, r, lane, false); continue; } r -= I_O;
        if (r < 4 * I_P) { const int g = r / I_P; r %= I_P; transpose_item(P.in[18] + (size_t)g * 512 * 512, 512, 512, Wp + (size_t)g * 512 * 512, 0, scr, r, lane, false); continue; } r -= 4 * I_P;
        if (r < 4 * I_1) { const int l = r / I_1; r %= I_1; transpose_item(P.in[20] + (size_t)l * D * FF, D, FF, W1 + (size_t)l * FF * D, 0, scr, r, lane, false); continue; } r -= 4 * I_1;
        { const int l = r / I_2; r %= I_2; transpose_item(P.in[21] + (size_t)l * FF * D, FF, D, W2 + (size_t)l * D * FF, 0, scr, r, lane, false); }
    }
    {   bf16_t* T1 = (bf16_t*)(ws + WS_T1); bf16_t* A2 = (bf16_t*)(ws + WS_A2); bf16_t* A2C = (bf16_t*)(ws + WS_A2C);
        constexpr int C_T1 = 1024 * 512 / 8, C_A2 = 2048 * 4096 / 8, C_A2C = 256 * 512 / 8;
        const int gt = gw * 64 + lane, NGT = NGW * 64;
        for (int ch = gt; ch < C_T1 + C_A2 + C_A2C; ch += NGT) {
            int r = ch; bf16_t* dst; int row, col0, N, ncol; float scale; bool negsin;
            if (r < C_T1) { row = r / 64; col0 = (r % 64) * 8; dst = T1 + (size_t)row * 512 + col0; N = 512; scale = 0.04419417382415922f; negsin = false;
                const int cs = row >> 9, k2 = row & 511; float vals[8];
#pragma unroll
                for (int e = 0; e < 8; ++e) { const int idx = (k2 * (col0 + e)) & 511; const float a = (float)idx * (1.0f / 256.0f); vals[e] = (cs ? sinpif(a) : cospif(a)) * scale; }
                u32x4 o; o.x = cvt_pk_bf16(vals[0], vals[1]); o.y = cvt_pk_bf16(vals[2], vals[3]); o.z = cvt_pk_bf16(vals[4], vals[5]); o.w = cvt_pk_bf16(vals[6], vals[7]); *(u32x4*)dst = o; continue; }
            r -= C_T1;
            if (r < C_A2) { row = r / 512; col0 = (r % 512) * 8; dst = A2 + (size_t)row * 4096 + col0; N = 2048; scale = 0.022097086912079608f; }
            else { r -= C_A2; row = r / 64; col0 = (r % 64) * 8; dst = A2C + (size_t)row * 512 + col0; N = 256; scale = 0.0625f; }
            (void)ncol; (void)negsin;
            { const int cs = col0 / N, n0 = col0 % N; float vals[8];
#pragma unroll
              for (int e = 0; e < 8; ++e) { const int idx = (row * (n0 + e)) & (N - 1); const float a = (float)idx * (2.0f / (float)N); vals[e] = (cs ? -sinpif(a) : cospif(a)) * scale; }
              u32x4 o; o.x = cvt_pk_bf16(vals[0], vals[1]); o.y = cvt_pk_bf16(vals[2], vals[3]); o.z = cvt_pk_bf16(vals[4], vals[5]); o.w = cvt_pk_bf16(vals[6], vals[7]); *(u32x4*)dst = o; }
        }
        float* rope = (float*)(ws + WS_ROPE);
        for (int i = gt; i < 64 * 16; i += NGT) { const int pos = i >> 4, f = i & 15; const float inv = 1.0f / powf(10000.0f, (float)f * (1.0f / 16.0f)); const float ang = (float)pos * inv;
            rope[2 * i] = cosf(ang); rope[2 * i + 1] = sinf(ang); }
    }
}

struct Ctx { LAS unsigned char* lds; int tid, lane, wave, G, bx, vcu, gw, NGW; };
#if MK_MULTI
#define GRID_BAR() do { } while (0)
#else
#define GRID_BAR() xcd_barrier(bar)
#endif
#define PH_BEGIN(k) if ((k) >= P.ph_lo && (k) < P.ph_hi) {
#define PH_END(k)   if ((k) + 1 < P.ph_hi) GRID_BAR(); }
#define WSP(T, off) ((T*)(P.ws + (off)))

template <int L, int PH0>
__device__ __forceinline__ void layer(const Params& P, const Ctx& C, const XcdBarrier& bar) {
    constexpr int kind = L % 3; constexpr bool lastl = (L == 3);
    constexpr int Mact = lastl ? ML : MT;
    constexpr int NMIX = (kind == 2) ? 1 : 2;
    LAS unsigned char* lds = C.lds;
    if constexpr (kind == 0) {
        constexpr int ia = L / 3;
        PH_BEGIN(PH0)
        { pg8::Sched S{}; S.A = (const char*)WSP(bf16_t, WS_U); S.B = (const char*)(WSP(bf16_t, WS_WQKV) + (size_t)ia * 3 * D * D); S.lda = D * 2; S.ldb = D * 2; S.nt = D / 64;
          S.nM = MT / 256; S.nN = 3 * D / 256; S.ngroups = 1; S.a_g = 0; S.b_g = 0; S.G = C.G; S.c = C.bx;
          pg8::EpiQKV E{WSP(bf16_t, WS_Q), WSP(const float, WS_ROPE)};
          pg8::gemm_phase(lds, S, E); }
        PH_END(PH0)
        PH_BEGIN(PH0 + 1)
        { const float* lq1 = P.in[12] + ia * 64; const float* lk1 = P.in[13] + ia * 64; const float* lq2 = P.in[14] + ia * 64; const float* lk2 = P.in[15] + ia * 64;
          const float d1 = wave_sum(lq1[C.lane] * lk1[C.lane]), d2 = wave_sum(lq2[C.lane] * lk2[C.lane]);
          const float li = (L == 0) ? P.lam_init0 : P.lam_init3;
          att::Args A{WSP(bf16_t, WS_Q), WSP(bf16_t, WS_K), WSP(bf16_t, WS_V), WSP(bf16_t, WS_O), P.in[16] + ia * 128, expf(d1) - expf(d2) + li, 1.0f - li};
          constexpr int nlat_units = NB * NH * (SEQ / 256);
          const int per = (nlat_units + C.G - 1) / C.G;
          for (int i = 0; i < per; ++i) { const int uu = C.vcu * per + i; if (uu < nlat_units) { const int bh = uu >> 3, qb = uu & 7; att::unit(lds, A, bh >> 4, bh & 15, (bh >> 4) * SEQ + qb * 256, SEQ / 64); } }
          if constexpr (!lastl) { for (int uc = C.bx; uc < NB * NH; uc += C.G) { const int b = uc >> 4, h = uc & 15; att::unit(lds, A, b, h, ML + b * CL, 0); } } }
        PH_END(PH0 + 1)
    } else if constexpr (kind == 1) {
        PH_BEGIN(PH0)
        { pg8::Sched S{}; S.A = (const char*)WSP(bf16_t, WS_T1); S.B = (const char*)WSP(bf16_t, WS_U); S.lda = 512 * 2; S.ldb = D * 2; S.nt = 8; S.nM = 4; S.nN = Mact / 256; S.ngroups = 4; S.a_g = 0; S.b_g = 512 * 2; S.G = C.G; S.c = C.bx;
          pg8::EpiFA E{WSP(bf16_t, WS_YT), WSP(bf16_t, WS_YTC)};
          pg8::gemm_phase(lds, S, E); }
        PH_END(PH0)
        PH_BEGIN(PH0 + 1)
        { pg8::Sched S{}; S.A = (const char*)WSP(bf16_t, WS_A2); S.B = (const char*)WSP(bf16_t, WS_YT); S.lda = 4096 * 2; S.ldb = 16384 * 2; S.nt = 64; S.nM = 8; S.nN = 8; S.ngroups = 4; S.a_g = 0; S.b_g = 4096 * 2; S.G = C.G; S.c = C.bx;
          pg8::EpiBf16<0> E{WSP(bf16_t, WS_O), (unsigned)D, SEQ};
          pg8::gemm_phase(lds, S, E);
          if constexpr (!lastl) { pg8::Sched S2{}; S2.A = (const char*)WSP(bf16_t, WS_A2C); S2.B = (const char*)WSP(bf16_t, WS_YTC); S2.lda = 512 * 2; S2.ldb = 2048 * 2; S2.nt = 8; S2.nM = 1; S2.nN = 8; S2.ngroups = 4; S2.a_g = 0; S2.b_g = 512 * 2; S2.G = C.G; S2.c = C.bx;
            pg8::EpiBf16<0> E2{WSP(bf16_t, WS_O) + (size_t)ML * D, (unsigned)D, CL};
            pg8::gemm_phase(lds, S2, E2); } }
        PH_END(PH0 + 1)
    } else {
        PH_BEGIN(PH0) pool_phase(WSP(bf16_t, WS_U), WSP(bf16_t, WS_O), Mact, C.gw, C.NGW, C.lane); PH_END(PH0)
    }
    PH_BEGIN(PH0 + NMIX)
    { pg8::Sched S{}; S.A = (const char*)WSP(bf16_t, WS_O); S.lda = D * 2; S.G = C.G; S.c = C.bx;
      if constexpr (kind == 2) { S.B = (const char*)WSP(bf16_t, WS_WPOOL); S.ldb = 512 * 2; S.nt = 8; S.nM = Mact / 256; S.nN = 2; S.ngroups = 4; S.a_g = 512 * 2; S.b_g = 512 * 512 * 2;
          pg8::EpiF32 E{WSP(float, WS_Y), (unsigned)D, P.in[19], 512, 0}; pg8::gemm_phase(lds, S, E); }
      else { S.B = kind == 0 ? (const char*)(WSP(bf16_t, WS_WO) + (size_t)(L / 3) * D * D) : (const char*)WSP(bf16_t, WS_WF); S.ldb = D * 2; S.nt = D / 64; S.nM = ML / 256; S.nN = D / 256; S.ngroups = 1;
          pg8::EpiF32 E{WSP(float, WS_Y), (unsigned)D, nullptr, 0, 0}; pg8::gemm_phase(lds, S, E);
          if constexpr (!lastl) { pg8::Sched S2 = S; S2.A = (const char*)(WSP(bf16_t, WS_O) + (size_t)ML * D); S2.nt = D / 64 / NSPLIT; S2.nM = MC / 256; S2.ngroups = NSPLIT; S2.a_g = (D / NSPLIT) * 2; S2.b_g = (D / NSPLIT) * 2;
              pg8::EpiF32 E2{WSP(float, WS_YC), (unsigned)D, nullptr, 0, (size_t)MC * D}; pg8::gemm_phase(lds, S2, E2); } } }
    PH_END(PH0 + NMIX)
    PH_BEGIN(PH0 + NMIX + 1)
    { const float* modl = WSP(const float, WS_MOD) + (size_t)L * 5 * MODROW; float* X = WSP(float, WS_X);
      ThinArgs T{}; T.xin_lat = L == 0 ? P.in[0] : X; T.xin_ctx = L == 0 ? P.in[2] : X + (size_t)ML * D; T.y = WSP(const float, WS_Y); T.xout_lat = X; T.xout_ctx = X + (size_t)ML * D;
      T.yc = WSP(const float, WS_YC); T.nslab = (kind == 2 || lastl) ? 0 : NSPLIT;
      T.g_post = P.in[7] + L * D; T.gate = modl + 2 * D; T.uout = WSP(bf16_t, WS_U); T.g_pre = P.in[8] + L * D; T.sc = modl + 4 * D; T.sh = modl + 3 * D; T.nrows = Mact;
      thin_phase(T, C.gw, C.NGW, C.lane); }
    PH_END(PH0 + NMIX + 1)
    PH_BEGIN(PH0 + NMIX + 2)
    { pg8::Sched S{}; S.A = (const char*)WSP(bf16_t, WS_U); S.B = (const char*)(WSP(bf16_t, WS_W1) + (size_t)L * FF * D); S.lda = D * 2; S.ldb = D * 2; S.nt = D / 64; S.nM = Mact / 256; S.nN = FF / 256; S.ngroups = 1; S.G = C.G; S.c = C.bx;
      pg8::EpiBf16<1> E{WSP(bf16_t, WS_H), (unsigned)FF, 0}; pg8::gemm_phase(lds, S, E); }
    PH_END(PH0 + NMIX + 2)
    PH_BEGIN(PH0 + NMIX + 3)
    { pg8::Sched S{}; S.A = (const char*)WSP(bf16_t, WS_H); S.B = (const char*)(WSP(bf16_t, WS_W2) + (size_t)L * D * FF); S.lda = FF * 2; S.ldb = FF * 2; S.nt = FF / 64; S.nM = ML / 256; S.nN = D / 256; S.ngroups = 1; S.G = C.G; S.c = C.bx;
      pg8::EpiF32 E{WSP(float, WS_Y), (unsigned)D, nullptr, 0, 0}; pg8::gemm_phase(lds, S, E);
      if constexpr (!lastl) { pg8::Sched S2 = S; S2.A = (const char*)(WSP(bf16_t, WS_H) + (size_t)ML * FF); S2.nt = FF / 64 / NSPLIT; S2.nM = MC / 256; S2.ngroups = NSPLIT; S2.a_g = (FF / NSPLIT) * 2; S2.b_g = (FF / NSPLIT) * 2;
          pg8::EpiF32 E2{WSP(float, WS_YC), (unsigned)D, nullptr, 0, (size_t)MC * D}; pg8::gemm_phase(lds, S2, E2); } }
    PH_END(PH0 + NMIX + 3)
    PH_BEGIN(PH0 + NMIX + 4)
    { const float* modl = WSP(const float, WS_MOD) + (size_t)L * 5 * MODROW; float* X = WSP(float, WS_X);
      ThinArgs T{}; T.xin_lat = X; T.xin_ctx = X + (size_t)ML * D; T.y = WSP(const float, WS_Y); T.xout_lat = lastl ? P.out : X; T.xout_ctx = X + (size_t)ML * D;
      T.yc = WSP(const float, WS_YC); T.nslab = lastl ? 0 : NSPLIT;
      T.g_post = P.in[9] + L * D; T.gate = modl + 5 * D; T.nrows = Mact;
      if constexpr (!lastl) { const float* modn = modl + 5 * MODROW; T.uout = WSP(bf16_t, WS_U); T.g_pre = P.in[6] + (L + 1) * D; T.sc = modn + 1 * D; T.sh = modn + 0 * D; }
      thin_phase(T, C.gw, C.NGW, C.lane); }
    PH_END(PH0 + NMIX + 4)
}
constexpr int PH_L0 = 2, PH_L1 = PH_L0 + 7, PH_L2 = PH_L1 + 7, PH_L3 = PH_L2 + 6, N_PHASES = PH_L3 + 7;

__global__ void __launch_bounds__(NTHR, 2) fwd_kernel(Params P) {
    extern __shared__ __attribute__((aligned(16))) unsigned char lds_raw[];
    Ctx C; C.lds = (LAS unsigned char*)lds_raw;
    C.tid = threadIdx.x; C.lane = C.tid & 63; C.wave = __builtin_amdgcn_readfirstlane(C.tid >> 6);
    C.G = gridDim.x; C.bx = blockIdx.x; C.vcu = (C.G % 8 == 0) ? (C.bx % 8) * (C.G / 8) + C.bx / 8 : C.bx;
    C.gw = C.vcu * NWAVES + C.wave; C.NGW = C.G * NWAVES;
    for (int u = C.tid; u < (LDS_BYTES - LDSCTL_OFF) / 4; u += NTHR) ((LAS unsigned*)(C.lds + LDSCTL_OFF))[u] = 0u;
    __syncthreads();
#if MK_MULTI
    XcdBarrier bar{};
#else
    XcdBarrier bar = xcd_barrier_post(WSP(unsigned, WS_CTL) + CW_BAR, (volatile LAS unsigned*)(C.lds + MISC_OFF) + 8);
#endif
    PH_BEGIN(0) prologue(P, C.lds, C.tid, C.wave, C.lane, C.vcu, C.G); PH_END(0)
    PH_BEGIN(1)
    { const float* mod = WSP(const float, WS_MOD);
      ThinArgs T{}; T.xin_lat = P.in[0]; T.xin_ctx = P.in[2]; T.y = nullptr; T.uout = WSP(bf16_t, WS_U); T.g_pre = P.in[6]; T.sc = mod + 1 * D; T.sh = mod + 0 * D; T.nrows = MT;
      thin_phase(T, C.gw, C.NGW, C.lane); }
    PH_END(1)
    layer<0, PH_L0>(P, C, bar);
    layer<1, PH_L1>(P, C, bar);
    layer<2, PH_L2>(P, C, bar);
    layer<3, PH_L3>(P, C, bar);
}
#undef PH_BEGIN
#undef PH_END
#undef GRID_BAR

extern "C" void kernel_launch(void* const* d_in, const int* in_sizes, int n_in, void* d_out, int out_size, void* d_ws, size_t ws_size, hipStream_t stream) {
    static int grid = 0;
    if (grid == 0) {
        if (n_in != 22 || out_size != ML * D || ws_size < WS_END) { fprintf(stderr, "kernel_launch: unexpected problem: n_in %d out %d ws %zu (need %zu)\n", n_in, out_size, ws_size, (size_t)WS_END); grid = -1; return; }
        int dev = 0, cus = 0, per_cu = 0;
        if (hipGetDevice(&dev) != hipSuccess || hipDeviceGetAttribute(&cus, hipDeviceAttributeMultiprocessorCount, dev) != hipSuccess) { grid = -1; return; }
        if (hipFuncSetAttribute((const void*)fwd_kernel, hipFuncAttributeMaxDynamicSharedMemorySize, LDS_BYTES) != hipSuccess) { fprintf(stderr, "kernel_launch: hipFuncSetAttribute failed\n"); grid = -1; return; }
        if (hipOccupancyMaxActiveBlocksPerMultiprocessor(&per_cu, (const void*)fwd_kernel, NTHR, LDS_BYTES) != hipSuccess || per_cu < 1) fprintf(stderr, "kernel_launch: occupancy query says %d\n", per_cu);
        (void)hipGetLastError();
        grid = cus;
    }
    if (grid < 0) return;
    (void)in_sizes;
    hipMemsetAsync((char*)d_ws + WS_CTL, 0, CTL_BYTES, stream);
    Params p{};
    for (int i = 0; i < 22; ++i) p.in[i] = (const float*)d_in[i];
    p.out = (float*)d_out; p.ws = (unsigned char*)d_ws;
    p.lam_init0 = (float)(0.8 - 0.6 * exp(-0.3 * 0.0)); p.lam_init3 = (float)(0.8 - 0.6 * exp(-0.3 * 3.0));
#if MK_MULTI
    for (int ph = 0; ph < N_PHASES; ++ph) { p.ph_lo = ph; p.ph_hi = ph + 1; hipLaunchKernelGGL(fwd_kernel, dim3(grid), dim3(NTHR), LDS_BYTES, stream, p); }
#else
    p.ph_lo = 0; p.ph_hi = N_PHASES;
    hipLaunchKernelGGL(fwd_kernel, dim3(grid), dim3(NTHR), LDS_BYTES, stream, p);
#endif
    const hipError_t le = hipPeekAtLastError();
    if (le != hipSuccess) fprintf(stderr, "kernel_launch: launch failed: %s\n", hipGetErrorName(le));
}
```

```cpp
#include <hip/hip_runtime.h>
#include <cstdio>
#include <cstdint>
#include <cmath>

#define PROBE_QKV 1
#define PROBE_FA 1
#define PROBE_FB 1
#define PROBE_MIX 1
#define PROBE_W1 1
#define PROBE_W2 1
#define PROBE_ATT 1
#define PROBE_PRO 1
#define PROBE_THIN 1
#ifndef MK_MULTI
#define MK_MULTI 0
#endif

#define LAS __attribute__((address_space(3)))
#define GAS __attribute__((address_space(1)))
typedef unsigned short bf16_t;
typedef short bf16x8 __attribute__((ext_vector_type(8)));
typedef short s16x4 __attribute__((ext_vector_type(4)));
typedef float f32x4 __attribute__((ext_vector_type(4)));
typedef float f32x2 __attribute__((ext_vector_type(2)));
typedef float f32x16 __attribute__((ext_vector_type(16)));
typedef unsigned u32x4 __attribute__((ext_vector_type(4)));
typedef unsigned u32x2 __attribute__((ext_vector_type(2)));

constexpr int D = 2048, NB = 4, SEQ = 2048, CL = 256, ML = NB * SEQ, MC = NB * CL, MT = ML + MC, FF = 8192, NH = 16, NMOD = 6, MODROW = NMOD * D;
constexpr int NWAVES = 8, NTHR = 512;
constexpr float NORM_EPS = 1e-6f, SUBLN_EPS = 1e-5f;
constexpr float QSCALE = 0.125f * 1.4426950408889634f;

constexpr size_t MiB = 1u << 20;
constexpr size_t WS_CTL = 0, CTL_BYTES = 1 * MiB;
constexpr size_t WS_MOD = 1 * MiB;
constexpr size_t WS_ROPE = 2 * MiB;
constexpr size_t WS_T1 = 3 * MiB;
constexpr size_t WS_A2C = 4 * MiB;
constexpr size_t WS_A2 = 5 * MiB;
constexpr size_t WS_WQKV = 22 * MiB;
constexpr size_t WS_WO = 70 * MiB;
constexpr size_t WS_WF = 86 * MiB;
constexpr size_t WS_WPOOL = 94 * MiB;
constexpr size_t WS_W1 = 96 * MiB;
constexpr size_t WS_W2 = 224 * MiB;
constexpr size_t WS_X = 352 * MiB;
constexpr size_t WS_Y = 424 * MiB;
constexpr size_t WS_U = 496 * MiB;
constexpr size_t WS_Q = 532 * MiB, WS_K = 568 * MiB, WS_V = 604 * MiB, WS_O = 640 * MiB;
constexpr size_t WS_H = 676 * MiB;
constexpr size_t WS_YT = 820 * MiB;
constexpr size_t WS_YTC = 884 * MiB;
constexpr size_t WS_YC = 892 * MiB;
constexpr size_t WS_END = 956 * MiB;
constexpr int NSPLIT = 8;

constexpr int RING_BYTES = 131072, LDSCTL_OFF = 139264  , MISC_OFF = LDSCTL_OFF + 320, LDS_BYTES = 147456;

__device__ __forceinline__ unsigned cvt_pk_bf16(float lo, float hi) { unsigned r; asm volatile("v_cvt_pk_bf16_f32 %0, %1, %2" : "=v"(r) : "v"(lo), "v"(hi)); return r; }
__device__ __forceinline__ float bf2f(unsigned short b) { return __uint_as_float(((unsigned)b) << 16); }
__device__ __forceinline__ float wave_sum(float v) {
#pragma unroll
    for (int o = 1; o < 64; o <<= 1) v += __shfl_xor(v, o);
    return v;
}

#define XB_TMO      128
#define XB_XCNT(j)  (256  + 64 * (j))
#define XB_XSUB(j)  (1280 + 64 * (j))
#define XB_XGEN(j)  (2304 + 64 * (j))
#define XB_TOP      3328
#define XB_TOPGEN   3392
#define XCD_BAR_WORDS 3456
#define XB_SPIN_CAP (1u << 18)
constexpr int CW_BAR = 4096;

__device__ __forceinline__ unsigned xb_ld(unsigned* p)              { return __hip_atomic_load(p, __ATOMIC_RELAXED, __HIP_MEMORY_SCOPE_AGENT); }
__device__ __forceinline__ unsigned xb_add(unsigned* p, unsigned v) { return __hip_atomic_fetch_add(p, v, __ATOMIC_RELAXED, __HIP_MEMORY_SCOPE_AGENT); }
__device__ __forceinline__ unsigned xb_xcc_id() { return (unsigned)__builtin_amdgcn_s_getreg((3 << 11) | 20) & 0xFu; }
#define XB_SPIN(cond, bar) do { unsigned _sp = 0; while (cond) { __builtin_amdgcn_s_sleep(1); \
    if ((++_sp & 255u) == 0u) { if (xb_ld(&(bar)[XB_TMO])) break; if (_sp > XB_SPIN_CAP) { atomicAdd(&(bar)[XB_TMO], 1u); break; } } } } while (0)

struct XcdBarrier { unsigned* bar; unsigned x; volatile LAS unsigned* st; };

__device__ __forceinline__ XcdBarrier xcd_barrier_post(unsigned* bar, volatile LAS unsigned* st) {
    XcdBarrier b; b.bar = bar; b.x = xb_xcc_id(); b.st = st;
    if (threadIdx.x == 0) (void)xb_add(&bar[XB_XCNT(b.x)], 1u);
    return b;
}
__device__ __forceinline__ void xcd_barrier_complete(unsigned* bar, unsigned x, unsigned& nloc, unsigned& nx) {
    const unsigned G = gridDim.x * gridDim.y * gridDim.z;
    unsigned sum, cnt, mine, sp = 0u;
    for (;;) {
        sum = 0u; cnt = 0u; mine = 0u;
#pragma unroll
        for (unsigned j = 0; j < 16; ++j) { const unsigned c = xb_ld(&bar[XB_XCNT(j)]); sum += c; cnt += (c > 0u) ? 1u : 0u; mine = (j == x) ? c : mine; }
        if (sum == G) break;
        __builtin_amdgcn_s_sleep(1);
        if ((++sp & 255u) == 0u) { if (xb_ld(&bar[XB_TMO])) break; if (sp > XB_SPIN_CAP) { atomicAdd(&bar[XB_TMO], 1u); break; } }
    }
    nloc = mine > 0u ? mine : 1u; nx = cnt > 0u ? cnt : 1u;
}
__device__ __forceinline__ void xcd_barrier(const XcdBarrier& b) {
    asm volatile("s_waitcnt vmcnt(0)" ::: "memory");
    __syncthreads();
    if (threadIdx.x == 0) {
        unsigned* bar = b.bar;
        __builtin_amdgcn_s_waitcnt(0);
        unsigned nloc = b.st[0], nx = b.st[1];
        if (nloc == 0u) { xcd_barrier_complete(bar, b.x, nloc, nx); b.st[0] = nloc; b.st[1] = nx; }
        const unsigned old = xb_add(&bar[XB_XSUB(b.x)], 1u);
        const unsigned gen = old / nloc;
        if (old + 1u == (gen + 1u) * nloc) {
            __builtin_amdgcn_fence(__ATOMIC_RELEASE, "agent");
            asm volatile("s_waitcnt vmcnt(0)" ::: "memory");
            const unsigned og = xb_add(&bar[XB_TOP], 1u);
            const unsigned tg = og / nx;
            if (og + 1u == (tg + 1u) * nx) xb_add(&bar[XB_TOPGEN], 1u);
            else XB_SPIN(xb_ld(&bar[XB_TOPGEN]) == tg, bar);
            __builtin_amdgcn_fence(__ATOMIC_ACQUIRE, "agent");
            xb_add(&bar[XB_XGEN(b.x)], 1u);
            asm volatile("s_waitcnt vmcnt(0)" ::: "memory");
        } else {
            XB_SPIN(xb_ld(&bar[XB_XGEN(b.x)]) == gen, bar);
            __builtin_amdgcn_fence(__ATOMIC_ACQUIRE, "agent");
            asm volatile("s_waitcnt vmcnt(0)" ::: "memory");
        }
    }
    __syncthreads();
}

namespace pg8 {
constexpr int BM = 256, BK = 64, HALF = 128, HTB = HALF * BK * 2, STAGE_BYTES = 8 * HTB, NXCD = 8, WGM = 8;
__device__ __forceinline__ int lds_byte(int r, int c) { const int st = (r >> 4) * 2 + (c >> 5), rr = r & 15, cc = c & 31, ob = rr * 64 + cc * 2; return st * 1024 + (ob ^ (((ob >> 9) & 1) << 5)); }
__device__ __forceinline__ void stage_rc(int b, int& R, int& C) { const int st = b / 1024, sb = b % 1024, swz = sb ^ (((sb >> 9) & 1) << 5); R = (st >> 1) * 16 + swz / 64; C = (st & 1) * 32 + (swz % 64) / 2; }
__device__ __forceinline__ int perm32(int rho) { const int n = rho >> 4, i = rho & 15; return 8 * (i >> 2) + 4 * n + (i & 3); }

struct Unit { const char* A; const char* B; int g, pm, pn; };

struct Sched {
    const char* A; const char* B; unsigned lda, ldb; int nt;
    int nM, nN, ngroups; long long a_g, b_g;
    int G, c;
    __device__ __forceinline__ bool next(int i, Unit& u) const {
        const int per = nM * nN, nwg = per * ngroups;
        const long L = (long)i * G + c; if (L >= nwg) return false;
        int wgid = (int)L; { const int q = nwg / NXCD, r = nwg % NXCD, xcd = wgid % NXCD, off = wgid / NXCD; wgid = (xcd < r ? xcd * (q + 1) : r * (q + 1) + (xcd - r) * q) + off; }
        const int g = wgid / per, w = wgid % per;
        const int nig = WGM * nN, gid = w / nig, fm = gid * WGM, gsz = (nM - fm) < WGM ? (nM - fm) : WGM;
        u.g = g; u.pm = fm + ((w % nig) % gsz); u.pn = (w % nig) / gsz;
        u.A = A + (long long)g * a_g + (size_t)u.pm * BM * lda; u.B = B + (long long)g * b_g + (size_t)u.pn * BM * ldb;
        return true;
    }
};

template <class Epi>
__device__ __forceinline__ void gemm_phase(LAS unsigned char* lds, const Sched& S, const Epi& E, int tid_in = -1) {
    const int tid = tid_in >= 0 ? tid_in : (int)threadIdx.x, wid = __builtin_amdgcn_readfirstlane(tid >> 6), lane = tid & 63, wr = wid >> 2, wc = wid & 3, fr = lane & 15, fq = lane >> 4;
    const int nt = S.nt;
    unsigned voffA[2], voffB[2];
#pragma unroll
    for (int i = 0; i < 2; ++i) { int R, C; stage_rc(tid * 16 + i * 8192, R, C); const int Rb = (R & ~31) + perm32(R & 31);
        voffA[i] = (unsigned)R * S.lda + (unsigned)C * 2u; voffB[i] = (unsigned)Rb * S.ldb + (unsigned)C * 2u; }
    const size_t kstep = (size_t)(BK * 2);
    const size_t hA = (size_t)HALF * S.lda, hB = (size_t)HALF * S.ldb;
    const unsigned ldsw = (unsigned)wid * 1024u;
    const int aoff = lds_byte(wr * 64 + fr, fq * 8), boff = lds_byte(wc * 32 + fr, fq * 8);
#define PG8_SA(b, h) (((b) * 2 + (h)) * HTB)
#define PG8_SB(b, h) ((4 + (b) * 2 + (h)) * HTB)
#define PG8_STAGE(bufoff, gbase, voff) do { _Pragma("unroll") for (int _i = 0; _i < 2; ++_i) \
        __builtin_amdgcn_global_load_lds((const unsigned*)((const char*)(gbase) + (voff)[_i]), (LAS unsigned*)(lds + (bufoff) + ldsw + _i * 8192), 16, 0, 0); } while (0)
#define PG8_LDA(dst, b, h) do { _Pragma("unroll") for (int m = 0; m < 4; ++m) _Pragma("unroll") for (int k = 0; k < 2; ++k) dst[m][k] = *(const LAS bf16x8*)(lds + PG8_SA(b, h) + aoff + m * 2048 + k * 1024); } while (0)
#define PG8_LDB(dst, b, h) do { _Pragma("unroll") for (int n = 0; n < 2; ++n) _Pragma("unroll") for (int k = 0; k < 2; ++k) dst[n][k] = *(const LAS bf16x8*)(lds + PG8_SB(b, h) + boff + n * 2048 + k * 1024); } while (0)
#define PG8_MMA(ai, bj, At, Bt) do { __builtin_amdgcn_s_setprio(1); _Pragma("unroll") for (int m = 0; m < 4; ++m) _Pragma("unroll") for (int n = 0; n < 2; ++n) _Pragma("unroll") for (int k = 0; k < 2; ++k) \
        acc[ai][bj][m][n] = __builtin_amdgcn_mfma_f32_16x16x32_bf16(Bt[n][k], At[m][k], acc[ai][bj][m][n], 0, 0, 0); __builtin_amdgcn_s_setprio(0); } while (0)
#define PG8_WAIT_V(n) asm volatile("s_waitcnt vmcnt(" #n ")" ::: "memory")
#define PG8_WAIT_L(n) asm volatile("s_waitcnt lgkmcnt(" #n ")" ::: "memory")
#define PG8_BAR __builtin_amdgcn_s_barrier()
#define PG8_SCHED __builtin_amdgcn_sched_barrier(0)
    Unit cur, nxt; int ui = 0;
    if (!S.next(0, cur)) return;
    f32x4 acc[2][2][4][2];
#pragma unroll
    for (int a = 0; a < 2; ++a)
#pragma unroll
        for (int b = 0; b < 2; ++b)
#pragma unroll
            for (int m = 0; m < 4; ++m)
#pragma unroll
                for (int n = 0; n < 2; ++n) acc[a][b][m][n] = (f32x4){0.f, 0.f, 0.f, 0.f};
    bf16x8 At[4][2], B0[2][2], B1[2][2];
    const char* cA = cur.A; const char* cB = cur.B;
    PG8_STAGE(PG8_SB(0, 0), cB, voffB); PG8_STAGE(PG8_SB(0, 1), cB + hB, voffB); PG8_STAGE(PG8_SA(0, 0), cA, voffA); PG8_STAGE(PG8_SA(0, 1), cA + hA, voffA);
    if (wr == 1) PG8_BAR;
    PG8_WAIT_V(2); PG8_BAR;
    PG8_STAGE(PG8_SB(1, 0), cB + kstep, voffB); PG8_STAGE(PG8_SA(1, 0), cA + kstep, voffA); PG8_STAGE(PG8_SB(1, 1), cB + hB + kstep, voffB);
    PG8_WAIT_V(6); PG8_BAR;
    for (;;) {
        const bool has_next = S.next(ui + 1, nxt);
        const char* nA = has_next ? nxt.A : cA; const char* nB = has_next ? nxt.B : cB;
        for (int t = 0; t < nt; t += 2) {
            const bool last = (t == nt - 2);
            const char* a1 = cA + (size_t)(t + 1) * kstep;
            const char* a2 = last ? nA : cA + (size_t)(t + 2) * kstep; const char* b2 = last ? nB : cB + (size_t)(t + 2) * kstep;
            const char* a3 = a2 + kstep; const char* b3 = b2 + kstep;
            PG8_LDB(B0, 0, 0); PG8_LDB(B1, 0, 1); PG8_SCHED; PG8_LDA(At, 0, 0); PG8_STAGE(PG8_SA(1, 1), a1 + hA, voffA);
            PG8_WAIT_V(8); PG8_WAIT_L(0); PG8_BAR; PG8_MMA(0, 0, At, B0); PG8_MMA(0, 1, At, B1); PG8_BAR; PG8_SCHED;
            PG8_LDA(At, 0, 1); PG8_STAGE(PG8_SB(0, 0), b2, voffB); PG8_STAGE(PG8_SB(0, 1), b2 + hB, voffB); PG8_STAGE(PG8_SA(0, 0), a2, voffA);
            PG8_WAIT_V(8); PG8_WAIT_L(0); PG8_BAR; PG8_MMA(1, 0, At, B0); PG8_MMA(1, 1, At, B1); PG8_BAR; PG8_SCHED;
            PG8_LDB(B0, 1, 0); PG8_LDB(B1, 1, 1); PG8_SCHED; PG8_LDA(At, 1, 0); PG8_STAGE(PG8_SA(0, 1), a2 + hA, voffA);
            PG8_WAIT_V(8); PG8_WAIT_L(0); PG8_BAR; PG8_MMA(0, 0, At, B0); PG8_MMA(0, 1, At, B1); PG8_BAR; PG8_SCHED;
            PG8_LDA(At, 1, 1); PG8_STAGE(PG8_SB(1, 0), b3, voffB); PG8_STAGE(PG8_SB(1, 1), b3 + hB, voffB); PG8_STAGE(PG8_SA(1, 0), a3, voffA);
            PG8_WAIT_V(8); PG8_WAIT_L(0); PG8_BAR; PG8_MMA(1, 0, At, B0); PG8_MMA(1, 1, At, B1); PG8_BAR; PG8_SCHED;
        }
        if (wr == 0) PG8_BAR;
        E(acc, cur, wr, wc, fr, fq);
        if (!has_next) break;
#pragma unroll
        for (int a = 0; a < 2; ++a)
#pragma unroll
            for (int b = 0; b < 2; ++b)
#pragma unroll
                for (int m = 0; m < 4; ++m)
#pragma unroll
                    for (int n = 0; n < 2; ++n) acc[a][b][m][n] = (f32x4){0.f, 0.f, 0.f, 0.f};
        cur = nxt; cA = nA; cB = nB; ++ui;
        if (wr == 1) PG8_BAR;
    }
    PG8_WAIT_V(0);
    PG8_BAR;
#undef PG8_SA
#undef PG8_SB
#undef PG8_STAGE
#undef PG8_LDA
#undef PG8_LDB
#undef PG8_MMA
#undef PG8_WAIT_V
#undef PG8_WAIT_L
#undef PG8_BAR
#undef PG8_SCHED
}

struct EpiF32 {
    float* C; unsigned ldc; const float* colscale; int c_g; size_t slab_g;
    __device__ __forceinline__ void operator()(const f32x4 (&acc)[2][2][4][2], const Unit& u, int wr, int wc, int fr, int fq) const {
        const int row0 = u.pm * BM + wr * 64 + fr, col0 = u.g * c_g + u.pn * BM + wc * 32 + 8 * fq;
        f32x4 sv[2][2];
#pragma unroll
        for (int bj = 0; bj < 2; ++bj)
#pragma unroll
            for (int n = 0; n < 2; ++n) sv[bj][n] = colscale ? *(const f32x4*)(colscale + col0 + bj * HALF + 4 * n) : (f32x4){1.f, 1.f, 1.f, 1.f};
#pragma unroll
        for (int ai = 0; ai < 2; ++ai)
#pragma unroll
            for (int m = 0; m < 4; ++m) { float* rowp = C + (size_t)u.g * slab_g + (size_t)(row0 + ai * HALF + m * 16) * ldc + col0;
#pragma unroll
                for (int bj = 0; bj < 2; ++bj) { *(f32x4*)(rowp + bj * HALF) = acc[ai][bj][m][0] * sv[bj][0]; *(f32x4*)(rowp + bj * HALF + 4) = acc[ai][bj][m][1] * sv[bj][1]; } }
    }
};
struct EpiY {
    bf16_t* C; unsigned ldc; const float* colscale; int c_g;
    __device__ __forceinline__ void operator()(const f32x4 (&acc)[2][2][4][2], const Unit& u, int wr, int wc, int fr, int fq) const {
        const int row0 = u.pm * BM + wr * 64 + fr, col0 = u.g * c_g + u.pn * BM + wc * 32 + 8 * fq;
        f32x4 sv[2][2];
#pragma unroll
        for (int bj = 0; bj < 2; ++bj)
#pragma unroll
            for (int n = 0; n < 2; ++n) sv[bj][n] = colscale ? *(const f32x4*)(colscale + col0 + bj * HALF + 4 * n) : (f32x4){1.f, 1.f, 1.f, 1.f};
#pragma unroll
        for (int ai = 0; ai < 2; ++ai)
#pragma unroll
            for (int m = 0; m < 4; ++m) { bf16_t* rowp = C + (size_t)(row0 + ai * HALF + m * 16) * ldc + col0;
#pragma unroll
                for (int bj = 0; bj < 2; ++bj) { const f32x4 v0 = acc[ai][bj][m][0] * sv[bj][0], v1 = acc[ai][bj][m][1] * sv[bj][1];
                    u32x4 w; w.x = cvt_pk_bf16(v0[0], v0[1]); w.y = cvt_pk_bf16(v0[2], v0[3]); w.z = cvt_pk_bf16(v1[0], v1[1]); w.w = cvt_pk_bf16(v1[2], v1[3]);
                    *(u32x4*)(rowp + bj * HALF) = w; } }
    }
};
template <int ACT> struct EpiBf16 {
    bf16_t* C; unsigned ldc; int row_g;
    __device__ __forceinline__ void operator()(const f32x4 (&acc)[2][2][4][2], const Unit& u, int wr, int wc, int fr, int fq) const {
        const int row0 = u.g * row_g + u.pm * BM + wr * 64 + fr, col0 = u.pn * BM + wc * 32 + 8 * fq;
#pragma unroll
        for (int ai = 0; ai < 2; ++ai)
#pragma unroll
            for (int m = 0; m < 4; ++m) { bf16_t* rowp = C + (size_t)(row0 + ai * HALF + m * 16) * ldc + col0;
#pragma unroll
                for (int bj = 0; bj < 2; ++bj) { f32x4 v0 = acc[ai][bj][m][0], v1 = acc[ai][bj][m][1];
                    if (ACT == 1) {
#pragma unroll
                        for (int e = 0; e < 4; ++e) { const float a = fmaxf(v0[e], 0.f), b = fmaxf(v1[e], 0.f); v0[e] = a * a; v1[e] = b * b; } }
                    u32x4 w; w.x = cvt_pk_bf16(v0[0], v0[1]); w.y = cvt_pk_bf16(v0[2], v0[3]); w.z = cvt_pk_bf16(v1[0], v1[1]); w.w = cvt_pk_bf16(v1[2], v1[3]);
                    *(u32x4*)(rowp + bj * HALF) = w; } }
    }
};
struct EpiFA {
    bf16_t* YT; bf16_t* YTC;
    __device__ __forceinline__ void operator()(const f32x4 (&acc)[2][2][4][2], const Unit& u, int wr, int wc, int fr, int fq) const {
        const int cs = u.pm >> 1, k2b = (u.pm & 1) * 256;
        bf16_t* base; size_t pitch;
        if (u.pn < 32) { const int b = u.pn >> 3; base = YT + (size_t)(u.g * 512 + k2b) * 16384 + b * 4096 + cs * 2048 + (u.pn & 7) * 256; pitch = 16384; }
        else { const int b = u.pn - 32; base = YTC + (size_t)(u.g * 512 + k2b) * 2048 + b * 512 + cs * 256; pitch = 2048; }
        const int row0 = wr * 64 + fr, col0 = wc * 32 + 8 * fq;
#pragma unroll
        for (int ai = 0; ai < 2; ++ai)
#pragma unroll
            for (int m = 0; m < 4; ++m) { bf16_t* rowp = base + (size_t)(row0 + ai * HALF + m * 16) * pitch + col0;
#pragma unroll
                for (int bj = 0; bj < 2; ++bj) { const f32x4 v0 = acc[ai][bj][m][0], v1 = acc[ai][bj][m][1];
                    u32x4 w; w.x = cvt_pk_bf16(v0[0], v0[1]); w.y = cvt_pk_bf16(v0[2], v0[3]); w.z = cvt_pk_bf16(v1[0], v1[1]); w.w = cvt_pk_bf16(v1[2], v1[3]);
                    *(u32x4*)(rowp + bj * HALF) = w; } }
    }
};
struct EpiQKV {
    bf16_t* Q; const float* rope;
    __device__ __forceinline__ void operator()(const f32x4 (&acc)[2][2][4][2], const Unit& u, int wr, int wc, int fr, int fq) const {
        const int part = u.pn >> 3;
        bf16_t* dst = Q + (size_t)part * ((WS_K - WS_Q) / 2);
        const int row0 = u.pm * BM + wr * 64 + fr, colp = (u.pn & 7) * BM + wc * 32 + 8 * fq;
        const bool dorope = (part < 2) && (u.pm < 32);
        const float sc = part == 0 ? QSCALE : 1.f;
#pragma unroll
        for (int ai = 0; ai < 2; ++ai)
#pragma unroll
            for (int m = 0; m < 4; ++m) { const int row = row0 + ai * HALF + m * 16; bf16_t* rowp = dst + (size_t)row * D + colp;
                const int t = row & 2047, prow = t >> 6, pcol = t & 63;
#pragma unroll
                for (int bj = 0; bj < 2; ++bj) { f32x4 v0 = acc[ai][bj][m][0], v1 = acc[ai][bj][m][1];
                    if (dorope) { const int c = colp + bj * HALF, j0 = (c & 63) >> 1, ax = j0 >> 4, f0 = j0 & 15;
                        const float* cs = rope + ((ax ? pcol : prow) * 16 + f0) * 2;
                        const f32x4 cs0 = *(const f32x4*)cs, cs1 = *(const f32x4*)(cs + 4);
                        f32x4 r0, r1;
                        r0[0] = v0[0] * cs0[0] - v0[1] * cs0[1]; r0[1] = v0[0] * cs0[1] + v0[1] * cs0[0];
                        r0[2] = v0[2] * cs0[2] - v0[3] * cs0[3]; r0[3] = v0[2] * cs0[3] + v0[3] * cs0[2];
                        r1[0] = v1[0] * cs1[0] - v1[1] * cs1[1]; r1[1] = v1[0] * cs1[1] + v1[1] * cs1[0];
                        r1[2] = v1[2] * cs1[2] - v1[3] * cs1[3]; r1[3] = v1[2] * cs1[3] + v1[3] * cs1[2];
                        v0 = r0; v1 = r1; }
                    v0 = v0 * sc; v1 = v1 * sc;
                    u32x4 w; w.x = cvt_pk_bf16(v0[0], v0[1]); w.y = cvt_pk_bf16(v0[2], v0[3]); w.z = cvt_pk_bf16(v1[0], v1[1]); w.w = cvt_pk_bf16(v1[2], v1[3]);
                    *(u32x4*)(rowp + bj * HALF) = w; } }
    }
};
}


namespace att {
__device__ __forceinline__ unsigned off_a(unsigned row, unsigned ch) { return 2048u * (row >> 3) + 512u * (ch >> 2) + 64u * (row & 7) + 16u * ((ch & 3) ^ ((row >> 2) & 3)); }
constexpr int KBUF = 0, VBUF = 32768, QOFF = 65536, WSF_OFF = LDSCTL_OFF + 1024;
constexpr float THR = 6.0f;
struct Args { const bf16_t* Q; const bf16_t* K; const bf16_t* V; bf16_t* O; const float* gsub; float lam, post; };
__device__ __forceinline__ s16x4 vtr(const LAS unsigned char* p) { return __builtin_bit_cast(s16x4, __builtin_amdgcn_ds_read_tr16_b64_v4i16((LAS s16x4*)p)); }
__device__ __forceinline__ float half_max(float v) { auto rr = __builtin_amdgcn_permlane32_swap(__float_as_uint(v), __float_as_uint(v), false, false); return fmaxf(__uint_as_float(rr[0]), __uint_as_float(rr[1])); }
__device__ __forceinline__ float half_sum(float v) { auto rr = __builtin_amdgcn_permlane32_swap(__float_as_uint(v), __float_as_uint(v), false, false); return __uint_as_float(rr[0]) + __uint_as_float(rr[1]); }

__device__ __forceinline__ void unit(LAS unsigned char* lds, const Args& P, int b, int h, int q0, int nlat) {
    const int tid = threadIdx.x, lane = tid & 63, r32 = lane & 31, hi = lane >> 5; const int wid = __builtin_amdgcn_readfirstlane(tid >> 6);
    const int nt = nlat + 4;
    LAS unsigned char* Qs = lds + QOFF + wid * 8192;
    LAS float* wsf = (LAS float*)(lds + WSF_OFF + wid * 256);
    {   const bf16_t* qrow = P.Q + (size_t)(q0 + wid * 32 + r32) * D + h * 128 + hi * 8;
#pragma unroll
        for (int c = 0; c < 2; ++c)
#pragma unroll
            for (int d0 = 0; d0 < 4; ++d0) { const u32x4 v = *(const u32x4*)(qrow + c * 64 + d0 * 16); *(LAS u32x4*)(Qs + ((c * 4 + d0) * 2 + hi) * 512 + r32 * 16) = v; } }
    unsigned goff[2];
#pragma unroll
    for (int i = 0; i < 2; ++i) { const unsigned p = 2 * wid + i, rg = p >> 1, chq = (p & 1) * 2 + (lane >> 5), r7 = (lane >> 2) & 7, x = lane & 3, rsw = (r7 >> 2) | ((rg & 1) << 1);
        goff[i] = ((8 * rg + r7) * D + h * 128 + (4 * chq + (x ^ rsw)) * 8) * 2; }
#define ATT_GROW(t) ((t) < nlat ? b * SEQ + 64 * (t) : ML + b * CL + 64 * ((t) - nlat))
#define ATT_DMA(t, buf) do { const size_t g_ = (size_t)ATT_GROW(t) * D * 2; _Pragma("unroll") for (int i_ = 0; i_ < 2; ++i_) { \
        __builtin_amdgcn_global_load_lds((const unsigned*)((const char*)P.K + g_ + goff[i_]), (LAS unsigned*)(lds + KBUF + (buf) * 16384 + (2 * wid + i_) * 1024), 16, 0, 0); \
        __builtin_amdgcn_global_load_lds((const unsigned*)((const char*)P.V + g_ + goff[i_]), (LAS unsigned*)(lds + VBUF + (buf) * 16384 + (2 * wid + i_) * 1024), 16, 0, 0); } } while (0)
    ATT_DMA(0, 0);
    unsigned kb[2];
#pragma unroll
    for (int e = 0; e < 2; ++e) kb[e] = 2048u * (r32 >> 3) + 64u * (r32 & 7) + 16u * ((unsigned)(2 * e + hi) ^ ((r32 >> 2) & 3));
    const unsigned blk = (lane >> 4) & 1, q_ = (lane & 15) >> 2, p_ = lane & 3;
    unsigned vb[2];
#pragma unroll
    for (int t = 0; t < 2; ++t) vb[t] = 2048u * t + 64u * (4 * hi + q_) + 16u * ((2 * blk + (p_ >> 1)) ^ ((2 * t + hi) & 3)) + 8u * (p_ & 1);
    float m0 = -1e30f, m1 = -1e30f, l0 = 0.f, l1 = 0.f;
    f32x16 o[2][4];
#pragma unroll
    for (int c = 0; c < 2; ++c)
#pragma unroll
        for (int d = 0; d < 4; ++d) o[c][d] = f32x16{};
    asm volatile("s_waitcnt vmcnt(0)" ::: "memory");
    __syncthreads();
#pragma unroll 1
    for (int t = 0; t < nt; ++t) {
        const int buf = t & 1;
        if (t + 1 < nt) ATT_DMA(t + 1, buf ^ 1);
        const LAS unsigned char* Kb = lds + KBUF + buf * 16384; const LAS unsigned char* Vb = lds + VBUF + buf * 16384;
#pragma unroll
        for (int c = 0; c < 2; ++c) {
            u32x4 pw[4];
            f32x16 s0 = f32x16{}, s1 = f32x16{};
            __builtin_amdgcn_sched_barrier(0);
#pragma unroll
            for (int dp = 0; dp < 2; ++dp) {
                bf16x8 qf[2], k0[2], k1[2];
#pragma unroll
                for (int e = 0; e < 2; ++e) { const int d0 = 2 * dp + e;
                    qf[e] = *(const LAS bf16x8*)(Qs + ((c * 4 + d0) * 2 + hi) * 512 + r32 * 16);
                    k0[e] = *(const LAS bf16x8*)(Kb + kb[e] + 512 * (2 * c + dp));
                    k1[e] = *(const LAS bf16x8*)(Kb + kb[e] + 512 * (2 * c + dp) + 8192); }
#pragma unroll
                for (int e = 0; e < 2; ++e) { s0 = __builtin_amdgcn_mfma_f32_32x32x16_bf16(k0[e], qf[e], s0, 0, 0, 0); s1 = __builtin_amdgcn_mfma_f32_32x32x16_bf16(k1[e], qf[e], s1, 0, 0, 0); }
                __builtin_amdgcn_sched_barrier(0);
            }
            float mx = fmaxf(s0[0], s1[0]);
#pragma unroll
            for (int r = 1; r < 16; ++r) mx = fmaxf(mx, fmaxf(s0[r], s1[r]));
            mx = half_max(mx);
            float mc = c == 0 ? m0 : m1, lc = c == 0 ? l0 : l1;
            if (__any(mx - mc > THR)) {
                const float mn = fmaxf(mc, mx), al = __builtin_amdgcn_exp2f(mc - mn);
                mc = mn; lc *= al;
                if (hi == 0) wsf[r32] = al;
#pragma unroll
                for (int g4 = 0; g4 < 4; ++g4) { const f32x4 a4 = *(const LAS f32x4*)(wsf + 8 * g4 + 4 * hi);
#pragma unroll
                    for (int d = 0; d < 4; ++d) { o[c][d][4 * g4 + 0] *= a4[0]; o[c][d][4 * g4 + 1] *= a4[1]; o[c][d][4 * g4 + 2] *= a4[2]; o[c][d][4 * g4 + 3] *= a4[3]; } }
            }
            float sum = 0.f;
#pragma unroll
            for (int r = 0; r < 16; ++r) { s0[r] = __builtin_amdgcn_exp2f(s0[r] - mc); s1[r] = __builtin_amdgcn_exp2f(s1[r] - mc); sum += s0[r] + s1[r]; }
            lc += sum;
            if (c == 0) { m0 = mc; l0 = lc; } else { m1 = mc; l1 = lc; }
#pragma unroll
            for (int ks = 0; ks < 2; ++ks) {
                pw[ks]     = (u32x4){cvt_pk_bf16(s0[8 * ks + 0], s0[8 * ks + 1]), cvt_pk_bf16(s0[8 * ks + 2], s0[8 * ks + 3]), cvt_pk_bf16(s0[8 * ks + 4], s0[8 * ks + 5]), cvt_pk_bf16(s0[8 * ks + 6], s0[8 * ks + 7])};
                pw[2 + ks] = (u32x4){cvt_pk_bf16(s1[8 * ks + 0], s1[8 * ks + 1]), cvt_pk_bf16(s1[8 * ks + 2], s1[8 * ks + 3]), cvt_pk_bf16(s1[8 * ks + 4], s1[8 * ks + 5]), cvt_pk_bf16(s1[8 * ks + 6], s1[8 * ks + 7])};
            }
            __builtin_amdgcn_sched_barrier(0);
#pragma unroll
            for (int ks = 0; ks < 4; ++ks) {
                s16x4 lo[4], hh[4];
#pragma unroll
                for (int d = 0; d < 4; ++d) { lo[d] = vtr(Vb + vb[0] + 4096 * ks + 512 * d); hh[d] = vtr(Vb + vb[1] + 4096 * ks + 512 * d); }
#pragma unroll
                for (int d = 0; d < 4; ++d) {
                    const bf16x8 vf = (bf16x8){lo[d][0], lo[d][1], lo[d][2], lo[d][3], hh[d][0], hh[d][1], hh[d][2], hh[d][3]};
                    o[c][d] = __builtin_amdgcn_mfma_f32_32x32x16_bf16(__builtin_bit_cast(bf16x8, pw[ks]), vf, o[c][d], 0, 0, 0);
                }
                __builtin_amdgcn_sched_barrier(0);
            }
        }
        asm volatile("s_waitcnt vmcnt(0)" ::: "memory");
        __syncthreads();
    }
#undef ATT_GROW
#undef ATT_DMA
    l0 = half_sum(l0); l1 = half_sum(l1);
    if (hi == 0) { wsf[r32] = 1.0f / l0; wsf[32 + r32] = P.lam / l1; }
    float ss[16];
#pragma unroll
    for (int r = 0; r < 16; ++r) ss[r] = 0.f;
#pragma unroll
    for (int g4 = 0; g4 < 4; ++g4) { const f32x4 a4 = *(const LAS f32x4*)(wsf + 8 * g4 + 4 * hi), b4 = *(const LAS f32x4*)(wsf + 32 + 8 * g4 + 4 * hi);
#pragma unroll
        for (int d = 0; d < 4; ++d)
#pragma unroll
            for (int e = 0; e < 4; ++e) { const float v = o[0][d][4 * g4 + e] * a4[e] - o[1][d][4 * g4 + e] * b4[e]; o[0][d][4 * g4 + e] = v; ss[4 * g4 + e] += v * v; } }
#pragma unroll
    for (int r = 0; r < 16; ++r) {
        float v = ss[r];
#pragma unroll
        for (int s = 1; s < 32; s <<= 1) v += __shfl_xor(v, s);
        ss[r] = (1.0f / sqrtf(v * (1.0f / 128.0f) + SUBLN_EPS)) * P.post;
    }
    bf16_t* Ow = P.O + (size_t)(q0 + wid * 32) * D + h * 128 + r32;
#pragma unroll
    for (int d = 0; d < 4; ++d) { const float gs = P.gsub[32 * d + r32];
#pragma unroll
        for (int r = 0; r < 16; ++r) { const int row = (r & 3) + 8 * (r >> 2) + 4 * hi; const float v = o[0][d][r] * ss[r] * gs;
            Ow[(size_t)row * D + 32 * d] = (bf16_t)(cvt_pk_bf16(v, 0.f) & 0xffffu); } }
    __syncthreads();
}
}

struct ThinArgs {
    const float* xin_lat; const float* xin_ctx;
    const bf16_t* y;
    float* xout_lat; float* xout_ctx;
    const float* g_post; const float* gate;
    bf16_t* uout;
    const float* g_pre; const float* sc; const float* sh;
    const float* yc; int nslab;
    int nrows;
};
__device__ __forceinline__ void thin_phase(const ThinArgs& T, int gw, int ngw, int lane) {
#pragma unroll 1
    for (int row = gw; row < T.nrows; row += ngw) {
        const int mrow = row < ML ? (row >> 11) : 4;
        const float* xr = row < ML ? T.xin_lat + (size_t)row * D : T.xin_ctx + (size_t)(row - ML) * D;
        f32x4 xv[8];
#pragma unroll
        for (int j = 0; j < 8; ++j) xv[j] = *(const f32x4*)(xr + 256 * j + 4 * lane);
        if (T.y) {
            f32x4 yv[8]; float s = 0.f;
            if (row >= ML && T.nslab > 0) {
                const float* yr = T.yc + (size_t)(row - ML) * D;
#pragma unroll
                for (int j = 0; j < 8; ++j) yv[j] = *(const f32x4*)(yr + 256 * j + 4 * lane);
#pragma unroll 1
                for (int sl = 1; sl < T.nslab; ++sl) { yr += (size_t)MC * D;
#pragma unroll
                    for (int j = 0; j < 8; ++j) yv[j] = yv[j] + *(const f32x4*)(yr + 256 * j + 4 * lane); }
            } else {
                const bf16_t* yr = T.y + (size_t)row * D;
#pragma unroll
                for (int j = 0; j < 8; ++j) { const u32x2 v = *(const u32x2*)(yr + 256 * j + 4 * lane);
                    yv[j][0] = __uint_as_float(v.x << 16); yv[j][1] = __uint_as_float(v.x & 0xffff0000u); yv[j][2] = __uint_as_float(v.y << 16); yv[j][3] = __uint_as_float(v.y & 0xffff0000u); }
            }
#pragma unroll
            for (int j = 0; j < 8; ++j) s += (yv[j][0] * yv[j][0] + yv[j][1] * yv[j][1]) + (yv[j][2] * yv[j][2] + yv[j][3] * yv[j][3]);
            const float rs = 1.0f / sqrtf(wave_sum(s) * (1.0f / D) + NORM_EPS);
            const float* gt = T.gate + (size_t)mrow * MODROW;
#pragma unroll
            for (int j = 0; j < 8; ++j) { const f32x4 g = *(const f32x4*)(T.g_post + 256 * j + 4 * lane), a = *(const f32x4*)(gt + 256 * j + 4 * lane); xv[j] = xv[j] + a * ((yv[j] * rs) * g); }
            float* xo = row < ML ? (T.xout_lat ? T.xout_lat + (size_t)row * D : nullptr) : (T.xout_ctx ? T.xout_ctx + (size_t)(row - ML) * D : nullptr);
            if (xo) {
#pragma unroll
                for (int j = 0; j < 8; ++j) *(f32x4*)(xo + 256 * j + 4 * lane) = xv[j]; }
        }
        if (T.uout) {
            float s = 0.f;
#pragma unroll
            for (int j = 0; j < 8; ++j) s += (xv[j][0] * xv[j][0] + xv[j][1] * xv[j][1]) + (xv[j][2] * xv[j][2] + xv[j][3] * xv[j][3]);
            const float rs = 1.0f / sqrtf(wave_sum(s) * (1.0f / D) + NORM_EPS);
            const float* scp = T.sc + (size_t)mrow * MODROW; const float* shp = T.sh + (size_t)mrow * MODROW;
            bf16_t* uo = T.uout + (size_t)row * D;
#pragma unroll
            for (int j = 0; j < 8; ++j) { const f32x4 g = *(const f32x4*)(T.g_pre + 256 * j + 4 * lane), a = *(const f32x4*)(scp + 256 * j + 4 * lane), c = *(const f32x4*)(shp + 256 * j + 4 * lane);
                const f32x4 u = ((xv[j] * rs) * g) * (a + 1.0f) + c;
                u32x2 w; w.x = cvt_pk_bf16(u[0], u[1]); w.y = cvt_pk_bf16(u[2], u[3]); *(u32x2*)(uo + 256 * j + 4 * lane) = w; }
        }
    }
}
__device__ __forceinline__ void pool_phase(const bf16_t* U, bf16_t* Dm, int nrows, int gw, int ngw, int lane) {
    for (int row = gw; row < nrows; row += ngw) {
        int base, t, Ls;
        if (row < ML) { base = row & ~2047; t = row & 2047; Ls = SEQ; } else { const int i = row - ML; base = ML + (i & ~255); t = i & 255; Ls = CL; }
#pragma unroll
        for (int j = 0; j < 8; ++j) {
            const int w = 2 << (j >> 1); int lo = t - (w >> 1), hi = lo + w; lo = lo < 0 ? 0 : lo; hi = hi > Ls ? Ls : hi;
            const bf16_t* p = U + (size_t)base * D + 256 * j + 4 * lane;
            f32x4 s = {0.f, 0.f, 0.f, 0.f};
            for (int tt = lo; tt < hi; ++tt) { const u32x2 v = *(const u32x2*)(p + (size_t)tt * D);
                s[0] += __uint_as_float(v.x << 16); s[1] += __uint_as_float(v.x & 0xffff0000u); s[2] += __uint_as_float(v.y << 16); s[3] += __uint_as_float(v.y & 0xffff0000u); }
            const u32x2 cv = *(const u32x2*)(p + (size_t)t * D);
            const float inv = 1.0f / (float)(hi - lo);
            f32x4 d; d[0] = s[0] * inv - __uint_as_float(cv.x << 16); d[1] = s[1] * inv - __uint_as_float(cv.x & 0xffff0000u); d[2] = s[2] * inv - __uint_as_float(cv.y << 16); d[3] = s[3] * inv - __uint_as_float(cv.y & 0xffff0000u);
            u32x2 o; o.x = cvt_pk_bf16(d[0], d[1]); o.y = cvt_pk_bf16(d[2], d[3]);
            *(u32x2*)(Dm + (size_t)row * D + 256 * j + 4 * lane) = o;
        }
    }
}

__device__ __forceinline__ void transpose_item(const float* W, int K, int N, bf16_t* WT, int row_off, LAS float* scr, int item, int lane, bool qkperm) {
    const int nblk = N / 64, kb = item / nblk, nb = item % nblk, k0 = 64 * kb, n0 = 64 * nb;
    const int kq = lane >> 4, n4 = lane & 15;
    f32x4 v[16];
#pragma unroll
    for (int i = 0; i < 16; ++i) v[i] = *(const f32x4*)(W + (size_t)(k0 + 4 * i + kq) * N + n0 + 4 * n4);
#pragma unroll
    for (int i = 0; i < 16; ++i) { LAS float* s = scr + (4 * i + kq) * 65 + 4 * n4; s[0] = v[i][0]; s[1] = v[i][1]; s[2] = v[i][2]; s[3] = v[i][3]; }
    asm volatile("s_waitcnt lgkmcnt(0)" ::: "memory");
    const int c = lane & 7;
#pragma unroll
    for (int j = 0; j < 8; ++j) { const int n = (lane >> 3) + 8 * j; int sc = n;
        if (qkperm) { const int jj = n >> 1, which = n & 1, ax = jj >> 4, f = jj & 15; sc = ax * 32 + which * 16 + f; }
        const LAS float* s = scr + (8 * c) * 65 + sc;
        u32x4 o; o.x = cvt_pk_bf16(s[0 * 65], s[1 * 65]); o.y = cvt_pk_bf16(s[2 * 65], s[3 * 65]); o.z = cvt_pk_bf16(s[4 * 65], s[5 * 65]); o.w = cvt_pk_bf16(s[6 * 65], s[7 * 65]);
        *(u32x4*)(WT + (size_t)(row_off + n0 + n) * K + k0 + 8 * c) = o; }
    asm volatile("s_waitcnt lgkmcnt(0)" ::: "memory");
}

struct Params {
    const float* in[22];
    float* out; unsigned char* ws;
    float lam_init0, lam_init3;
    int ph_lo, ph_hi;
};

__device__ __forceinline__ void prologue(const Params& P, LAS unsigned char* lds, int tid, int wave, int lane, int vcu, int G) {
    unsigned char* ws = P.ws;
    const float* c_in = P.in[1]; const float* cctx = P.in[3]; const float* w_mod = P.in[4]; const float* b_mod = P.in[5];
    LAS float* sil = (LAS float*)lds;
    LAS float* red = (LAS float*)(lds + 65536);
    for (int i = tid; i < 5 * D; i += NTHR) { const int r = i / D, k = i % D; const float x = r < 4 ? c_in[r * D + k] : cctx[k]; sil[k * 8 + r] = x / (1.0f + __expf(-x)); }
    __syncthreads();
    float* mod = (float*)(ws + WS_MOD);
    for (int item = blockIdx.x; item < 4 * 192; item += G) {
        const int l = item / 192, col = (item % 192) * 64 + lane;
        const float* W = w_mod + (size_t)l * D * MODROW + col;
        float a0 = 0.f, a1 = 0.f, a2 = 0.f, a3 = 0.f, a4 = 0.f;
        const int k0 = wave * 256;
        for (int kk = 0; kk < 256; kk += 16) {
            float w[16];
#pragma unroll
            for (int j = 0; j < 16; ++j) w[j] = W[(size_t)(k0 + kk + j) * MODROW];
#pragma unroll
            for (int j = 0; j < 16; ++j) { const f32x4 s4 = *(const LAS f32x4*)(sil + (k0 + kk + j) * 8); const float s5 = sil[(k0 + kk + j) * 8 + 4];
                a0 += s4[0] * w[j]; a1 += s4[1] * w[j]; a2 += s4[2] * w[j]; a3 += s4[3] * w[j]; a4 += s5 * w[j]; }
        }
        red[(wave * 5 + 0) * 64 + lane] = a0; red[(wave * 5 + 1) * 64 + lane] = a1; red[(wave * 5 + 2) * 64 + lane] = a2; red[(wave * 5 + 3) * 64 + lane] = a3; red[(wave * 5 + 4) * 64 + lane] = a4;
        __syncthreads();
        if (wave < 5) { float s = b_mod[l * MODROW + col];
#pragma unroll
            for (int w8 = 0; w8 < 8; ++w8) s += red[(w8 * 5 + wave) * 64 + lane];
            mod[((size_t)l * 5 + wave) * MODROW + col] = s; }
        __syncthreads();
    }
    LAS float* scr = (LAS float*)(lds + wave * 16640);
    const int gw = vcu * NWAVES + wave, NGW = G * NWAVES;
    bf16_t* Wqkv = (bf16_t*)(ws + WS_WQKV); bf16_t* Wo = (bf16_t*)(ws + WS_WO); bf16_t* Wf = (bf16_t*)(ws + WS_WF); bf16_t* Wp = (bf16_t*)(ws + WS_WPOOL);
    bf16_t* W1 = (bf16_t*)(ws + WS_W1); bf16_t* W2 = (bf16_t*)(ws + WS_W2);
    constexpr int I_QKV = (D / 64) * (3 * D / 64), I_O = (D / 64) * (D / 64), I_P = 8 * 8, I_1 = (D / 64) * (FF / 64), I_2 = (FF / 64) * (D / 64);
    constexpr int NITEMS = 2 * I_QKV + 2 * I_O + I_O + 4 * I_P + 4 * I_1 + 4 * I_2;
    for (int it = gw; it < NITEMS; it += NGW) {
        int r = it;
        if (r < 2 * I_QKV) { const int ia = r / I_QKV; r %= I_QKV; const int nb = r % (3 * D / 64);
            transpose_item(P.in[10] + (size_t)ia * D * 3 * D, D, 3 * D, Wqkv + (size_t)ia * 3 * D * D, 0, scr, r, lane, nb < 2 * D / 64); continue; } r -= 2 * I_QKV;
        if (r < 2 * I_O) { const int ia = r / I_O; r %= I_O; transpose_item(P.in[11] + (size_t)ia * D * D, D, D, Wo + (size_t)ia * D * D, 0, scr, r, lane, false); continue; } r -= 2 * I_O;
        if (r < I_O) { transpose_item(P.in[17], D, D, Wf, 0, scr, r, lane, false); continue; } r -= I_O;
        if (r < 4 * I_P) { const int g = r / I_P; r %= I_P; transpose_item(P.in[18] + (size_t)g * 512 * 512, 512, 512, Wp + (size_t)g * 512 * 512, 0, scr, r, lane, false); continue; } r -= 4 * I_P;
        if (r < 4 * I_1) { const int l = r / I_1; r %= I_1; transpose_item(P.in[20] + (size_t)l * D * FF, D, FF, W1 + (size_t)l * FF * D, 0, scr, r, lane, false); continue; } r -= 4 * I_1;
        { const int l = r / I_2; r %= I_2; transpose_item(P.in[21] + (size_t)l * FF * D, FF, D, W2 + (size_t)l * D * FF, 0, scr, r, lane, false); }
    }
    {   bf16_t* T1 = (bf16_t*)(ws + WS_T1); bf16_t* A2 = (bf16_t*)(ws + WS_A2); bf16_t* A2C = (bf16_t*)(ws + WS_A2C);
        constexpr int C_T1 = 1024 * 512 / 8, C_A2 = 2048 * 4096 / 8, C_A2C = 256 * 512 / 8;
        const int gt = gw * 64 + lane, NGT = NGW * 64;
        for (int ch = gt; ch < C_T1 + C_A2 + C_A2C; ch += NGT) {
            int r = ch; bf16_t* dst; int row, col0, N, ncol; float scale; bool negsin;
            if (r < C_T1) { row = r / 64; col0 = (r % 64) * 8; dst = T1 + (size_t)row * 512 + col0; N = 512; scale = 0.04419417382415922f; negsin = false;
                const int cs = row >> 9, k2 = row & 511; float vals[8];
#pragma unroll
                for (int e = 0; e < 8; ++e) { const int idx = (k2 * (col0 + e)) & 511; const float a = (float)idx * (1.0f / 256.0f); vals[e] = (cs ? sinpif(a) : cospif(a)) * scale; }
                u32x4 o; o.x = cvt_pk_bf16(vals[0], vals[1]); o.y = cvt_pk_bf16(vals[2], vals[3]); o.z = cvt_pk_bf16(vals[4], vals[5]); o.w = cvt_pk_bf16(vals[6], vals[7]); *(u32x4*)dst = o; continue; }
            r -= C_T1;
            if (r < C_A2) { row = r / 512; col0 = (r % 512) * 8; dst = A2 + (size_t)row * 4096 + col0; N = 2048; scale = 0.022097086912079608f; }
            else { r -= C_A2; row = r / 64; col0 = (r % 64) * 8; dst = A2C + (size_t)row * 512 + col0; N = 256; scale = 0.0625f; }
            (void)ncol; (void)negsin;
            { const int cs = col0 / N, n0 = col0 % N; float vals[8];
#pragma unroll
              for (int e = 0; e < 8; ++e) { const int idx = (row * (n0 + e)) & (N - 1); const float a = (float)idx * (2.0f / (float)N); vals[e] = (cs ? -sinpif(a) : cospif(a)) * scale; }
              u32x4 o; o.x = cvt_pk_bf16(vals[0], vals[1]); o.y = cvt_pk_bf16(vals[2], vals[3]); o.z = cvt_pk_bf16(vals[4], vals[5]); o.w = cvt_pk_bf16(vals[6], vals[7]); *(u32x4*)dst = o; }
        }
        float* rope = (float*)(ws + WS_ROPE);
        for (int i = gt; i < 64 * 16; i += NGT) { const int pos = i >> 4, f = i & 15; const float inv = 1.0f / powf(10000.0f, (float)f * (1.0f / 16.0f)); const float ang = (float)pos * inv;
            rope[2 * i] = cosf(ang); rope[2 * i + 1] = sinf(ang); }
    }
}

struct Ctx { LAS unsigned char* lds; int tid, lane, wave, G, bx, vcu, gw, NGW; };
#if MK_MULTI
#define GRID_BAR() do { } while (0)
#else
#define GRID_BAR() xcd_barrier(bar)
#endif
#define PH_BEGIN(k) if ((k) >= P.ph_lo && (k) < P.ph_hi) {
#define PH_END(k)   if ((k) + 1 < P.ph_hi) GRID_BAR(); }
#define WSP(T, off) ((T*)(P.ws + (off)))

template <int L, int PH0>
__device__ __forceinline__ void layer(const Params& P, const Ctx& C, const XcdBarrier& bar) {
    constexpr int kind = L % 3; constexpr bool lastl = (L == 3);
    constexpr int Mact = lastl ? ML : MT;
    constexpr int NMIX = (kind == 2) ? 1 : 2;
    LAS unsigned char* lds = C.lds;
    if constexpr (kind == 0) {
        constexpr int ia = L / 3;
        PH_BEGIN(PH0)
        { pg8::Sched S{}; S.A = (const char*)WSP(bf16_t, WS_U); S.B = (const char*)(WSP(bf16_t, WS_WQKV) + (size_t)ia * 3 * D * D); S.lda = D * 2; S.ldb = D * 2; S.nt = D / 64;
          S.nM = MT / 256; S.nN = 3 * D / 256; S.ngroups = 1; S.a_g = 0; S.b_g = 0; S.G = C.G; S.c = C.bx;
          pg8::EpiQKV E{WSP(bf16_t, WS_Q), WSP(const float, WS_ROPE)};
          _Pragma("unroll") for (int rep_ = 0; rep_ < PROBE_QKV; ++rep_) { int tid_ = C.tid; if (rep_) { __builtin_amdgcn_sched_barrier(0); __syncthreads(); asm volatile("" : "+v"(tid_)); __builtin_amdgcn_sched_barrier(0); } pg8::gemm_phase(lds, S, E, tid_); } }
        PH_END(PH0)
        PH_BEGIN(PH0 + 1)
        { const float* lq1 = P.in[12] + ia * 64; const float* lk1 = P.in[13] + ia * 64; const float* lq2 = P.in[14] + ia * 64; const float* lk2 = P.in[15] + ia * 64;
          const float d1 = wave_sum(lq1[C.lane] * lk1[C.lane]), d2 = wave_sum(lq2[C.lane] * lk2[C.lane]);
          const float li = (L == 0) ? P.lam_init0 : P.lam_init3;
          att::Args A{WSP(bf16_t, WS_Q), WSP(bf16_t, WS_K), WSP(bf16_t, WS_V), WSP(bf16_t, WS_O), P.in[16] + ia * 128, expf(d1) - expf(d2) + li, 1.0f - li};
          _Pragma("unroll 1") for (int rep_ = 0; rep_ < PROBE_ATT; ++rep_) {
          constexpr int nlat_units = NB * NH * (SEQ / 256);
          const int per = (nlat_units + C.G - 1) / C.G;
          for (int i = 0; i < per; ++i) { const int uu = C.vcu * per + i; if (uu < nlat_units) { const int bh = uu >> 3, qb = uu & 7; att::unit(lds, A, bh >> 4, bh & 15, (bh >> 4) * SEQ + qb * 256, SEQ / 64); } }
          if constexpr (!lastl) { for (int uc = C.bx; uc < NB * NH; uc += C.G) { const int b = uc >> 4, h = uc & 15; att::unit(lds, A, b, h, ML + b * CL, 0); } } } }
        PH_END(PH0 + 1)
    } else if constexpr (kind == 1) {
        PH_BEGIN(PH0)
        { pg8::Sched S{}; S.A = (const char*)WSP(bf16_t, WS_T1); S.B = (const char*)WSP(bf16_t, WS_U); S.lda = 512 * 2; S.ldb = D * 2; S.nt = 8; S.nM = 4; S.nN = Mact / 256; S.ngroups = 4; S.a_g = 0; S.b_g = 512 * 2; S.G = C.G; S.c = C.bx;
          pg8::EpiFA E{WSP(bf16_t, WS_YT), WSP(bf16_t, WS_YTC)};
          _Pragma("unroll") for (int rep_ = 0; rep_ < PROBE_FA; ++rep_) { int tid_ = C.tid; if (rep_) { __builtin_amdgcn_sched_barrier(0); __syncthreads(); asm volatile("" : "+v"(tid_)); __builtin_amdgcn_sched_barrier(0); } pg8::gemm_phase(lds, S, E, tid_); } }
        PH_END(PH0)
        PH_BEGIN(PH0 + 1)
        { pg8::Sched S{}; S.A = (const char*)WSP(bf16_t, WS_A2); S.B = (const char*)WSP(bf16_t, WS_YT); S.lda = 4096 * 2; S.ldb = 16384 * 2; S.nt = 64; S.nM = 8; S.nN = 8; S.ngroups = 4; S.a_g = 0; S.b_g = 4096 * 2; S.G = C.G; S.c = C.bx;
          pg8::EpiBf16<0> E{WSP(bf16_t, WS_O), (unsigned)D, SEQ};
          _Pragma("unroll") for (int rep_ = 0; rep_ < PROBE_FB; ++rep_) { int tid_ = C.tid; if (rep_) { __builtin_amdgcn_sched_barrier(0); __syncthreads(); asm volatile("" : "+v"(tid_)); __builtin_amdgcn_sched_barrier(0); } pg8::gemm_phase(lds, S, E, tid_); }
          if constexpr (!lastl) { pg8::Sched S2{}; S2.A = (const char*)WSP(bf16_t, WS_A2C); S2.B = (const char*)WSP(bf16_t, WS_YTC); S2.lda = 512 * 2; S2.ldb = 2048 * 2; S2.nt = 8; S2.nM = 1; S2.nN = 8; S2.ngroups = 4; S2.a_g = 0; S2.b_g = 512 * 2; S2.G = C.G; S2.c = C.bx;
            pg8::EpiBf16<0> E2{WSP(bf16_t, WS_O) + (size_t)ML * D, (unsigned)D, CL};
            _Pragma("unroll") for (int rep_ = 0; rep_ < PROBE_FB; ++rep_) { int tid_ = C.tid; if (rep_) { __builtin_amdgcn_sched_barrier(0); __syncthreads(); asm volatile("" : "+v"(tid_)); __builtin_amdgcn_sched_barrier(0); } pg8::gemm_phase(lds, S2, E2, tid_); } } }
        PH_END(PH0 + 1)
    } else {
        PH_BEGIN(PH0) for (int rep_ = 0; rep_ < PROBE_THIN; ++rep_) pool_phase(WSP(bf16_t, WS_U), WSP(bf16_t, WS_O), Mact, C.gw, C.NGW, C.lane); PH_END(PH0)
    }
    PH_BEGIN(PH0 + NMIX)
    { pg8::Sched S{}; S.A = (const char*)WSP(bf16_t, WS_O); S.lda = D * 2; S.G = C.G; S.c = C.bx;
      if constexpr (kind == 2) { S.B = (const char*)WSP(bf16_t, WS_WPOOL); S.ldb = 512 * 2; S.nt = 8; S.nM = Mact / 256; S.nN = 2; S.ngroups = 4; S.a_g = 512 * 2; S.b_g = 512 * 512 * 2;
          pg8::EpiY E{WSP(bf16_t, WS_Y), (unsigned)D, P.in[19], 512}; _Pragma("unroll") for (int rep_ = 0; rep_ < PROBE_MIX; ++rep_) { int tid_ = C.tid; if (rep_) { __builtin_amdgcn_sched_barrier(0); __syncthreads(); asm volatile("" : "+v"(tid_)); __builtin_amdgcn_sched_barrier(0); } pg8::gemm_phase(lds, S, E, tid_); } }
      else { S.B = kind == 0 ? (const char*)(WSP(bf16_t, WS_WO) + (size_t)(L / 3) * D * D) : (const char*)WSP(bf16_t, WS_WF); S.ldb = D * 2; S.nt = D / 64; S.nM = ML / 256; S.nN = D / 256; S.ngroups = 1;
          pg8::EpiY E{WSP(bf16_t, WS_Y), (unsigned)D, nullptr, 0}; _Pragma("unroll") for (int rep_ = 0; rep_ < PROBE_MIX; ++rep_) { int tid_ = C.tid; if (rep_) { __builtin_amdgcn_sched_barrier(0); __syncthreads(); asm volatile("" : "+v"(tid_)); __builtin_amdgcn_sched_barrier(0); } pg8::gemm_phase(lds, S, E, tid_); }
          if constexpr (!lastl) { pg8::Sched S2 = S; S2.A = (const char*)(WSP(bf16_t, WS_O) + (size_t)ML * D); S2.nt = D / 64 / NSPLIT; S2.nM = MC / 256; S2.ngroups = NSPLIT; S2.a_g = (D / NSPLIT) * 2; S2.b_g = (D / NSPLIT) * 2;
              pg8::EpiF32 E2{WSP(float, WS_YC), (unsigned)D, nullptr, 0, (size_t)MC * D}; _Pragma("unroll") for (int rep_ = 0; rep_ < PROBE_MIX; ++rep_) { int tid_ = C.tid; if (rep_) { __builtin_amdgcn_sched_barrier(0); __syncthreads(); asm volatile("" : "+v"(tid_)); __builtin_amdgcn_sched_barrier(0); } pg8::gemm_phase(lds, S2, E2, tid_); } } } }
    PH_END(PH0 + NMIX)
    PH_BEGIN(PH0 + NMIX + 1)
    { const float* modl = WSP(const float, WS_MOD) + (size_t)L * 5 * MODROW; float* X = WSP(float, WS_X);
      ThinArgs T{}; T.xin_lat = L == 0 ? P.in[0] : X; T.xin_ctx = L == 0 ? P.in[2] : X + (size_t)ML * D; T.y = WSP(const bf16_t, WS_Y); T.xout_lat = X; T.xout_ctx = X + (size_t)ML * D;
      T.yc = WSP(const float, WS_YC); T.nslab = (kind == 2 || lastl) ? 0 : NSPLIT;
      T.g_post = P.in[7] + L * D; T.gate = modl + 2 * D; T.uout = WSP(bf16_t, WS_U); T.g_pre = P.in[8] + L * D; T.sc = modl + 4 * D; T.sh = modl + 3 * D; T.nrows = Mact;
      thin_phase(T, C.gw, C.NGW, C.lane);
      for (int rep_ = 1; rep_ < PROBE_THIN; ++rep_) { ThinArgs T2 = T; if (T2.xout_lat) { T2.xout_lat = WSP(float, WS_END); T2.xout_ctx = WSP(float, WS_END) + (size_t)ML * D; } if (T2.uout) T2.uout = WSP(bf16_t, WS_END + 80 * MiB); thin_phase(T2, C.gw, C.NGW, C.lane); } }
    PH_END(PH0 + NMIX + 1)
    PH_BEGIN(PH0 + NMIX + 2)
    { pg8::Sched S{}; S.A = (const char*)WSP(bf16_t, WS_U); S.B = (const char*)(WSP(bf16_t, WS_W1) + (size_t)L * FF * D); S.lda = D * 2; S.ldb = D * 2; S.nt = D / 64; S.nM = Mact / 256; S.nN = FF / 256; S.ngroups = 1; S.G = C.G; S.c = C.bx;
      pg8::EpiBf16<1> E{WSP(bf16_t, WS_H), (unsigned)FF, 0}; _Pragma("unroll") for (int rep_ = 0; rep_ < PROBE_W1; ++rep_) { int tid_ = C.tid; if (rep_) { __builtin_amdgcn_sched_barrier(0); __syncthreads(); asm volatile("" : "+v"(tid_)); __builtin_amdgcn_sched_barrier(0); } pg8::gemm_phase(lds, S, E, tid_); } }
    PH_END(PH0 + NMIX + 2)
    PH_BEGIN(PH0 + NMIX + 3)
    { pg8::Sched S{}; S.A = (const char*)WSP(bf16_t, WS_H); S.B = (const char*)(WSP(bf16_t, WS_W2) + (size_t)L * D * FF); S.lda = FF * 2; S.ldb = FF * 2; S.nt = FF / 64; S.nM = ML / 256; S.nN = D / 256; S.ngroups = 1; S.G = C.G; S.c = C.bx;
      pg8::EpiY E{WSP(bf16_t, WS_Y), (unsigned)D, nullptr, 0}; _Pragma("unroll") for (int rep_ = 0; rep_ < PROBE_W2; ++rep_) { int tid_ = C.tid; if (rep_) { __builtin_amdgcn_sched_barrier(0); __syncthreads(); asm volatile("" : "+v"(tid_)); __builtin_amdgcn_sched_barrier(0); } pg8::gemm_phase(lds, S, E, tid_); }
      if constexpr (!lastl) { pg8::Sched S2 = S; S2.A = (const char*)(WSP(bf16_t, WS_H) + (size_t)ML * FF); S2.nt = FF / 64 / NSPLIT; S2.nM = MC / 256; S2.ngroups = NSPLIT; S2.a_g = (FF / NSPLIT) * 2; S2.b_g = (FF / NSPLIT) * 2;
          pg8::EpiF32 E2{WSP(float, WS_YC), (unsigned)D, nullptr, 0, (size_t)MC * D}; _Pragma("unroll") for (int rep_ = 0; rep_ < PROBE_W2; ++rep_) { int tid_ = C.tid; if (rep_) { __builtin_amdgcn_sched_barrier(0); __syncthreads(); asm volatile("" : "+v"(tid_)); __builtin_amdgcn_sched_barrier(0); } pg8::gemm_phase(lds, S2, E2, tid_); } } }
    PH_END(PH0 + NMIX + 3)
    PH_BEGIN(PH0 + NMIX + 4)
    { const float* modl = WSP(const float, WS_MOD) + (size_t)L * 5 * MODROW; float* X = WSP(float, WS_X);
      ThinArgs T{}; T.xin_lat = X; T.xin_ctx = X + (size_t)ML * D; T.y = WSP(const bf16_t, WS_Y); T.xout_lat = lastl ? P.out : X; T.xout_ctx = X + (size_t)ML * D;
      T.yc = WSP(const float, WS_YC); T.nslab = lastl ? 0 : NSPLIT;
      T.g_post = P.in[9] + L * D; T.gate = modl + 5 * D; T.nrows = Mact;
      if constexpr (!lastl) { const float* modn = modl + 5 * MODROW; T.uout = WSP(bf16_t, WS_U); T.g_pre = P.in[6] + (L + 1) * D; T.sc = modn + 1 * D; T.sh = modn + 0 * D; }
      thin_phase(T, C.gw, C.NGW, C.lane);
      for (int rep_ = 1; rep_ < PROBE_THIN; ++rep_) { ThinArgs T2 = T; if (T2.xout_lat) { T2.xout_lat = WSP(float, WS_END); T2.xout_ctx = WSP(float, WS_END) + (size_t)ML * D; } if (T2.uout) T2.uout = WSP(bf16_t, WS_END + 80 * MiB); thin_phase(T2, C.gw, C.NGW, C.lane); } }
    PH_END(PH0 + NMIX + 4)
}
constexpr int PH_L0 = 2, PH_L1 = PH_L0 + 7, PH_L2 = PH_L1 + 7, PH_L3 = PH_L2 + 6, N_PHASES = PH_L3 + 7;

__global__ void __launch_bounds__(NTHR, 2) fwd_kernel(Params P) {
    extern __shared__ __attribute__((aligned(16))) unsigned char lds_raw[];
    Ctx C; C.lds = (LAS unsigned char*)lds_raw;
    C.tid = threadIdx.x; C.lane = C.tid & 63; C.wave = __builtin_amdgcn_readfirstlane(C.tid >> 6);
    C.G = gridDim.x; C.bx = blockIdx.x; C.vcu = (C.G % 8 == 0) ? (C.bx % 8) * (C.G / 8) + C.bx / 8 : C.bx;
    C.gw = C.vcu * NWAVES + C.wave; C.NGW = C.G * NWAVES;
    for (int u = C.tid; u < (LDS_BYTES - LDSCTL_OFF) / 4; u += NTHR) ((LAS unsigned*)(C.lds + LDSCTL_OFF))[u] = 0u;
    __syncthreads();
#if MK_MULTI
    XcdBarrier bar{};
#else
    XcdBarrier bar = xcd_barrier_post(WSP(unsigned, WS_CTL) + CW_BAR, (volatile LAS unsigned*)(C.lds + MISC_OFF) + 8);
#endif
    PH_BEGIN(0) for (int rep_ = 0; rep_ < PROBE_PRO; ++rep_) { prologue(P, C.lds, C.tid, C.wave, C.lane, C.vcu, C.G); __syncthreads(); } PH_END(0)
    PH_BEGIN(1)
    { const float* mod = WSP(const float, WS_MOD);
      ThinArgs T{}; T.xin_lat = P.in[0]; T.xin_ctx = P.in[2]; T.y = nullptr; T.uout = WSP(bf16_t, WS_U); T.g_pre = P.in[6]; T.sc = mod + 1 * D; T.sh = mod + 0 * D; T.nrows = MT;
      thin_phase(T, C.gw, C.NGW, C.lane);
      for (int rep_ = 1; rep_ < PROBE_THIN; ++rep_) { ThinArgs T2 = T; if (T2.xout_lat) { T2.xout_lat = WSP(float, WS_END); T2.xout_ctx = WSP(float, WS_END) + (size_t)ML * D; } if (T2.uout) T2.uout = WSP(bf16_t, WS_END + 80 * MiB); thin_phase(T2, C.gw, C.NGW, C.lane); } }
    PH_END(1)
    layer<0, PH_L0>(P, C, bar);
    layer<1, PH_L1>(P, C, bar);
    layer<2, PH_L2>(P, C, bar);
    layer<3, PH_L3>(P, C, bar);
}
#undef PH_BEGIN
#undef PH_END
#undef GRID_BAR

extern "C" void kernel_launch(void* const* d_in, const int* in_sizes, int n_in, void* d_out, int out_size, void* d_ws, size_t ws_size, hipStream_t stream) {
    static int grid = 0;
    if (grid == 0) {
        if (n_in != 22 || out_size != ML * D || ws_size < WS_END + 128 * MiB) { fprintf(stderr, "kernel_launch: unexpected problem: n_in %d out %d ws %zu (need %zu)\n", n_in, out_size, ws_size, (size_t)WS_END); grid = -1; return; }
        int dev = 0, cus = 0, per_cu = 0;
        if (hipGetDevice(&dev) != hipSuccess || hipDeviceGetAttribute(&cus, hipDeviceAttributeMultiprocessorCount, dev) != hipSuccess) { grid = -1; return; }
        if (hipFuncSetAttribute((const void*)fwd_kernel, hipFuncAttributeMaxDynamicSharedMemorySize, LDS_BYTES) != hipSuccess) { fprintf(stderr, "kernel_launch: hipFuncSetAttribute failed\n"); grid = -1; return; }
        if (hipOccupancyMaxActiveBlocksPerMultiprocessor(&per_cu, (const void*)fwd_kernel, NTHR, LDS_BYTES) != hipSuccess || per_cu < 1) fprintf(stderr, "kernel_launch: occupancy query says %d\n", per_cu);
        (void)hipGetLastError();
        grid = cus;
    }
    if (grid < 0) return;
    (void)in_sizes;
    hipMemsetAsync((char*)d_ws + WS_CTL, 0, CTL_BYTES, stream);
    Params p{};
    for (int i = 0; i < 22; ++i) p.in[i] = (const float*)d_in[i];
    p.out = (float*)d_out; p.ws = (unsigned char*)d_ws;
    p.lam_init0 = (float)(0.8 - 0.6 * exp(-0.3 * 0.0)); p.lam_init3 = (float)(0.8 - 0.6 * exp(-0.3 * 3.0));
#if MK_MULTI
    for (int ph = 0; ph < N_PHASES; ++ph) { p.ph_lo = ph; p.ph_hi = ph + 1; hipLaunchKernelGGL(fwd_kernel, dim3(grid), dim3(NTHR), LDS_BYTES, stream, p); }
#else
    p.ph_lo = 0; p.ph_hi = N_PHASES;
    hipLaunchKernelGGL(fwd_kernel, dim3(grid), dim3(NTHR), LDS_BYTES, stream, p);
#endif
    const hipError_t le = hipPeekAtLastError();
    if (le != hipSuccess) fprintf(stderr, "kernel_launch: launch failed: %s\n", hipGetErrorName(le));
}
```

```cpp
#include <hip/hip_runtime.h>
#include <cstdio>
#include <cstdint>
#include <cmath>

#define PROBE_QKV 1
#define PROBE_FA 1
#define PROBE_FB 1
#define PROBE_MIX 1
#define PROBE_W1 1
#define PROBE_W2 1
#define PROBE_BAR 1
#define PROBE_ATT 1
#define PROBE_PRO 1
#define PROBE_THIN 1
#ifndef MK_MULTI
#define MK_MULTI 0
#endif

#define LAS __attribute__((address_space(3)))
#define GAS __attribute__((address_space(1)))
typedef unsigned short bf16_t;
typedef short bf16x8 __attribute__((ext_vector_type(8)));
typedef short s16x4 __attribute__((ext_vector_type(4)));
typedef float f32x4 __attribute__((ext_vector_type(4)));
typedef float f32x2 __attribute__((ext_vector_type(2)));
typedef float f32x16 __attribute__((ext_vector_type(16)));
typedef unsigned u32x4 __attribute__((ext_vector_type(4)));
typedef unsigned u32x2 __attribute__((ext_vector_type(2)));

constexpr int D = 2048, NB = 4, SEQ = 2048, CL = 256, ML = NB * SEQ, MC = NB * CL, MT = ML + MC, FF = 8192, NH = 16, NMOD = 6, MODROW = NMOD * D;
constexpr int NWAVES = 8, NTHR = 512;
constexpr float NORM_EPS = 1e-6f, SUBLN_EPS = 1e-5f;
constexpr float QSCALE = 0.125f * 1.4426950408889634f;

constexpr size_t MiB = 1u << 20;
constexpr size_t WS_CTL = 0, CTL_BYTES = 1 * MiB;
constexpr size_t WS_MOD = 1 * MiB;
constexpr size_t WS_ROPE = 2 * MiB;
constexpr size_t WS_T1 = 3 * MiB;
constexpr size_t WS_A2C = 4 * MiB;
constexpr size_t WS_A2 = 5 * MiB;
constexpr size_t WS_WQKV = 22 * MiB;
constexpr size_t WS_WO = 70 * MiB;
constexpr size_t WS_WF = 86 * MiB;
constexpr size_t WS_WPOOL = 94 * MiB;
constexpr size_t WS_W1 = 96 * MiB;
constexpr size_t WS_W2 = 224 * MiB;
constexpr size_t WS_X = 352 * MiB;
constexpr size_t WS_Y = 424 * MiB;
constexpr size_t WS_U = 496 * MiB;
constexpr size_t WS_Q = 532 * MiB, WS_K = 568 * MiB, WS_V = 604 * MiB, WS_O = 640 * MiB;
constexpr size_t WS_H = 676 * MiB;
constexpr size_t WS_YT = 820 * MiB;
constexpr size_t WS_YTC = 884 * MiB;
constexpr size_t WS_YC = 892 * MiB;
constexpr size_t WS_END = 956 * MiB;
constexpr int NSPLIT = 8;

constexpr int RING_BYTES = 131072, LDSCTL_OFF = 139264  , MISC_OFF = LDSCTL_OFF + 320, LDS_BYTES = 147456;

__device__ __forceinline__ unsigned cvt_pk_bf16(float lo, float hi) { unsigned r; asm volatile("v_cvt_pk_bf16_f32 %0, %1, %2" : "=v"(r) : "v"(lo), "v"(hi)); return r; }
__device__ __forceinline__ float bf2f(unsigned short b) { return __uint_as_float(((unsigned)b) << 16); }
__device__ __forceinline__ float wave_sum(float v) {
#pragma unroll
    for (int o = 1; o < 64; o <<= 1) v += __shfl_xor(v, o);
    return v;
}

#define XB_TMO      128
#define XB_XCNT(j)  (256  + 64 * (j))
#define XB_XSUB(j)  (1280 + 64 * (j))
#define XB_XGEN(j)  (2304 + 64 * (j))
#define XB_TOP      3328
#define XB_TOPGEN   3392
#define XCD_BAR_WORDS 3456
#define XB_SPIN_CAP (1u << 18)
constexpr int CW_BAR = 4096;

__device__ __forceinline__ unsigned xb_ld(unsigned* p)              { return __hip_atomic_load(p, __ATOMIC_RELAXED, __HIP_MEMORY_SCOPE_AGENT); }
__device__ __forceinline__ unsigned xb_add(unsigned* p, unsigned v) { return __hip_atomic_fetch_add(p, v, __ATOMIC_RELAXED, __HIP_MEMORY_SCOPE_AGENT); }
__device__ __forceinline__ unsigned xb_xcc_id() { return (unsigned)__builtin_amdgcn_s_getreg((3 << 11) | 20) & 0xFu; }
#define XB_SPIN(cond, bar) do { unsigned _sp = 0; while (cond) { __builtin_amdgcn_s_sleep(1); \
    if ((++_sp & 255u) == 0u) { if (xb_ld(&(bar)[XB_TMO])) break; if (_sp > XB_SPIN_CAP) { atomicAdd(&(bar)[XB_TMO], 1u); break; } } } } while (0)

struct XcdBarrier { unsigned* bar; unsigned x; volatile LAS unsigned* st; };

__device__ __forceinline__ XcdBarrier xcd_barrier_post(unsigned* bar, volatile LAS unsigned* st) {
    XcdBarrier b; b.bar = bar; b.x = xb_xcc_id(); b.st = st;
    if (threadIdx.x == 0) (void)xb_add(&bar[XB_XCNT(b.x)], 1u);
    return b;
}
__device__ __forceinline__ void xcd_barrier_complete(unsigned* bar, unsigned x, unsigned& nloc, unsigned& nx) {
    const unsigned G = gridDim.x * gridDim.y * gridDim.z;
    unsigned sum, cnt, mine, sp = 0u;
    for (;;) {
        sum = 0u; cnt = 0u; mine = 0u;
#pragma unroll
        for (unsigned j = 0; j < 16; ++j) { const unsigned c = xb_ld(&bar[XB_XCNT(j)]); sum += c; cnt += (c > 0u) ? 1u : 0u; mine = (j == x) ? c : mine; }
        if (sum == G) break;
        __builtin_amdgcn_s_sleep(1);
        if ((++sp & 255u) == 0u) { if (xb_ld(&bar[XB_TMO])) break; if (sp > XB_SPIN_CAP) { atomicAdd(&bar[XB_TMO], 1u); break; } }
    }
    nloc = mine > 0u ? mine : 1u; nx = cnt > 0u ? cnt : 1u;
}
__device__ __forceinline__ void xcd_barrier(const XcdBarrier& b) {
    asm volatile("s_waitcnt vmcnt(0)" ::: "memory");
    __syncthreads();
    if (threadIdx.x == 0) {
        unsigned* bar = b.bar;
        __builtin_amdgcn_s_waitcnt(0);
        unsigned nloc = b.st[0], nx = b.st[1];
        if (nloc == 0u) { xcd_barrier_complete(bar, b.x, nloc, nx); b.st[0] = nloc; b.st[1] = nx; }
        const unsigned old = xb_add(&bar[XB_XSUB(b.x)], 1u);
        const unsigned gen = old / nloc;
        if (old + 1u == (gen + 1u) * nloc) {
            __builtin_amdgcn_fence(__ATOMIC_RELEASE, "agent");
            asm volatile("s_waitcnt vmcnt(0)" ::: "memory");
            const unsigned og = xb_add(&bar[XB_TOP], 1u);
            const unsigned tg = og / nx;
            if (og + 1u == (tg + 1u) * nx) xb_add(&bar[XB_TOPGEN], 1u);
            else XB_SPIN(xb_ld(&bar[XB_TOPGEN]) == tg, bar);
            __builtin_amdgcn_fence(__ATOMIC_ACQUIRE, "agent");
            xb_add(&bar[XB_XGEN(b.x)], 1u);
            asm volatile("s_waitcnt vmcnt(0)" ::: "memory");
        } else {
            XB_SPIN(xb_ld(&bar[XB_XGEN(b.x)]) == gen, bar);
            __builtin_amdgcn_fence(__ATOMIC_ACQUIRE, "agent");
            asm volatile("s_waitcnt vmcnt(0)" ::: "memory");
        }
    }
    __syncthreads();
}

namespace pg8 {
constexpr int BM = 256, BK = 64, HALF = 128, HTB = HALF * BK * 2, STAGE_BYTES = 8 * HTB, NXCD = 8, WGM = 8;
__device__ __forceinline__ int lds_byte(int r, int c) { const int st = (r >> 4) * 2 + (c >> 5), rr = r & 15, cc = c & 31, ob = rr * 64 + cc * 2; return st * 1024 + (ob ^ (((ob >> 9) & 1) << 5)); }
__device__ __forceinline__ void stage_rc(int b, int& R, int& C) { const int st = b / 1024, sb = b % 1024, swz = sb ^ (((sb >> 9) & 1) << 5); R = (st >> 1) * 16 + swz / 64; C = (st & 1) * 32 + (swz % 64) / 2; }
__device__ __forceinline__ int perm32(int rho) { const int n = rho >> 4, i = rho & 15; return 8 * (i >> 2) + 4 * n + (i & 3); }

struct Unit { const char* A; const char* B; int g, pm, pn; };

struct Sched {
    const char* A; const char* B; unsigned lda, ldb; int nt;
    int nM, nN, ngroups; long long a_g, b_g;
    int G, c;
    __device__ __forceinline__ bool next(int i, Unit& u) const {
        const int per = nM * nN, nwg = per * ngroups;
        const long L = (long)i * G + c; if (L >= nwg) return false;
        int wgid = (int)L; { const int q = nwg / NXCD, r = nwg % NXCD, xcd = wgid % NXCD, off = wgid / NXCD; wgid = (xcd < r ? xcd * (q + 1) : r * (q + 1) + (xcd - r) * q) + off; }
        const int g = wgid / per, w = wgid % per;
        const int nig = WGM * nN, gid = w / nig, fm = gid * WGM, gsz = (nM - fm) < WGM ? (nM - fm) : WGM;
        u.g = g; u.pm = fm + ((w % nig) % gsz); u.pn = (w % nig) / gsz;
        u.A = A + (long long)g * a_g + (size_t)u.pm * BM * lda; u.B = B + (long long)g * b_g + (size_t)u.pn * BM * ldb;
        return true;
    }
};

template <class Epi>
__device__ __forceinline__ void gemm_phase(LAS unsigned char* lds, const Sched& S, const Epi& E, int tid_in = -1) {
    const int tid = tid_in >= 0 ? tid_in : (int)threadIdx.x, wid = __builtin_amdgcn_readfirstlane(tid >> 6), lane = tid & 63, wr = wid >> 2, wc = wid & 3, fr = lane & 15, fq = lane >> 4;
    const int nt = S.nt;
    unsigned voffA[2], voffB[2];
#pragma unroll
    for (int i = 0; i < 2; ++i) { int R, C; stage_rc(tid * 16 + i * 8192, R, C); const int Rb = (R & ~31) + perm32(R & 31);
        voffA[i] = (unsigned)R * S.lda + (unsigned)C * 2u; voffB[i] = (unsigned)Rb * S.ldb + (unsigned)C * 2u; }
    const size_t kstep = (size_t)(BK * 2);
    const size_t hA = (size_t)HALF * S.lda, hB = (size_t)HALF * S.ldb;
    const unsigned ldsw = (unsigned)wid * 1024u;
    const int aoff = lds_byte(wr * 64 + fr, fq * 8), boff = lds_byte(wc * 32 + fr, fq * 8);
#define PG8_SA(b, h) (((b) * 2 + (h)) * HTB)
#define PG8_SB(b, h) ((4 + (b) * 2 + (h)) * HTB)
#define PG8_STAGE(bufoff, gbase, voff) do { _Pragma("unroll") for (int _i = 0; _i < 2; ++_i) \
        __builtin_amdgcn_global_load_lds((const unsigned*)((const char*)(gbase) + (voff)[_i]), (LAS unsigned*)(lds + (bufoff) + ldsw + _i * 8192), 16, 0, 0); } while (0)
#define PG8_LDA(dst, b, h) do { _Pragma("unroll") for (int m = 0; m < 4; ++m) _Pragma("unroll") for (int k = 0; k < 2; ++k) dst[m][k] = *(const LAS bf16x8*)(lds + PG8_SA(b, h) + aoff + m * 2048 + k * 1024); } while (0)
#define PG8_LDB(dst, b, h) do { _Pragma("unroll") for (int n = 0; n < 2; ++n) _Pragma("unroll") for (int k = 0; k < 2; ++k) dst[n][k] = *(const LAS bf16x8*)(lds + PG8_SB(b, h) + boff + n * 2048 + k * 1024); } while (0)
#define PG8_MMA(ai, bj, At, Bt) do { __builtin_amdgcn_s_setprio(1); _Pragma("unroll") for (int m = 0; m < 4; ++m) _Pragma("unroll") for (int n = 0; n < 2; ++n) _Pragma("unroll") for (int k = 0; k < 2; ++k) \
        acc[ai][bj][m][n] = __builtin_amdgcn_mfma_f32_16x16x32_bf16(Bt[n][k], At[m][k], acc[ai][bj][m][n], 0, 0, 0); __builtin_amdgcn_s_setprio(0); } while (0)
#define PG8_WAIT_V(n) asm volatile("s_waitcnt vmcnt(" #n ")" ::: "memory")
#define PG8_WAIT_L(n) asm volatile("s_waitcnt lgkmcnt(" #n ")" ::: "memory")
#define PG8_BAR __builtin_amdgcn_s_barrier()
#define PG8_SCHED __builtin_amdgcn_sched_barrier(0)
    Unit cur, nxt; int ui = 0;
    if (!S.next(0, cur)) return;
    f32x4 acc[2][2][4][2];
#pragma unroll
    for (int a = 0; a < 2; ++a)
#pragma unroll
        for (int b = 0; b < 2; ++b)
#pragma unroll
            for (int m = 0; m < 4; ++m)
#pragma unroll
                for (int n = 0; n < 2; ++n) acc[a][b][m][n] = (f32x4){0.f, 0.f, 0.f, 0.f};
    bf16x8 At[4][2], B0[2][2], B1[2][2];
    const char* cA = cur.A; const char* cB = cur.B;
    PG8_STAGE(PG8_SB(0, 0), cB, voffB); PG8_STAGE(PG8_SB(0, 1), cB + hB, voffB); PG8_STAGE(PG8_SA(0, 0), cA, voffA); PG8_STAGE(PG8_SA(0, 1), cA + hA, voffA);
    if (wr == 1) PG8_BAR;
    PG8_WAIT_V(2); PG8_BAR;
    PG8_STAGE(PG8_SB(1, 0), cB + kstep, voffB); PG8_STAGE(PG8_SA(1, 0), cA + kstep, voffA); PG8_STAGE(PG8_SB(1, 1), cB + hB + kstep, voffB);
    PG8_WAIT_V(6); PG8_BAR;
    for (;;) {
        const bool has_next = S.next(ui + 1, nxt);
        const char* nA = has_next ? nxt.A : cA; const char* nB = has_next ? nxt.B : cB;
        for (int t = 0; t < nt; t += 2) {
            const bool last = (t == nt - 2);
            const char* a1 = cA + (size_t)(t + 1) * kstep;
            const char* a2 = last ? nA : cA + (size_t)(t + 2) * kstep; const char* b2 = last ? nB : cB + (size_t)(t + 2) * kstep;
            const char* a3 = a2 + kstep; const char* b3 = b2 + kstep;
            PG8_LDB(B0, 0, 0); PG8_LDB(B1, 0, 1); PG8_SCHED; PG8_LDA(At, 0, 0); PG8_STAGE(PG8_SA(1, 1), a1 + hA, voffA);
            PG8_WAIT_V(8); PG8_WAIT_L(0); PG8_BAR; PG8_MMA(0, 0, At, B0); PG8_MMA(0, 1, At, B1); PG8_BAR; PG8_SCHED;
            PG8_LDA(At, 0, 1); PG8_STAGE(PG8_SB(0, 0), b2, voffB); PG8_STAGE(PG8_SB(0, 1), b2 + hB, voffB); PG8_STAGE(PG8_SA(0, 0), a2, voffA);
            PG8_WAIT_V(8); PG8_WAIT_L(0); PG8_BAR; PG8_MMA(1, 0, At, B0); PG8_MMA(1, 1, At, B1); PG8_BAR; PG8_SCHED;
            PG8_LDB(B0, 1, 0); PG8_LDB(B1, 1, 1); PG8_SCHED; PG8_LDA(At, 1, 0); PG8_STAGE(PG8_SA(0, 1), a2 + hA, voffA);
            PG8_WAIT_V(8); PG8_WAIT_L(0); PG8_BAR; PG8_MMA(0, 0, At, B0); PG8_MMA(0, 1, At, B1); PG8_BAR; PG8_SCHED;
            PG8_LDA(At, 1, 1); PG8_STAGE(PG8_SB(1, 0), b3, voffB); PG8_STAGE(PG8_SB(1, 1), b3 + hB, voffB); PG8_STAGE(PG8_SA(1, 0), a3, voffA);
            PG8_WAIT_V(8); PG8_WAIT_L(0); PG8_BAR; PG8_MMA(1, 0, At, B0); PG8_MMA(1, 1, At, B1); PG8_BAR; PG8_SCHED;
        }
        if (wr == 0) PG8_BAR;
        E(acc, cur, wr, wc, fr, fq);
        if (!has_next) break;
#pragma unroll
        for (int a = 0; a < 2; ++a)
#pragma unroll
            for (int b = 0; b < 2; ++b)
#pragma unroll
                for (int m = 0; m < 4; ++m)
#pragma unroll
                    for (int n = 0; n < 2; ++n) acc[a][b][m][n] = (f32x4){0.f, 0.f, 0.f, 0.f};
        cur = nxt; cA = nA; cB = nB; ++ui;
        if (wr == 1) PG8_BAR;
    }
    PG8_WAIT_V(0);
    PG8_BAR;
#undef PG8_SA
#undef PG8_SB
#undef PG8_STAGE
#undef PG8_LDA
#undef PG8_LDB
#undef PG8_MMA
#undef PG8_WAIT_V
#undef PG8_WAIT_L
#undef PG8_BAR
#undef PG8_SCHED
}

struct EpiF32 {
    float* C; unsigned ldc; const float* colscale; int c_g; size_t slab_g;
    __device__ __forceinline__ void operator()(const f32x4 (&acc)[2][2][4][2], const Unit& u, int wr, int wc, int fr, int fq) const {
        const int row0 = u.pm * BM + wr * 64 + fr, col0 = u.g * c_g + u.pn * BM + wc * 32 + 8 * fq;
        f32x4 sv[2][2];
#pragma unroll
        for (int bj = 0; bj < 2; ++bj)
#pragma unroll
            for (int n = 0; n < 2; ++n) sv[bj][n] = colscale ? *(const f32x4*)(colscale + col0 + bj * HALF + 4 * n) : (f32x4){1.f, 1.f, 1.f, 1.f};
#pragma unroll
        for (int ai = 0; ai < 2; ++ai)
#pragma unroll
            for (int m = 0; m < 4; ++m) { float* rowp = C + (size_t)u.g * slab_g + (size_t)(row0 + ai * HALF + m * 16) * ldc + col0;
#pragma unroll
                for (int bj = 0; bj < 2; ++bj) { *(f32x4*)(rowp + bj * HALF) = acc[ai][bj][m][0] * sv[bj][0]; *(f32x4*)(rowp + bj * HALF + 4) = acc[ai][bj][m][1] * sv[bj][1]; } }
    }
};
struct EpiY {
    bf16_t* C; unsigned ldc; const float* colscale; int c_g;
    __device__ __forceinline__ void operator()(const f32x4 (&acc)[2][2][4][2], const Unit& u, int wr, int wc, int fr, int fq) const {
        const int row0 = u.pm * BM + wr * 64 + fr, col0 = u.g * c_g + u.pn * BM + wc * 32 + 8 * fq;
        f32x4 sv[2][2];
#pragma unroll
        for (int bj = 0; bj < 2; ++bj)
#pragma unroll
            for (int n = 0; n < 2; ++n) sv[bj][n] = colscale ? *(const f32x4*)(colscale + col0 + bj * HALF + 4 * n) : (f32x4){1.f, 1.f, 1.f, 1.f};
#pragma unroll
        for (int ai = 0; ai < 2; ++ai)
#pragma unroll
            for (int m = 0; m < 4; ++m) { bf16_t* rowp = C + (size_t)(row0 + ai * HALF + m * 16) * ldc + col0;
#pragma unroll
                for (int bj = 0; bj < 2; ++bj) { const f32x4 v0 = acc[ai][bj][m][0] * sv[bj][0], v1 = acc[ai][bj][m][1] * sv[bj][1];
                    u32x4 w; w.x = cvt_pk_bf16(v0[0], v0[1]); w.y = cvt_pk_bf16(v0[2], v0[3]); w.z = cvt_pk_bf16(v1[0], v1[1]); w.w = cvt_pk_bf16(v1[2], v1[3]);
                    *(u32x4*)(rowp + bj * HALF) = w; } }
    }
};
template <int ACT> struct EpiBf16 {
    bf16_t* C; unsigned ldc; int row_g;
    __device__ __forceinline__ void operator()(const f32x4 (&acc)[2][2][4][2], const Unit& u, int wr, int wc, int fr, int fq) const {
        const int row0 = u.g * row_g + u.pm * BM + wr * 64 + fr, col0 = u.pn * BM + wc * 32 + 8 * fq;
#pragma unroll
        for (int ai = 0; ai < 2; ++ai)
#pragma unroll
            for (int m = 0; m < 4; ++m) { bf16_t* rowp = C + (size_t)(row0 + ai * HALF + m * 16) * ldc + col0;
#pragma unroll
                for (int bj = 0; bj < 2; ++bj) { f32x4 v0 = acc[ai][bj][m][0], v1 = acc[ai][bj][m][1];
                    if (ACT == 1) {
#pragma unroll
                        for (int e = 0; e < 4; ++e) { const float a = fmaxf(v0[e], 0.f), b = fmaxf(v1[e], 0.f); v0[e] = a * a; v1[e] = b * b; } }
                    u32x4 w; w.x = cvt_pk_bf16(v0[0], v0[1]); w.y = cvt_pk_bf16(v0[2], v0[3]); w.z = cvt_pk_bf16(v1[0], v1[1]); w.w = cvt_pk_bf16(v1[2], v1[3]);
                    *(u32x4*)(rowp + bj * HALF) = w; } }
    }
};
struct EpiFA {
    bf16_t* YT; bf16_t* YTC;
    __device__ __forceinline__ void operator()(const f32x4 (&acc)[2][2][4][2], const Unit& u, int wr, int wc, int fr, int fq) const {
        const int cs = u.pm >> 1, k2b = (u.pm & 1) * 256;
        bf16_t* base; size_t pitch;
        if (u.pn < 32) { const int b = u.pn >> 3; base = YT + (size_t)(u.g * 512 + k2b) * 16384 + b * 4096 + cs * 2048 + (u.pn & 7) * 256; pitch = 16384; }
        else { const int b = u.pn - 32; base = YTC + (size_t)(u.g * 512 + k2b) * 2048 + b * 512 + cs * 256; pitch = 2048; }
        const int row0 = wr * 64 + fr, col0 = wc * 32 + 8 * fq;
#pragma unroll
        for (int ai = 0; ai < 2; ++ai)
#pragma unroll
            for (int m = 0; m < 4; ++m) { bf16_t* rowp = base + (size_t)(row0 + ai * HALF + m * 16) * pitch + col0;
#pragma unroll
                for (int bj = 0; bj < 2; ++bj) { const f32x4 v0 = acc[ai][bj][m][0], v1 = acc[ai][bj][m][1];
                    u32x4 w; w.x = cvt_pk_bf16(v0[0], v0[1]); w.y = cvt_pk_bf16(v0[2], v0[3]); w.z = cvt_pk_bf16(v1[0], v1[1]); w.w = cvt_pk_bf16(v1[2], v1[3]);
                    *(u32x4*)(rowp + bj * HALF) = w; } }
    }
};
struct EpiQKV {
    bf16_t* Q; const float* rope;
    __device__ __forceinline__ void operator()(const f32x4 (&acc)[2][2][4][2], const Unit& u, int wr, int wc, int fr, int fq) const {
        const int part = u.pn >> 3;
        bf16_t* dst = Q + (size_t)part * ((WS_K - WS_Q) / 2);
        const int row0 = u.pm * BM + wr * 64 + fr, colp = (u.pn & 7) * BM + wc * 32 + 8 * fq;
        const bool dorope = (part < 2) && (u.pm < 32);
        const float sc = part == 0 ? QSCALE : 1.f;
#pragma unroll
        for (int ai = 0; ai < 2; ++ai)
#pragma unroll
            for (int m = 0; m < 4; ++m) { const int row = row0 + ai * HALF + m * 16; bf16_t* rowp = dst + (size_t)row * D + colp;
                const int t = row & 2047, prow = t >> 6, pcol = t & 63;
#pragma unroll
                for (int bj = 0; bj < 2; ++bj) { f32x4 v0 = acc[ai][bj][m][0], v1 = acc[ai][bj][m][1];
                    if (dorope) { const int c = colp + bj * HALF, j0 = (c & 63) >> 1, ax = j0 >> 4, f0 = j0 & 15;
                        const float* cs = rope + ((ax ? pcol : prow) * 16 + f0) * 2;
                        const f32x4 cs0 = *(const f32x4*)cs, cs1 = *(const f32x4*)(cs + 4);
                        f32x4 r0, r1;
                        r0[0] = v0[0] * cs0[0] - v0[1] * cs0[1]; r0[1] = v0[0] * cs0[1] + v0[1] * cs0[0];
                        r0[2] = v0[2] * cs0[2] - v0[3] * cs0[3]; r0[3] = v0[2] * cs0[3] + v0[3] * cs0[2];
                        r1[0] = v1[0] * cs1[0] - v1[1] * cs1[1]; r1[1] = v1[0] * cs1[1] + v1[1] * cs1[0];
                        r1[2] = v1[2] * cs1[2] - v1[3] * cs1[3]; r1[3] = v1[2] * cs1[3] + v1[3] * cs1[2];
                        v0 = r0; v1 = r1; }
                    v0 = v0 * sc; v1 = v1 * sc;
                    u32x4 w; w.x = cvt_pk_bf16(v0[0], v0[1]); w.y = cvt_pk_bf16(v0[2], v0[3]); w.z = cvt_pk_bf16(v1[0], v1[1]); w.w = cvt_pk_bf16(v1[2], v1[3]);
                    *(u32x4*)(rowp + bj * HALF) = w; } }
    }
};
}


namespace att {
__device__ __forceinline__ unsigned off_a(unsigned row, unsigned ch) { return 2048u * (row >> 3) + 512u * (ch >> 2) + 64u * (row & 7) + 16u * ((ch & 3) ^ ((row >> 2) & 3)); }
constexpr int KBUF = 0, VBUF = 32768, QOFF = 65536, WSF_OFF = LDSCTL_OFF + 1024;
constexpr float THR = 6.0f;
struct Args { const bf16_t* Q; const bf16_t* K; const bf16_t* V; bf16_t* O; const float* gsub; float lam, post; };
__device__ __forceinline__ s16x4 vtr(const LAS unsigned char* p) { return __builtin_bit_cast(s16x4, __builtin_amdgcn_ds_read_tr16_b64_v4i16((LAS s16x4*)p)); }
__device__ __forceinline__ float half_max(float v) { auto rr = __builtin_amdgcn_permlane32_swap(__float_as_uint(v), __float_as_uint(v), false, false); return fmaxf(__uint_as_float(rr[0]), __uint_as_float(rr[1])); }
__device__ __forceinline__ float half_sum(float v) { auto rr = __builtin_amdgcn_permlane32_swap(__float_as_uint(v), __float_as_uint(v), false, false); return __uint_as_float(rr[0]) + __uint_as_float(rr[1]); }

__device__ __forceinline__ void glds16(const void* gsrc, unsigned lds_dst) { unsigned keep;
    asm volatile("s_mov_b32 %0, m0\n\ts_mov_b32 m0, %2\n\ts_nop 0\n\tglobal_load_lds_dwordx4 %1, off\n\ts_mov_b32 m0, %0" : "=&s"(keep) : "v"(gsrc), "s"(lds_dst) : "memory"); }
__device__ __forceinline__ float max3f(float a, float b, float c) { float r; asm("v_max3_f32 %0, %1, %2, %3" : "=v"(r) : "v"(a), "v"(b), "v"(c)); return r; }
__device__ __forceinline__ float max2f(float a, float b) { float r; asm("v_max_f32_e32 %0, %1, %2" : "=v"(r) : "v"(a), "v"(b)); return r; }
__device__ __forceinline__ float fsub_s(float a, float b) { float r; asm("v_sub_f32_e32 %0, %1, %2" : "=v"(r) : "v"(a), "v"(b)); return r; }
__device__ __forceinline__ float fadd_s(float a, float b) { float r; asm("v_add_f32_e32 %0, %1, %2" : "=v"(r) : "v"(a), "v"(b)); return r; }
typedef __bf16 bf16x2_t __attribute__((ext_vector_type(2)));
__device__ __forceinline__ unsigned cvtpk_b(float lo, float hi) { const f32x2 v = {lo, hi}; const bf16x2_t b = __builtin_convertvector(v, bf16x2_t); return __builtin_bit_cast(unsigned, b); }
__device__ __forceinline__ void unit(LAS unsigned char* lds, const Args& P, int b, int h, int q0, int nlat) {
    const int tid = threadIdx.x, lane = tid & 63, r32 = lane & 31, hi = lane >> 5; const int wid = __builtin_amdgcn_readfirstlane(tid >> 6);
    const int nt = nlat + 4;
    LAS unsigned char* Qs = lds + QOFF + wid * 8192;
    LAS float* wsf = (LAS float*)(lds + WSF_OFF + wid * 256);
    {   const bf16_t* qrow = P.Q + (size_t)(q0 + wid * 32 + r32) * D + h * 128 + hi * 8;
#pragma unroll
        for (int c = 0; c < 2; ++c)
#pragma unroll
            for (int d0 = 0; d0 < 4; ++d0) { const u32x4 v = *(const u32x4*)(qrow + c * 64 + d0 * 16); *(LAS u32x4*)(Qs + ((c * 4 + d0) * 2 + hi) * 512 + r32 * 16) = v; } }
    unsigned goff[2];
#pragma unroll
    for (int i = 0; i < 2; ++i) { const unsigned p = 2 * wid + i, rg = p >> 1, chq = (p & 1) * 2 + (lane >> 5), r7 = (lane >> 2) & 7, x = lane & 3, rsw = (r7 >> 2) | ((rg & 1) << 1);
        goff[i] = ((8 * rg + r7) * D + h * 128 + (4 * chq + (x ^ rsw)) * 8) * 2; }
#define ATT_GROW(t) ((t) < nlat ? b * SEQ + 64 * (t) : ML + b * CL + 64 * ((t) - nlat))
#define ATT_DMA(t, buf) do { const size_t g_ = (size_t)ATT_GROW(t) * D * 2; _Pragma("unroll") for (int i_ = 0; i_ < 2; ++i_) { \
        glds16((const char*)P.K + g_ + goff[i_], (unsigned)__builtin_amdgcn_readfirstlane(lds0 + KBUF + (buf) * 16384 + (2 * wid + i_) * 1024)); \
        glds16((const char*)P.V + g_ + goff[i_], (unsigned)__builtin_amdgcn_readfirstlane(lds0 + VBUF + (buf) * 16384 + (2 * wid + i_) * 1024)); } } while (0)
    const unsigned lds0 = (unsigned)(uintptr_t)lds;
    ATT_DMA(0, 0);
    unsigned kb[2];
#pragma unroll
    for (int e = 0; e < 2; ++e) kb[e] = 2048u * (r32 >> 3) + 64u * (r32 & 7) + 16u * ((unsigned)(2 * e + hi) ^ ((r32 >> 2) & 3));
    const unsigned blk = (lane >> 4) & 1, q_ = (lane & 15) >> 2, p_ = lane & 3;
    unsigned vb[2];
#pragma unroll
    for (int t = 0; t < 2; ++t) vb[t] = 2048u * t + 64u * (4 * hi + q_) + 16u * ((2 * blk + (p_ >> 1)) ^ ((2 * t + hi) & 3)) + 8u * (p_ & 1);
    float m0 = -1e30f, m1 = -1e30f, l0 = 0.f, l1 = 0.f;
    f32x16 o[2][4];
#pragma unroll
    for (int c = 0; c < 2; ++c)
#pragma unroll
        for (int d = 0; d < 4; ++d) o[c][d] = f32x16{};
    asm volatile("s_waitcnt vmcnt(0)" ::: "memory");
    __syncthreads();
#define SB() __builtin_amdgcn_sched_barrier(0)
#define ATT_SMB(S0, S1, i, M, SUM, PW) do { const float a_ = (i) < 8 ? S0[2 * ((i) & 7)] : S1[2 * ((i) & 7)], b_ = (i) < 8 ? S0[2 * ((i) & 7) + 1] : S1[2 * ((i) & 7) + 1]; \
        const float ea_ = __builtin_amdgcn_exp2f(fsub_s(a_, M)), eb_ = __builtin_amdgcn_exp2f(fsub_s(b_, M)); SUM += ea_; SUM += eb_; PW[i] = cvtpk_b(ea_, eb_); asm volatile("" : "+v"(SUM), "+v"(PW[i])); } while (0)
#define ATT_SMA(S0, S1, c, MC, LC) do { asm volatile("s_nop 15\n\ts_nop 7" : "+v"(S0), "+v"(S1)); \
        float a_ = max3f(S0[0], S0[1], S1[0]), b_ = max3f(S0[2], S0[3], S1[1]); a_ = max3f(a_, S1[2], S1[3]); \
        _Pragma("unroll") for (int r_ = 4; r_ < 16; r_ += 4) { a_ = max3f(a_, S0[r_], S0[r_ + 1]); b_ = max3f(b_, S0[r_ + 2], S0[r_ + 3]); a_ = max3f(a_, S1[r_], S1[r_ + 1]); b_ = max3f(b_, S1[r_ + 2], S1[r_ + 3]); } \
        const float mx_ = half_max(max2f(a_, b_)); \
        if (__any(mx_ - MC > THR)) { const float mn_ = fmaxf(MC, mx_), al_ = __builtin_amdgcn_exp2f(MC - mn_); MC = mn_; LC *= al_; if (hi == 0) wsf[r32] = al_; \
            _Pragma("unroll") for (int g4 = 0; g4 < 4; ++g4) { const f32x4 a4 = *(const LAS f32x4*)(wsf + 8 * g4 + 4 * hi); \
                _Pragma("unroll") for (int d = 0; d < 4; ++d) { o[c][d][4 * g4 + 0] *= a4[0]; o[c][d][4 * g4 + 1] *= a4[1]; o[c][d][4 * g4 + 2] *= a4[2]; o[c][d][4 * g4 + 3] *= a4[3]; } } } } while (0)
#define ATT_LDQK(c, d0, QF, K0, K1) do { QF = *(const LAS bf16x8*)(Qs + (((c) * 4 + (d0)) * 2 + hi) * 512 + r32 * 16); \
        K0 = *(const LAS bf16x8*)(Kb + kb[(d0) & 1] + 512 * (2 * (c) + ((d0) >> 1))); K1 = *(const LAS bf16x8*)(Kb + kb[(d0) & 1] + 512 * (2 * (c) + ((d0) >> 1)) + 8192); } while (0)
#define ATT_LDV(i, LO, HH) do { LO = vtr(Vb + vb[0] + 4096 * ((i) >> 2) + 512 * ((i) & 3)); HH = vtr(Vb + vb[1] + 4096 * ((i) >> 2) + 512 * ((i) & 3)); } while (0)
#define ATT_VF(LO, HH) ((bf16x8){LO[0], LO[1], LO[2], LO[3], HH[0], HH[1], HH[2], HH[3]})
#define ATT_PA(PW, ks) ((bf16x8)__builtin_bit_cast(bf16x8, (u32x4){PW[4 * (ks)], PW[4 * (ks) + 1], PW[4 * (ks) + 2], PW[4 * (ks) + 3]}))
#pragma unroll 1
    for (int t = 0; t < nt; ++t) {
        const int buf = t & 1;
        if (t + 1 < nt) ATT_DMA(t + 1, buf ^ 1);
        const LAS unsigned char* Kb = lds + KBUF + buf * 16384; const LAS unsigned char* Vb = lds + VBUF + buf * 16384;
        unsigned pw0[16], pw1[16];
        f32x16 sa = f32x16{}, sb = f32x16{};
        SB();
        {   bf16x8 qfA, k0A, k1A, qfB, k0B, k1B;
            ATT_LDQK(0, 0, qfA, k0A, k1A); ATT_LDQK(0, 1, qfB, k0B, k1B); SB();
            sa = __builtin_amdgcn_mfma_f32_32x32x16_bf16(k0A, qfA, sa, 0, 0, 0); sb = __builtin_amdgcn_mfma_f32_32x32x16_bf16(k1A, qfA, sb, 0, 0, 0); SB();
            ATT_LDQK(0, 2, qfA, k0A, k1A); SB();
            sa = __builtin_amdgcn_mfma_f32_32x32x16_bf16(k0B, qfB, sa, 0, 0, 0); sb = __builtin_amdgcn_mfma_f32_32x32x16_bf16(k1B, qfB, sb, 0, 0, 0); SB();
            ATT_LDQK(0, 3, qfB, k0B, k1B); SB();
            sa = __builtin_amdgcn_mfma_f32_32x32x16_bf16(k0A, qfA, sa, 0, 0, 0); sb = __builtin_amdgcn_mfma_f32_32x32x16_bf16(k1A, qfA, sb, 0, 0, 0); SB();
            sa = __builtin_amdgcn_mfma_f32_32x32x16_bf16(k0B, qfB, sa, 0, 0, 0); sb = __builtin_amdgcn_mfma_f32_32x32x16_bf16(k1B, qfB, sb, 0, 0, 0); }
        SB();
        ATT_SMA(sa, sb, 0, m0, l0);
        SB();
        f32x16 ta = f32x16{}, tb = f32x16{};
        {   bf16x8 qf, k0, k1; float sum = 0.f;
            ATT_LDQK(1, 0, qf, k0, k1); SB();
#define ATT_C(d0) do { ta = __builtin_amdgcn_mfma_f32_32x32x16_bf16(k0, qf, ta, 0, 0, 0); SB(); \
            if ((d0) < 3) k0 = *(const LAS bf16x8*)(Kb + kb[((d0) + 1) & 1] + 512 * (2 + (((d0) + 1) >> 1))); \
            ATT_SMB(sa, sb, 4 * (d0) + 0, m0, sum, pw0); ATT_SMB(sa, sb, 4 * (d0) + 1, m0, sum, pw0); SB(); \
            tb = __builtin_amdgcn_mfma_f32_32x32x16_bf16(k1, qf, tb, 0, 0, 0); SB(); \
            if ((d0) < 3) { qf = *(const LAS bf16x8*)(Qs + ((4 + (d0) + 1) * 2 + hi) * 512 + r32 * 16); k1 = *(const LAS bf16x8*)(Kb + kb[((d0) + 1) & 1] + 512 * (2 + (((d0) + 1) >> 1)) + 8192); } \
            ATT_SMB(sa, sb, 4 * (d0) + 2, m0, sum, pw0); ATT_SMB(sa, sb, 4 * (d0) + 3, m0, sum, pw0); SB(); } while (0)
            ATT_C(0); ATT_C(1); ATT_C(2); ATT_C(3);
#undef ATT_C
            l0 += sum; }
        ATT_SMA(ta, tb, 1, m1, l1);
        SB();
        {   s16x4 loA, hhA, loB, hhB, loC, hhC; float sum = 0.f;
            ATT_LDV(0, loA, hhA); ATT_LDV(1, loB, hhB); SB();
#define ATT_E(i, LOc, HHc, LOn, HHn) do { if ((i) + 2 < 16) ATT_LDV((i) + 2, LOn, HHn); SB(); \
            o[0][(i) & 3] = __builtin_amdgcn_mfma_f32_32x32x16_bf16(ATT_PA(pw0, (i) >> 2), ATT_VF(LOc, HHc), o[0][(i) & 3], 0, 0, 0); SB(); ATT_SMB(ta, tb, i, m1, sum, pw1); SB(); } while (0)
            ATT_E(0, loA, hhA, loC, hhC); ATT_E(1, loB, hhB, loA, hhA); ATT_E(2, loC, hhC, loB, hhB);
            ATT_E(3, loA, hhA, loC, hhC); ATT_E(4, loB, hhB, loA, hhA); ATT_E(5, loC, hhC, loB, hhB);
            ATT_E(6, loA, hhA, loC, hhC); ATT_E(7, loB, hhB, loA, hhA); ATT_E(8, loC, hhC, loB, hhB);
            ATT_E(9, loA, hhA, loC, hhC); ATT_E(10, loB, hhB, loA, hhA); ATT_E(11, loC, hhC, loB, hhB);
            ATT_E(12, loA, hhA, loC, hhC); ATT_E(13, loB, hhB, loA, hhA); ATT_E(14, loC, hhC, loB, hhB);
            ATT_E(15, loA, hhA, loC, hhC);
#undef ATT_E
            l1 += sum; }
#pragma unroll
        for (int ks = 0; ks < 4; ++ks) {
            s16x4 lo[4], hh[4];
#pragma unroll
            for (int d = 0; d < 4; ++d) ATT_LDV(4 * ks + d, lo[d], hh[d]);
#pragma unroll
            for (int d = 0; d < 4; ++d) o[1][d] = __builtin_amdgcn_mfma_f32_32x32x16_bf16(ATT_PA(pw1, ks), ATT_VF(lo[d], hh[d]), o[1][d], 0, 0, 0);
            SB();
        }
        asm volatile("s_waitcnt vmcnt(0)" ::: "memory");
        __syncthreads();
    }
#undef ATT_SMB
#undef ATT_SMA
#undef ATT_LDQK
#undef ATT_LDV
#undef ATT_VF
#undef ATT_PA
#undef SB
#undef ATT_GROW
#undef ATT_DMA
    l0 = half_sum(l0); l1 = half_sum(l1);
    if (hi == 0) { wsf[r32] = 1.0f / l0; wsf[32 + r32] = P.lam / l1; }
    float ss[16];
#pragma unroll
    for (int r = 0; r < 16; ++r) ss[r] = 0.f;
#pragma unroll
    for (int g4 = 0; g4 < 4; ++g4) { const f32x4 a4 = *(const LAS f32x4*)(wsf + 8 * g4 + 4 * hi), b4 = *(const LAS f32x4*)(wsf + 32 + 8 * g4 + 4 * hi);
#pragma unroll
        for (int d = 0; d < 4; ++d)
#pragma unroll
            for (int e = 0; e < 4; ++e) { const float v = o[0][d][4 * g4 + e] * a4[e] - o[1][d][4 * g4 + e] * b4[e]; o[0][d][4 * g4 + e] = v; ss[4 * g4 + e] += v * v; } }
#pragma unroll
    for (int r = 0; r < 16; ++r) {
        float v = ss[r];
#pragma unroll
        for (int s = 1; s < 32; s <<= 1) v += __shfl_xor(v, s);
        ss[r] = (1.0f / sqrtf(v * (1.0f / 128.0f) + SUBLN_EPS)) * P.post;
    }
    bf16_t* Ow = P.O + (size_t)(q0 + wid * 32) * D + h * 128 + r32;
#pragma unroll
    for (int d = 0; d < 4; ++d) { const float gs = P.gsub[32 * d + r32];
#pragma unroll
        for (int r = 0; r < 16; ++r) { const int row = (r & 3) + 8 * (r >> 2) + 4 * hi; const float v = o[0][d][r] * ss[r] * gs;
            Ow[(size_t)row * D + 32 * d] = (bf16_t)(cvt_pk_bf16(v, 0.f) & 0xffffu); } }
    __syncthreads();
}
}

struct ThinArgs {
    const float* xin_lat; const float* xin_ctx;
    const bf16_t* y;
    float* xout_lat; float* xout_ctx;
    const float* g_post; const float* gate;
    bf16_t* uout;
    const float* g_pre; const float* sc; const float* sh;
    const float* yc; int nslab;
    int nrows;
};
__device__ __forceinline__ void thin_phase(const ThinArgs& T, int gw, int ngw, int lane) {
#pragma unroll 1
    for (int row = gw; row < T.nrows; row += ngw) {
        const int mrow = row < ML ? (row >> 11) : 4;
        const float* xr = row < ML ? T.xin_lat + (size_t)row * D : T.xin_ctx + (size_t)(row - ML) * D;
        f32x4 xv[8];
#pragma unroll
        for (int j = 0; j < 8; ++j) xv[j] = *(const f32x4*)(xr + 256 * j + 4 * lane);
        if (T.y) {
            f32x4 yv[8]; float s = 0.f;
            if (row >= ML && T.nslab > 0) {
                const float* yr = T.yc + (size_t)(row - ML) * D;
#pragma unroll
                for (int j = 0; j < 8; ++j) yv[j] = *(const f32x4*)(yr + 256 * j + 4 * lane);
#pragma unroll 1
                for (int sl = 1; sl < T.nslab; ++sl) { yr += (size_t)MC * D;
#pragma unroll
                    for (int j = 0; j < 8; ++j) yv[j] = yv[j] + *(const f32x4*)(yr + 256 * j + 4 * lane); }
            } else {
                const bf16_t* yr = T.y + (size_t)row * D;
#pragma unroll
                for (int j = 0; j < 8; ++j) { const u32x2 v = *(const u32x2*)(yr + 256 * j + 4 * lane);
                    yv[j][0] = __uint_as_float(v.x << 16); yv[j][1] = __uint_as_float(v.x & 0xffff0000u); yv[j][2] = __uint_as_float(v.y << 16); yv[j][3] = __uint_as_float(v.y & 0xffff0000u); }
            }
#pragma unroll
            for (int j = 0; j < 8; ++j) s += (yv[j][0] * yv[j][0] + yv[j][1] * yv[j][1]) + (yv[j][2] * yv[j][2] + yv[j][3] * yv[j][3]);
            const float rs = 1.0f / sqrtf(wave_sum(s) * (1.0f / D) + NORM_EPS);
            const float* gt = T.gate + (size_t)mrow * MODROW;
#pragma unroll
            for (int j = 0; j < 8; ++j) { const f32x4 g = *(const f32x4*)(T.g_post + 256 * j + 4 * lane), a = *(const f32x4*)(gt + 256 * j + 4 * lane); xv[j] = xv[j] + a * ((yv[j] * rs) * g); }
            float* xo = row < ML ? (T.xout_lat ? T.xout_lat + (size_t)row * D : nullptr) : (T.xout_ctx ? T.xout_ctx + (size_t)(row - ML) * D : nullptr);
            if (xo) {
#pragma unroll
                for (int j = 0; j < 8; ++j) *(f32x4*)(xo + 256 * j + 4 * lane) = xv[j]; }
        }
        if (T.uout) {
            float s = 0.f;
#pragma unroll
            for (int j = 0; j < 8; ++j) s += (xv[j][0] * xv[j][0] + xv[j][1] * xv[j][1]) + (xv[j][2] * xv[j][2] + xv[j][3] * xv[j][3]);
            const float rs = 1.0f / sqrtf(wave_sum(s) * (1.0f / D) + NORM_EPS);
            const float* scp = T.sc + (size_t)mrow * MODROW; const float* shp = T.sh + (size_t)mrow * MODROW;
            bf16_t* uo = T.uout + (size_t)row * D;
#pragma unroll
            for (int j = 0; j < 8; ++j) { const f32x4 g = *(const f32x4*)(T.g_pre + 256 * j + 4 * lane), a = *(const f32x4*)(scp + 256 * j + 4 * lane), c = *(const f32x4*)(shp + 256 * j + 4 * lane);
                const f32x4 u = ((xv[j] * rs) * g) * (a + 1.0f) + c;
                u32x2 w; w.x = cvt_pk_bf16(u[0], u[1]); w.y = cvt_pk_bf16(u[2], u[3]); *(u32x2*)(uo + 256 * j + 4 * lane) = w; }
        }
    }
}
__device__ __forceinline__ void pool_phase(const bf16_t* U, bf16_t* Dm, int nrows, int gw, int ngw, int lane) {
    for (int row = gw; row < nrows; row += ngw) {
        int base, t, Ls;
        if (row < ML) { base = row & ~2047; t = row & 2047; Ls = SEQ; } else { const int i = row - ML; base = ML + (i & ~255); t = i & 255; Ls = CL; }
#pragma unroll
        for (int j = 0; j < 8; ++j) {
            const int w = 2 << (j >> 1); int lo = t - (w >> 1), hi = lo + w; lo = lo < 0 ? 0 : lo; hi = hi > Ls ? Ls : hi;
            const bf16_t* p = U + (size_t)base * D + 256 * j + 4 * lane;
            f32x4 s = {0.f, 0.f, 0.f, 0.f};
            for (int tt = lo; tt < hi; ++tt) { const u32x2 v = *(const u32x2*)(p + (size_t)tt * D);
                s[0] += __uint_as_float(v.x << 16); s[1] += __uint_as_float(v.x & 0xffff0000u); s[2] += __uint_as_float(v.y << 16); s[3] += __uint_as_float(v.y & 0xffff0000u); }
            const u32x2 cv = *(const u32x2*)(p + (size_t)t * D);
            const float inv = 1.0f / (float)(hi - lo);
            f32x4 d; d[0] = s[0] * inv - __uint_as_float(cv.x << 16); d[1] = s[1] * inv - __uint_as_float(cv.x & 0xffff0000u); d[2] = s[2] * inv - __uint_as_float(cv.y << 16); d[3] = s[3] * inv - __uint_as_float(cv.y & 0xffff0000u);
            u32x2 o; o.x = cvt_pk_bf16(d[0], d[1]); o.y = cvt_pk_bf16(d[2], d[3]);
            *(u32x2*)(Dm + (size_t)row * D + 256 * j + 4 * lane) = o;
        }
    }
}

__device__ __forceinline__ void transpose_item(const float* W, int K, int N, bf16_t* WT, int row_off, LAS float* scr, int item, int lane, bool qkperm) {
    const int nblk = N / 64, kb = item / nblk, nb = item % nblk, k0 = 64 * kb, n0 = 64 * nb;
    const int kq = lane >> 4, n4 = lane & 15;
    f32x4 v[16];
#pragma unroll
    for (int i = 0; i < 16; ++i) v[i] = *(const f32x4*)(W + (size_t)(k0 + 4 * i + kq) * N + n0 + 4 * n4);
#pragma unroll
    for (int i = 0; i < 16; ++i) { LAS float* s = scr + (4 * i + kq) * 65 + 4 * n4; s[0] = v[i][0]; s[1] = v[i][1]; s[2] = v[i][2]; s[3] = v[i][3]; }
    asm volatile("s_waitcnt lgkmcnt(0)" ::: "memory");
    const int c = lane & 7;
#pragma unroll
    for (int j = 0; j < 8; ++j) { const int n = (lane >> 3) + 8 * j; int sc = n;
        if (qkperm) { const int jj = n >> 1, which = n & 1, ax = jj >> 4, f = jj & 15; sc = ax * 32 + which * 16 + f; }
        const LAS float* s = scr + (8 * c) * 65 + sc;
        u32x4 o; o.x = cvt_pk_bf16(s[0 * 65], s[1 * 65]); o.y = cvt_pk_bf16(s[2 * 65], s[3 * 65]); o.z = cvt_pk_bf16(s[4 * 65], s[5 * 65]); o.w = cvt_pk_bf16(s[6 * 65], s[7 * 65]);
        *(u32x4*)(WT + (size_t)(row_off + n0 + n) * K + k0 + 8 * c) = o; }
    asm volatile("s_waitcnt lgkmcnt(0)" ::: "memory");
}

struct Params {
    const float* in[22];
    float* out; unsigned char* ws;
    float lam_init0, lam_init3;
    int ph_lo, ph_hi;
};

__device__ __forceinline__ void prologue(const Params& P, LAS unsigned char* lds, int tid, int wave, int lane, int vcu, int G) {
    unsigned char* ws = P.ws;
    const float* c_in = P.in[1]; const float* cctx = P.in[3]; const float* w_mod = P.in[4]; const float* b_mod = P.in[5];
    LAS float* sil = (LAS float*)lds;
    LAS float* red = (LAS float*)(lds + 65536);
    for (int i = tid; i < 5 * D; i += NTHR) { const int r = i / D, k = i % D; const float x = r < 4 ? c_in[r * D + k] : cctx[k]; sil[k * 8 + r] = x / (1.0f + __expf(-x)); }
    __syncthreads();
    float* mod = (float*)(ws + WS_MOD);
    for (int item = blockIdx.x; item < 4 * 192; item += G) {
        const int l = item / 192, col = (item % 192) * 64 + lane;
        const float* W = w_mod + (size_t)l * D * MODROW + col;
        float a0 = 0.f, a1 = 0.f, a2 = 0.f, a3 = 0.f, a4 = 0.f;
        const int k0 = wave * 256;
        for (int kk = 0; kk < 256; kk += 16) {
            float w[16];
#pragma unroll
            for (int j = 0; j < 16; ++j) w[j] = W[(size_t)(k0 + kk + j) * MODROW];
#pragma unroll
            for (int j = 0; j < 16; ++j) { const f32x4 s4 = *(const LAS f32x4*)(sil + (k0 + kk + j) * 8); const float s5 = sil[(k0 + kk + j) * 8 + 4];
                a0 += s4[0] * w[j]; a1 += s4[1] * w[j]; a2 += s4[2] * w[j]; a3 += s4[3] * w[j]; a4 += s5 * w[j]; }
        }
        red[(wave * 5 + 0) * 64 + lane] = a0; red[(wave * 5 + 1) * 64 + lane] = a1; red[(wave * 5 + 2) * 64 + lane] = a2; red[(wave * 5 + 3) * 64 + lane] = a3; red[(wave * 5 + 4) * 64 + lane] = a4;
        __syncthreads();
        if (wave < 5) { float s = b_mod[l * MODROW + col];
#pragma unroll
            for (int w8 = 0; w8 < 8; ++w8) s += red[(w8 * 5 + wave) * 64 + lane];
            mod[((size_t)l * 5 + wave) * MODROW + col] = s; }
        __syncthreads();
    }
    LAS float* scr = (LAS float*)(lds + wave * 16640);
    const int gw = vcu * NWAVES + wave, NGW = G * NWAVES;
    bf16_t* Wqkv = (bf16_t*)(ws + WS_WQKV); bf16_t* Wo = (bf16_t*)(ws + WS_WO); bf16_t* Wf = (bf16_t*)(ws + WS_WF); bf16_t* Wp = (bf16_t*)(ws + WS_WPOOL);
    bf16_t* W1 = (bf16_t*)(ws + WS_W1); bf16_t* W2 = (bf16_t*)(ws + WS_W2);
    constexpr int I_QKV = (D / 64) * (3 * D / 64), I_O = (D / 64) * (D / 64), I_P = 8 * 8, I_1 = (D / 64) * (FF / 64), I_2 = (FF / 64) * (D / 64);
    constexpr int NITEMS = 2 * I_QKV + 2 * I_O + I_O + 4 * I_P + 4 * I_1 + 4 * I_2;
    for (int it = gw; it < NITEMS; it += NGW) {
        int r = it;
        if (r < 2 * I_QKV) { const int ia = r / I_QKV; r %= I_QKV; const int nb = r % (3 * D / 64);
            transpose_item(P.in[10] + (size_t)ia * D * 3 * D, D, 3 * D, Wqkv + (size_t)ia * 3 * D * D, 0, scr, r, lane, nb < 2 * D / 64); continue; } r -= 2 * I_QKV;
        if (r < 2 * I_O) { const int ia = r / I_O; r %= I_O; transpose_item(P.in[11] + (size_t)ia * D * D, D, D, Wo + (size_t)ia * D * D, 0, scr, r, lane, false); continue; } r -= 2 * I_O;
        if (r < I_O) { transpose_item(P.in[17], D, D, Wf, 0, scr, r, lane, false); continue; } r -= I_O;
        if (r < 4 * I_P) { const int g = r / I_P; r %= I_P; transpose_item(P.in[18] + (size_t)g * 512 * 512, 512, 512, Wp + (size_t)g * 512 * 512, 0, scr, r, lane, false); continue; } r -= 4 * I_P;
        if (r < 4 * I_1) { const int l = r / I_1; r %= I_1; transpose_item(P.in[20] + (size_t)l * D * FF, D, FF, W1 + (size_t)l * FF * D, 0, scr, r, lane, false); continue; } r -= 4 * I_1;
        { const int l = r / I_2; r %= I_2; transpose_item(P.in[21] + (size_t)l * FF * D, FF, D, W2 + (size_t)l * D * FF, 0, scr, r, lane, false); }
    }
    {   bf16_t* T1 = (bf16_t*)(ws + WS_T1); bf16_t* A2 = (bf16_t*)(ws + WS_A2); bf16_t* A2C = (bf16_t*)(ws + WS_A2C);
        constexpr int C_T1 = 1024 * 512 / 8, C_A2 = 2048 * 4096 / 8, C_A2C = 256 * 512 / 8;
        const int gt = gw * 64 + lane, NGT = NGW * 64;
        for (int ch = gt; ch < C_T1 + C_A2 + C_A2C; ch += NGT) {
            int r = ch; bf16_t* dst; int row, col0, N, ncol; float scale; bool negsin;
            if (r < C_T1) { row = r / 64; col0 = (r % 64) * 8; dst = T1 + (size_t)row * 512 + col0; N = 512; scale = 0.04419417382415922f; negsin = false;
                const int cs = row >> 9, k2 = row & 511; float vals[8];
#pragma unroll
                for (int e = 0; e < 8; ++e) { const int idx = (k2 * (col0 + e)) & 511; const float a = (float)idx * (1.0f / 256.0f); vals[e] = (cs ? sinpif(a) : cospif(a)) * scale; }
                u32x4 o; o.x = cvt_pk_bf16(vals[0], vals[1]); o.y = cvt_pk_bf16(vals[2], vals[3]); o.z = cvt_pk_bf16(vals[4], vals[5]); o.w = cvt_pk_bf16(vals[6], vals[7]); *(u32x4*)dst = o; continue; }
            r -= C_T1;
            if (r < C_A2) { row = r / 512; col0 = (r % 512) * 8; dst = A2 + (size_t)row * 4096 + col0; N = 2048; scale = 0.022097086912079608f; }
            else { r -= C_A2; row = r / 64; col0 = (r % 64) * 8; dst = A2C + (size_t)row * 512 + col0; N = 256; scale = 0.0625f; }
            (void)ncol; (void)negsin;
            { const int cs = col0 / N, n0 = col0 % N; float vals[8];
#pragma unroll
              for (int e = 0; e < 8; ++e) { const int idx = (row * (n0 + e)) & (N - 1); const float a = (float)idx * (2.0f / (float)N); vals[e] = (cs ? -sinpif(a) : cospif(a)) * scale; }
              u32x4 o; o.x = cvt_pk_bf16(vals[0], vals[1]); o.y = cvt_pk_bf16(vals[2], vals[3]); o.z = cvt_pk_bf16(vals[4], vals[5]); o.w = cvt_pk_bf16(vals[6], vals[7]); *(u32x4*)dst = o; }
        }
        float* rope = (float*)(ws + WS_ROPE);
        for (int i = gt; i < 64 * 16; i += NGT) { const int pos = i >> 4, f = i & 15; const float inv = 1.0f / powf(10000.0f, (float)f * (1.0f / 16.0f)); const float ang = (float)pos * inv;
            rope[2 * i] = cosf(ang); rope[2 * i + 1] = sinf(ang); }
    }
}

struct Ctx { LAS unsigned char* lds; int tid, lane, wave, G, bx, vcu, gw, NGW; };
#if MK_MULTI
#define GRID_BAR() do { } while (0)
#else
#define GRID_BAR() xcd_barrier(bar)
#endif
#define PH_BEGIN(k) if ((k) >= P.ph_lo && (k) < P.ph_hi) {
#define PH_END(k)   if ((k) + 1 < P.ph_hi) { GRID_BAR(); for (int rb_ = 1; rb_ < PROBE_BAR; ++rb_) GRID_BAR(); } }
#define WSP(T, off) ((T*)(P.ws + (off)))

template <int L, int PH0>
__device__ __forceinline__ void layer(const Params& P, const Ctx& C, const XcdBarrier& bar) {
    constexpr int kind = L % 3; constexpr bool lastl = (L == 3);
    constexpr int Mact = lastl ? ML : MT;
    constexpr int NMIX = (kind == 2) ? 1 : 2;
    LAS unsigned char* lds = C.lds;
    if constexpr (kind == 0) {
        constexpr int ia = L / 3;
        PH_BEGIN(PH0)
        { pg8::Sched S{}; S.A = (const char*)WSP(bf16_t, WS_U); S.B = (const char*)(WSP(bf16_t, WS_WQKV) + (size_t)ia * 3 * D * D); S.lda = D * 2; S.ldb = D * 2; S.nt = D / 64;
          S.nM = MT / 256; S.nN = 3 * D / 256; S.ngroups = 1; S.a_g = 0; S.b_g = 0; S.G = C.G; S.c = C.bx;
          pg8::EpiQKV E{WSP(bf16_t, WS_Q), WSP(const float, WS_ROPE)};
          _Pragma("unroll") for (int rep_ = 0; rep_ < PROBE_QKV; ++rep_) { int tid_ = C.tid; if (rep_) { __builtin_amdgcn_sched_barrier(0); __syncthreads(); asm volatile("" : "+v"(tid_)); __builtin_amdgcn_sched_barrier(0); } pg8::gemm_phase(lds, S, E, tid_); } }
        PH_END(PH0)
        PH_BEGIN(PH0 + 1)
        { const float* lq1 = P.in[12] + ia * 64; const float* lk1 = P.in[13] + ia * 64; const float* lq2 = P.in[14] + ia * 64; const float* lk2 = P.in[15] + ia * 64;
          const float d1 = wave_sum(lq1[C.lane] * lk1[C.lane]), d2 = wave_sum(lq2[C.lane] * lk2[C.lane]);
          const float li = (L == 0) ? P.lam_init0 : P.lam_init3;
          att::Args A{WSP(bf16_t, WS_Q), WSP(bf16_t, WS_K), WSP(bf16_t, WS_V), WSP(bf16_t, WS_O), P.in[16] + ia * 128, expf(d1) - expf(d2) + li, 1.0f - li};
          _Pragma("unroll 1") for (int rep_ = 0; rep_ < PROBE_ATT; ++rep_) {
          constexpr int nlat_units = NB * NH * (SEQ / 256);
          const int per = (nlat_units + C.G - 1) / C.G;
          for (int i = 0; i < per; ++i) { const int uu = C.vcu * per + i; if (uu < nlat_units) { const int bh = uu >> 3, qb = uu & 7; att::unit(lds, A, bh >> 4, bh & 15, (bh >> 4) * SEQ + qb * 256, SEQ / 64); } }
          if constexpr (!lastl) { for (int uc = C.bx; uc < NB * NH; uc += C.G) { const int b = uc >> 4, h = uc & 15; att::unit(lds, A, b, h, ML + b * CL, 0); } } } }
        PH_END(PH0 + 1)
    } else if constexpr (kind == 1) {
        PH_BEGIN(PH0)
        { pg8::Sched S{}; S.A = (const char*)WSP(bf16_t, WS_T1); S.B = (const char*)WSP(bf16_t, WS_U); S.lda = 512 * 2; S.ldb = D * 2; S.nt = 8; S.nM = 4; S.nN = Mact / 256; S.ngroups = 4; S.a_g = 0; S.b_g = 512 * 2; S.G = C.G; S.c = C.bx;
          pg8::EpiFA E{WSP(bf16_t, WS_YT), WSP(bf16_t, WS_YTC)};
          _Pragma("unroll") for (int rep_ = 0; rep_ < PROBE_FA; ++rep_) { int tid_ = C.tid; if (rep_) { __builtin_amdgcn_sched_barrier(0); __syncthreads(); asm volatile("" : "+v"(tid_)); __builtin_amdgcn_sched_barrier(0); } pg8::gemm_phase(lds, S, E, tid_); } }
        PH_END(PH0)
        PH_BEGIN(PH0 + 1)
        { pg8::Sched S{}; S.A = (const char*)WSP(bf16_t, WS_A2); S.B = (const char*)WSP(bf16_t, WS_YT); S.lda = 4096 * 2; S.ldb = 16384 * 2; S.nt = 64; S.nM = 8; S.nN = 8; S.ngroups = 4; S.a_g = 0; S.b_g = 4096 * 2; S.G = C.G; S.c = C.bx;
          pg8::EpiBf16<0> E{WSP(bf16_t, WS_O), (unsigned)D, SEQ};
          _Pragma("unroll") for (int rep_ = 0; rep_ < PROBE_FB; ++rep_) { int tid_ = C.tid; if (rep_) { __builtin_amdgcn_sched_barrier(0); __syncthreads(); asm volatile("" : "+v"(tid_)); __builtin_amdgcn_sched_barrier(0); } pg8::gemm_phase(lds, S, E, tid_); }
          if constexpr (!lastl) { pg8::Sched S2{}; S2.A = (const char*)WSP(bf16_t, WS_A2C); S2.B = (const char*)WSP(bf16_t, WS_YTC); S2.lda = 512 * 2; S2.ldb = 2048 * 2; S2.nt = 8; S2.nM = 1; S2.nN = 8; S2.ngroups = 4; S2.a_g = 0; S2.b_g = 512 * 2; S2.G = C.G; S2.c = C.bx;
            pg8::EpiBf16<0> E2{WSP(bf16_t, WS_O) + (size_t)ML * D, (unsigned)D, CL};
            _Pragma("unroll") for (int rep_ = 0; rep_ < PROBE_FB; ++rep_) { int tid_ = C.tid; if (rep_) { __builtin_amdgcn_sched_barrier(0); __syncthreads(); asm volatile("" : "+v"(tid_)); __builtin_amdgcn_sched_barrier(0); } pg8::gemm_phase(lds, S2, E2, tid_); } } }
        PH_END(PH0 + 1)
    } else {
        PH_BEGIN(PH0) for (int rep_ = 0; rep_ < PROBE_THIN; ++rep_) pool_phase(WSP(bf16_t, WS_U), WSP(bf16_t, WS_O), Mact, C.gw, C.NGW, C.lane); PH_END(PH0)
    }
    PH_BEGIN(PH0 + NMIX)
    { pg8::Sched S{}; S.A = (const char*)WSP(bf16_t, WS_O); S.lda = D * 2; S.G = C.G; S.c = C.bx;
      if constexpr (kind == 2) { S.B = (const char*)WSP(bf16_t, WS_WPOOL); S.ldb = 512 * 2; S.nt = 8; S.nM = Mact / 256; S.nN = 2; S.ngroups = 4; S.a_g = 512 * 2; S.b_g = 512 * 512 * 2;
          pg8::EpiY E{WSP(bf16_t, WS_Y), (unsigned)D, P.in[19], 512}; _Pragma("unroll") for (int rep_ = 0; rep_ < PROBE_MIX; ++rep_) { int tid_ = C.tid; if (rep_) { __builtin_amdgcn_sched_barrier(0); __syncthreads(); asm volatile("" : "+v"(tid_)); __builtin_amdgcn_sched_barrier(0); } pg8::gemm_phase(lds, S, E, tid_); } }
      else { S.B = kind == 0 ? (const char*)(WSP(bf16_t, WS_WO) + (size_t)(L / 3) * D * D) : (const char*)WSP(bf16_t, WS_WF); S.ldb = D * 2; S.nt = D / 64; S.nM = ML / 256; S.nN = D / 256; S.ngroups = 1;
          pg8::EpiY E{WSP(bf16_t, WS_Y), (unsigned)D, nullptr, 0}; _Pragma("unroll") for (int rep_ = 0; rep_ < PROBE_MIX; ++rep_) { int tid_ = C.tid; if (rep_) { __builtin_amdgcn_sched_barrier(0); __syncthreads(); asm volatile("" : "+v"(tid_)); __builtin_amdgcn_sched_barrier(0); } pg8::gemm_phase(lds, S, E, tid_); }
          if constexpr (!lastl) { pg8::Sched S2 = S; S2.A = (const char*)(WSP(bf16_t, WS_O) + (size_t)ML * D); S2.nt = D / 64 / NSPLIT; S2.nM = MC / 256; S2.ngroups = NSPLIT; S2.a_g = (D / NSPLIT) * 2; S2.b_g = (D / NSPLIT) * 2;
              pg8::EpiF32 E2{WSP(float, WS_YC), (unsigned)D, nullptr, 0, (size_t)MC * D}; _Pragma("unroll") for (int rep_ = 0; rep_ < PROBE_MIX; ++rep_) { int tid_ = C.tid; if (rep_) { __builtin_amdgcn_sched_barrier(0); __syncthreads(); asm volatile("" : "+v"(tid_)); __builtin_amdgcn_sched_barrier(0); } pg8::gemm_phase(lds, S2, E2, tid_); } } } }
    PH_END(PH0 + NMIX)
    PH_BEGIN(PH0 + NMIX + 1)
    { const float* modl = WSP(const float, WS_MOD) + (size_t)L * 5 * MODROW; float* X = WSP(float, WS_X);
      ThinArgs T{}; T.xin_lat = L == 0 ? P.in[0] : X; T.xin_ctx = L == 0 ? P.in[2] : X + (size_t)ML * D; T.y = WSP(const bf16_t, WS_Y); T.xout_lat = X; T.xout_ctx = X + (size_t)ML * D;
      T.yc = WSP(const float, WS_YC); T.nslab = (kind == 2 || lastl) ? 0 : NSPLIT;
      T.g_post = P.in[7] + L * D; T.gate = modl + 2 * D; T.uout = WSP(bf16_t, WS_U); T.g_pre = P.in[8] + L * D; T.sc = modl + 4 * D; T.sh = modl + 3 * D; T.nrows = Mact;
      thin_phase(T, C.gw, C.NGW, C.lane);
      for (int rep_ = 1; rep_ < PROBE_THIN; ++rep_) { ThinArgs T2 = T; if (T2.xout_lat) { T2.xout_lat = WSP(float, WS_END); T2.xout_ctx = WSP(float, WS_END) + (size_t)ML * D; } if (T2.uout) T2.uout = WSP(bf16_t, WS_END + 80 * MiB); thin_phase(T2, C.gw, C.NGW, C.lane); } }
    PH_END(PH0 + NMIX + 1)
    PH_BEGIN(PH0 + NMIX + 2)
    { pg8::Sched S{}; S.A = (const char*)WSP(bf16_t, WS_U); S.B = (const char*)(WSP(bf16_t, WS_W1) + (size_t)L * FF * D); S.lda = D * 2; S.ldb = D * 2; S.nt = D / 64; S.nM = Mact / 256; S.nN = FF / 256; S.ngroups = 1; S.G = C.G; S.c = C.bx;
      pg8::EpiBf16<1> E{WSP(bf16_t, WS_H), (unsigned)FF, 0}; _Pragma("unroll") for (int rep_ = 0; rep_ < PROBE_W1; ++rep_) { int tid_ = C.tid; if (rep_) { __builtin_amdgcn_sched_barrier(0); __syncthreads(); asm volatile("" : "+v"(tid_)); __builtin_amdgcn_sched_barrier(0); } pg8::gemm_phase(lds, S, E, tid_); } }
    PH_END(PH0 + NMIX + 2)
    PH_BEGIN(PH0 + NMIX + 3)
    { pg8::Sched S{}; S.A = (const char*)WSP(bf16_t, WS_H); S.B = (const char*)(WSP(bf16_t, WS_W2) + (size_t)L * D * FF); S.lda = FF * 2; S.ldb = FF * 2; S.nt = FF / 64; S.nM = ML / 256; S.nN = D / 256; S.ngroups = 1; S.G = C.G; S.c = C.bx;
      pg8::EpiY E{WSP(bf16_t, WS_Y), (unsigned)D, nullptr, 0}; _Pragma("unroll") for (int rep_ = 0; rep_ < PROBE_W2; ++rep_) { int tid_ = C.tid; if (rep_) { __builtin_amdgcn_sched_barrier(0); __syncthreads(); asm volatile("" : "+v"(tid_)); __builtin_amdgcn_sched_barrier(0); } pg8::gemm_phase(lds, S, E, tid_); }
      if constexpr (!lastl) { pg8::Sched S2 = S; S2.A = (const char*)(WSP(bf16_t, WS_H) + (size_t)ML * FF); S2.nt = FF / 64 / NSPLIT; S2.nM = MC / 256; S2.ngroups = NSPLIT; S2.a_g = (FF / NSPLIT) * 2; S2.b_g = (FF / NSPLIT) * 2;
          pg8::EpiF32 E2{WSP(float, WS_YC), (unsigned)D, nullptr, 0, (size_t)MC * D}; _Pragma("unroll") for (int rep_ = 0; rep_ < PROBE_W2; ++rep_) { int tid_ = C.tid; if (rep_) { __builtin_amdgcn_sched_barrier(0); __syncthreads(); asm volatile("" : "+v"(tid_)); __builtin_amdgcn_sched_barrier(0); } pg8::gemm_phase(lds, S2, E2, tid_); } } }
    PH_END(PH0 + NMIX + 3)
    PH_BEGIN(PH0 + NMIX + 4)
    { const float* modl = WSP(const float, WS_MOD) + (size_t)L * 5 * MODROW; float* X = WSP(float, WS_X);
      ThinArgs T{}; T.xin_lat = X; T.xin_ctx = X + (size_t)ML * D; T.y = WSP(const bf16_t, WS_Y); T.xout_lat = lastl ? P.out : X; T.xout_ctx = X + (size_t)ML * D;
      T.yc = WSP(const float, WS_YC); T.nslab = lastl ? 0 : NSPLIT;
      T.g_post = P.in[9] + L * D; T.gate = modl + 5 * D; T.nrows = Mact;
      if constexpr (!lastl) { const float* modn = modl + 5 * MODROW; T.uout = WSP(bf16_t, WS_U); T.g_pre = P.in[6] + (L + 1) * D; T.sc = modn + 1 * D; T.sh = modn + 0 * D; }
      thin_phase(T, C.gw, C.NGW, C.lane);
      for (int rep_ = 1; rep_ < PROBE_THIN; ++rep_) { ThinArgs T2 = T; if (T2.xout_lat) { T2.xout_lat = WSP(float, WS_END); T2.xout_ctx = WSP(float, WS_END) + (size_t)ML * D; } if (T2.uout) T2.uout = WSP(bf16_t, WS_END + 80 * MiB); thin_phase(T2, C.gw, C.NGW, C.lane); } }
    PH_END(PH0 + NMIX + 4)
}
constexpr int PH_L0 = 2, PH_L1 = PH_L0 + 7, PH_L2 = PH_L1 + 7, PH_L3 = PH_L2 + 6, N_PHASES = PH_L3 + 7;

__global__ void __launch_bounds__(NTHR, 2) fwd_kernel(Params P) {
    extern __shared__ __attribute__((aligned(16))) unsigned char lds_raw[];
    Ctx C; C.lds = (LAS unsigned char*)lds_raw;
    C.tid = threadIdx.x; C.lane = C.tid & 63; C.wave = __builtin_amdgcn_readfirstlane(C.tid >> 6);
    C.G = gridDim.x; C.bx = blockIdx.x; C.vcu = (C.G % 8 == 0) ? (C.bx % 8) * (C.G / 8) + C.bx / 8 : C.bx;
    C.gw = C.vcu * NWAVES + C.wave; C.NGW = C.G * NWAVES;
    for (int u = C.tid; u < (LDS_BYTES - LDSCTL_OFF) / 4; u += NTHR) ((LAS unsigned*)(C.lds + LDSCTL_OFF))[u] = 0u;
    __syncthreads();
#if MK_MULTI
    XcdBarrier bar{};
#else
    XcdBarrier bar = xcd_barrier_post(WSP(unsigned, WS_CTL) + CW_BAR, (volatile LAS unsigned*)(C.lds + MISC_OFF) + 8);
#endif
    PH_BEGIN(0) for (int rep_ = 0; rep_ < PROBE_PRO; ++rep_) { prologue(P, C.lds, C.tid, C.wave, C.lane, C.vcu, C.G); __syncthreads(); } PH_END(0)
    PH_BEGIN(1)
    { const float* mod = WSP(const float, WS_MOD);
      ThinArgs T{}; T.xin_lat = P.in[0]; T.xin_ctx = P.in[2]; T.y = nullptr; T.uout = WSP(bf16_t, WS_U); T.g_pre = P.in[6]; T.sc = mod + 1 * D; T.sh = mod + 0 * D; T.nrows = MT;
      thin_phase(T, C.gw, C.NGW, C.lane);
      for (int rep_ = 1; rep_ < PROBE_THIN; ++rep_) { ThinArgs T2 = T; if (T2.xout_lat) { T2.xout_lat = WSP(float, WS_END); T2.xout_ctx = WSP(float, WS_END) + (size_t)ML * D; } if (T2.uout) T2.uout = WSP(bf16_t, WS_END + 80 * MiB); thin_phase(T2, C.gw, C.NGW, C.lane); } }
    PH_END(1)
    layer<0, PH_L0>(P, C, bar);
    layer<1, PH_L1>(P, C, bar);
    layer<2, PH_L2>(P, C, bar);
    layer<3, PH_L3>(P, C, bar);
}
#undef PH_BEGIN
#undef PH_END
#undef GRID_BAR

extern "C" void kernel_launch(void* const* d_in, const int* in_sizes, int n_in, void* d_out, int out_size, void* d_ws, size_t ws_size, hipStream_t stream) {
    static int grid = 0;
    if (grid == 0) {
        if (n_in != 22 || out_size != ML * D || ws_size < WS_END + 128 * MiB) { fprintf(stderr, "kernel_launch: unexpected problem: n_in %d out %d ws %zu (need %zu)\n", n_in, out_size, ws_size, (size_t)WS_END); grid = -1; return; }
        int dev = 0, cus = 0, per_cu = 0;
        if (hipGetDevice(&dev) != hipSuccess || hipDeviceGetAttribute(&cus, hipDeviceAttributeMultiprocessorCount, dev) != hipSuccess) { grid = -1; return; }
        if (hipFuncSetAttribute((const void*)fwd_kernel, hipFuncAttributeMaxDynamicSharedMemorySize, LDS_BYTES) != hipSuccess) { fprintf(stderr, "kernel_launch: hipFuncSetAttribute failed\n"); grid = -1; return; }
        if (hipOccupancyMaxActiveBlocksPerMultiprocessor(&per_cu, (const void*)fwd_kernel, NTHR, LDS_BYTES) != hipSuccess || per_cu < 1) fprintf(stderr, "kernel_launch: occupancy query says %d\n", per_cu);
        (void)hipGetLastError();
        grid = cus;
    }
    if (grid < 0) return;
    (void)in_sizes;
    hipMemsetAsync((char*)d_ws + WS_CTL, 0, CTL_BYTES, stream);
    Params p{};
    for (int i = 0; i < 22; ++i) p.in[i] = (const float*)d_in[i];
    p.out = (float*)d_out; p.ws = (unsigned char*)d_ws;
    p.lam_init0 = (float)(0.8 - 0.6 * exp(-0.3 * 0.0)); p.lam_init3 = (float)(0.8 - 0.6 * exp(-0.3 * 3.0));
#if MK_MULTI
    for (int ph = 0; ph < N_PHASES; ++ph) { p.ph_lo = ph; p.ph_hi = ph + 1; hipLaunchKernelGGL(fwd_kernel, dim3(grid), dim3(NTHR), LDS_BYTES, stream, p); }
#else
    p.ph_lo = 0; p.ph_hi = N_PHASES;
    hipLaunchKernelGGL(fwd_kernel, dim3(grid), dim3(NTHR), LDS_BYTES, stream, p);
#endif
    const hipError_t le = hipPeekAtLastError();
    if (le != hipSuccess) fprintf(stderr, "kernel_launch: launch failed: %s\n", hipGetErrorName(le));
}
```

```cpp
#include <hip/hip_runtime.h>
#include <cstdio>
#include <cstdint>
#include <cmath>

#define PROBE_QKV 1
#define PROBE_FA 1
#define PROBE_FB 1
#define PROBE_MIX 1
#define PROBE_W1 1
#define PROBE_W2 1
#define PROBE_BAR 1
#define PROBE_ATT 1
#define PROBE_PRO 1
#define PROBE_THIN 1
#ifndef MK_MULTI
#define MK_MULTI 0
#endif

#define LAS __attribute__((address_space(3)))
#define GAS __attribute__((address_space(1)))
typedef unsigned short bf16_t;
typedef short bf16x8 __attribute__((ext_vector_type(8)));
typedef short s16x4 __attribute__((ext_vector_type(4)));
typedef float f32x4 __attribute__((ext_vector_type(4)));
typedef float f32x2 __attribute__((ext_vector_type(2)));
typedef float f32x16 __attribute__((ext_vector_type(16)));
typedef unsigned u32x4 __attribute__((ext_vector_type(4)));
typedef unsigned u32x2 __attribute__((ext_vector_type(2)));

constexpr int D = 2048, NB = 4, SEQ = 2048, CL = 256, ML = NB * SEQ, MC = NB * CL, MT = ML + MC, FF = 8192, NH = 16, NMOD = 6, MODROW = NMOD * D;
constexpr int NWAVES = 8, NTHR = 512;
constexpr float NORM_EPS = 1e-6f, SUBLN_EPS = 1e-5f;
constexpr float QSCALE = 0.125f * 1.4426950408889634f;

constexpr size_t MiB = 1u << 20;
constexpr size_t WS_CTL = 0, CTL_BYTES = 1 * MiB;
constexpr size_t WS_MOD = 1 * MiB;
constexpr size_t WS_ROPE = 2 * MiB;
constexpr size_t WS_T1 = 3 * MiB;
constexpr size_t WS_A2C = 4 * MiB;
constexpr size_t WS_A2 = 5 * MiB;
constexpr size_t WS_WQKV = 22 * MiB;
constexpr size_t WS_WO = 70 * MiB;
constexpr size_t WS_WF = 86 * MiB;
constexpr size_t WS_WPOOL = 94 * MiB;
constexpr size_t WS_W1 = 96 * MiB;
constexpr size_t WS_W2 = 224 * MiB;
constexpr size_t WS_X = 352 * MiB;
constexpr size_t WS_Y = 424 * MiB;
constexpr size_t WS_U = 496 * MiB;
constexpr size_t WS_Q = 532 * MiB, WS_K = 568 * MiB, WS_V = 604 * MiB, WS_O = 640 * MiB;
constexpr size_t WS_H = 676 * MiB;
constexpr size_t WS_YT = 820 * MiB;
constexpr size_t WS_YTC = 884 * MiB;
constexpr size_t WS_YC = 892 * MiB;
constexpr size_t WS_END = 956 * MiB;
constexpr int NSPLIT = 8;

constexpr int RING_BYTES = 131072, LDSCTL_OFF = 139264  , MISC_OFF = LDSCTL_OFF + 320, LDS_BYTES = 147456;

__device__ __forceinline__ unsigned cvt_pk_bf16(float lo, float hi) { unsigned r; asm volatile("v_cvt_pk_bf16_f32 %0, %1, %2" : "=v"(r) : "v"(lo), "v"(hi)); return r; }
__device__ __forceinline__ float bf2f(unsigned short b) { return __uint_as_float(((unsigned)b) << 16); }
__device__ __forceinline__ float wave_sum(float v) {
#pragma unroll
    for (int o = 1; o < 64; o <<= 1) v += __shfl_xor(v, o);
    return v;
}

#define XB_TMO      128
#define XB_XCNT(j)  (256  + 64 * (j))
#define XB_XSUB(j)  (1280 + 64 * (j))
#define XB_XGEN(j)  (2304 + 64 * (j))
#define XB_TOP      3328
#define XB_TOPGEN   3392
#define XCD_BAR_WORDS 3456
#define XB_SPIN_CAP (1u << 18)
constexpr int CW_BAR = 4096;

__device__ __forceinline__ unsigned xb_ld(unsigned* p)              { return __hip_atomic_load(p, __ATOMIC_RELAXED, __HIP_MEMORY_SCOPE_AGENT); }
__device__ __forceinline__ unsigned xb_add(unsigned* p, unsigned v) { return __hip_atomic_fetch_add(p, v, __ATOMIC_RELAXED, __HIP_MEMORY_SCOPE_AGENT); }
__device__ __forceinline__ unsigned xb_xcc_id() { return (unsigned)__builtin_amdgcn_s_getreg((3 << 11) | 20) & 0xFu; }
#define XB_SPIN(cond, bar) do { unsigned _sp = 0; while (cond) { __builtin_amdgcn_s_sleep(1); \
    if ((++_sp & 255u) == 0u) { if (xb_ld(&(bar)[XB_TMO])) break; if (_sp > XB_SPIN_CAP) { atomicAdd(&(bar)[XB_TMO], 1u); break; } } } } while (0)

struct XcdBarrier { unsigned* bar; unsigned x; volatile LAS unsigned* st; };

__device__ __forceinline__ XcdBarrier xcd_barrier_post(unsigned* bar, volatile LAS unsigned* st) {
    XcdBarrier b; b.bar = bar; b.x = xb_xcc_id(); b.st = st;
    if (threadIdx.x == 0) (void)xb_add(&bar[XB_XCNT(b.x)], 1u);
    return b;
}
__device__ __forceinline__ void xcd_barrier_complete(unsigned* bar, unsigned x, unsigned& nloc, unsigned& nx) {
    const unsigned G = gridDim.x * gridDim.y * gridDim.z;
    unsigned sum, cnt, mine, sp = 0u;
    for (;;) {
        sum = 0u; cnt = 0u; mine = 0u;
#pragma unroll
        for (unsigned j = 0; j < 16; ++j) { const unsigned c = xb_ld(&bar[XB_XCNT(j)]); sum += c; cnt += (c > 0u) ? 1u : 0u; mine = (j == x) ? c : mine; }
        if (sum == G) break;
        __builtin_amdgcn_s_sleep(1);
        if ((++sp & 255u) == 0u) { if (xb_ld(&bar[XB_TMO])) break; if (sp > XB_SPIN_CAP) { atomicAdd(&bar[XB_TMO], 1u); break; } }
    }
    nloc = mine > 0u ? mine : 1u; nx = cnt > 0u ? cnt : 1u;
}
__device__ __forceinline__ void xcd_barrier(const XcdBarrier& b) {
    asm volatile("s_waitcnt vmcnt(0)" ::: "memory");
    __syncthreads();
    if (threadIdx.x == 0) {
        unsigned* bar = b.bar;
        __builtin_amdgcn_s_waitcnt(0);
        unsigned nloc = b.st[0], nx = b.st[1];
        if (nloc == 0u) { xcd_barrier_complete(bar, b.x, nloc, nx); b.st[0] = nloc; b.st[1] = nx; }
        const unsigned old = xb_add(&bar[XB_XSUB(b.x)], 1u);
        const unsigned gen = old / nloc;
        if (old + 1u == (gen + 1u) * nloc) {
            __builtin_amdgcn_fence(__ATOMIC_RELEASE, "agent");
            asm volatile("s_waitcnt vmcnt(0)" ::: "memory");
            const unsigned og = xb_add(&bar[XB_TOP], 1u);
            const unsigned tg = og / nx;
            if (og + 1u == (tg + 1u) * nx) xb_add(&bar[XB_TOPGEN], 1u);
            else XB_SPIN(xb_ld(&bar[XB_TOPGEN]) == tg, bar);
            __builtin_amdgcn_fence(__ATOMIC_ACQUIRE, "agent");
            xb_add(&bar[XB_XGEN(b.x)], 1u);
            asm volatile("s_waitcnt vmcnt(0)" ::: "memory");
        } else {
            XB_SPIN(xb_ld(&bar[XB_XGEN(b.x)]) == gen, bar);
            __builtin_amdgcn_fence(__ATOMIC_ACQUIRE, "agent");
            asm volatile("s_waitcnt vmcnt(0)" ::: "memory");
        }
    }
    __syncthreads();
}

namespace pg8 {
constexpr int BM = 256, BK = 64, HALF = 128, HTB = HALF * BK * 2, STAGE_BYTES = 8 * HTB, NXCD = 8, WGM = 8;
__device__ __forceinline__ int lds_byte(int r, int c) { const int st = (r >> 4) * 2 + (c >> 5), rr = r & 15, cc = c & 31, ob = rr * 64 + cc * 2; return st * 1024 + (ob ^ (((ob >> 9) & 1) << 5)); }
__device__ __forceinline__ void stage_rc(int b, int& R, int& C) { const int st = b / 1024, sb = b % 1024, swz = sb ^ (((sb >> 9) & 1) << 5); R = (st >> 1) * 16 + swz / 64; C = (st & 1) * 32 + (swz % 64) / 2; }
__device__ __forceinline__ int perm32(int rho) { const int n = rho >> 4, i = rho & 15; return 8 * (i >> 2) + 4 * n + (i & 3); }

struct Unit { const char* A; const char* B; int g, pm, pn; };

struct Sched {
    const char* A; const char* B; unsigned lda, ldb; int nt;
    int nM, nN, ngroups; long long a_g, b_g;
    int G, c;
    __device__ __forceinline__ bool next(int i, Unit& u) const {
        const int per = nM * nN, nwg = per * ngroups;
        const long L = (long)i * G + c; if (L >= nwg) return false;
        int wgid = (int)L; { const int q = nwg / NXCD, r = nwg % NXCD, xcd = wgid % NXCD, off = wgid / NXCD; wgid = (xcd < r ? xcd * (q + 1) : r * (q + 1) + (xcd - r) * q) + off; }
        const int g = wgid / per, w = wgid % per;
        const int nig = WGM * nN, gid = w / nig, fm = gid * WGM, gsz = (nM - fm) < WGM ? (nM - fm) : WGM;
        u.g = g; u.pm = fm + ((w % nig) % gsz); u.pn = (w % nig) / gsz;
        u.A = A + (long long)g * a_g + (size_t)u.pm * BM * lda; u.B = B + (long long)g * b_g + (size_t)u.pn * BM * ldb;
        return true;
    }
};

template <class Epi>
__device__ __forceinline__ void gemm_phase(LAS unsigned char* lds, const Sched& S, const Epi& E, int tid_in = -1) {
    const int tid = tid_in >= 0 ? tid_in : (int)threadIdx.x, wid = __builtin_amdgcn_readfirstlane(tid >> 6), lane = tid & 63, wr = wid >> 2, wc = wid & 3, fr = lane & 15, fq = lane >> 4;
    const int nt = S.nt;
    unsigned voffA[2], voffB[2];
#pragma unroll
    for (int i = 0; i < 2; ++i) { int R, C; stage_rc(tid * 16 + i * 8192, R, C); const int Rb = (R & ~31) + perm32(R & 31);
        voffA[i] = (unsigned)R * S.lda + (unsigned)C * 2u; voffB[i] = (unsigned)Rb * S.ldb + (unsigned)C * 2u; }
    const size_t kstep = (size_t)(BK * 2);
    const size_t hA = (size_t)HALF * S.lda, hB = (size_t)HALF * S.ldb;
    const unsigned ldsw = (unsigned)wid * 1024u;
    const int aoff = lds_byte(wr * 64 + fr, fq * 8), boff = lds_byte(wc * 32 + fr, fq * 8);
#define PG8_SA(b, h) (((b) * 2 + (h)) * HTB)
#define PG8_SB(b, h) ((4 + (b) * 2 + (h)) * HTB)
#define PG8_STAGE(bufoff, gbase, voff) do { _Pragma("unroll") for (int _i = 0; _i < 2; ++_i) \
        __builtin_amdgcn_global_load_lds((const unsigned*)((const char*)(gbase) + (voff)[_i]), (LAS unsigned*)(lds + (bufoff) + ldsw + _i * 8192), 16, 0, 0); } while (0)
#define PG8_LDA(dst, b, h) do { _Pragma("unroll") for (int m = 0; m < 4; ++m) _Pragma("unroll") for (int k = 0; k < 2; ++k) dst[m][k] = *(const LAS bf16x8*)(lds + PG8_SA(b, h) + aoff + m * 2048 + k * 1024); } while (0)
#define PG8_LDB(dst, b, h) do { _Pragma("unroll") for (int n = 0; n < 2; ++n) _Pragma("unroll") for (int k = 0; k < 2; ++k) dst[n][k] = *(const LAS bf16x8*)(lds + PG8_SB(b, h) + boff + n * 2048 + k * 1024); } while (0)
#define PG8_MMA(ai, bj, At, Bt) do { __builtin_amdgcn_s_setprio(1); _Pragma("unroll") for (int m = 0; m < 4; ++m) _Pragma("unroll") for (int n = 0; n < 2; ++n) _Pragma("unroll") for (int k = 0; k < 2; ++k) \
        acc[ai][bj][m][n] = __builtin_amdgcn_mfma_f32_16x16x32_bf16(Bt[n][k], At[m][k], acc[ai][bj][m][n], 0, 0, 0); __builtin_amdgcn_s_setprio(0); } while (0)
#define PG8_WAIT_V(n) asm volatile("s_waitcnt vmcnt(" #n ")" ::: "memory")
#define PG8_WAIT_L(n) asm volatile("s_waitcnt lgkmcnt(" #n ")" ::: "memory")
#define PG8_BAR __builtin_amdgcn_s_barrier()
#define PG8_SCHED __builtin_amdgcn_sched_barrier(0)
    Unit cur, nxt; int ui = 0;
    if (!S.next(0, cur)) return;
    f32x4 acc[2][2][4][2];
#pragma unroll
    for (int a = 0; a < 2; ++a)
#pragma unroll
        for (int b = 0; b < 2; ++b)
#pragma unroll
            for (int m = 0; m < 4; ++m)
#pragma unroll
                for (int n = 0; n < 2; ++n) acc[a][b][m][n] = (f32x4){0.f, 0.f, 0.f, 0.f};
    bf16x8 At[4][2], B0[2][2], B1[2][2];
    const char* cA = cur.A; const char* cB = cur.B;
    PG8_STAGE(PG8_SB(0, 0), cB, voffB); PG8_STAGE(PG8_SB(0, 1), cB + hB, voffB); PG8_STAGE(PG8_SA(0, 0), cA, voffA); PG8_STAGE(PG8_SA(0, 1), cA + hA, voffA);
    if (wr == 1) PG8_BAR;
    PG8_WAIT_V(2); PG8_BAR;
    PG8_STAGE(PG8_SB(1, 0), cB + kstep, voffB); PG8_STAGE(PG8_SA(1, 0), cA + kstep, voffA); PG8_STAGE(PG8_SB(1, 1), cB + hB + kstep, voffB);
    PG8_WAIT_V(6); PG8_BAR;
    for (;;) {
        const bool has_next = S.next(ui + 1, nxt);
        const char* nA = has_next ? nxt.A : cA; const char* nB = has_next ? nxt.B : cB;
        for (int t = 0; t < nt; t += 2) {
            const bool last = (t == nt - 2);
            const char* a1 = cA + (size_t)(t + 1) * kstep;
            const char* a2 = last ? nA : cA + (size_t)(t + 2) * kstep; const char* b2 = last ? nB : cB + (size_t)(t + 2) * kstep;
            const char* a3 = a2 + kstep; const char* b3 = b2 + kstep;
            PG8_LDB(B0, 0, 0); PG8_LDB(B1, 0, 1); PG8_SCHED; PG8_LDA(At, 0, 0); PG8_STAGE(PG8_SA(1, 1), a1 + hA, voffA);
            PG8_WAIT_V(8); PG8_WAIT_L(0); PG8_BAR; PG8_MMA(0, 0, At, B0); PG8_MMA(0, 1, At, B1); PG8_BAR; PG8_SCHED;
            PG8_LDA(At, 0, 1); PG8_STAGE(PG8_SB(0, 0), b2, voffB); PG8_STAGE(PG8_SB(0, 1), b2 + hB, voffB); PG8_STAGE(PG8_SA(0, 0), a2, voffA);
            PG8_WAIT_V(8); PG8_WAIT_L(0); PG8_BAR; PG8_MMA(1, 0, At, B0); PG8_MMA(1, 1, At, B1); PG8_BAR; PG8_SCHED;
            PG8_LDB(B0, 1, 0); PG8_LDB(B1, 1, 1); PG8_SCHED; PG8_LDA(At, 1, 0); PG8_STAGE(PG8_SA(0, 1), a2 + hA, voffA);
            PG8_WAIT_V(8); PG8_WAIT_L(0); PG8_BAR; PG8_MMA(0, 0, At, B0); PG8_MMA(0, 1, At, B1); PG8_BAR; PG8_SCHED;
            PG8_LDA(At, 1, 1); PG8_STAGE(PG8_SB(1, 0), b3, voffB); PG8_STAGE(PG8_SB(1, 1), b3 + hB, voffB); PG8_STAGE(PG8_SA(1, 0), a3, voffA);
            PG8_WAIT_V(8); PG8_WAIT_L(0); PG8_BAR; PG8_MMA(1, 0, At, B0); PG8_MMA(1, 1, At, B1); PG8_BAR; PG8_SCHED;
        }
        if (wr == 0) PG8_BAR;
        E(acc, cur, wr, wc, fr, fq);
        if (!has_next) break;
#pragma unroll
        for (int a = 0; a < 2; ++a)
#pragma unroll
            for (int b = 0; b < 2; ++b)
#pragma unroll
                for (int m = 0; m < 4; ++m)
#pragma unroll
                    for (int n = 0; n < 2; ++n) acc[a][b][m][n] = (f32x4){0.f, 0.f, 0.f, 0.f};
        cur = nxt; cA = nA; cB = nB; ++ui;
        if (wr == 1) PG8_BAR;
    }
    PG8_WAIT_V(0);
    PG8_BAR;
#undef PG8_SA
#undef PG8_SB
#undef PG8_STAGE
#undef PG8_LDA
#undef PG8_LDB
#undef PG8_MMA
#undef PG8_WAIT_V
#undef PG8_WAIT_L
#undef PG8_BAR
#undef PG8_SCHED
}

struct EpiF32 {
    float* C; unsigned ldc; const float* colscale; int c_g; size_t slab_g;
    __device__ __forceinline__ void operator()(const f32x4 (&acc)[2][2][4][2], const Unit& u, int wr, int wc, int fr, int fq) const {
        const int row0 = u.pm * BM + wr * 64 + fr, col0 = u.g * c_g + u.pn * BM + wc * 32 + 8 * fq;
        f32x4 sv[2][2];
#pragma unroll
        for (int bj = 0; bj < 2; ++bj)
#pragma unroll
            for (int n = 0; n < 2; ++n) sv[bj][n] = colscale ? *(const f32x4*)(colscale + col0 + bj * HALF + 4 * n) : (f32x4){1.f, 1.f, 1.f, 1.f};
#pragma unroll
        for (int ai = 0; ai < 2; ++ai)
#pragma unroll
            for (int m = 0; m < 4; ++m) { float* rowp = C + (size_t)u.g * slab_g + (size_t)(row0 + ai * HALF + m * 16) * ldc + col0;
#pragma unroll
                for (int bj = 0; bj < 2; ++bj) { *(f32x4*)(rowp + bj * HALF) = acc[ai][bj][m][0] * sv[bj][0]; *(f32x4*)(rowp + bj * HALF + 4) = acc[ai][bj][m][1] * sv[bj][1]; } }
    }
};
struct EpiY {
    bf16_t* C; unsigned ldc; const float* colscale; int c_g;
    __device__ __forceinline__ void operator()(const f32x4 (&acc)[2][2][4][2], const Unit& u, int wr, int wc, int fr, int fq) const {
        const int row0 = u.pm * BM + wr * 64 + fr, col0 = u.g * c_g + u.pn * BM + wc * 32 + 8 * fq;
        f32x4 sv[2][2];
#pragma unroll
        for (int bj = 0; bj < 2; ++bj)
#pragma unroll
            for (int n = 0; n < 2; ++n) sv[bj][n] = colscale ? *(const f32x4*)(colscale + col0 + bj * HALF + 4 * n) : (f32x4){1.f, 1.f, 1.f, 1.f};
#pragma unroll
        for (int ai = 0; ai < 2; ++ai)
#pragma unroll
            for (int m = 0; m < 4; ++m) { bf16_t* rowp = C + (size_t)(row0 + ai * HALF + m * 16) * ldc + col0;
#pragma unroll
                for (int bj = 0; bj < 2; ++bj) { const f32x4 v0 = acc[ai][bj][m][0] * sv[bj][0], v1 = acc[ai][bj][m][1] * sv[bj][1];
                    u32x4 w; w.x = cvt_pk_bf16(v0[0], v0[1]); w.y = cvt_pk_bf16(v0[2], v0[3]); w.z = cvt_pk_bf16(v1[0], v1[1]); w.w = cvt_pk_bf16(v1[2], v1[3]);
                    *(u32x4*)(rowp + bj * HALF) = w; } }
    }
};
template <int ACT> struct EpiBf16 {
    bf16_t* C; unsigned ldc; int row_g;
    __device__ __forceinline__ void operator()(const f32x4 (&acc)[2][2][4][2], const Unit& u, int wr, int wc, int fr, int fq) const {
        const int row0 = u.g * row_g + u.pm * BM + wr * 64 + fr, col0 = u.pn * BM + wc * 32 + 8 * fq;
#pragma unroll
        for (int ai = 0; ai < 2; ++ai)
#pragma unroll
            for (int m = 0; m < 4; ++m) { bf16_t* rowp = C + (size_t)(row0 + ai * HALF + m * 16) * ldc + col0;
#pragma unroll
                for (int bj = 0; bj < 2; ++bj) { f32x4 v0 = acc[ai][bj][m][0], v1 = acc[ai][bj][m][1];
                    if (ACT == 1) {
#pragma unroll
                        for (int e = 0; e < 4; ++e) { const float a = fmaxf(v0[e], 0.f), b = fmaxf(v1[e], 0.f); v0[e] = a * a; v1[e] = b * b; } }
                    u32x4 w; w.x = cvt_pk_bf16(v0[0], v0[1]); w.y = cvt_pk_bf16(v0[2], v0[3]); w.z = cvt_pk_bf16(v1[0], v1[1]); w.w = cvt_pk_bf16(v1[2], v1[3]);
                    *(u32x4*)(rowp + bj * HALF) = w; } }
    }
};
struct EpiFA {
    bf16_t* YT; bf16_t* YTC;
    __device__ __forceinline__ void operator()(const f32x4 (&acc)[2][2][4][2], const Unit& u, int wr, int wc, int fr, int fq) const {
        const int cs = u.pm >> 1, k2b = (u.pm & 1) * 256;
        bf16_t* base; size_t pitch;
        if (u.pn < 32) { const int b = u.pn >> 3; base = YT + (size_t)(u.g * 512 + k2b) * 16384 + b * 4096 + cs * 2048 + (u.pn & 7) * 256; pitch = 16384; }
        else { const int b = u.pn - 32; base = YTC + (size_t)(u.g * 512 + k2b) * 2048 + b * 512 + cs * 256; pitch = 2048; }
        const int row0 = wr * 64 + fr, col0 = wc * 32 + 8 * fq;
#pragma unroll
        for (int ai = 0; ai < 2; ++ai)
#pragma unroll
            for (int m = 0; m < 4; ++m) { bf16_t* rowp = base + (size_t)(row0 + ai * HALF + m * 16) * pitch + col0;
#pragma unroll
                for (int bj = 0; bj < 2; ++bj) { const f32x4 v0 = acc[ai][bj][m][0], v1 = acc[ai][bj][m][1];
                    u32x4 w; w.x = cvt_pk_bf16(v0[0], v0[1]); w.y = cvt_pk_bf16(v0[2], v0[3]); w.z = cvt_pk_bf16(v1[0], v1[1]); w.w = cvt_pk_bf16(v1[2], v1[3]);
                    *(u32x4*)(rowp + bj * HALF) = w; } }
    }
};
struct EpiQKV {
    bf16_t* Q; const float* rope;
    __device__ __forceinline__ void operator()(const f32x4 (&acc)[2][2][4][2], const Unit& u, int wr, int wc, int fr, int fq) const {
        const int part = u.pn >> 3;
        bf16_t* dst = Q + (size_t)part * ((WS_K - WS_Q) / 2);
        const int row0 = u.pm * BM + wr * 64 + fr, colp = (u.pn & 7) * BM + wc * 32 + 8 * fq;
        const bool dorope = (part < 2) && (u.pm < 32);
        const float sc = part == 0 ? QSCALE : 1.f;
#pragma unroll
        for (int ai = 0; ai < 2; ++ai)
#pragma unroll
            for (int m = 0; m < 4; ++m) { const int row = row0 + ai * HALF + m * 16; bf16_t* rowp = dst + (size_t)row * D + colp;
                const int t = row & 2047, prow = t >> 6, pcol = t & 63;
#pragma unroll
                for (int bj = 0; bj < 2; ++bj) { f32x4 v0 = acc[ai][bj][m][0], v1 = acc[ai][bj][m][1];
                    if (dorope) { const int c = colp + bj * HALF, j0 = (c & 63) >> 1, ax = j0 >> 4, f0 = j0 & 15;
                        const float* cs = rope + ((ax ? pcol : prow) * 16 + f0) * 2;
                        const f32x4 cs0 = *(const f32x4*)cs, cs1 = *(const f32x4*)(cs + 4);
                        f32x4 r0, r1;
                        r0[0] = v0[0] * cs0[0] - v0[1] * cs0[1]; r0[1] = v0[0] * cs0[1] + v0[1] * cs0[0];
                        r0[2] = v0[2] * cs0[2] - v0[3] * cs0[3]; r0[3] = v0[2] * cs0[3] + v0[3] * cs0[2];
                        r1[0] = v1[0] * cs1[0] - v1[1] * cs1[1]; r1[1] = v1[0] * cs1[1] + v1[1] * cs1[0];
                        r1[2] = v1[2] * cs1[2] - v1[3] * cs1[3]; r1[3] = v1[2] * cs1[3] + v1[3] * cs1[2];
                        v0 = r0; v1 = r1; }
                    v0 = v0 * sc; v1 = v1 * sc;
                    u32x4 w; w.x = cvt_pk_bf16(v0[0], v0[1]); w.y = cvt_pk_bf16(v0[2], v0[3]); w.z = cvt_pk_bf16(v1[0], v1[1]); w.w = cvt_pk_bf16(v1[2], v1[3]);
                    *(u32x4*)(rowp + bj * HALF) = w; } }
    }
};
}


namespace att {
__device__ __forceinline__ unsigned off_a(unsigned row, unsigned ch) { return 2048u * (row >> 3) + 512u * (ch >> 2) + 64u * (row & 7) + 16u * ((ch & 3) ^ ((row >> 2) & 3)); }
constexpr int KBUF = 0, VBUF = 32768, QOFF = 65536, WSF_OFF = LDSCTL_OFF + 1024;
constexpr float THR = 6.0f;
struct Args { const bf16_t* Q; const bf16_t* K; const bf16_t* V; bf16_t* O; const float* gsub; float lam, post; };
__device__ __forceinline__ s16x4 vtr(const LAS unsigned char* p) { return __builtin_bit_cast(s16x4, __builtin_amdgcn_ds_read_tr16_b64_v4i16((LAS s16x4*)p)); }
__device__ __forceinline__ float half_max(float v) { auto rr = __builtin_amdgcn_permlane32_swap(__float_as_uint(v), __float_as_uint(v), false, false); return fmaxf(__uint_as_float(rr[0]), __uint_as_float(rr[1])); }
__device__ __forceinline__ float half_sum(float v) { auto rr = __builtin_amdgcn_permlane32_swap(__float_as_uint(v), __float_as_uint(v), false, false); return __uint_as_float(rr[0]) + __uint_as_float(rr[1]); }

__device__ __forceinline__ void glds16(const void* gsrc, unsigned lds_dst) { unsigned keep;
    asm volatile("s_mov_b32 %0, m0\n\ts_mov_b32 m0, %2\n\ts_nop 0\n\tglobal_load_lds_dwordx4 %1, off\n\ts_mov_b32 m0, %0" : "=&s"(keep) : "v"(gsrc), "s"(lds_dst) : "memory"); }
__device__ __forceinline__ float max3f(float a, float b, float c) { float r; asm("v_max3_f32 %0, %1, %2, %3" : "=v"(r) : "v"(a), "v"(b), "v"(c)); return r; }
__device__ __forceinline__ float max2f(float a, float b) { float r; asm("v_max_f32_e32 %0, %1, %2" : "=v"(r) : "v"(a), "v"(b)); return r; }
__device__ __forceinline__ float fsub_s(float a, float b) { float r; asm("v_sub_f32_e32 %0, %1, %2" : "=v"(r) : "v"(a), "v"(b)); return r; }
__device__ __forceinline__ float fadd_s(float a, float b) { float r; asm("v_add_f32_e32 %0, %1, %2" : "=v"(r) : "v"(a), "v"(b)); return r; }
typedef __bf16 bf16x2_t __attribute__((ext_vector_type(2)));
__device__ __forceinline__ unsigned cvtpk_b(float lo, float hi) { const f32x2 v = {lo, hi}; const bf16x2_t b = __builtin_convertvector(v, bf16x2_t); return __builtin_bit_cast(unsigned, b); }
__device__ __forceinline__ void unit(LAS unsigned char* lds, const Args& P, int b, int h, int q0, int nlat, int tid) {
    const int lane = tid & 63, r32 = lane & 31, hi = lane >> 5; const int wid = __builtin_amdgcn_readfirstlane(tid >> 6);
    const int nt = nlat + 4;
    LAS unsigned char* Qs = lds + QOFF + wid * 8192;
    LAS float* wsf = (LAS float*)(lds + WSF_OFF + wid * 256);
    {   const bf16_t* qrow = P.Q + (size_t)(q0 + wid * 32 + r32) * D + h * 128 + hi * 8;
#pragma unroll
        for (int c = 0; c < 2; ++c)
#pragma unroll
            for (int d0 = 0; d0 < 4; ++d0) { const u32x4 v = *(const u32x4*)(qrow + c * 64 + d0 * 16); *(LAS u32x4*)(Qs + ((c * 4 + d0) * 2 + hi) * 512 + r32 * 16) = v; } }
    unsigned goff[2];
#pragma unroll
    for (int i = 0; i < 2; ++i) { const unsigned p = 2 * wid + i, rg = p >> 1, chq = (p & 1) * 2 + (lane >> 5), r7 = (lane >> 2) & 7, x = lane & 3, rsw = (r7 >> 2) | ((rg & 1) << 1);
        goff[i] = ((8 * rg + r7) * D + h * 128 + (4 * chq + (x ^ rsw)) * 8) * 2; }
#define ATT_GROW(t) ((t) < nlat ? b * SEQ + 64 * (t) : ML + b * CL + 64 * ((t) - nlat))
#define ATT_DMA(t, buf) do { const size_t g_ = (size_t)ATT_GROW(t) * D * 2; _Pragma("unroll") for (int i_ = 0; i_ < 2; ++i_) { \
        glds16((const char*)P.K + g_ + goff[i_], (unsigned)__builtin_amdgcn_readfirstlane(lds0 + KBUF + (buf) * 16384 + (2 * wid + i_) * 1024)); \
        glds16((const char*)P.V + g_ + goff[i_], (unsigned)__builtin_amdgcn_readfirstlane(lds0 + VBUF + (buf) * 16384 + (2 * wid + i_) * 1024)); } } while (0)
    const unsigned lds0 = (unsigned)(uintptr_t)lds;
    ATT_DMA(0, 0);
    unsigned kb[2];
#pragma unroll
    for (int e = 0; e < 2; ++e) kb[e] = 2048u * (r32 >> 3) + 64u * (r32 & 7) + 16u * ((unsigned)(2 * e + hi) ^ ((r32 >> 2) & 3));
    const unsigned blk = (lane >> 4) & 1, q_ = (lane & 15) >> 2, p_ = lane & 3;
    unsigned vb[2];
#pragma unroll
    for (int t = 0; t < 2; ++t) vb[t] = 2048u * t + 64u * (4 * hi + q_) + 16u * ((2 * blk + (p_ >> 1)) ^ ((2 * t + hi) & 3)) + 8u * (p_ & 1);
    float m0 = -1e30f, m1 = -1e30f, l0 = 0.f, l1 = 0.f;
    f32x16 o[2][4];
#pragma unroll
    for (int c = 0; c < 2; ++c)
#pragma unroll
        for (int d = 0; d < 4; ++d) o[c][d] = f32x16{};
    asm volatile("s_waitcnt vmcnt(0)" ::: "memory");
    __syncthreads();
#define SB() __builtin_amdgcn_sched_barrier(0)
#define ATT_SMB(S0, S1, i, M, SUM, PW) do { const float a_ = (i) < 8 ? S0[2 * ((i) & 7)] : S1[2 * ((i) & 7)], b_ = (i) < 8 ? S0[2 * ((i) & 7) + 1] : S1[2 * ((i) & 7) + 1]; \
        const float ea_ = __builtin_amdgcn_exp2f(fsub_s(a_, M)), eb_ = __builtin_amdgcn_exp2f(fsub_s(b_, M)); SUM += ea_; SUM += eb_; PW[i] = cvtpk_b(ea_, eb_); asm volatile("" : "+v"(SUM), "+v"(PW[i])); } while (0)
#define ATT_SMA(S0, S1, c, MC, LC) do { asm volatile("s_nop 15\n\ts_nop 7" : "+v"(S0), "+v"(S1)); \
        float a_ = max3f(S0[0], S0[1], S1[0]), b_ = max3f(S0[2], S0[3], S1[1]); a_ = max3f(a_, S1[2], S1[3]); \
        _Pragma("unroll") for (int r_ = 4; r_ < 16; r_ += 4) { a_ = max3f(a_, S0[r_], S0[r_ + 1]); b_ = max3f(b_, S0[r_ + 2], S0[r_ + 3]); a_ = max3f(a_, S1[r_], S1[r_ + 1]); b_ = max3f(b_, S1[r_ + 2], S1[r_ + 3]); } \
        const float mx_ = half_max(max2f(a_, b_)); \
        if (__any(mx_ - MC > THR)) { const float mn_ = fmaxf(MC, mx_), al_ = __builtin_amdgcn_exp2f(MC - mn_); MC = mn_; LC *= al_; if (hi == 0) wsf[r32] = al_; \
            _Pragma("unroll") for (int g4 = 0; g4 < 4; ++g4) { const f32x4 a4 = *(const LAS f32x4*)(wsf + 8 * g4 + 4 * hi); \
                _Pragma("unroll") for (int d = 0; d < 4; ++d) { o[c][d][4 * g4 + 0] *= a4[0]; o[c][d][4 * g4 + 1] *= a4[1]; o[c][d][4 * g4 + 2] *= a4[2]; o[c][d][4 * g4 + 3] *= a4[3]; } } } } while (0)
#define ATT_LDQK(c, d0, QF, K0, K1) do { QF = *(const LAS bf16x8*)(Qs + (((c) * 4 + (d0)) * 2 + hi) * 512 + r32 * 16); \
        K0 = *(const LAS bf16x8*)(Kb + kb[(d0) & 1] + 512 * (2 * (c) + ((d0) >> 1))); K1 = *(const LAS bf16x8*)(Kb + kb[(d0) & 1] + 512 * (2 * (c) + ((d0) >> 1)) + 8192); } while (0)
#define ATT_LDV(i, LO, HH) do { LO = vtr(Vb + vb[0] + 4096 * ((i) >> 2) + 512 * ((i) & 3)); HH = vtr(Vb + vb[1] + 4096 * ((i) >> 2) + 512 * ((i) & 3)); } while (0)
#define ATT_VF(LO, HH) ((bf16x8){LO[0], LO[1], LO[2], LO[3], HH[0], HH[1], HH[2], HH[3]})
#define ATT_PA(PW, ks) ((bf16x8)__builtin_bit_cast(bf16x8, (u32x4){PW[4 * (ks)], PW[4 * (ks) + 1], PW[4 * (ks) + 2], PW[4 * (ks) + 3]}))
#pragma unroll 1
    for (int t = 0; t < nt; ++t) {
        const int buf = t & 1;
        if (t + 1 < nt) ATT_DMA(t + 1, buf ^ 1);
        const LAS unsigned char* Kb = lds + KBUF + buf * 16384; const LAS unsigned char* Vb = lds + VBUF + buf * 16384;
        unsigned pw0[16], pw1[16];
        f32x16 sa = f32x16{}, sb = f32x16{};
        SB();
        {   bf16x8 qfA, k0A, k1A, qfB, k0B, k1B;
            ATT_LDQK(0, 0, qfA, k0A, k1A); ATT_LDQK(0, 1, qfB, k0B, k1B); SB();
            sa = __builtin_amdgcn_mfma_f32_32x32x16_bf16(k0A, qfA, sa, 0, 0, 0); sb = __builtin_amdgcn_mfma_f32_32x32x16_bf16(k1A, qfA, sb, 0, 0, 0); SB();
            ATT_LDQK(0, 2, qfA, k0A, k1A); SB();
            sa = __builtin_amdgcn_mfma_f32_32x32x16_bf16(k0B, qfB, sa, 0, 0, 0); sb = __builtin_amdgcn_mfma_f32_32x32x16_bf16(k1B, qfB, sb, 0, 0, 0); SB();
            ATT_LDQK(0, 3, qfB, k0B, k1B); SB();
            sa = __builtin_amdgcn_mfma_f32_32x32x16_bf16(k0A, qfA, sa, 0, 0, 0); sb = __builtin_amdgcn_mfma_f32_32x32x16_bf16(k1A, qfA, sb, 0, 0, 0); SB();
            sa = __builtin_amdgcn_mfma_f32_32x32x16_bf16(k0B, qfB, sa, 0, 0, 0); sb = __builtin_amdgcn_mfma_f32_32x32x16_bf16(k1B, qfB, sb, 0, 0, 0); }
        SB();
        ATT_SMA(sa, sb, 0, m0, l0);
        SB();
        f32x16 ta = f32x16{}, tb = f32x16{};
        {   bf16x8 qf, k0, k1; float sum = 0.f;
            ATT_LDQK(1, 0, qf, k0, k1); SB();
#define ATT_C(d0) do { ta = __builtin_amdgcn_mfma_f32_32x32x16_bf16(k0, qf, ta, 0, 0, 0); SB(); \
            if ((d0) < 3) k0 = *(const LAS bf16x8*)(Kb + kb[((d0) + 1) & 1] + 512 * (2 + (((d0) + 1) >> 1))); \
            ATT_SMB(sa, sb, 4 * (d0) + 0, m0, sum, pw0); ATT_SMB(sa, sb, 4 * (d0) + 1, m0, sum, pw0); SB(); \
            tb = __builtin_amdgcn_mfma_f32_32x32x16_bf16(k1, qf, tb, 0, 0, 0); SB(); \
            if ((d0) < 3) { qf = *(const LAS bf16x8*)(Qs + ((4 + (d0) + 1) * 2 + hi) * 512 + r32 * 16); k1 = *(const LAS bf16x8*)(Kb + kb[((d0) + 1) & 1] + 512 * (2 + (((d0) + 1) >> 1)) + 8192); } \
            ATT_SMB(sa, sb, 4 * (d0) + 2, m0, sum, pw0); ATT_SMB(sa, sb, 4 * (d0) + 3, m0, sum, pw0); SB(); } while (0)
            ATT_C(0); ATT_C(1); ATT_C(2); ATT_C(3);
#undef ATT_C
            l0 += sum; }
        ATT_SMA(ta, tb, 1, m1, l1);
        SB();
        {   s16x4 loA, hhA, loB, hhB, loC, hhC; float sum = 0.f;
            ATT_LDV(0, loA, hhA); ATT_LDV(1, loB, hhB); SB();
#define ATT_E(i, LOc, HHc, LOn, HHn) do { if ((i) + 2 < 16) ATT_LDV((i) + 2, LOn, HHn); SB(); \
            o[0][(i) & 3] = __builtin_amdgcn_mfma_f32_32x32x16_bf16(ATT_PA(pw0, (i) >> 2), ATT_VF(LOc, HHc), o[0][(i) & 3], 0, 0, 0); SB(); ATT_SMB(ta, tb, i, m1, sum, pw1); SB(); } while (0)
            ATT_E(0, loA, hhA, loC, hhC); ATT_E(1, loB, hhB, loA, hhA); ATT_E(2, loC, hhC, loB, hhB);
            ATT_E(3, loA, hhA, loC, hhC); ATT_E(4, loB, hhB, loA, hhA); ATT_E(5, loC, hhC, loB, hhB);
            ATT_E(6, loA, hhA, loC, hhC); ATT_E(7, loB, hhB, loA, hhA); ATT_E(8, loC, hhC, loB, hhB);
            ATT_E(9, loA, hhA, loC, hhC); ATT_E(10, loB, hhB, loA, hhA); ATT_E(11, loC, hhC, loB, hhB);
            ATT_E(12, loA, hhA, loC, hhC); ATT_E(13, loB, hhB, loA, hhA); ATT_E(14, loC, hhC, loB, hhB);
            ATT_E(15, loA, hhA, loC, hhC);
#undef ATT_E
            l1 += sum; }
#pragma unroll
        for (int ks = 0; ks < 4; ++ks) {
            s16x4 lo[4], hh[4];
#pragma unroll
            for (int d = 0; d < 4; ++d) ATT_LDV(4 * ks + d, lo[d], hh[d]);
#pragma unroll
            for (int d = 0; d < 4; ++d) o[1][d] = __builtin_amdgcn_mfma_f32_32x32x16_bf16(ATT_PA(pw1, ks), ATT_VF(lo[d], hh[d]), o[1][d], 0, 0, 0);
            SB();
        }
        asm volatile("s_waitcnt vmcnt(0)" ::: "memory");
        __syncthreads();
    }
#undef ATT_SMB
#undef ATT_SMA
#undef ATT_LDQK
#undef ATT_LDV
#undef ATT_VF
#undef ATT_PA
#undef SB
#undef ATT_GROW
#undef ATT_DMA
    l0 = half_sum(l0); l1 = half_sum(l1);
    if (hi == 0) { wsf[r32] = 1.0f / l0; wsf[32 + r32] = P.lam / l1; }
    float ss[16];
#pragma unroll
    for (int r = 0; r < 16; ++r) ss[r] = 0.f;
#pragma unroll
    for (int g4 = 0; g4 < 4; ++g4) { const f32x4 a4 = *(const LAS f32x4*)(wsf + 8 * g4 + 4 * hi), b4 = *(const LAS f32x4*)(wsf + 32 + 8 * g4 + 4 * hi);
#pragma unroll
        for (int d = 0; d < 4; ++d)
#pragma unroll
            for (int e = 0; e < 4; ++e) { const float v = o[0][d][4 * g4 + e] * a4[e] - o[1][d][4 * g4 + e] * b4[e]; o[0][d][4 * g4 + e] = v; ss[4 * g4 + e] += v * v; } }
#pragma unroll
    for (int r = 0; r < 16; ++r) {
        float v = ss[r];
#pragma unroll
        for (int s = 1; s < 32; s <<= 1) v += __shfl_xor(v, s);
        ss[r] = (1.0f / sqrtf(v * (1.0f / 128.0f) + SUBLN_EPS)) * P.post;
    }
    bf16_t* Ow = P.O + (size_t)(q0 + wid * 32) * D + h * 128 + r32;
#pragma unroll
    for (int d = 0; d < 4; ++d) { const float gs = P.gsub[32 * d + r32];
#pragma unroll
        for (int r = 0; r < 16; ++r) { const int row = (r & 3) + 8 * (r >> 2) + 4 * hi; const float v = o[0][d][r] * ss[r] * gs;
            Ow[(size_t)row * D + 32 * d] = (bf16_t)(cvt_pk_bf16(v, 0.f) & 0xffffu); } }
    __syncthreads();
}
}

struct ThinArgs {
    const float* xin_lat; const float* xin_ctx;
    const bf16_t* y;
    float* xout_lat; float* xout_ctx;
    const float* g_post; const float* gate;
    bf16_t* uout;
    const float* g_pre; const float* sc; const float* sh;
    const float* yc; int nslab;
    int nrows;
};
__device__ __forceinline__ void thin_phase(const ThinArgs& T, int gw, int ngw, int lane) {
#pragma unroll 1
    for (int row = gw; row < T.nrows; row += ngw) {
        const int mrow = row < ML ? (row >> 11) : 4;
        const float* xr = row < ML ? T.xin_lat + (size_t)row * D : T.xin_ctx + (size_t)(row - ML) * D;
        f32x4 xv[8];
#pragma unroll
        for (int j = 0; j < 8; ++j) xv[j] = *(const f32x4*)(xr + 256 * j + 4 * lane);
        if (T.y) {
            f32x4 yv[8]; float s = 0.f;
            if (row >= ML && T.nslab > 0) {
                const float* yr = T.yc + (size_t)(row - ML) * D;
#pragma unroll
                for (int j = 0; j < 8; ++j) yv[j] = *(const f32x4*)(yr + 256 * j + 4 * lane);
#pragma unroll 1
                for (int sl = 1; sl < T.nslab; ++sl) { yr += (size_t)MC * D;
#pragma unroll
                    for (int j = 0; j < 8; ++j) yv[j] = yv[j] + *(const f32x4*)(yr + 256 * j + 4 * lane); }
            } else {
                const bf16_t* yr = T.y + (size_t)row * D;
#pragma unroll
                for (int j = 0; j < 8; ++j) { const u32x2 v = *(const u32x2*)(yr + 256 * j + 4 * lane);
                    yv[j][0] = __uint_as_float(v.x << 16); yv[j][1] = __uint_as_float(v.x & 0xffff0000u); yv[j][2] = __uint_as_float(v.y << 16); yv[j][3] = __uint_as_float(v.y & 0xffff0000u); }
            }
#pragma unroll
            for (int j = 0; j < 8; ++j) s += (yv[j][0] * yv[j][0] + yv[j][1] * yv[j][1]) + (yv[j][2] * yv[j][2] + yv[j][3] * yv[j][3]);
            const float rs = 1.0f / sqrtf(wave_sum(s) * (1.0f / D) + NORM_EPS);
            const float* gt = T.gate + (size_t)mrow * MODROW;
#pragma unroll
            for (int j = 0; j < 8; ++j) { const f32x4 g = *(const f32x4*)(T.g_post + 256 * j + 4 * lane), a = *(const f32x4*)(gt + 256 * j + 4 * lane); xv[j] = xv[j] + a * ((yv[j] * rs) * g); }
            float* xo = row < ML ? (T.xout_lat ? T.xout_lat + (size_t)row * D : nullptr) : (T.xout_ctx ? T.xout_ctx + (size_t)(row - ML) * D : nullptr);
            if (xo) {
#pragma unroll
                for (int j = 0; j < 8; ++j) *(f32x4*)(xo + 256 * j + 4 * lane) = xv[j]; }
        }
        if (T.uout) {
            float s = 0.f;
#pragma unroll
            for (int j = 0; j < 8; ++j) s += (xv[j][0] * xv[j][0] + xv[j][1] * xv[j][1]) + (xv[j][2] * xv[j][2] + xv[j][3] * xv[j][3]);
            const float rs = 1.0f / sqrtf(wave_sum(s) * (1.0f / D) + NORM_EPS);
            const float* scp = T.sc + (size_t)mrow * MODROW; const float* shp = T.sh + (size_t)mrow * MODROW;
            bf16_t* uo = T.uout + (size_t)row * D;
#pragma unroll
            for (int j = 0; j < 8; ++j) { const f32x4 g = *(const f32x4*)(T.g_pre + 256 * j + 4 * lane), a = *(const f32x4*)(scp + 256 * j + 4 * lane), c = *(const f32x4*)(shp + 256 * j + 4 * lane);
                const f32x4 u = ((xv[j] * rs) * g) * (a + 1.0f) + c;
                u32x2 w; w.x = cvt_pk_bf16(u[0], u[1]); w.y = cvt_pk_bf16(u[2], u[3]); *(u32x2*)(uo + 256 * j + 4 * lane) = w; }
        }
    }
}
__device__ __forceinline__ void pool_phase(const bf16_t* U, bf16_t* Dm, int nrows, int gw, int ngw, int lane) {
    for (int row = gw; row < nrows; row += ngw) {
        int base, t, Ls;
        if (row < ML) { base = row & ~2047; t = row & 2047; Ls = SEQ; } else { const int i = row - ML; base = ML + (i & ~255); t = i & 255; Ls = CL; }
#pragma unroll
        for (int j = 0; j < 8; ++j) {
            const int w = 2 << (j >> 1); int lo = t - (w >> 1), hi = lo + w; lo = lo < 0 ? 0 : lo; hi = hi > Ls ? Ls : hi;
            const bf16_t* p = U + (size_t)base * D + 256 * j + 4 * lane;
            f32x4 s = {0.f, 0.f, 0.f, 0.f};
            for (int tt = lo; tt < hi; ++tt) { const u32x2 v = *(const u32x2*)(p + (size_t)tt * D);
                s[0] += __uint_as_float(v.x << 16); s[1] += __uint_as_float(v.x & 0xffff0000u); s[2] += __uint_as_float(v.y << 16); s[3] += __uint_as_float(v.y & 0xffff0000u); }
            const u32x2 cv = *(const u32x2*)(p + (size_t)t * D);
            const float inv = 1.0f / (float)(hi - lo);
            f32x4 d; d[0] = s[0] * inv - __uint_as_float(cv.x << 16); d[1] = s[1] * inv - __uint_as_float(cv.x & 0xffff0000u); d[2] = s[2] * inv - __uint_as_float(cv.y << 16); d[3] = s[3] * inv - __uint_as_float(cv.y & 0xffff0000u);
            u32x2 o; o.x = cvt_pk_bf16(d[0], d[1]); o.y = cvt_pk_bf16(d[2], d[3]);
            *(u32x2*)(Dm + (size_t)row * D + 256 * j + 4 * lane) = o;
        }
    }
}

struct TrDesc { const float* src; bf16_t* dst; int N, K; int perm; };
__device__ __forceinline__ void tr_load(const TrDesc& d, f32x4 (&v)[16], int lane) {
    const int kq = lane >> 4, n4 = lane & 15;
#pragma unroll
    for (int i = 0; i < 16; ++i) v[i] = __builtin_nontemporal_load((const f32x4*)(d.src + (size_t)(4 * i + kq) * d.N + 4 * n4));
}
__device__ __forceinline__ void tr_store(const TrDesc& d, const f32x4 (&v)[16], LAS float* scr, int lane) {
    const int kq = lane >> 4, n4 = lane & 15;
#pragma unroll
    for (int i = 0; i < 16; ++i) { LAS float* s = scr + (4 * i + kq) * 65 + 4 * n4; s[0] = v[i][0]; s[1] = v[i][1]; s[2] = v[i][2]; s[3] = v[i][3]; }
    asm volatile("s_waitcnt lgkmcnt(0)" ::: "memory");
    const int c = lane & 7;
#pragma unroll
    for (int j = 0; j < 8; ++j) { const int n = (lane >> 3) + 8 * j; int sc = n;
        if (d.perm) { const int jj = n >> 1, which = n & 1, ax = jj >> 4, f = jj & 15; sc = ax * 32 + which * 16 + f; }
        const LAS float* s = scr + (8 * c) * 65 + sc;
        u32x4 o; o.x = cvt_pk_bf16(s[0 * 65], s[1 * 65]); o.y = cvt_pk_bf16(s[2 * 65], s[3 * 65]); o.z = cvt_pk_bf16(s[4 * 65], s[5 * 65]); o.w = cvt_pk_bf16(s[6 * 65], s[7 * 65]);
        *(u32x4*)(d.dst + (size_t)n * d.K + 8 * c) = o; }
    asm volatile("s_waitcnt lgkmcnt(0)" ::: "memory");
}

struct Params {
    const float* in[22];
    float* out; unsigned char* ws;
    float lam_init0, lam_init3;
    int ph_lo, ph_hi;
};

template <int PART>
__device__ __forceinline__ void prologue(const Params& P, LAS unsigned char* lds, int tid, int wave, int lane, int vcu, int G) {
    unsigned char* ws = P.ws;
    const float* c_in = P.in[1]; const float* cctx = P.in[3]; const float* w_mod = P.in[4]; const float* b_mod = P.in[5];
    LAS float* sil = (LAS float*)lds;
    LAS float* red = (LAS float*)(lds + 65536);
    for (int i = tid; i < 5 * D; i += NTHR) { const int r = i / D, k = i % D; const float x = r < 4 ? c_in[r * D + k] : cctx[k]; sil[k * 8 + r] = x / (1.0f + __expf(-x)); }
    __syncthreads();
    float* mod = (float*)(ws + WS_MOD);
    for (int item = (PART == 1 ? 192 : 0) + blockIdx.x; item < (PART == 0 ? 192 : 4 * 192); item += G) {
        const int l = item / 192, col = (item % 192) * 64 + lane;
        const float* W = w_mod + (size_t)l * D * MODROW + col;
        float a0 = 0.f, a1 = 0.f, a2 = 0.f, a3 = 0.f, a4 = 0.f;
        const int k0 = wave * 256;
        for (int kk = 0; kk < 256; kk += 32) {
            float w[32];
#pragma unroll
            for (int j = 0; j < 32; ++j) w[j] = __builtin_nontemporal_load(W + (size_t)(k0 + kk + j) * MODROW);
#pragma unroll
            for (int j = 0; j < 32; ++j) { const f32x4 s4 = *(const LAS f32x4*)(sil + (k0 + kk + j) * 8); const float s5 = sil[(k0 + kk + j) * 8 + 4];
                a0 += s4[0] * w[j]; a1 += s4[1] * w[j]; a2 += s4[2] * w[j]; a3 += s4[3] * w[j]; a4 += s5 * w[j]; }
        }
        red[(wave * 5 + 0) * 64 + lane] = a0; red[(wave * 5 + 1) * 64 + lane] = a1; red[(wave * 5 + 2) * 64 + lane] = a2; red[(wave * 5 + 3) * 64 + lane] = a3; red[(wave * 5 + 4) * 64 + lane] = a4;
        __syncthreads();
        if (wave < 5) { float s = b_mod[l * MODROW + col];
#pragma unroll
            for (int w8 = 0; w8 < 8; ++w8) s += red[(w8 * 5 + wave) * 64 + lane];
            mod[((size_t)l * 5 + wave) * MODROW + col] = s; }
        __syncthreads();
    }
    LAS float* scr = (LAS float*)(lds + wave * 16640);
    const int gw = vcu * NWAVES + wave, NGW = G * NWAVES;
    bf16_t* Wqkv = (bf16_t*)(ws + WS_WQKV); bf16_t* Wo = (bf16_t*)(ws + WS_WO); bf16_t* Wf = (bf16_t*)(ws + WS_WF); bf16_t* Wp = (bf16_t*)(ws + WS_WPOOL);
    bf16_t* W1 = (bf16_t*)(ws + WS_W1); bf16_t* W2 = (bf16_t*)(ws + WS_W2);
    constexpr int I_QKV = (D / 64) * (3 * D / 64), I_O = (D / 64) * (D / 64), I_P = 8 * 8, I_1 = (D / 64) * (FF / 64), I_2 = (FF / 64) * (D / 64);
    constexpr int NITEMS = 2 * I_QKV + 2 * I_O + I_O + 4 * I_P + 4 * I_1 + 4 * I_2;
    auto decode = [&](int it) -> TrDesc {
        int r = it; const float* W; bf16_t* WT; int K, N, perm = 0;
        if (r < 2 * I_QKV) { const int ia = r / I_QKV; r %= I_QKV; W = P.in[10] + (size_t)ia * D * 3 * D; WT = Wqkv + (size_t)ia * 3 * D * D; K = D; N = 3 * D; perm = (r % (3 * D / 64)) < 2 * D / 64; }
        else if ((r -= 2 * I_QKV) < 2 * I_O) { const int ia = r / I_O; r %= I_O; W = P.in[11] + (size_t)ia * D * D; WT = Wo + (size_t)ia * D * D; K = D; N = D; }
        else if ((r -= 2 * I_O) < I_O) { W = P.in[17]; WT = Wf; K = D; N = D; }
        else if ((r -= I_O) < 4 * I_P) { const int g = r / I_P; r %= I_P; W = P.in[18] + (size_t)g * 512 * 512; WT = Wp + (size_t)g * 512 * 512; K = 512; N = 512; }
        else if ((r -= 4 * I_P) < 4 * I_1) { const int l = r / I_1; r %= I_1; W = P.in[20] + (size_t)l * D * FF; WT = W1 + (size_t)l * FF * D; K = D; N = FF; }
        else { r -= 4 * I_1; const int l = r / I_2; r %= I_2; W = P.in[21] + (size_t)l * FF * D; WT = W2 + (size_t)l * D * FF; K = FF; N = D; }
        const int nblk = N / 64, k0 = 64 * (r / nblk), n0 = 64 * (r % nblk);
        TrDesc d; d.src = W + (size_t)k0 * N + n0; d.dst = WT + (size_t)n0 * K + k0; d.N = N; d.K = K; d.perm = perm; return d; };
    {   const int it_end = (PART == 0 ? I_QKV : NITEMS); int it = (PART == 1 ? I_QKV : 0) + gw;
        f32x4 va[16], vb[16]; TrDesc da, db;
        if (it < it_end) { da = decode(it); tr_load(da, va, lane); }
        while (it < it_end) {
            const bool hb = it + NGW < it_end; if (hb) { db = decode(it + NGW); tr_load(db, vb, lane); }
            tr_store(da, va, scr, lane);
            if (!hb) break;
            const bool ha = it + 2 * NGW < it_end; if (ha) { da = decode(it + 2 * NGW); tr_load(da, va, lane); }
            tr_store(db, vb, scr, lane);
            if (!ha) break;
            it += 2 * NGW;
        } }
    if constexpr (PART != 1) {
        const int gt = gw * 64 + lane, NGT = NGW * 64; float* rope = (float*)(ws + WS_ROPE);
        for (int i = gt; i < 64 * 16; i += NGT) { const int pos = i >> 4, f = i & 15; const float inv = 1.0f / powf(10000.0f, (float)f * (1.0f / 16.0f)); const float ang = (float)pos * inv;
            rope[2 * i] = cosf(ang); rope[2 * i + 1] = sinf(ang); }
    }
    if constexpr (PART != 0) {   bf16_t* T1 = (bf16_t*)(ws + WS_T1); bf16_t* A2 = (bf16_t*)(ws + WS_A2); bf16_t* A2C = (bf16_t*)(ws + WS_A2C);
        constexpr int C_T1 = 1024 * 512 / 8, C_A2 = 2048 * 4096 / 8, C_A2C = 256 * 512 / 8;
        const int gt = gw * 64 + lane, NGT = NGW * 64;
        for (int ch = gt; ch < C_T1 + C_A2 + C_A2C; ch += NGT) {
            int r = ch; bf16_t* dst; int row, col0, N, ncol; float scale; bool negsin;
            if (r < C_T1) { row = r / 64; col0 = (r % 64) * 8; dst = T1 + (size_t)row * 512 + col0; N = 512; scale = 0.04419417382415922f; negsin = false;
                const int cs = row >> 9, k2 = row & 511; float vals[8];
#pragma unroll
                for (int e = 0; e < 8; ++e) { const int idx = (k2 * (col0 + e)) & 511; const float a = (float)idx * (1.0f / 256.0f); vals[e] = (cs ? sinpif(a) : cospif(a)) * scale; }
                u32x4 o; o.x = cvt_pk_bf16(vals[0], vals[1]); o.y = cvt_pk_bf16(vals[2], vals[3]); o.z = cvt_pk_bf16(vals[4], vals[5]); o.w = cvt_pk_bf16(vals[6], vals[7]); *(u32x4*)dst = o; continue; }
            r -= C_T1;
            if (r < C_A2) { row = r / 512; col0 = (r % 512) * 8; dst = A2 + (size_t)row * 4096 + col0; N = 2048; scale = 0.022097086912079608f; }
            else { r -= C_A2; row = r / 64; col0 = (r % 64) * 8; dst = A2C + (size_t)row * 512 + col0; N = 256; scale = 0.0625f; }
            (void)ncol; (void)negsin;
            { const int cs = col0 / N, n0 = col0 % N; float vals[8];
#pragma unroll
              for (int e = 0; e < 8; ++e) { const int idx = (row * (n0 + e)) & (N - 1); const float a = (float)idx * (2.0f / (float)N); vals[e] = (cs ? -sinpif(a) : cospif(a)) * scale; }
              u32x4 o; o.x = cvt_pk_bf16(vals[0], vals[1]); o.y = cvt_pk_bf16(vals[2], vals[3]); o.z = cvt_pk_bf16(vals[4], vals[5]); o.w = cvt_pk_bf16(vals[6], vals[7]); *(u32x4*)dst = o; }
        }
    }
}

struct Ctx { LAS unsigned char* lds; int tid, lane, wave, G, bx, vcu, gw, NGW; };
#if MK_MULTI
#define GRID_BAR() do { } while (0)
#else
#define GRID_BAR() xcd_barrier(bar)
#endif
#define PH_BEGIN(k) if ((k) >= P.ph_lo && (k) < P.ph_hi) {
#define PH_END(k)   if ((k) + 1 < P.ph_hi) { GRID_BAR(); for (int rb_ = 1; rb_ < PROBE_BAR; ++rb_) GRID_BAR(); } }
#define WSP(T, off) ((T*)(P.ws + (off)))

template <int L, int PH0>
__device__ __forceinline__ void layer(const Params& P, const Ctx& C, const XcdBarrier& bar) {
    constexpr int kind = L % 3; constexpr bool lastl = (L == 3);
    constexpr int Mact = lastl ? ML : MT;
    constexpr int NMIX = (kind == 2) ? 1 : 2;
    LAS unsigned char* lds = C.lds;
    if constexpr (kind == 0) {
        constexpr int ia = L / 3;
        PH_BEGIN(PH0)
        { pg8::Sched S{}; S.A = (const char*)WSP(bf16_t, WS_U); S.B = (const char*)(WSP(bf16_t, WS_WQKV) + (size_t)ia * 3 * D * D); S.lda = D * 2; S.ldb = D * 2; S.nt = D / 64;
          S.nM = MT / 256; S.nN = 3 * D / 256; S.ngroups = 1; S.a_g = 0; S.b_g = 0; S.G = C.G; S.c = C.bx;
          pg8::EpiQKV E{WSP(bf16_t, WS_Q), WSP(const float, WS_ROPE)};
          _Pragma("unroll") for (int rep_ = 0; rep_ < PROBE_QKV; ++rep_) { int tid_ = C.tid; if (rep_) { __builtin_amdgcn_sched_barrier(0); __syncthreads(); asm volatile("" : "+v"(tid_)); __builtin_amdgcn_sched_barrier(0); } pg8::gemm_phase(lds, S, E, tid_); } }
        PH_END(PH0)
        PH_BEGIN(PH0 + 1)
        { const float* lq1 = P.in[12] + ia * 64; const float* lk1 = P.in[13] + ia * 64; const float* lq2 = P.in[14] + ia * 64; const float* lk2 = P.in[15] + ia * 64;
          const float d1 = wave_sum(lq1[C.lane] * lk1[C.lane]), d2 = wave_sum(lq2[C.lane] * lk2[C.lane]);
          const float li = (L == 0) ? P.lam_init0 : P.lam_init3;
          att::Args A{WSP(bf16_t, WS_Q), WSP(bf16_t, WS_K), WSP(bf16_t, WS_V), WSP(bf16_t, WS_O), P.in[16] + ia * 128, expf(d1) - expf(d2) + li, 1.0f - li};
          _Pragma("unroll 1") for (int rep_ = 0; rep_ < PROBE_ATT; ++rep_) {
          constexpr int nlat_units = NB * NH * (SEQ / 256);
          const int per = (nlat_units + C.G - 1) / C.G;
#pragma unroll 1
          for (int i = 0; i < per; ++i) {
              if constexpr (false) { if (i == (C.vcu & 1)) { int tid_ = C.tid; asm volatile("" : "+v"(tid_));
                  prologue<1>(P, lds, tid_, __builtin_amdgcn_readfirstlane(tid_ >> 6), tid_ & 63, C.vcu, C.G); __syncthreads(); } }
              const int uu = C.vcu * per + i; if (uu < nlat_units) { const int bh = uu >> 3, qb = uu & 7; { int tid_ = C.tid; asm volatile("" : "+v"(tid_)); att::unit(lds, A, bh >> 4, bh & 15, (bh >> 4) * SEQ + qb * 256, SEQ / 64, tid_); } } }
          if constexpr (!lastl) { for (int uc = C.bx; uc < NB * NH; uc += C.G) { const int b = uc >> 4, h = uc & 15; { int tid_ = C.tid; asm volatile("" : "+v"(tid_)); att::unit(lds, A, b, h, ML + b * CL, 0, tid_); } } } } }
        PH_END(PH0 + 1)
    } else if constexpr (kind == 1) {
        PH_BEGIN(PH0)
        { pg8::Sched S{}; S.A = (const char*)WSP(bf16_t, WS_T1); S.B = (const char*)WSP(bf16_t, WS_U); S.lda = 512 * 2; S.ldb = D * 2; S.nt = 8; S.nM = 4; S.nN = Mact / 256; S.ngroups = 4; S.a_g = 0; S.b_g = 512 * 2; S.G = C.G; S.c = C.bx;
          pg8::EpiFA E{WSP(bf16_t, WS_YT), WSP(bf16_t, WS_YTC)};
          _Pragma("unroll") for (int rep_ = 0; rep_ < PROBE_FA; ++rep_) { int tid_ = C.tid; if (rep_) { __builtin_amdgcn_sched_barrier(0); __syncthreads(); asm volatile("" : "+v"(tid_)); __builtin_amdgcn_sched_barrier(0); } pg8::gemm_phase(lds, S, E, tid_); } }
        PH_END(PH0)
        PH_BEGIN(PH0 + 1)
        { pg8::Sched S{}; S.A = (const char*)WSP(bf16_t, WS_A2); S.B = (const char*)WSP(bf16_t, WS_YT); S.lda = 4096 * 2; S.ldb = 16384 * 2; S.nt = 64; S.nM = 8; S.nN = 8; S.ngroups = 4; S.a_g = 0; S.b_g = 4096 * 2; S.G = C.G; S.c = C.bx;
          pg8::EpiBf16<0> E{WSP(bf16_t, WS_O), (unsigned)D, SEQ};
          _Pragma("unroll") for (int rep_ = 0; rep_ < PROBE_FB; ++rep_) { int tid_ = C.tid; if (rep_) { __builtin_amdgcn_sched_barrier(0); __syncthreads(); asm volatile("" : "+v"(tid_)); __builtin_amdgcn_sched_barrier(0); } pg8::gemm_phase(lds, S, E, tid_); }
          if constexpr (!lastl) { pg8::Sched S2{}; S2.A = (const char*)WSP(bf16_t, WS_A2C); S2.B = (const char*)WSP(bf16_t, WS_YTC); S2.lda = 512 * 2; S2.ldb = 2048 * 2; S2.nt = 8; S2.nM = 1; S2.nN = 8; S2.ngroups = 4; S2.a_g = 0; S2.b_g = 512 * 2; S2.G = C.G; S2.c = C.bx;
            pg8::EpiBf16<0> E2{WSP(bf16_t, WS_O) + (size_t)ML * D, (unsigned)D, CL};
            _Pragma("unroll") for (int rep_ = 0; rep_ < PROBE_FB; ++rep_) { int tid_ = C.tid; if (rep_) { __builtin_amdgcn_sched_barrier(0); __syncthreads(); asm volatile("" : "+v"(tid_)); __builtin_amdgcn_sched_barrier(0); } pg8::gemm_phase(lds, S2, E2, tid_); } } }
        PH_END(PH0 + 1)
    } else {
        PH_BEGIN(PH0) for (int rep_ = 0; rep_ < PROBE_THIN; ++rep_) pool_phase(WSP(bf16_t, WS_U), WSP(bf16_t, WS_O), Mact, C.gw, C.NGW, C.lane); PH_END(PH0)
    }
    PH_BEGIN(PH0 + NMIX)
    { pg8::Sched S{}; S.A = (const char*)WSP(bf16_t, WS_O); S.lda = D * 2; S.G = C.G; S.c = C.bx;
      if constexpr (kind == 2) { S.B = (const char*)WSP(bf16_t, WS_WPOOL); S.ldb = 512 * 2; S.nt = 8; S.nM = Mact / 256; S.nN = 2; S.ngroups = 4; S.a_g = 512 * 2; S.b_g = 512 * 512 * 2;
          pg8::EpiY E{WSP(bf16_t, WS_Y), (unsigned)D, P.in[19], 512}; _Pragma("unroll") for (int rep_ = 0; rep_ < PROBE_MIX; ++rep_) { int tid_ = C.tid; if (rep_) { __builtin_amdgcn_sched_barrier(0); __syncthreads(); asm volatile("" : "+v"(tid_)); __builtin_amdgcn_sched_barrier(0); } pg8::gemm_phase(lds, S, E, tid_); } }
      else { S.B = kind == 0 ? (const char*)(WSP(bf16_t, WS_WO) + (size_t)(L / 3) * D * D) : (const char*)WSP(bf16_t, WS_WF); S.ldb = D * 2; S.nt = D / 64; S.nM = ML / 256; S.nN = D / 256; S.ngroups = 1;
          pg8::EpiY E{WSP(bf16_t, WS_Y), (unsigned)D, nullptr, 0}; _Pragma("unroll") for (int rep_ = 0; rep_ < PROBE_MIX; ++rep_) { int tid_ = C.tid; if (rep_) { __builtin_amdgcn_sched_barrier(0); __syncthreads(); asm volatile("" : "+v"(tid_)); __builtin_amdgcn_sched_barrier(0); } pg8::gemm_phase(lds, S, E, tid_); }
          if constexpr (!lastl) { pg8::Sched S2 = S; S2.A = (const char*)(WSP(bf16_t, WS_O) + (size_t)ML * D); S2.nt = D / 64 / NSPLIT; S2.nM = MC / 256; S2.ngroups = NSPLIT; S2.a_g = (D / NSPLIT) * 2; S2.b_g = (D / NSPLIT) * 2;
              pg8::EpiF32 E2{WSP(float, WS_YC), (unsigned)D, nullptr, 0, (size_t)MC * D}; _Pragma("unroll") for (int rep_ = 0; rep_ < PROBE_MIX; ++rep_) { int tid_ = C.tid; if (rep_) { __builtin_amdgcn_sched_barrier(0); __syncthreads(); asm volatile("" : "+v"(tid_)); __builtin_amdgcn_sched_barrier(0); } pg8::gemm_phase(lds, S2, E2, tid_); } } } }
    PH_END(PH0 + NMIX)
    PH_BEGIN(PH0 + NMIX + 1)
    { const float* modl = WSP(const float, WS_MOD) + (size_t)L * 5 * MODROW; float* X = WSP(float, WS_X);
      ThinArgs T{}; T.xin_lat = L == 0 ? P.in[0] : X; T.xin_ctx = L == 0 ? P.in[2] : X + (size_t)ML * D; T.y = WSP(const bf16_t, WS_Y); T.xout_lat = X; T.xout_ctx = X + (size_t)ML * D;
      T.yc = WSP(const float, WS_YC); T.nslab = (kind == 2 || lastl) ? 0 : NSPLIT;
      T.g_post = P.in[7] + L * D; T.gate = modl + 2 * D; T.uout = WSP(bf16_t, WS_U); T.g_pre = P.in[8] + L * D; T.sc = modl + 4 * D; T.sh = modl + 3 * D; T.nrows = Mact;
      thin_phase(T, C.gw, C.NGW, C.lane);
      for (int rep_ = 1; rep_ < PROBE_THIN; ++rep_) { ThinArgs T2 = T; if (T2.xout_lat) { T2.xout_lat = WSP(float, WS_END); T2.xout_ctx = WSP(float, WS_END) + (size_t)ML * D; } if (T2.uout) T2.uout = WSP(bf16_t, WS_END + 80 * MiB); thin_phase(T2, C.gw, C.NGW, C.lane); } }
    PH_END(PH0 + NMIX + 1)
    PH_BEGIN(PH0 + NMIX + 2)
    { pg8::Sched S{}; S.A = (const char*)WSP(bf16_t, WS_U); S.B = (const char*)(WSP(bf16_t, WS_W1) + (size_t)L * FF * D); S.lda = D * 2; S.ldb = D * 2; S.nt = D / 64; S.nM = Mact / 256; S.nN = FF / 256; S.ngroups = 1; S.G = C.G; S.c = C.bx;
      pg8::EpiBf16<1> E{WSP(bf16_t, WS_H), (unsigned)FF, 0}; _Pragma("unroll") for (int rep_ = 0; rep_ < PROBE_W1; ++rep_) { int tid_ = C.tid; if (rep_) { __builtin_amdgcn_sched_barrier(0); __syncthreads(); asm volatile("" : "+v"(tid_)); __builtin_amdgcn_sched_barrier(0); } pg8::gemm_phase(lds, S, E, tid_); } }
    PH_END(PH0 + NMIX + 2)
    PH_BEGIN(PH0 + NMIX + 3)
    { pg8::Sched S{}; S.A = (const char*)WSP(bf16_t, WS_H); S.B = (const char*)(WSP(bf16_t, WS_W2) + (size_t)L * D * FF); S.lda = FF * 2; S.ldb = FF * 2; S.nt = FF / 64; S.nM = ML / 256; S.nN = D / 256; S.ngroups = 1; S.G = C.G; S.c = C.bx;
      pg8::EpiY E{WSP(bf16_t, WS_Y), (unsigned)D, nullptr, 0}; _Pragma("unroll") for (int rep_ = 0; rep_ < PROBE_W2; ++rep_) { int tid_ = C.tid; if (rep_) { __builtin_amdgcn_sched_barrier(0); __syncthreads(); asm volatile("" : "+v"(tid_)); __builtin_amdgcn_sched_barrier(0); } pg8::gemm_phase(lds, S, E, tid_); }
      if constexpr (!lastl) { pg8::Sched S2 = S; S2.A = (const char*)(WSP(bf16_t, WS_H) + (size_t)ML * FF); S2.nt = FF / 64 / NSPLIT; S2.nM = MC / 256; S2.ngroups = NSPLIT; S2.a_g = (FF / NSPLIT) * 2; S2.b_g = (FF / NSPLIT) * 2;
          pg8::EpiF32 E2{WSP(float, WS_YC), (unsigned)D, nullptr, 0, (size_t)MC * D}; _Pragma("unroll") for (int rep_ = 0; rep_ < PROBE_W2; ++rep_) { int tid_ = C.tid; if (rep_) { __builtin_amdgcn_sched_barrier(0); __syncthreads(); asm volatile("" : "+v"(tid_)); __builtin_amdgcn_sched_barrier(0); } pg8::gemm_phase(lds, S2, E2, tid_); } } }
    PH_END(PH0 + NMIX + 3)
    PH_BEGIN(PH0 + NMIX + 4)
    { const float* modl = WSP(const float, WS_MOD) + (size_t)L * 5 * MODROW; float* X = WSP(float, WS_X);
      ThinArgs T{}; T.xin_lat = X; T.xin_ctx = X + (size_t)ML * D; T.y = WSP(const bf16_t, WS_Y); T.xout_lat = lastl ? P.out : X; T.xout_ctx = X + (size_t)ML * D;
      T.yc = WSP(const float, WS_YC); T.nslab = lastl ? 0 : NSPLIT;
      T.g_post = P.in[9] + L * D; T.gate = modl + 5 * D; T.nrows = Mact;
      if constexpr (!lastl) { const float* modn = modl + 5 * MODROW; T.uout = WSP(bf16_t, WS_U); T.g_pre = P.in[6] + (L + 1) * D; T.sc = modn + 1 * D; T.sh = modn + 0 * D; }
      thin_phase(T, C.gw, C.NGW, C.lane);
      for (int rep_ = 1; rep_ < PROBE_THIN; ++rep_) { ThinArgs T2 = T; if (T2.xout_lat) { T2.xout_lat = WSP(float, WS_END); T2.xout_ctx = WSP(float, WS_END) + (size_t)ML * D; } if (T2.uout) T2.uout = WSP(bf16_t, WS_END + 80 * MiB); thin_phase(T2, C.gw, C.NGW, C.lane); } }
    PH_END(PH0 + NMIX + 4)
}
constexpr int PH_L0 = 2, PH_L1 = PH_L0 + 7, PH_L2 = PH_L1 + 7, PH_L3 = PH_L2 + 6, N_PHASES = PH_L3 + 7;

__global__ void __launch_bounds__(NTHR, 2) fwd_kernel(Params P) {
    extern __shared__ __attribute__((aligned(16))) unsigned char lds_raw[];
    Ctx C; C.lds = (LAS unsigned char*)lds_raw;
    C.tid = threadIdx.x; C.lane = C.tid & 63; C.wave = __builtin_amdgcn_readfirstlane(C.tid >> 6);
    C.G = gridDim.x; C.bx = blockIdx.x; C.vcu = (C.G % 8 == 0) ? (C.bx % 8) * (C.G / 8) + C.bx / 8 : C.bx;
    C.gw = C.vcu * NWAVES + C.wave; C.NGW = C.G * NWAVES;
    for (int u = C.tid; u < (LDS_BYTES - LDSCTL_OFF) / 4; u += NTHR) ((LAS unsigned*)(C.lds + LDSCTL_OFF))[u] = 0u;
    __syncthreads();
#if MK_MULTI
    XcdBarrier bar{};
#else
    XcdBarrier bar = xcd_barrier_post(WSP(unsigned, WS_CTL) + CW_BAR, (volatile LAS unsigned*)(C.lds + MISC_OFF) + 8);
#endif
    PH_BEGIN(0) for (int rep_ = 0; rep_ < PROBE_PRO; ++rep_) { prologue<2>(P, C.lds, C.tid, C.wave, C.lane, C.vcu, C.G); __syncthreads(); } PH_END(0)
    PH_BEGIN(1)
    { const float* mod = WSP(const float, WS_MOD);
      ThinArgs T{}; T.xin_lat = P.in[0]; T.xin_ctx = P.in[2]; T.y = nullptr; T.uout = WSP(bf16_t, WS_U); T.g_pre = P.in[6]; T.sc = mod + 1 * D; T.sh = mod + 0 * D; T.nrows = MT;
      thin_phase(T, C.gw, C.NGW, C.lane);
      for (int rep_ = 1; rep_ < PROBE_THIN; ++rep_) { ThinArgs T2 = T; if (T2.xout_lat) { T2.xout_lat = WSP(float, WS_END); T2.xout_ctx = WSP(float, WS_END) + (size_t)ML * D; } if (T2.uout) T2.uout = WSP(bf16_t, WS_END + 80 * MiB); thin_phase(T2, C.gw, C.NGW, C.lane); } }
    PH_END(1)
    layer<0, PH_L0>(P, C, bar);
    layer<1, PH_L1>(P, C, bar);
    layer<2, PH_L2>(P, C, bar);
    layer<3, PH_L3>(P, C, bar);
}
#undef PH_BEGIN
#undef PH_END
#undef GRID_BAR

extern "C" void kernel_launch(void* const* d_in, const int* in_sizes, int n_in, void* d_out, int out_size, void* d_ws, size_t ws_size, hipStream_t stream) {
    static int grid = 0;
    if (grid == 0) {
        if (n_in != 22 || out_size != ML * D || ws_size < WS_END + 128 * MiB) { fprintf(stderr, "kernel_launch: unexpected problem: n_in %d out %d ws %zu (need %zu)\n", n_in, out_size, ws_size, (size_t)WS_END); grid = -1; return; }
        int dev = 0, cus = 0, per_cu = 0;
        if (hipGetDevice(&dev) != hipSuccess || hipDeviceGetAttribute(&cus, hipDeviceAttributeMultiprocessorCount, dev) != hipSuccess) { grid = -1; return; }
        if (hipFuncSetAttribute((const void*)fwd_kernel, hipFuncAttributeMaxDynamicSharedMemorySize, LDS_BYTES) != hipSuccess) { fprintf(stderr, "kernel_launch: hipFuncSetAttribute failed\n"); grid = -1; return; }
        if (hipOccupancyMaxActiveBlocksPerMultiprocessor(&per_cu, (const void*)fwd_kernel, NTHR, LDS_BYTES) != hipSuccess || per_cu < 1) fprintf(stderr, "kernel_launch: occupancy query says %d\n", per_cu);
        (void)hipGetLastError();
        grid = cus;
    }
    if (grid < 0) return;
    (void)in_sizes;
    hipMemsetAsync((char*)d_ws + WS_CTL, 0, CTL_BYTES, stream);
    Params p{};
    for (int i = 0; i < 22; ++i) p.in[i] = (const float*)d_in[i];
    p.out = (float*)d_out; p.ws = (unsigned char*)d_ws;
    p.lam_init0 = (float)(0.8 - 0.6 * exp(-0.3 * 0.0)); p.lam_init3 = (float)(0.8 - 0.6 * exp(-0.3 * 3.0));
#if MK_MULTI
    for (int ph = 0; ph < N_PHASES; ++ph) { p.ph_lo = ph; p.ph_hi = ph + 1; hipLaunchKernelGGL(fwd_kernel, dim3(grid), dim3(NTHR), LDS_BYTES, stream, p); }
#else
    p.ph_lo = 0; p.ph_hi = N_PHASES;
    hipLaunchKernelGGL(fwd_kernel, dim3(grid), dim3(NTHR), LDS_BYTES, stream, p);
#endif
    const hipError_t le = hipPeekAtLastError();
    if (le != hipSuccess) fprintf(stderr, "kernel_launch: launch failed: %s\n", hipGetErrorName(le));
}
```

```cpp
#include <hip/hip_runtime.h>
#include <cstdio>
#include <cstdint>
#include <cmath>

#define PROBE_QKV 1
#define PROBE_FA 1
#define PROBE_FB 1
#define PROBE_MIX 1
#define PROBE_W1 1
#define PROBE_W2 1
#define PROBE_BAR 1
#define PROBE_ATT 1
#define PROBE_PRO 1
#define PROBE_THIN 1
#ifndef MK_MULTI
#define MK_MULTI 0
#endif

#define LAS __attribute__((address_space(3)))
#define GAS __attribute__((address_space(1)))
typedef unsigned short bf16_t;
typedef short bf16x8 __attribute__((ext_vector_type(8)));
typedef short s16x4 __attribute__((ext_vector_type(4)));
typedef float f32x4 __attribute__((ext_vector_type(4)));
typedef float f32x2 __attribute__((ext_vector_type(2)));
typedef float f32x16 __attribute__((ext_vector_type(16)));
typedef unsigned u32x4 __attribute__((ext_vector_type(4)));
typedef unsigned u32x2 __attribute__((ext_vector_type(2)));

constexpr int D = 2048, NB = 4, SEQ = 2048, CL = 256, ML = NB * SEQ, MC = NB * CL, MT = ML + MC, FF = 8192, NH = 16, NMOD = 6, MODROW = NMOD * D;
constexpr int NWAVES = 8, NTHR = 512;
constexpr float NORM_EPS = 1e-6f, SUBLN_EPS = 1e-5f;
constexpr float QSCALE = 0.125f * 1.4426950408889634f;

constexpr size_t MiB = 1u << 20;
constexpr size_t WS_CTL = 0, CTL_BYTES = 1 * MiB;
constexpr size_t WS_MOD = 1 * MiB;
constexpr size_t WS_ROPE = 2 * MiB;
constexpr size_t WS_T1 = 3 * MiB;
constexpr size_t WS_A2C = 4 * MiB;
constexpr size_t WS_A2 = 5 * MiB;
constexpr size_t WS_WQKV = 22 * MiB;
constexpr size_t WS_WO = 70 * MiB;
constexpr size_t WS_WF = 86 * MiB;
constexpr size_t WS_WPOOL = 94 * MiB;
constexpr size_t WS_W1 = 96 * MiB;
constexpr size_t WS_W2 = 224 * MiB;
constexpr size_t WS_X = 352 * MiB;
constexpr size_t WS_Y = 424 * MiB;
constexpr size_t WS_U = 496 * MiB;
constexpr size_t WS_Q = 532 * MiB, WS_K = 568 * MiB, WS_V = 604 * MiB, WS_O = 640 * MiB;
constexpr size_t WS_H = 676 * MiB;
constexpr size_t WS_YT = 820 * MiB;
constexpr size_t WS_YTC = 884 * MiB;
constexpr size_t WS_YC = 892 * MiB;
constexpr size_t WS_END = 956 * MiB;
constexpr int NSPLIT = 8;

constexpr int RING_BYTES = 131072, LDSCTL_OFF = 139264  , MISC_OFF = LDSCTL_OFF + 320, LDS_BYTES = 147456;

__device__ __forceinline__ unsigned cvt_pk_bf16(float lo, float hi) { unsigned r; asm volatile("v_cvt_pk_bf16_f32 %0, %1, %2" : "=v"(r) : "v"(lo), "v"(hi)); return r; }
__device__ __forceinline__ float bf2f(unsigned short b) { return __uint_as_float(((unsigned)b) << 16); }
__device__ __forceinline__ float wave_sum(float v) {
#pragma unroll
    for (int o = 1; o < 64; o <<= 1) v += __shfl_xor(v, o);
    return v;
}

#define XB_TMO      128
#define XB_XCNT(j)  (256  + 64 * (j))
#define XB_XSUB(j)  (1280 + 64 * (j))
#define XB_XGEN(j)  (2304 + 64 * (j))
#define XB_TOP      3328
#define XB_TOPGEN   3392
#define XCD_BAR_WORDS 3456
#define XB_SPIN_CAP (1u << 18)
constexpr int CW_BAR = 4096;

__device__ __forceinline__ unsigned xb_ld(unsigned* p)              { return __hip_atomic_load(p, __ATOMIC_RELAXED, __HIP_MEMORY_SCOPE_AGENT); }
__device__ __forceinline__ unsigned xb_add(unsigned* p, unsigned v) { return __hip_atomic_fetch_add(p, v, __ATOMIC_RELAXED, __HIP_MEMORY_SCOPE_AGENT); }
__device__ __forceinline__ unsigned xb_xcc_id() { return (unsigned)__builtin_amdgcn_s_getreg((3 << 11) | 20) & 0xFu; }
#define XB_SPIN(cond, bar) do { unsigned _sp = 0; while (cond) { __builtin_amdgcn_s_sleep(1); \
    if ((++_sp & 255u) == 0u) { if (xb_ld(&(bar)[XB_TMO])) break; if (_sp > XB_SPIN_CAP) { atomicAdd(&(bar)[XB_TMO], 1u); break; } } } } while (0)

struct XcdBarrier { unsigned* bar; unsigned x; volatile LAS unsigned* st; };

__device__ __forceinline__ XcdBarrier xcd_barrier_post(unsigned* bar, volatile LAS unsigned* st) {
    XcdBarrier b; b.bar = bar; b.x = xb_xcc_id(); b.st = st;
    if (threadIdx.x == 0) st[2] = xb_add(&bar[XB_XCNT(b.x)], 1u);
    return b;
}
__device__ __forceinline__ void xcd_barrier_complete(unsigned* bar, unsigned x, unsigned& nloc, unsigned& nx) {
    const unsigned G = gridDim.x * gridDim.y * gridDim.z;
    unsigned sum, cnt, mine, sp = 0u;
    for (;;) {
        sum = 0u; cnt = 0u; mine = 0u;
#pragma unroll
        for (unsigned j = 0; j < 16; ++j) { const unsigned c = xb_ld(&bar[XB_XCNT(j)]); sum += c; cnt += (c > 0u) ? 1u : 0u; mine = (j == x) ? c : mine; }
        if (sum == G) break;
        __builtin_amdgcn_s_sleep(1);
        if ((++sp & 255u) == 0u) { if (xb_ld(&bar[XB_TMO])) break; if (sp > XB_SPIN_CAP) { atomicAdd(&bar[XB_TMO], 1u); break; } }
    }
    nloc = mine > 0u ? mine : 1u; nx = cnt > 0u ? cnt : 1u;
}
__device__ __forceinline__ void xcd_barrier(const XcdBarrier& b) {
    asm volatile("s_waitcnt vmcnt(0)" ::: "memory");
    __syncthreads();
    if (threadIdx.x == 0) {
        unsigned* bar = b.bar;
        __builtin_amdgcn_s_waitcnt(0);
        unsigned nloc = b.st[0], nx = b.st[1];
        if (nloc == 0u) { xcd_barrier_complete(bar, b.x, nloc, nx); b.st[0] = nloc; b.st[1] = nx; }
        const unsigned old = xb_add(&bar[XB_XSUB(b.x)], 1u);
        const unsigned gen = old / nloc;
        if (old + 1u == (gen + 1u) * nloc) {
            __builtin_amdgcn_fence(__ATOMIC_RELEASE, "agent");
            asm volatile("s_waitcnt vmcnt(0)" ::: "memory");
            const unsigned og = xb_add(&bar[XB_TOP], 1u);
            const unsigned tg = og / nx;
            if (og + 1u == (tg + 1u) * nx) xb_add(&bar[XB_TOPGEN], 1u);
            else XB_SPIN(xb_ld(&bar[XB_TOPGEN]) == tg, bar);
            __builtin_amdgcn_fence(__ATOMIC_ACQUIRE, "agent");
            xb_add(&bar[XB_XGEN(b.x)], 1u);
            asm volatile("s_waitcnt vmcnt(0)" ::: "memory");
        } else {
            XB_SPIN(xb_ld(&bar[XB_XGEN(b.x)]) == gen, bar);
            __builtin_amdgcn_fence(__ATOMIC_ACQUIRE, "agent");
            asm volatile("s_waitcnt vmcnt(0)" ::: "memory");
        }
    }
    __syncthreads();
}

namespace pg8 {
constexpr int BM = 256, BK = 64, HALF = 128, HTB = HALF * BK * 2, STAGE_BYTES = 8 * HTB, NXCD = 8, WGM = 8;
__device__ __forceinline__ int lds_byte(int r, int c) { const int st = (r >> 4) * 2 + (c >> 5), rr = r & 15, cc = c & 31, ob = rr * 64 + cc * 2; return st * 1024 + (ob ^ (((ob >> 9) & 1) << 5)); }
__device__ __forceinline__ void stage_rc(int b, int& R, int& C) { const int st = b / 1024, sb = b % 1024, swz = sb ^ (((sb >> 9) & 1) << 5); R = (st >> 1) * 16 + swz / 64; C = (st & 1) * 32 + (swz % 64) / 2; }
__device__ __forceinline__ int perm32(int rho) { const int n = rho >> 4, i = rho & 15; return 8 * (i >> 2) + 4 * n + (i & 3); }

struct Unit { const char* A; const char* B; int g, pm, pn; };

struct Sched {
    const char* A; const char* B; unsigned lda, ldb; int nt;
    int nM, nN, ngroups; long long a_g, b_g;
    int G, c;
    __device__ __forceinline__ bool next(int i, Unit& u) const {
        const int per = nM * nN, nwg = per * ngroups;
        const long L = (long)i * G + c; if (L >= nwg) return false;
        int wgid = (int)L; { const int q = nwg / NXCD, r = nwg % NXCD, xcd = wgid % NXCD, off = wgid / NXCD; wgid = (xcd < r ? xcd * (q + 1) : r * (q + 1) + (xcd - r) * q) + off; }
        const int g = wgid / per, w = wgid % per;
        const int nig = WGM * nN, gid = w / nig, fm = gid * WGM, gsz = (nM - fm) < WGM ? (nM - fm) : WGM;
        u.g = g; u.pm = fm + ((w % nig) % gsz); u.pn = (w % nig) / gsz;
        u.A = A + (long long)g * a_g + (size_t)u.pm * BM * lda; u.B = B + (long long)g * b_g + (size_t)u.pn * BM * ldb;
        return true;
    }
};

template <class Epi>
__device__ __forceinline__ void gemm_phase(LAS unsigned char* lds, const Sched& S, const Epi& E, int tid_in = -1) {
    const int tid = tid_in >= 0 ? tid_in : (int)threadIdx.x, wid = __builtin_amdgcn_readfirstlane(tid >> 6), lane = tid & 63, wr = wid >> 2, wc = wid & 3, fr = lane & 15, fq = lane >> 4;
    const int nt = S.nt;
    unsigned voffA[2], voffB[2];
#pragma unroll
    for (int i = 0; i < 2; ++i) { int R, C; stage_rc(tid * 16 + i * 8192, R, C); const int Rb = (R & ~31) + perm32(R & 31);
        voffA[i] = (unsigned)R * S.lda + (unsigned)C * 2u; voffB[i] = (unsigned)Rb * S.ldb + (unsigned)C * 2u; }
    const size_t kstep = (size_t)(BK * 2);
    const size_t hA = (size_t)HALF * S.lda, hB = (size_t)HALF * S.ldb;
    const unsigned ldsw = (unsigned)wid * 1024u;
    const int aoff = lds_byte(wr * 64 + fr, fq * 8), boff = lds_byte(wc * 32 + fr, fq * 8);
#define PG8_SA(b, h) (((b) * 2 + (h)) * HTB)
#define PG8_SB(b, h) ((4 + (b) * 2 + (h)) * HTB)
#define PG8_STAGE(bufoff, gbase, voff) do { _Pragma("unroll") for (int _i = 0; _i < 2; ++_i) \
        __builtin_amdgcn_global_load_lds((const unsigned*)((const char*)(gbase) + (voff)[_i]), (LAS unsigned*)(lds + (bufoff) + ldsw + _i * 8192), 16, 0, 0); } while (0)
#define PG8_LDA(dst, b, h) do { _Pragma("unroll") for (int m = 0; m < 4; ++m) _Pragma("unroll") for (int k = 0; k < 2; ++k) dst[m][k] = *(const LAS bf16x8*)(lds + PG8_SA(b, h) + aoff + m * 2048 + k * 1024); } while (0)
#define PG8_LDB(dst, b, h) do { _Pragma("unroll") for (int n = 0; n < 2; ++n) _Pragma("unroll") for (int k = 0; k < 2; ++k) dst[n][k] = *(const LAS bf16x8*)(lds + PG8_SB(b, h) + boff + n * 2048 + k * 1024); } while (0)
#define PG8_MMA(ai, bj, At, Bt) do { __builtin_amdgcn_s_setprio(1); _Pragma("unroll") for (int m = 0; m < 4; ++m) _Pragma("unroll") for (int n = 0; n < 2; ++n) _Pragma("unroll") for (int k = 0; k < 2; ++k) \
        acc[ai][bj][m][n] = __builtin_amdgcn_mfma_f32_16x16x32_bf16(Bt[n][k], At[m][k], acc[ai][bj][m][n], 0, 0, 0); __builtin_amdgcn_s_setprio(0); } while (0)
#define PG8_WAIT_V(n) asm volatile("s_waitcnt vmcnt(" #n ")" ::: "memory")
#define PG8_WAIT_L(n) asm volatile("s_waitcnt lgkmcnt(" #n ")" ::: "memory")
#define PG8_BAR __builtin_amdgcn_s_barrier()
#define PG8_SCHED __builtin_amdgcn_sched_barrier(0)
    Unit cur, nxt; int ui = 0;
    if (!S.next(0, cur)) return;
    f32x4 acc[2][2][4][2];
#pragma unroll
    for (int a = 0; a < 2; ++a)
#pragma unroll
        for (int b = 0; b < 2; ++b)
#pragma unroll
            for (int m = 0; m < 4; ++m)
#pragma unroll
                for (int n = 0; n < 2; ++n) acc[a][b][m][n] = (f32x4){0.f, 0.f, 0.f, 0.f};
    bf16x8 At[4][2], B0[2][2], B1[2][2];
    const char* cA = cur.A; const char* cB = cur.B;
    PG8_STAGE(PG8_SB(0, 0), cB, voffB); PG8_STAGE(PG8_SB(0, 1), cB + hB, voffB); PG8_STAGE(PG8_SA(0, 0), cA, voffA); PG8_STAGE(PG8_SA(0, 1), cA + hA, voffA);
    if (wr == 1) PG8_BAR;
    PG8_WAIT_V(2); PG8_BAR;
    PG8_STAGE(PG8_SB(1, 0), cB + kstep, voffB); PG8_STAGE(PG8_SA(1, 0), cA + kstep, voffA); PG8_STAGE(PG8_SB(1, 1), cB + hB + kstep, voffB);
    PG8_WAIT_V(6); PG8_BAR;
    for (;;) {
        const bool has_next = S.next(ui + 1, nxt);
        const char* nA = has_next ? nxt.A : cA; const char* nB = has_next ? nxt.B : cB;
        for (int t = 0; t < nt; t += 2) {
            const bool last = (t == nt - 2);
            const char* a1 = cA + (size_t)(t + 1) * kstep;
            const char* a2 = last ? nA : cA + (size_t)(t + 2) * kstep; const char* b2 = last ? nB : cB + (size_t)(t + 2) * kstep;
            const char* a3 = a2 + kstep; const char* b3 = b2 + kstep;
            PG8_LDB(B0, 0, 0); PG8_LDB(B1, 0, 1); PG8_SCHED; PG8_LDA(At, 0, 0); PG8_STAGE(PG8_SA(1, 1), a1 + hA, voffA);
            PG8_WAIT_V(8); PG8_WAIT_L(0); PG8_BAR; PG8_MMA(0, 0, At, B0); PG8_MMA(0, 1, At, B1); PG8_BAR; PG8_SCHED;
            PG8_LDA(At, 0, 1); PG8_STAGE(PG8_SB(0, 0), b2, voffB); PG8_STAGE(PG8_SB(0, 1), b2 + hB, voffB); PG8_STAGE(PG8_SA(0, 0), a2, voffA);
            PG8_WAIT_V(8); PG8_WAIT_L(0); PG8_BAR; PG8_MMA(1, 0, At, B0); PG8_MMA(1, 1, At, B1); PG8_BAR; PG8_SCHED;
            PG8_LDB(B0, 1, 0); PG8_LDB(B1, 1, 1); PG8_SCHED; PG8_LDA(At, 1, 0); PG8_STAGE(PG8_SA(0, 1), a2 + hA, voffA);
            PG8_WAIT_V(8); PG8_WAIT_L(0); PG8_BAR; PG8_MMA(0, 0, At, B0); PG8_MMA(0, 1, At, B1); PG8_BAR; PG8_SCHED;
            PG8_LDA(At, 1, 1); PG8_STAGE(PG8_SB(1, 0), b3, voffB); PG8_STAGE(PG8_SB(1, 1), b3 + hB, voffB); PG8_STAGE(PG8_SA(1, 0), a3, voffA);
            PG8_WAIT_V(8); PG8_WAIT_L(0); PG8_BAR; PG8_MMA(1, 0, At, B0); PG8_MMA(1, 1, At, B1); PG8_BAR; PG8_SCHED;
        }
        if (wr == 0) PG8_BAR;
        E(acc, cur, wr, wc, fr, fq);
        if (!has_next) break;
#pragma unroll
        for (int a = 0; a < 2; ++a)
#pragma unroll
            for (int b = 0; b < 2; ++b)
#pragma unroll
                for (int m = 0; m < 4; ++m)
#pragma unroll
                    for (int n = 0; n < 2; ++n) acc[a][b][m][n] = (f32x4){0.f, 0.f, 0.f, 0.f};
        cur = nxt; cA = nA; cB = nB; ++ui;
        if (wr == 1) PG8_BAR;
    }
    PG8_WAIT_V(0);
    PG8_BAR;
#undef PG8_SA
#undef PG8_SB
#undef PG8_STAGE
#undef PG8_LDA
#undef PG8_LDB
#undef PG8_MMA
#undef PG8_WAIT_V
#undef PG8_WAIT_L
#undef PG8_BAR
#undef PG8_SCHED
}

struct EpiF32 {
    float* C; unsigned ldc; const float* colscale; int c_g; size_t slab_g;
    __device__ __forceinline__ void operator()(const f32x4 (&acc)[2][2][4][2], const Unit& u, int wr, int wc, int fr, int fq) const {
        const int row0 = u.pm * BM + wr * 64 + fr, col0 = u.g * c_g + u.pn * BM + wc * 32 + 8 * fq;
        f32x4 sv[2][2];
#pragma unroll
        for (int bj = 0; bj < 2; ++bj)
#pragma unroll
            for (int n = 0; n < 2; ++n) sv[bj][n] = colscale ? *(const f32x4*)(colscale + col0 + bj * HALF + 4 * n) : (f32x4){1.f, 1.f, 1.f, 1.f};
#pragma unroll
        for (int ai = 0; ai < 2; ++ai)
#pragma unroll
            for (int m = 0; m < 4; ++m) { float* rowp = C + (size_t)u.g * slab_g + (size_t)(row0 + ai * HALF + m * 16) * ldc + col0;
#pragma unroll
                for (int bj = 0; bj < 2; ++bj) { *(f32x4*)(rowp + bj * HALF) = acc[ai][bj][m][0] * sv[bj][0]; *(f32x4*)(rowp + bj * HALF + 4) = acc[ai][bj][m][1] * sv[bj][1]; } }
    }
};
struct EpiY {
    bf16_t* C; unsigned ldc; const float* colscale; int c_g;
    __device__ __forceinline__ void operator()(const f32x4 (&acc)[2][2][4][2], const Unit& u, int wr, int wc, int fr, int fq) const {
        const int row0 = u.pm * BM + wr * 64 + fr, col0 = u.g * c_g + u.pn * BM + wc * 32 + 8 * fq;
        f32x4 sv[2][2];
#pragma unroll
        for (int bj = 0; bj < 2; ++bj)
#pragma unroll
            for (int n = 0; n < 2; ++n) sv[bj][n] = colscale ? *(const f32x4*)(colscale + col0 + bj * HALF + 4 * n) : (f32x4){1.f, 1.f, 1.f, 1.f};
#pragma unroll
        for (int ai = 0; ai < 2; ++ai)
#pragma unroll
            for (int m = 0; m < 4; ++m) { bf16_t* rowp = C + (size_t)(row0 + ai * HALF + m * 16) * ldc + col0;
#pragma unroll
                for (int bj = 0; bj < 2; ++bj) { const f32x4 v0 = acc[ai][bj][m][0] * sv[bj][0], v1 = acc[ai][bj][m][1] * sv[bj][1];
                    u32x4 w; w.x = cvt_pk_bf16(v0[0], v0[1]); w.y = cvt_pk_bf16(v0[2], v0[3]); w.z = cvt_pk_bf16(v1[0], v1[1]); w.w = cvt_pk_bf16(v1[2], v1[3]);
                    *(u32x4*)(rowp + bj * HALF) = w; } }
    }
};
template <int ACT> struct EpiBf16 {
    bf16_t* C; unsigned ldc; int row_g;
    __device__ __forceinline__ void operator()(const f32x4 (&acc)[2][2][4][2], const Unit& u, int wr, int wc, int fr, int fq) const {
        const int row0 = u.g * row_g + u.pm * BM + wr * 64 + fr, col0 = u.pn * BM + wc * 32 + 8 * fq;
#pragma unroll
        for (int ai = 0; ai < 2; ++ai)
#pragma unroll
            for (int m = 0; m < 4; ++m) { bf16_t* rowp = C + (size_t)(row0 + ai * HALF + m * 16) * ldc + col0;
#pragma unroll
                for (int bj = 0; bj < 2; ++bj) { f32x4 v0 = acc[ai][bj][m][0], v1 = acc[ai][bj][m][1];
                    if (ACT == 1) {
#pragma unroll
                        for (int e = 0; e < 4; ++e) { const float a = fmaxf(v0[e], 0.f), b = fmaxf(v1[e], 0.f); v0[e] = a * a; v1[e] = b * b; } }
                    u32x4 w; w.x = cvt_pk_bf16(v0[0], v0[1]); w.y = cvt_pk_bf16(v0[2], v0[3]); w.z = cvt_pk_bf16(v1[0], v1[1]); w.w = cvt_pk_bf16(v1[2], v1[3]);
                    *(u32x4*)(rowp + bj * HALF) = w; } }
    }
};
struct EpiFA {
    bf16_t* YT; bf16_t* YTC;
    __device__ __forceinline__ void operator()(const f32x4 (&acc)[2][2][4][2], const Unit& u, int wr, int wc, int fr, int fq) const {
        const int cs = u.pm >> 1, k2b = (u.pm & 1) * 256;
        bf16_t* base; size_t pitch;
        if (u.pn < 32) { const int b = u.pn >> 3; base = YT + (size_t)(u.g * 512 + k2b) * 16384 + b * 4096 + cs * 2048 + (u.pn & 7) * 256; pitch = 16384; }
        else { const int b = u.pn - 32; base = YTC + (size_t)(u.g * 512 + k2b) * 2048 + b * 512 + cs * 256; pitch = 2048; }
        const int row0 = wr * 64 + fr, col0 = wc * 32 + 8 * fq;
#pragma unroll
        for (int ai = 0; ai < 2; ++ai)
#pragma unroll
            for (int m = 0; m < 4; ++m) { bf16_t* rowp = base + (size_t)(row0 + ai * HALF + m * 16) * pitch + col0;
#pragma unroll
                for (int bj = 0; bj < 2; ++bj) { const f32x4 v0 = acc[ai][bj][m][0], v1 = acc[ai][bj][m][1];
                    u32x4 w; w.x = cvt_pk_bf16(v0[0], v0[1]); w.y = cvt_pk_bf16(v0[2], v0[3]); w.z = cvt_pk_bf16(v1[0], v1[1]); w.w = cvt_pk_bf16(v1[2], v1[3]);
                    *(u32x4*)(rowp + bj * HALF) = w; } }
    }
};
struct EpiQKV {
    bf16_t* Q; const float* rope;
    __device__ __forceinline__ void operator()(const f32x4 (&acc)[2][2][4][2], const Unit& u, int wr, int wc, int fr, int fq) const {
        const int part = u.pn >> 3;
        bf16_t* dst = Q + (size_t)part * ((WS_K - WS_Q) / 2);
        const int row0 = u.pm * BM + wr * 64 + fr, colp = (u.pn & 7) * BM + wc * 32 + 8 * fq;
        const bool dorope = (part < 2) && (u.pm < 32);
        const float sc = part == 0 ? QSCALE : 1.f;
#pragma unroll
        for (int ai = 0; ai < 2; ++ai)
#pragma unroll
            for (int m = 0; m < 4; ++m) { const int row = row0 + ai * HALF + m * 16; bf16_t* rowp = dst + (size_t)row * D + colp;
                const int t = row & 2047, prow = t >> 6, pcol = t & 63;
#pragma unroll
                for (int bj = 0; bj < 2; ++bj) { f32x4 v0 = acc[ai][bj][m][0], v1 = acc[ai][bj][m][1];
                    if (dorope) { const int c = colp + bj * HALF, j0 = (c & 63) >> 1, ax = j0 >> 4, f0 = j0 & 15;
                        const float* cs = rope + ((ax ? pcol : prow) * 16 + f0) * 2;
                        const f32x4 cs0 = *(const f32x4*)cs, cs1 = *(const f32x4*)(cs + 4);
                        f32x4 r0, r1;
                        r0[0] = v0[0] * cs0[0] - v0[1] * cs0[1]; r0[1] = v0[0] * cs0[1] + v0[1] * cs0[0];
                        r0[2] = v0[2] * cs0[2] - v0[3] * cs0[3]; r0[3] = v0[2] * cs0[3] + v0[3] * cs0[2];
                        r1[0] = v1[0] * cs1[0] - v1[1] * cs1[1]; r1[1] = v1[0] * cs1[1] + v1[1] * cs1[0];
                        r1[2] = v1[2] * cs1[2] - v1[3] * cs1[3]; r1[3] = v1[2] * cs1[3] + v1[3] * cs1[2];
                        v0 = r0; v1 = r1; }
                    v0 = v0 * sc; v1 = v1 * sc;
                    u32x4 w; w.x = cvt_pk_bf16(v0[0], v0[1]); w.y = cvt_pk_bf16(v0[2], v0[3]); w.z = cvt_pk_bf16(v1[0], v1[1]); w.w = cvt_pk_bf16(v1[2], v1[3]);
                    *(u32x4*)(rowp + bj * HALF) = w; } }
    }
};
}


namespace att {
__device__ __forceinline__ unsigned off_a(unsigned row, unsigned ch) { return 2048u * (row >> 3) + 512u * (ch >> 2) + 64u * (row & 7) + 16u * ((ch & 3) ^ ((row >> 2) & 3)); }
constexpr int KBUF = 0, VBUF = 32768, QOFF = 65536, WSF_OFF = LDSCTL_OFF + 1024;
constexpr float THR = 6.0f;
struct Args { const bf16_t* Q; const bf16_t* K; const bf16_t* V; bf16_t* O; const float* gsub; float lam, post; };
__device__ __forceinline__ s16x4 vtr(const LAS unsigned char* p) { return __builtin_bit_cast(s16x4, __builtin_amdgcn_ds_read_tr16_b64_v4i16((LAS s16x4*)p)); }
__device__ __forceinline__ float half_max(float v) { auto rr = __builtin_amdgcn_permlane32_swap(__float_as_uint(v), __float_as_uint(v), false, false); return fmaxf(__uint_as_float(rr[0]), __uint_as_float(rr[1])); }
__device__ __forceinline__ float half_sum(float v) { auto rr = __builtin_amdgcn_permlane32_swap(__float_as_uint(v), __float_as_uint(v), false, false); return __uint_as_float(rr[0]) + __uint_as_float(rr[1]); }

__device__ __forceinline__ void glds16(const void* gsrc, unsigned lds_dst) { unsigned keep;
    asm volatile("s_mov_b32 %0, m0\n\ts_mov_b32 m0, %2\n\ts_nop 0\n\tglobal_load_lds_dwordx4 %1, off\n\ts_mov_b32 m0, %0" : "=&s"(keep) : "v"(gsrc), "s"(lds_dst) : "memory"); }
__device__ __forceinline__ float max3f(float a, float b, float c) { float r; asm("v_max3_f32 %0, %1, %2, %3" : "=v"(r) : "v"(a), "v"(b), "v"(c)); return r; }
__device__ __forceinline__ float max2f(float a, float b) { float r; asm("v_max_f32_e32 %0, %1, %2" : "=v"(r) : "v"(a), "v"(b)); return r; }
__device__ __forceinline__ float fsub_s(float a, float b) { float r; asm("v_sub_f32_e32 %0, %1, %2" : "=v"(r) : "v"(a), "v"(b)); return r; }
__device__ __forceinline__ float fadd_s(float a, float b) { float r; asm("v_add_f32_e32 %0, %1, %2" : "=v"(r) : "v"(a), "v"(b)); return r; }
typedef __bf16 bf16x2_t __attribute__((ext_vector_type(2)));
__device__ __forceinline__ unsigned cvtpk_b(float lo, float hi) { const f32x2 v = {lo, hi}; const bf16x2_t b = __builtin_convertvector(v, bf16x2_t); return __builtin_bit_cast(unsigned, b); }
template <bool SAFE>
__device__ __forceinline__ bool unit(LAS unsigned char* lds, const Args& P, int b, int h, int q0, int nlat, int tid) {
    const int lane = tid & 63, r32 = lane & 31, hi = lane >> 5; const int wid = __builtin_amdgcn_readfirstlane(tid >> 6);
    const int nt = nlat + 4;
    LAS unsigned char* Qs = lds + QOFF + wid * 8192;
    LAS float* wsf = (LAS float*)(lds + WSF_OFF + wid * 256);
    {   const bf16_t* qrow = P.Q + (size_t)(q0 + wid * 32 + r32) * D + h * 128 + hi * 8;
#pragma unroll
        for (int c = 0; c < 2; ++c)
#pragma unroll
            for (int d0 = 0; d0 < 4; ++d0) { const u32x4 v = *(const u32x4*)(qrow + c * 64 + d0 * 16); *(LAS u32x4*)(Qs + ((c * 4 + d0) * 2 + hi) * 512 + r32 * 16) = v; } }
    unsigned goff[2];
#pragma unroll
    for (int i = 0; i < 2; ++i) { const unsigned p = 2 * wid + i, rg = p >> 1, chq = (p & 1) * 2 + (lane >> 5), r7 = (lane >> 2) & 7, x = lane & 3, rsw = (r7 >> 2) | ((rg & 1) << 1);
        goff[i] = ((8 * rg + r7) * D + h * 128 + (4 * chq + (x ^ rsw)) * 8) * 2; }
#define ATT_GROW(t) ((t) < nlat ? b * SEQ + 64 * (t) : ML + b * CL + 64 * ((t) - nlat))
#define ATT_DMA(t, buf) do { const size_t g_ = (size_t)ATT_GROW(t) * D * 2; _Pragma("unroll") for (int i_ = 0; i_ < 2; ++i_) { \
        glds16((const char*)P.K + g_ + goff[i_], (unsigned)__builtin_amdgcn_readfirstlane(lds0 + KBUF + (buf) * 16384 + (2 * wid + i_) * 1024)); \
        glds16((const char*)P.V + g_ + goff[i_], (unsigned)__builtin_amdgcn_readfirstlane(lds0 + VBUF + (buf) * 16384 + (2 * wid + i_) * 1024)); } } while (0)
    const unsigned lds0 = (unsigned)(uintptr_t)lds;
    ATT_DMA(0, 0);
    unsigned kb[2];
#pragma unroll
    for (int e = 0; e < 2; ++e) kb[e] = 2048u * (r32 >> 3) + 64u * (r32 & 7) + 16u * ((unsigned)(2 * e + hi) ^ ((r32 >> 2) & 3));
    const unsigned blk = (lane >> 4) & 1, q_ = (lane & 15) >> 2, p_ = lane & 3;
    unsigned vb[2];
#pragma unroll
    for (int t = 0; t < 2; ++t) vb[t] = 2048u * t + 64u * (4 * hi + q_) + 16u * ((2 * blk + (p_ >> 1)) ^ ((2 * t + hi) & 3)) + 8u * (p_ & 1);
    float m0 = -1e30f, m1 = -1e30f, l0 = 0.f, l1 = 0.f;
    f32x16 o[2][4];
#pragma unroll
    for (int c = 0; c < 2; ++c)
#pragma unroll
        for (int d = 0; d < 4; ++d) o[c][d] = f32x16{};
    asm volatile("s_waitcnt vmcnt(0)" ::: "memory");
    __syncthreads();
#define SB() __builtin_amdgcn_sched_barrier(0)
#define ATT_SMB(S0, S1, i, M, SUM, PW) do { const float a_ = (i) < 8 ? S0[2 * ((i) & 7)] : S1[2 * ((i) & 7)], b_ = (i) < 8 ? S0[2 * ((i) & 7) + 1] : S1[2 * ((i) & 7) + 1]; \
        const float ea_ = SAFE ? __builtin_amdgcn_exp2f(fsub_s(a_, M)) : __builtin_amdgcn_exp2f(a_), eb_ = SAFE ? __builtin_amdgcn_exp2f(fsub_s(b_, M)) : __builtin_amdgcn_exp2f(b_); \
        SUM += ea_; SUM += eb_; PW[i] = cvtpk_b(ea_, eb_); asm volatile("" : "+v"(SUM), "+v"(PW[i])); } while (0)
#define ATT_SMA(S0, S1, c, MC, LC) do { asm volatile("s_nop 15\n\ts_nop 7" : "+v"(S0), "+v"(S1)); \
        float a_ = max3f(S0[0], S0[1], S1[0]), b_ = max3f(S0[2], S0[3], S1[1]); a_ = max3f(a_, S1[2], S1[3]); \
        _Pragma("unroll") for (int r_ = 4; r_ < 16; r_ += 4) { a_ = max3f(a_, S0[r_], S0[r_ + 1]); b_ = max3f(b_, S0[r_ + 2], S0[r_ + 3]); a_ = max3f(a_, S1[r_], S1[r_ + 1]); b_ = max3f(b_, S1[r_ + 2], S1[r_ + 3]); } \
        const float mx_ = half_max(max2f(a_, b_)); \
        if (__any(mx_ - MC > THR)) { const float mn_ = fmaxf(MC, mx_), al_ = __builtin_amdgcn_exp2f(MC - mn_); MC = mn_; LC *= al_; if (hi == 0) wsf[r32] = al_; \
            _Pragma("unroll") for (int g4 = 0; g4 < 4; ++g4) { const f32x4 a4 = *(const LAS f32x4*)(wsf + 8 * g4 + 4 * hi); \
                _Pragma("unroll") for (int d = 0; d < 4; ++d) { o[c][d][4 * g4 + 0] *= a4[0]; o[c][d][4 * g4 + 1] *= a4[1]; o[c][d][4 * g4 + 2] *= a4[2]; o[c][d][4 * g4 + 3] *= a4[3]; } } } } while (0)
#define ATT_LDQK(c, d0, QF, K0, K1) do { QF = *(const LAS bf16x8*)(Qs + (((c) * 4 + (d0)) * 2 + hi) * 512 + r32 * 16); \
        K0 = *(const LAS bf16x8*)(Kb + kb[(d0) & 1] + 512 * (2 * (c) + ((d0) >> 1))); K1 = *(const LAS bf16x8*)(Kb + kb[(d0) & 1] + 512 * (2 * (c) + ((d0) >> 1)) + 8192); } while (0)
#define ATT_LDV(i, LO, HH) do { LO = vtr(Vb + vb[0] + 4096 * ((i) >> 2) + 512 * ((i) & 3)); HH = vtr(Vb + vb[1] + 4096 * ((i) >> 2) + 512 * ((i) & 3)); } while (0)
#define ATT_VF(LO, HH) ((bf16x8){LO[0], LO[1], LO[2], LO[3], HH[0], HH[1], HH[2], HH[3]})
#define ATT_PA(PW, ks) ((bf16x8)__builtin_bit_cast(bf16x8, (u32x4){PW[4 * (ks)], PW[4 * (ks) + 1], PW[4 * (ks) + 2], PW[4 * (ks) + 3]}))
#pragma unroll 1
    for (int t = 0; t < nt; ++t) {
        const int buf = t & 1;
        if (t + 1 < nt) ATT_DMA(t + 1, buf ^ 1);
        const LAS unsigned char* Kb = lds + KBUF + buf * 16384; const LAS unsigned char* Vb = lds + VBUF + buf * 16384;
        unsigned pw0[16], pw1[16];
        f32x16 sa = f32x16{}, sb = f32x16{};
        SB();
        {   bf16x8 qfA, k0A, k1A, qfB, k0B, k1B;
            ATT_LDQK(0, 0, qfA, k0A, k1A); ATT_LDQK(0, 1, qfB, k0B, k1B); SB();
            sa = __builtin_amdgcn_mfma_f32_32x32x16_bf16(k0A, qfA, sa, 0, 0, 0); sb = __builtin_amdgcn_mfma_f32_32x32x16_bf16(k1A, qfA, sb, 0, 0, 0); SB();
            ATT_LDQK(0, 2, qfA, k0A, k1A); SB();
            sa = __builtin_amdgcn_mfma_f32_32x32x16_bf16(k0B, qfB, sa, 0, 0, 0); sb = __builtin_amdgcn_mfma_f32_32x32x16_bf16(k1B, qfB, sb, 0, 0, 0); SB();
            ATT_LDQK(0, 3, qfB, k0B, k1B); SB();
            sa = __builtin_amdgcn_mfma_f32_32x32x16_bf16(k0A, qfA, sa, 0, 0, 0); sb = __builtin_amdgcn_mfma_f32_32x32x16_bf16(k1A, qfA, sb, 0, 0, 0); SB();
            sa = __builtin_amdgcn_mfma_f32_32x32x16_bf16(k0B, qfB, sa, 0, 0, 0); sb = __builtin_amdgcn_mfma_f32_32x32x16_bf16(k1B, qfB, sb, 0, 0, 0); }
        SB();
        if constexpr (SAFE) ATT_SMA(sa, sb, 0, m0, l0);
        SB();
        f32x16 ta = f32x16{}, tb = f32x16{};
        {   bf16x8 qf, k0, k1; float sum = 0.f;
            ATT_LDQK(1, 0, qf, k0, k1); SB();
#define ATT_C(d0) do { ta = __builtin_amdgcn_mfma_f32_32x32x16_bf16(k0, qf, ta, 0, 0, 0); SB(); \
            if ((d0) < 3) k0 = *(const LAS bf16x8*)(Kb + kb[((d0) + 1) & 1] + 512 * (2 + (((d0) + 1) >> 1))); \
            ATT_SMB(sa, sb, 4 * (d0) + 0, m0, sum, pw0); ATT_SMB(sa, sb, 4 * (d0) + 1, m0, sum, pw0); SB(); \
            tb = __builtin_amdgcn_mfma_f32_32x32x16_bf16(k1, qf, tb, 0, 0, 0); SB(); \
            if ((d0) < 3) { qf = *(const LAS bf16x8*)(Qs + ((4 + (d0) + 1) * 2 + hi) * 512 + r32 * 16); k1 = *(const LAS bf16x8*)(Kb + kb[((d0) + 1) & 1] + 512 * (2 + (((d0) + 1) >> 1)) + 8192); } \
            ATT_SMB(sa, sb, 4 * (d0) + 2, m0, sum, pw0); ATT_SMB(sa, sb, 4 * (d0) + 3, m0, sum, pw0); SB(); } while (0)
            ATT_C(0); ATT_C(1); ATT_C(2); ATT_C(3);
#undef ATT_C
            l0 += sum; }
        if constexpr (SAFE) ATT_SMA(ta, tb, 1, m1, l1);
        SB();
        {   s16x4 loA, hhA, loB, hhB, loC, hhC; float sum = 0.f;
            ATT_LDV(0, loA, hhA); ATT_LDV(1, loB, hhB); SB();
#define ATT_E(i, LOc, HHc, LOn, HHn) do { if ((i) + 2 < 16) ATT_LDV((i) + 2, LOn, HHn); SB(); \
            o[0][(i) & 3] = __builtin_amdgcn_mfma_f32_32x32x16_bf16(ATT_PA(pw0, (i) >> 2), ATT_VF(LOc, HHc), o[0][(i) & 3], 0, 0, 0); SB(); ATT_SMB(ta, tb, i, m1, sum, pw1); SB(); } while (0)
            ATT_E(0, loA, hhA, loC, hhC); ATT_E(1, loB, hhB, loA, hhA); ATT_E(2, loC, hhC, loB, hhB);
            ATT_E(3, loA, hhA, loC, hhC); ATT_E(4, loB, hhB, loA, hhA); ATT_E(5, loC, hhC, loB, hhB);
            ATT_E(6, loA, hhA, loC, hhC); ATT_E(7, loB, hhB, loA, hhA); ATT_E(8, loC, hhC, loB, hhB);
            ATT_E(9, loA, hhA, loC, hhC); ATT_E(10, loB, hhB, loA, hhA); ATT_E(11, loC, hhC, loB, hhB);
            ATT_E(12, loA, hhA, loC, hhC); ATT_E(13, loB, hhB, loA, hhA); ATT_E(14, loC, hhC, loB, hhB);
            ATT_E(15, loA, hhA, loC, hhC);
#undef ATT_E
            l1 += sum; }
#pragma unroll
        for (int ks = 0; ks < 4; ++ks) {
            s16x4 lo[4], hh[4];
#pragma unroll
            for (int d = 0; d < 4; ++d) ATT_LDV(4 * ks + d, lo[d], hh[d]);
#pragma unroll
            for (int d = 0; d < 4; ++d) o[1][d] = __builtin_amdgcn_mfma_f32_32x32x16_bf16(ATT_PA(pw1, ks), ATT_VF(lo[d], hh[d]), o[1][d], 0, 0, 0);
            SB();
        }
        asm volatile("s_waitcnt vmcnt(0)" ::: "memory");
        __syncthreads();
    }
#undef ATT_SMB
#undef ATT_SMA
#undef ATT_LDQK
#undef ATT_LDV
#undef ATT_VF
#undef ATT_PA
#undef SB
#undef ATT_GROW
#undef ATT_DMA
    l0 = half_sum(l0); l1 = half_sum(l1);
    const bool ok = SAFE || !__any(!(l0 > 7.9e-31f && l0 < 1.26e30f && l1 > 7.9e-31f && l1 < 1.26e30f));
    if (hi == 0) { wsf[r32] = 1.0f / l0; wsf[32 + r32] = P.lam / l1; }
    float ss[16];
#pragma unroll
    for (int r = 0; r < 16; ++r) ss[r] = 0.f;
#pragma unroll
    for (int g4 = 0; g4 < 4; ++g4) { const f32x4 a4 = *(const LAS f32x4*)(wsf + 8 * g4 + 4 * hi), b4 = *(const LAS f32x4*)(wsf + 32 + 8 * g4 + 4 * hi);
#pragma unroll
        for (int d = 0; d < 4; ++d)
#pragma unroll
            for (int e = 0; e < 4; ++e) { const float v = o[0][d][4 * g4 + e] * a4[e] - o[1][d][4 * g4 + e] * b4[e]; o[0][d][4 * g4 + e] = v; ss[4 * g4 + e] += v * v; } }
#pragma unroll
    for (int r = 0; r < 16; ++r) {
        float v = ss[r];
#pragma unroll
        for (int s = 1; s < 32; s <<= 1) v += __shfl_xor(v, s);
        ss[r] = (1.0f / sqrtf(v * (1.0f / 128.0f) + SUBLN_EPS)) * P.post;
    }
    bf16_t* Ow = P.O + (size_t)(q0 + wid * 32) * D + h * 128 + r32;
#pragma unroll
    for (int d = 0; d < 4; ++d) { const float gs = P.gsub[32 * d + r32];
#pragma unroll
        for (int r = 0; r < 16; ++r) { const int row = (r & 3) + 8 * (r >> 2) + 4 * hi; const float v = o[0][d][r] * ss[r] * gs;
            Ow[(size_t)row * D + 32 * d] = (bf16_t)(cvt_pk_bf16(v, 0.f) & 0xffffu); } }
    __syncthreads();
    return ok;
}
__device__ __forceinline__ void unit_checked(LAS unsigned char* lds, const Args& P, int b, int h, int q0, int nlat, int tid) {
    volatile LAS unsigned* flag = (volatile LAS unsigned*)(lds + MISC_OFF) + 16;
    const bool ok = unit<false>(lds, P, b, h, q0, nlat, tid);
    if (!ok && (tid & 63) == 0) *flag = 1u;
    __syncthreads();
    const unsigned f = *flag;
    __syncthreads();
    if (f) { if (tid == 0) *flag = 0u; (void)unit<true>(lds, P, b, h, q0, nlat, tid); }
}
}

struct ThinArgs {
    const float* xin_lat; const float* xin_ctx;
    const bf16_t* y;
    float* xout_lat; float* xout_ctx;
    const float* g_post; const float* gate;
    bf16_t* uout;
    const float* g_pre; const float* sc; const float* sh;
    const float* yc; int nslab;
    int nrows;
};
__device__ __forceinline__ void thin_phase(const ThinArgs& T, int gw, int ngw, int lane) {
#pragma unroll 1
    for (int row = gw; row < T.nrows; row += ngw) {
        const int mrow = row < ML ? (row >> 11) : 4;
        const float* xr = row < ML ? T.xin_lat + (size_t)row * D : T.xin_ctx + (size_t)(row - ML) * D;
        f32x4 xv[8];
#pragma unroll
        for (int j = 0; j < 8; ++j) xv[j] = *(const f32x4*)(xr + 256 * j + 4 * lane);
        if (T.y) {
            f32x4 yv[8]; float s = 0.f;
            if (row >= ML && T.nslab > 0) {
                const float* yr = T.yc + (size_t)(row - ML) * D;
#pragma unroll
                for (int j = 0; j < 8; ++j) yv[j] = *(const f32x4*)(yr + 256 * j + 4 * lane);
#pragma unroll 1
                for (int sl = 1; sl < T.nslab; ++sl) { yr += (size_t)MC * D;
#pragma unroll
                    for (int j = 0; j < 8; ++j) yv[j] = yv[j] + *(const f32x4*)(yr + 256 * j + 4 * lane); }
            } else {
                const bf16_t* yr = T.y + (size_t)row * D;
#pragma unroll
                for (int j = 0; j < 8; ++j) { const u32x2 v = *(const u32x2*)(yr + 256 * j + 4 * lane);
                    yv[j][0] = __uint_as_float(v.x << 16); yv[j][1] = __uint_as_float(v.x & 0xffff0000u); yv[j][2] = __uint_as_float(v.y << 16); yv[j][3] = __uint_as_float(v.y & 0xffff0000u); }
            }
#pragma unroll
            for (int j = 0; j < 8; ++j) s += (yv[j][0] * yv[j][0] + yv[j][1] * yv[j][1]) + (yv[j][2] * yv[j][2] + yv[j][3] * yv[j][3]);
            const float rs = 1.0f / sqrtf(wave_sum(s) * (1.0f / D) + NORM_EPS);
            const float* gt = T.gate + (size_t)mrow * MODROW;
#pragma unroll
            for (int j = 0; j < 8; ++j) { const f32x4 g = *(const f32x4*)(T.g_post + 256 * j + 4 * lane), a = *(const f32x4*)(gt + 256 * j + 4 * lane); xv[j] = xv[j] + a * ((yv[j] * rs) * g); }
            float* xo = row < ML ? (T.xout_lat ? T.xout_lat + (size_t)row * D : nullptr) : (T.xout_ctx ? T.xout_ctx + (size_t)(row - ML) * D : nullptr);
            if (xo) {
#pragma unroll
                for (int j = 0; j < 8; ++j) *(f32x4*)(xo + 256 * j + 4 * lane) = xv[j]; }
        }
        if (T.uout) {
            float s = 0.f;
#pragma unroll
            for (int j = 0; j < 8; ++j) s += (xv[j][0] * xv[j][0] + xv[j][1] * xv[j][1]) + (xv[j][2] * xv[j][2] + xv[j][3] * xv[j][3]);
            const float rs = 1.0f / sqrtf(wave_sum(s) * (1.0f / D) + NORM_EPS);
            const float* scp = T.sc + (size_t)mrow * MODROW; const float* shp = T.sh + (size_t)mrow * MODROW;
            bf16_t* uo = T.uout + (size_t)row * D;
#pragma unroll
            for (int j = 0; j < 8; ++j) { const f32x4 g = *(const f32x4*)(T.g_pre + 256 * j + 4 * lane), a = *(const f32x4*)(scp + 256 * j + 4 * lane), c = *(const f32x4*)(shp + 256 * j + 4 * lane);
                const f32x4 u = ((xv[j] * rs) * g) * (a + 1.0f) + c;
                u32x2 w; w.x = cvt_pk_bf16(u[0], u[1]); w.y = cvt_pk_bf16(u[2], u[3]); *(u32x2*)(uo + 256 * j + 4 * lane) = w; }
        }
    }
}
__device__ __forceinline__ void pool_phase(const bf16_t* U, bf16_t* Dm, int nrows, int gw, int ngw, int lane) {
    for (int row = gw; row < nrows; row += ngw) {
        int base, t, Ls;
        if (row < ML) { base = row & ~2047; t = row & 2047; Ls = SEQ; } else { const int i = row - ML; base = ML + (i & ~255); t = i & 255; Ls = CL; }
#pragma unroll
        for (int j = 0; j < 8; ++j) {
            const int w = 2 << (j >> 1); int lo = t - (w >> 1), hi = lo + w; lo = lo < 0 ? 0 : lo; hi = hi > Ls ? Ls : hi;
            const bf16_t* p = U + (size_t)base * D + 256 * j + 4 * lane;
            f32x4 s = {0.f, 0.f, 0.f, 0.f};
            for (int tt = lo; tt < hi; ++tt) { const u32x2 v = *(const u32x2*)(p + (size_t)tt * D);
                s[0] += __uint_as_float(v.x << 16); s[1] += __uint_as_float(v.x & 0xffff0000u); s[2] += __uint_as_float(v.y << 16); s[3] += __uint_as_float(v.y & 0xffff0000u); }
            const u32x2 cv = *(const u32x2*)(p + (size_t)t * D);
            const float inv = 1.0f / (float)(hi - lo);
            f32x4 d; d[0] = s[0] * inv - __uint_as_float(cv.x << 16); d[1] = s[1] * inv - __uint_as_float(cv.x & 0xffff0000u); d[2] = s[2] * inv - __uint_as_float(cv.y << 16); d[3] = s[3] * inv - __uint_as_float(cv.y & 0xffff0000u);
            u32x2 o; o.x = cvt_pk_bf16(d[0], d[1]); o.y = cvt_pk_bf16(d[2], d[3]);
            *(u32x2*)(Dm + (size_t)row * D + 256 * j + 4 * lane) = o;
        }
    }
}

struct TrDesc { const float* src; bf16_t* dst; int N, K; int perm; };
__device__ __forceinline__ void tr_load(const TrDesc& d, f32x4 (&v)[16], int lane) {
    const int kq = lane >> 4, n4 = lane & 15;
#pragma unroll
    for (int i = 0; i < 16; ++i) v[i] = __builtin_nontemporal_load((const f32x4*)(d.src + (size_t)(4 * i + kq) * d.N + 4 * n4));
}
__device__ __forceinline__ void tr_store(const TrDesc& d, const f32x4 (&v)[16], LAS float* scr, int lane) {
    const int kq = lane >> 4, n4 = lane & 15;
#pragma unroll
    for (int i = 0; i < 16; ++i) { LAS float* s = scr + (4 * i + kq) * 65 + 4 * n4; s[0] = v[i][0]; s[1] = v[i][1]; s[2] = v[i][2]; s[3] = v[i][3]; }
    asm volatile("s_waitcnt lgkmcnt(0)" ::: "memory");
    const int c = lane & 7;
#pragma unroll
    for (int j = 0; j < 8; ++j) { const int n = (lane >> 3) + 8 * j; int sc = n;
        if (d.perm) { const int jj = n >> 1, which = n & 1, ax = jj >> 4, f = jj & 15; sc = ax * 32 + which * 16 + f; }
        const LAS float* s = scr + (8 * c) * 65 + sc;
        u32x4 o; o.x = cvt_pk_bf16(s[0 * 65], s[1 * 65]); o.y = cvt_pk_bf16(s[2 * 65], s[3 * 65]); o.z = cvt_pk_bf16(s[4 * 65], s[5 * 65]); o.w = cvt_pk_bf16(s[6 * 65], s[7 * 65]);
        *(u32x4*)(d.dst + (size_t)n * d.K + 8 * c) = o; }
    asm volatile("s_waitcnt lgkmcnt(0)" ::: "memory");
}

struct Params {
    const float* in[22];
    float* out; unsigned char* ws;
    float lam_init0, lam_init3;
    int ph_lo, ph_hi;
};

template <int PART>
__device__ __forceinline__ void prologue(const Params& P, LAS unsigned char* lds, int tid, int wave, int lane, int vcu, int G) {
    unsigned char* ws = P.ws;
    const float* c_in = P.in[1]; const float* cctx = P.in[3]; const float* w_mod = P.in[4]; const float* b_mod = P.in[5];
    LAS float* sil = (LAS float*)lds;
    LAS float* red = (LAS float*)(lds + 65536);
    for (int i = tid; i < 5 * D; i += NTHR) { const int r = i / D, k = i % D; const float x = r < 4 ? c_in[r * D + k] : cctx[k]; sil[k * 8 + r] = x / (1.0f + __expf(-x)); }
    __syncthreads();
    float* mod = (float*)(ws + WS_MOD);
    for (int item = (PART == 1 ? 192 : 0) + blockIdx.x; item < (PART == 0 ? 192 : 4 * 192); item += G) {
        const int l = item / 192, col = (item % 192) * 64 + lane;
        const float* W = w_mod + (size_t)l * D * MODROW + col;
        float a0 = 0.f, a1 = 0.f, a2 = 0.f, a3 = 0.f, a4 = 0.f;
        const int k0 = wave * 256;
        for (int kk = 0; kk < 256; kk += 32) {
            float w[32];
#pragma unroll
            for (int j = 0; j < 32; ++j) w[j] = __builtin_nontemporal_load(W + (size_t)(k0 + kk + j) * MODROW);
#pragma unroll
            for (int j = 0; j < 32; ++j) { const f32x4 s4 = *(const LAS f32x4*)(sil + (k0 + kk + j) * 8); const float s5 = sil[(k0 + kk + j) * 8 + 4];
                a0 += s4[0] * w[j]; a1 += s4[1] * w[j]; a2 += s4[2] * w[j]; a3 += s4[3] * w[j]; a4 += s5 * w[j]; }
        }
        red[(wave * 5 + 0) * 64 + lane] = a0; red[(wave * 5 + 1) * 64 + lane] = a1; red[(wave * 5 + 2) * 64 + lane] = a2; red[(wave * 5 + 3) * 64 + lane] = a3; red[(wave * 5 + 4) * 64 + lane] = a4;
        __syncthreads();
        if (wave < 5) { float s = b_mod[l * MODROW + col];
#pragma unroll
            for (int w8 = 0; w8 < 8; ++w8) s += red[(w8 * 5 + wave) * 64 + lane];
            mod[((size_t)l * 5 + wave) * MODROW + col] = s; }
        __syncthreads();
    }
    LAS float* scr = (LAS float*)(lds + wave * 16640);
    const int gw = vcu * NWAVES + wave, NGW = G * NWAVES;
    bf16_t* Wqkv = (bf16_t*)(ws + WS_WQKV); bf16_t* Wo = (bf16_t*)(ws + WS_WO); bf16_t* Wf = (bf16_t*)(ws + WS_WF); bf16_t* Wp = (bf16_t*)(ws + WS_WPOOL);
    bf16_t* W1 = (bf16_t*)(ws + WS_W1); bf16_t* W2 = (bf16_t*)(ws + WS_W2);
    constexpr int I_QKV = (D / 64) * (3 * D / 64), I_O = (D / 64) * (D / 64), I_P = 8 * 8, I_1 = (D / 64) * (FF / 64), I_2 = (FF / 64) * (D / 64);
    constexpr int NITEMS = 2 * I_QKV + 2 * I_O + I_O + 4 * I_P + 4 * I_1 + 4 * I_2;
    auto decode = [&](int it) -> TrDesc {
        int r = it; const float* W; bf16_t* WT; int K, N, perm = 0;
        if (r < 2 * I_QKV) { const int ia = r / I_QKV; r %= I_QKV; W = P.in[10] + (size_t)ia * D * 3 * D; WT = Wqkv + (size_t)ia * 3 * D * D; K = D; N = 3 * D; perm = (r % (3 * D / 64)) < 2 * D / 64; }
        else if ((r -= 2 * I_QKV) < 2 * I_O) { const int ia = r / I_O; r %= I_O; W = P.in[11] + (size_t)ia * D * D; WT = Wo + (size_t)ia * D * D; K = D; N = D; }
        else if ((r -= 2 * I_O) < I_O) { W = P.in[17]; WT = Wf; K = D; N = D; }
        else if ((r -= I_O) < 4 * I_P) { const int g = r / I_P; r %= I_P; W = P.in[18] + (size_t)g * 512 * 512; WT = Wp + (size_t)g * 512 * 512; K = 512; N = 512; }
        else if ((r -= 4 * I_P) < 4 * I_1) { const int l = r / I_1; r %= I_1; W = P.in[20] + (size_t)l * D * FF; WT = W1 + (size_t)l * FF * D; K = D; N = FF; }
        else { r -= 4 * I_1; const int l = r / I_2; r %= I_2; W = P.in[21] + (size_t)l * FF * D; WT = W2 + (size_t)l * D * FF; K = FF; N = D; }
        const int nblk = N / 64, k0 = 64 * (r / nblk), n0 = 64 * (r % nblk);
        TrDesc d; d.src = W + (size_t)k0 * N + n0; d.dst = WT + (size_t)n0 * K + k0; d.N = N; d.K = K; d.perm = perm; return d; };
    {   const int it_end = (PART == 0 ? I_QKV : NITEMS); int it = (PART == 1 ? I_QKV : 0) + gw;
        f32x4 va[16], vb[16]; TrDesc da, db;
        if (it < it_end) { da = decode(it); tr_load(da, va, lane); }
        while (it < it_end) {
            const bool hb = it + NGW < it_end; if (hb) { db = decode(it + NGW); tr_load(db, vb, lane); }
            tr_store(da, va, scr, lane);
            if (!hb) break;
            const bool ha = it + 2 * NGW < it_end; if (ha) { da = decode(it + 2 * NGW); tr_load(da, va, lane); }
            tr_store(db, vb, scr, lane);
            if (!ha) break;
            it += 2 * NGW;
        } }
    if constexpr (PART != 1) {
        const int gt = gw * 64 + lane, NGT = NGW * 64; float* rope = (float*)(ws + WS_ROPE);
        for (int i = gt; i < 64 * 16; i += NGT) { const int pos = i >> 4, f = i & 15; const float inv = 1.0f / powf(10000.0f, (float)f * (1.0f / 16.0f)); const float ang = (float)pos * inv;
            rope[2 * i] = cosf(ang); rope[2 * i + 1] = sinf(ang); }
    }
    if constexpr (PART != 0) {   bf16_t* T1 = (bf16_t*)(ws + WS_T1); bf16_t* A2 = (bf16_t*)(ws + WS_A2); bf16_t* A2C = (bf16_t*)(ws + WS_A2C);
        constexpr int C_T1 = 1024 * 512 / 8, C_A2 = 2048 * 4096 / 8, C_A2C = 256 * 512 / 8;
        const int gt = gw * 64 + lane, NGT = NGW * 64;
        for (int ch = gt; ch < C_T1 + C_A2 + C_A2C; ch += NGT) {
            int r = ch; bf16_t* dst; int row, col0, N, ncol; float scale; bool negsin;
            if (r < C_T1) { row = r / 64; col0 = (r % 64) * 8; dst = T1 + (size_t)row * 512 + col0; N = 512; scale = 0.04419417382415922f; negsin = false;
                const int cs = row >> 9, k2 = row & 511; float vals[8];
#pragma unroll
                for (int e = 0; e < 8; ++e) { const int idx = (k2 * (col0 + e)) & 511; const float a = (float)idx * (1.0f / 256.0f); vals[e] = (cs ? sinpif(a) : cospif(a)) * scale; }
                u32x4 o; o.x = cvt_pk_bf16(vals[0], vals[1]); o.y = cvt_pk_bf16(vals[2], vals[3]); o.z = cvt_pk_bf16(vals[4], vals[5]); o.w = cvt_pk_bf16(vals[6], vals[7]); *(u32x4*)dst = o; continue; }
            r -= C_T1;
            if (r < C_A2) { row = r / 512; col0 = (r % 512) * 8; dst = A2 + (size_t)row * 4096 + col0; N = 2048; scale = 0.022097086912079608f; }
            else { r -= C_A2; row = r / 64; col0 = (r % 64) * 8; dst = A2C + (size_t)row * 512 + col0; N = 256; scale = 0.0625f; }
            (void)ncol; (void)negsin;
            { const int cs = col0 / N, n0 = col0 % N; float vals[8];
#pragma unroll
              for (int e = 0; e < 8; ++e) { const int idx = (row * (n0 + e)) & (N - 1); const float a = (float)idx * (2.0f / (float)N); vals[e] = (cs ? -sinpif(a) : cospif(a)) * scale; }
              u32x4 o; o.x = cvt_pk_bf16(vals[0], vals[1]); o.y = cvt_pk_bf16(vals[2], vals[3]); o.z = cvt_pk_bf16(vals[4], vals[5]); o.w = cvt_pk_bf16(vals[6], vals[7]); *(u32x4*)dst = o; }
        }
    }
}

struct Ctx { LAS unsigned char* lds; int tid, lane, wave, G, bx, vcu, gw, NGW; };
#if MK_MULTI
#define GRID_BAR() do { } while (0)
#else
#define GRID_BAR() xcd_barrier(bar)
#endif
#define PH_BEGIN(k) if ((k) >= P.ph_lo && (k) < P.ph_hi) {
#define PH_END(k)   if ((k) + 1 < P.ph_hi) { GRID_BAR(); for (int rb_ = 1; rb_ < PROBE_BAR; ++rb_) GRID_BAR(); } }
#define WSP(T, off) ((T*)(P.ws + (off)))

template <int L, int PH0>
__device__ __forceinline__ void layer(const Params& P, const Ctx& C, const XcdBarrier& bar) {
    constexpr int kind = L % 3; constexpr bool lastl = (L == 3);
    constexpr int Mact = lastl ? ML : MT;
    constexpr int NMIX = (kind == 2) ? 1 : 2;
    LAS unsigned char* lds = C.lds;
    if constexpr (kind == 0) {
        constexpr int ia = L / 3;
        PH_BEGIN(PH0)
        { pg8::Sched S{}; S.A = (const char*)WSP(bf16_t, WS_U); S.B = (const char*)(WSP(bf16_t, WS_WQKV) + (size_t)ia * 3 * D * D); S.lda = D * 2; S.ldb = D * 2; S.nt = D / 64;
          S.nM = MT / 256; S.nN = 3 * D / 256; S.ngroups = 1; S.a_g = 0; S.b_g = 0; S.G = C.G; S.c = C.bx;
          pg8::EpiQKV E{WSP(bf16_t, WS_Q), WSP(const float, WS_ROPE)};
          _Pragma("unroll") for (int rep_ = 0; rep_ < PROBE_QKV; ++rep_) { int tid_ = C.tid; if (rep_) { __builtin_amdgcn_sched_barrier(0); __syncthreads(); asm volatile("" : "+v"(tid_)); __builtin_amdgcn_sched_barrier(0); } pg8::gemm_phase(lds, S, E, tid_); } }
        PH_END(PH0)
        PH_BEGIN(PH0 + 1)
        { const float* lq1 = P.in[12] + ia * 64; const float* lk1 = P.in[13] + ia * 64; const float* lq2 = P.in[14] + ia * 64; const float* lk2 = P.in[15] + ia * 64;
          const float d1 = wave_sum(lq1[C.lane] * lk1[C.lane]), d2 = wave_sum(lq2[C.lane] * lk2[C.lane]);
          const float li = (L == 0) ? P.lam_init0 : P.lam_init3;
          att::Args A{WSP(bf16_t, WS_Q), WSP(bf16_t, WS_K), WSP(bf16_t, WS_V), WSP(bf16_t, WS_O), P.in[16] + ia * 128, expf(d1) - expf(d2) + li, 1.0f - li};
          _Pragma("unroll 1") for (int rep_ = 0; rep_ < PROBE_ATT; ++rep_) {
          constexpr int nlat_units = NB * NH * (SEQ / 256);
          const int per = (nlat_units + C.G - 1) / C.G;
#pragma unroll 1
          for (int i = 0; i < per; ++i) {
              if constexpr (false) { if (i == (C.vcu & 1)) { int tid_ = C.tid; asm volatile("" : "+v"(tid_));
                  prologue<1>(P, lds, tid_, __builtin_amdgcn_readfirstlane(tid_ >> 6), tid_ & 63, C.vcu, C.G); __syncthreads(); } }
              const int uu = C.vcu * per + i; if (uu < nlat_units) { const int bh = uu >> 3, qb = uu & 7; { int tid_ = C.tid; asm volatile("" : "+v"(tid_)); att::unit_checked(lds, A, bh >> 4, bh & 15, (bh >> 4) * SEQ + qb * 256, SEQ / 64, tid_); } } }
          if constexpr (!lastl) { for (int uc = C.bx; uc < NB * NH; uc += C.G) { const int b = uc >> 4, h = uc & 15; { int tid_ = C.tid; asm volatile("" : "+v"(tid_)); att::unit_checked(lds, A, b, h, ML + b * CL, 0, tid_); } } } } }
        PH_END(PH0 + 1)
    } else if constexpr (kind == 1) {
        PH_BEGIN(PH0)
        { pg8::Sched S{}; S.A = (const char*)WSP(bf16_t, WS_T1); S.B = (const char*)WSP(bf16_t, WS_U); S.lda = 512 * 2; S.ldb = D * 2; S.nt = 8; S.nM = 4; S.nN = Mact / 256; S.ngroups = 4; S.a_g = 0; S.b_g = 512 * 2; S.G = C.G; S.c = C.bx;
          pg8::EpiFA E{WSP(bf16_t, WS_YT), WSP(bf16_t, WS_YTC)};
          _Pragma("unroll") for (int rep_ = 0; rep_ < PROBE_FA; ++rep_) { int tid_ = C.tid; if (rep_) { __builtin_amdgcn_sched_barrier(0); __syncthreads(); asm volatile("" : "+v"(tid_)); __builtin_amdgcn_sched_barrier(0); } pg8::gemm_phase(lds, S, E, tid_); } }
        PH_END(PH0)
        PH_BEGIN(PH0 + 1)
        { pg8::Sched S{}; S.A = (const char*)WSP(bf16_t, WS_A2); S.B = (const char*)WSP(bf16_t, WS_YT); S.lda = 4096 * 2; S.ldb = 16384 * 2; S.nt = 64; S.nM = 8; S.nN = 8; S.ngroups = 4; S.a_g = 0; S.b_g = 4096 * 2; S.G = C.G; S.c = C.bx;
          pg8::EpiBf16<0> E{WSP(bf16_t, WS_O), (unsigned)D, SEQ};
          _Pragma("unroll") for (int rep_ = 0; rep_ < PROBE_FB; ++rep_) { int tid_ = C.tid; if (rep_) { __builtin_amdgcn_sched_barrier(0); __syncthreads(); asm volatile("" : "+v"(tid_)); __builtin_amdgcn_sched_barrier(0); } pg8::gemm_phase(lds, S, E, tid_); }
          if constexpr (!lastl) { pg8::Sched S2{}; S2.A = (const char*)WSP(bf16_t, WS_A2C); S2.B = (const char*)WSP(bf16_t, WS_YTC); S2.lda = 512 * 2; S2.ldb = 2048 * 2; S2.nt = 8; S2.nM = 1; S2.nN = 8; S2.ngroups = 4; S2.a_g = 0; S2.b_g = 512 * 2; S2.G = C.G; S2.c = C.bx;
            pg8::EpiBf16<0> E2{WSP(bf16_t, WS_O) + (size_t)ML * D, (unsigned)D, CL};
            _Pragma("unroll") for (int rep_ = 0; rep_ < PROBE_FB; ++rep_) { int tid_ = C.tid; if (rep_) { __builtin_amdgcn_sched_barrier(0); __syncthreads(); asm volatile("" : "+v"(tid_)); __builtin_amdgcn_sched_barrier(0); } pg8::gemm_phase(lds, S2, E2, tid_); } } }
        PH_END(PH0 + 1)
    } else {
        PH_BEGIN(PH0) for (int rep_ = 0; rep_ < PROBE_THIN; ++rep_) pool_phase(WSP(bf16_t, WS_U), WSP(bf16_t, WS_O), Mact, C.gw, C.NGW, C.lane); PH_END(PH0)
    }
    PH_BEGIN(PH0 + NMIX)
    { pg8::Sched S{}; S.A = (const char*)WSP(bf16_t, WS_O); S.lda = D * 2; S.G = C.G; S.c = C.bx;
      if constexpr (kind == 2) { S.B = (const char*)WSP(bf16_t, WS_WPOOL); S.ldb = 512 * 2; S.nt = 8; S.nM = Mact / 256; S.nN = 2; S.ngroups = 4; S.a_g = 512 * 2; S.b_g = 512 * 512 * 2;
          pg8::EpiY E{WSP(bf16_t, WS_Y), (unsigned)D, P.in[19], 512}; _Pragma("unroll") for (int rep_ = 0; rep_ < PROBE_MIX; ++rep_) { int tid_ = C.tid; if (rep_) { __builtin_amdgcn_sched_barrier(0); __syncthreads(); asm volatile("" : "+v"(tid_)); __builtin_amdgcn_sched_barrier(0); } pg8::gemm_phase(lds, S, E, tid_); } }
      else { S.B = kind == 0 ? (const char*)(WSP(bf16_t, WS_WO) + (size_t)(L / 3) * D * D) : (const char*)WSP(bf16_t, WS_WF); S.ldb = D * 2; S.nt = D / 64; S.nM = ML / 256; S.nN = D / 256; S.ngroups = 1;
          pg8::EpiY E{WSP(bf16_t, WS_Y), (unsigned)D, nullptr, 0}; _Pragma("unroll") for (int rep_ = 0; rep_ < PROBE_MIX; ++rep_) { int tid_ = C.tid; if (rep_) { __builtin_amdgcn_sched_barrier(0); __syncthreads(); asm volatile("" : "+v"(tid_)); __builtin_amdgcn_sched_barrier(0); } pg8::gemm_phase(lds, S, E, tid_); }
          if constexpr (!lastl) { pg8::Sched S2 = S; S2.A = (const char*)(WSP(bf16_t, WS_O) + (size_t)ML * D); S2.nt = D / 64 / NSPLIT; S2.nM = MC / 256; S2.ngroups = NSPLIT; S2.a_g = (D / NSPLIT) * 2; S2.b_g = (D / NSPLIT) * 2;
              pg8::EpiF32 E2{WSP(float, WS_YC), (unsigned)D, nullptr, 0, (size_t)MC * D}; _Pragma("unroll") for (int rep_ = 0; rep_ < PROBE_MIX; ++rep_) { int tid_ = C.tid; if (rep_) { __builtin_amdgcn_sched_barrier(0); __syncthreads(); asm volatile("" : "+v"(tid_)); __builtin_amdgcn_sched_barrier(0); } pg8::gemm_phase(lds, S2, E2, tid_); } } } }
    PH_END(PH0 + NMIX)
    PH_BEGIN(PH0 + NMIX + 1)
    { const float* modl = WSP(const float, WS_MOD) + (size_t)L * 5 * MODROW; float* X = WSP(float, WS_X);
      ThinArgs T{}; T.xin_lat = L == 0 ? P.in[0] : X; T.xin_ctx = L == 0 ? P.in[2] : X + (size_t)ML * D; T.y = WSP(const bf16_t, WS_Y); T.xout_lat = X; T.xout_ctx = X + (size_t)ML * D;
      T.yc = WSP(const float, WS_YC); T.nslab = (kind == 2 || lastl) ? 0 : NSPLIT;
      T.g_post = P.in[7] + L * D; T.gate = modl + 2 * D; T.uout = WSP(bf16_t, WS_U); T.g_pre = P.in[8] + L * D; T.sc = modl + 4 * D; T.sh = modl + 3 * D; T.nrows = Mact;
      thin_phase(T, C.gw, C.NGW, C.lane);
      for (int rep_ = 1; rep_ < PROBE_THIN; ++rep_) { ThinArgs T2 = T; if (T2.xout_lat) { T2.xout_lat = WSP(float, WS_END); T2.xout_ctx = WSP(float, WS_END) + (size_t)ML * D; } if (T2.uout) T2.uout = WSP(bf16_t, WS_END + 80 * MiB); thin_phase(T2, C.gw, C.NGW, C.lane); } }
    PH_END(PH0 + NMIX + 1)
    PH_BEGIN(PH0 + NMIX + 2)
    { pg8::Sched S{}; S.A = (const char*)WSP(bf16_t, WS_U); S.B = (const char*)(WSP(bf16_t, WS_W1) + (size_t)L * FF * D); S.lda = D * 2; S.ldb = D * 2; S.nt = D / 64; S.nM = Mact / 256; S.nN = FF / 256; S.ngroups = 1; S.G = C.G; S.c = C.bx;
      pg8::EpiBf16<1> E{WSP(bf16_t, WS_H), (unsigned)FF, 0}; _Pragma("unroll") for (int rep_ = 0; rep_ < PROBE_W1; ++rep_) { int tid_ = C.tid; if (rep_) { __builtin_amdgcn_sched_barrier(0); __syncthreads(); asm volatile("" : "+v"(tid_)); __builtin_amdgcn_sched_barrier(0); } pg8::gemm_phase(lds, S, E, tid_); } }
    PH_END(PH0 + NMIX + 2)
    PH_BEGIN(PH0 + NMIX + 3)
    { pg8::Sched S{}; S.A = (const char*)WSP(bf16_t, WS_H); S.B = (const char*)(WSP(bf16_t, WS_W2) + (size_t)L * D * FF); S.lda = FF * 2; S.ldb = FF * 2; S.nt = FF / 64; S.nM = ML / 256; S.nN = D / 256; S.ngroups = 1; S.G = C.G; S.c = C.bx;
      pg8::EpiY E{WSP(bf16_t, WS_Y), (unsigned)D, nullptr, 0}; _Pragma("unroll") for (int rep_ = 0; rep_ < PROBE_W2; ++rep_) { int tid_ = C.tid; if (rep_) { __builtin_amdgcn_sched_barrier(0); __syncthreads(); asm volatile("" : "+v"(tid_)); __builtin_amdgcn_sched_barrier(0); } pg8::gemm_phase(lds, S, E, tid_); }
      if constexpr (!lastl) { pg8::Sched S2 = S; S2.A = (const char*)(WSP(bf16_t, WS_H) + (size_t)ML * FF); S2.nt = FF / 64 / NSPLIT; S2.nM = MC / 256; S2.ngroups = NSPLIT; S2.a_g = (FF / NSPLIT) * 2; S2.b_g = (FF / NSPLIT) * 2;
          pg8::EpiF32 E2{WSP(float, WS_YC), (unsigned)D, nullptr, 0, (size_t)MC * D}; _Pragma("unroll") for (int rep_ = 0; rep_ < PROBE_W2; ++rep_) { int tid_ = C.tid; if (rep_) { __builtin_amdgcn_sched_barrier(0); __syncthreads(); asm volatile("" : "+v"(tid_)); __builtin_amdgcn_sched_barrier(0); } pg8::gemm_phase(lds, S2, E2, tid_); } } }
    PH_END(PH0 + NMIX + 3)
    PH_BEGIN(PH0 + NMIX + 4)
    { const float* modl = WSP(const float, WS_MOD) + (size_t)L * 5 * MODROW; float* X = WSP(float, WS_X);
      ThinArgs T{}; T.xin_lat = X; T.xin_ctx = X + (size_t)ML * D; T.y = WSP(const bf16_t, WS_Y); T.xout_lat = lastl ? P.out : X; T.xout_ctx = X + (size_t)ML * D;
      T.yc = WSP(const float, WS_YC); T.nslab = lastl ? 0 : NSPLIT;
      T.g_post = P.in[9] + L * D; T.gate = modl + 5 * D; T.nrows = Mact;
      if constexpr (!lastl) { const float* modn = modl + 5 * MODROW; T.uout = WSP(bf16_t, WS_U); T.g_pre = P.in[6] + (L + 1) * D; T.sc = modn + 1 * D; T.sh = modn + 0 * D; }
      thin_phase(T, C.gw, C.NGW, C.lane);
      for (int rep_ = 1; rep_ < PROBE_THIN; ++rep_) { ThinArgs T2 = T; if (T2.xout_lat) { T2.xout_lat = WSP(float, WS_END); T2.xout_ctx = WSP(float, WS_END) + (size_t)ML * D; } if (T2.uout) T2.uout = WSP(bf16_t, WS_END + 80 * MiB); thin_phase(T2, C.gw, C.NGW, C.lane); } }
    PH_END(PH0 + NMIX + 4)
}
constexpr int PH_L0 = 2, PH_L1 = PH_L0 + 7, PH_L2 = PH_L1 + 7, PH_L3 = PH_L2 + 6, N_PHASES = PH_L3 + 7;

__global__ void __launch_bounds__(NTHR, 2) fwd_kernel(Params P) {
    extern __shared__ __attribute__((aligned(16))) unsigned char lds_raw[];
    Ctx C; C.lds = (LAS unsigned char*)lds_raw;
    C.tid = threadIdx.x; C.lane = C.tid & 63; C.wave = __builtin_amdgcn_readfirstlane(C.tid >> 6);
    C.G = gridDim.x; C.bx = blockIdx.x; C.vcu = (C.G % 8 == 0) ? (C.bx % 8) * (C.G / 8) + C.bx / 8 : C.bx;
    C.gw = C.vcu * NWAVES + C.wave; C.NGW = C.G * NWAVES;
    for (int u = C.tid; u < (LDS_BYTES - LDSCTL_OFF) / 4; u += NTHR) ((LAS unsigned*)(C.lds + LDSCTL_OFF))[u] = 0u;
    __syncthreads();
#if MK_MULTI
    XcdBarrier bar{};
#else
    XcdBarrier bar = xcd_barrier_post(WSP(unsigned, WS_CTL) + CW_BAR, (volatile LAS unsigned*)(C.lds + MISC_OFF) + 8);
#endif
    PH_BEGIN(0) for (int rep_ = 0; rep_ < PROBE_PRO; ++rep_) { prologue<2>(P, C.lds, C.tid, C.wave, C.lane, C.vcu, C.G); __syncthreads(); } PH_END(0)
#if !MK_MULTI
    if (P.ph_lo == 0 && P.ph_hi > 1) {
        volatile LAS unsigned* st = (volatile LAS unsigned*)(C.lds + MISC_OFF) + 8;
        if (C.tid == 0) { unsigned* bw = WSP(unsigned, WS_CTL) + CW_BAR; bool okc = (C.G % 8 == 0);
            for (unsigned j = 0; j < 16; ++j) { const unsigned cnt = xb_ld(&bw[XB_XCNT(j)]); okc = okc && (cnt == (j < 8 ? (unsigned)C.G / 8u : 0u)); }
            st[3] = okc ? st[2] * 8u + bar.x : (unsigned)blockIdx.x; }
        __syncthreads();
        C.bx = (int)st[3]; C.vcu = (C.G % 8 == 0) ? (C.bx % 8) * (C.G / 8) + C.bx / 8 : C.bx; C.gw = C.vcu * NWAVES + C.wave;
    }
#endif
    PH_BEGIN(1)
    { const float* mod = WSP(const float, WS_MOD);
      ThinArgs T{}; T.xin_lat = P.in[0]; T.xin_ctx = P.in[2]; T.y = nullptr; T.uout = WSP(bf16_t, WS_U); T.g_pre = P.in[6]; T.sc = mod + 1 * D; T.sh = mod + 0 * D; T.nrows = MT;
      thin_phase(T, C.gw, C.NGW, C.lane);
      for (int rep_ = 1; rep_ < PROBE_THIN; ++rep_) { ThinArgs T2 = T; if (T2.xout_lat) { T2.xout_lat = WSP(float, WS_END); T2.xout_ctx = WSP(float, WS_END) + (size_t)ML * D; } if (T2.uout) T2.uout = WSP(bf16_t, WS_END + 80 * MiB); thin_phase(T2, C.gw, C.NGW, C.lane); } }
    PH_END(1)
    layer<0, PH_L0>(P, C, bar);
    layer<1, PH_L1>(P, C, bar);
    layer<2, PH_L2>(P, C, bar);
    layer<3, PH_L3>(P, C, bar);
}
#undef PH_BEGIN
#undef PH_END
#undef GRID_BAR

extern "C" void kernel_launch(void* const* d_in, const int* in_sizes, int n_in, void* d_out, int out_size, void* d_ws, size_t ws_size, hipStream_t stream) {
    static int grid = 0;
    if (grid == 0) {
        if (n_in != 22 || out_size != ML * D || ws_size < WS_END + 128 * MiB) { fprintf(stderr, "kernel_launch: unexpected problem: n_in %d out %d ws %zu (need %zu)\n", n_in, out_size, ws_size, (size_t)WS_END); grid = -1; return; }
        int dev = 0, cus = 0, per_cu = 0;
        if (hipGetDevice(&dev) != hipSuccess || hipDeviceGetAttribute(&cus, hipDeviceAttributeMultiprocessorCount, dev) != hipSuccess) { grid = -1; return; }
        if (hipFuncSetAttribute((const void*)fwd_kernel, hipFuncAttributeMaxDynamicSharedMemorySize, LDS_BYTES) != hipSuccess) { fprintf(stderr, "kernel_launch: hipFuncSetAttribute failed\n"); grid = -1; return; }
        if (hipOccupancyMaxActiveBlocksPerMultiprocessor(&per_cu, (const void*)fwd_kernel, NTHR, LDS_BYTES) != hipSuccess || per_cu < 1) fprintf(stderr, "kernel_launch: occupancy query says %d\n", per_cu);
        (void)hipGetLastError();
        grid = cus;
    }
    if (grid < 0) return;
    (void)in_sizes;
    hipMemsetAsync((char*)d_ws + WS_CTL, 0, CTL_BYTES, stream);
    Params p{};
    for (int i = 0; i < 22; ++i) p.in[i] = (const float*)d_in[i];
    p.out = (float*)d_out; p.ws = (unsigned char*)d_ws;
    p.lam_init0 = (float)(0.8 - 0.6 * exp(-0.3 * 0.0)); p.lam_init3 = (float)(0.8 - 0.6 * exp(-0.3 * 3.0));
#if MK_MULTI
    for (int ph = 0; ph < N_PHASES; ++ph) { p.ph_lo = ph; p.ph_hi = ph + 1; hipLaunchKernelGGL(fwd_kernel, dim3(grid), dim3(NTHR), LDS_BYTES, stream, p); }
#else
    p.ph_lo = 0; p.ph_hi = N_PHASES;
    hipLaunchKernelGGL(fwd_kernel, dim3(grid), dim3(NTHR), LDS_BYTES, stream, p);
#endif
    const hipError_t le = hipPeekAtLastError();
    if (le != hipSuccess) fprintf(stderr, "kernel_launch: launch failed: %s\n", hipGetErrorName(le));
}
```

```cpp
#include <hip/hip_runtime.h>
#include <cstdio>
#include <cstdint>
#include <cmath>

#define PROBE_QKV 1
#define PROBE_FA 1
#define PROBE_FB 1
#define PROBE_MIX 1
#define PROBE_W1 1
#define PROBE_W2 1
#define PROBE_BAR 1
#define PROBE_ATT 1
#define PROBE_PRO 1
#define PROBE_THIN 1
#ifndef MK_MULTI
#define MK_MULTI 0
#endif

#define LAS __attribute__((address_space(3)))
#define GAS __attribute__((address_space(1)))
typedef unsigned short bf16_t;
typedef short bf16x8 __attribute__((ext_vector_type(8)));
typedef short s16x4 __attribute__((ext_vector_type(4)));
typedef float f32x4 __attribute__((ext_vector_type(4)));
typedef float f32x2 __attribute__((ext_vector_type(2)));
typedef float f32x16 __attribute__((ext_vector_type(16)));
typedef unsigned u32x4 __attribute__((ext_vector_type(4)));
typedef unsigned u32x2 __attribute__((ext_vector_type(2)));

constexpr int D = 2048, NB = 4, SEQ = 2048, CL = 256, ML = NB * SEQ, MC = NB * CL, MT = ML + MC, FF = 8192, NH = 16, NMOD = 6, MODROW = NMOD * D;
constexpr int NWAVES = 8, NTHR = 512;
constexpr float NORM_EPS = 1e-6f, SUBLN_EPS = 1e-5f;
constexpr float QSCALE = 0.125f * 1.4426950408889634f;

constexpr size_t MiB = 1u << 20;
constexpr size_t WS_CTL = 0, CTL_BYTES = 1 * MiB;
constexpr size_t WS_MOD = 1 * MiB;
constexpr size_t WS_ROPE = 2 * MiB;
constexpr size_t WS_T1 = 3 * MiB;
constexpr size_t WS_A2C = 4 * MiB;
constexpr size_t WS_A2 = 5 * MiB;
constexpr size_t WS_WQKV = 22 * MiB;
constexpr size_t WS_WO = 70 * MiB;
constexpr size_t WS_WF = 86 * MiB;
constexpr size_t WS_WPOOL = 94 * MiB;
constexpr size_t WS_W1 = 96 * MiB;
constexpr size_t WS_W2 = 224 * MiB;
constexpr size_t WS_X = 352 * MiB;
constexpr size_t WS_Y = 424 * MiB;
constexpr size_t WS_U = 496 * MiB;
constexpr size_t WS_Q = 532 * MiB, WS_K = 568 * MiB, WS_V = 604 * MiB, WS_O = 640 * MiB;
constexpr size_t WS_H = 676 * MiB;
constexpr size_t WS_YT = 820 * MiB;
constexpr size_t WS_YTC = 884 * MiB;
constexpr size_t WS_YC = 892 * MiB;
constexpr size_t WS_END = 956 * MiB;
constexpr int NSPLIT = 8;

constexpr int RING_BYTES = 131072, LDSCTL_OFF = 139264  , MISC_OFF = LDSCTL_OFF + 320, LDS_BYTES = 147456;

__device__ __forceinline__ unsigned cvt_pk_bf16(float lo, float hi) { unsigned r; asm volatile("v_cvt_pk_bf16_f32 %0, %1, %2" : "=v"(r) : "v"(lo), "v"(hi)); return r; }
__device__ __forceinline__ float bf2f(unsigned short b) { return __uint_as_float(((unsigned)b) << 16); }
__device__ __forceinline__ float wave_sum(float v) {
#pragma unroll
    for (int o = 1; o < 64; o <<= 1) v += __shfl_xor(v, o);
    return v;
}

#define XB_TMO      128
#define XB_XCNT(j)  (256  + 64 * (j))
#define XB_XSUB(j)  (1280 + 64 * (j))
#define XB_XGEN(j)  (2304 + 64 * (j))
#define XB_TOP      3328
#define XB_TOPGEN   3392
#define XCD_BAR_WORDS 3456
#define XB_SPIN_CAP (1u << 18)
constexpr int CW_BAR = 4096;

__device__ __forceinline__ unsigned xb_ld(unsigned* p)              { return __hip_atomic_load(p, __ATOMIC_RELAXED, __HIP_MEMORY_SCOPE_AGENT); }
__device__ __forceinline__ unsigned xb_add(unsigned* p, unsigned v) { return __hip_atomic_fetch_add(p, v, __ATOMIC_RELAXED, __HIP_MEMORY_SCOPE_AGENT); }
__device__ __forceinline__ unsigned xb_xcc_id() { return (unsigned)__builtin_amdgcn_s_getreg((3 << 11) | 20) & 0xFu; }
#define XB_SPIN(cond, bar) do { unsigned _sp = 0; while (cond) { __builtin_amdgcn_s_sleep(1); \
    if ((++_sp & 255u) == 0u) { if (xb_ld(&(bar)[XB_TMO])) break; if (_sp > XB_SPIN_CAP) { atomicAdd(&(bar)[XB_TMO], 1u); break; } } } } while (0)

struct XcdBarrier { unsigned* bar; unsigned x; volatile LAS unsigned* st; };

__device__ __forceinline__ XcdBarrier xcd_barrier_post(unsigned* bar, volatile LAS unsigned* st) {
    XcdBarrier b; b.bar = bar; b.x = xb_xcc_id(); b.st = st;
    if (threadIdx.x == 0) st[2] = xb_add(&bar[XB_XCNT(b.x)], 1u);
    return b;
}
__device__ __forceinline__ void xcd_barrier_complete(unsigned* bar, unsigned x, unsigned& nloc, unsigned& nx) {
    const unsigned G = gridDim.x * gridDim.y * gridDim.z;
    unsigned sum, cnt, mine, sp = 0u;
    for (;;) {
        sum = 0u; cnt = 0u; mine = 0u;
#pragma unroll
        for (unsigned j = 0; j < 16; ++j) { const unsigned c = xb_ld(&bar[XB_XCNT(j)]); sum += c; cnt += (c > 0u) ? 1u : 0u; mine = (j == x) ? c : mine; }
        if (sum == G) break;
        __builtin_amdgcn_s_sleep(1);
        if ((++sp & 255u) == 0u) { if (xb_ld(&bar[XB_TMO])) break; if (sp > XB_SPIN_CAP) { atomicAdd(&bar[XB_TMO], 1u); break; } }
    }
    nloc = mine > 0u ? mine : 1u; nx = cnt > 0u ? cnt : 1u;
}
__device__ __forceinline__ void xcd_barrier(const XcdBarrier& b) {
    asm volatile("s_waitcnt vmcnt(0)" ::: "memory");
    __syncthreads();
    if (threadIdx.x == 0) {
        unsigned* bar = b.bar;
        __builtin_amdgcn_s_waitcnt(0);
        unsigned nloc = b.st[0], nx = b.st[1];
        if (nloc == 0u) { xcd_barrier_complete(bar, b.x, nloc, nx); b.st[0] = nloc; b.st[1] = nx; }
        const unsigned old = xb_add(&bar[XB_XSUB(b.x)], 1u);
        const unsigned gen = old / nloc;
        if (old + 1u == (gen + 1u) * nloc) {
            __builtin_amdgcn_fence(__ATOMIC_RELEASE, "agent");
            asm volatile("s_waitcnt vmcnt(0)" ::: "memory");
            const unsigned og = xb_add(&bar[XB_TOP], 1u);
            const unsigned tg = og / nx;
            if (og + 1u == (tg + 1u) * nx) xb_add(&bar[XB_TOPGEN], 1u);
            else XB_SPIN(xb_ld(&bar[XB_TOPGEN]) == tg, bar);
            __builtin_amdgcn_fence(__ATOMIC_ACQUIRE, "agent");
            xb_add(&bar[XB_XGEN(b.x)], 1u);
            asm volatile("s_waitcnt vmcnt(0)" ::: "memory");
        } else {
            XB_SPIN(xb_ld(&bar[XB_XGEN(b.x)]) == gen, bar);
            __builtin_amdgcn_fence(__ATOMIC_ACQUIRE, "agent");
            asm volatile("s_waitcnt vmcnt(0)" ::: "memory");
        }
    }
    __syncthreads();
}

namespace pg8 {
constexpr int BM = 256, BK = 64, HALF = 128, HTB = HALF * BK * 2, STAGE_BYTES = 8 * HTB, NXCD = 8, WGM = 8;
__device__ __forceinline__ int lds_byte(int r, int c) { const int st = (r >> 4) * 2 + (c >> 5), rr = r & 15, cc = c & 31, ob = rr * 64 + cc * 2; return st * 1024 + (ob ^ (((ob >> 9) & 1) << 5)); }
__device__ __forceinline__ void stage_rc(int b, int& R, int& C) { const int st = b / 1024, sb = b % 1024, swz = sb ^ (((sb >> 9) & 1) << 5); R = (st >> 1) * 16 + swz / 64; C = (st & 1) * 32 + (swz % 64) / 2; }
__device__ __forceinline__ int perm32(int rho) { const int n = rho >> 4, i = rho & 15; return 8 * (i >> 2) + 4 * n + (i & 3); }

struct Unit { const char* A; const char* B; int g, pm, pn; };

struct Sched {
    const char* A; const char* B; unsigned lda, ldb; int nt;
    int nM, nN, ngroups; long long a_g, b_g;
    int G, c;
    __device__ __forceinline__ bool next(int i, Unit& u) const {
        const int per = nM * nN, nwg = per * ngroups;
        const long L = (long)i * G + c; if (L >= nwg) return false;
        int wgid = (int)L; { const int q = nwg / NXCD, r = nwg % NXCD, xcd = wgid % NXCD, off = wgid / NXCD; wgid = (xcd < r ? xcd * (q + 1) : r * (q + 1) + (xcd - r) * q) + off; }
        const int g = wgid / per, w = wgid % per;
        const int nig = WGM * nN, gid = w / nig, fm = gid * WGM, gsz = (nM - fm) < WGM ? (nM - fm) : WGM;
        u.g = g; u.pm = fm + ((w % nig) % gsz); u.pn = (w % nig) / gsz;
        u.A = A + (long long)g * a_g + (size_t)u.pm * BM * lda; u.B = B + (long long)g * b_g + (size_t)u.pn * BM * ldb;
        return true;
    }
};

template <class Epi>
__device__ __forceinline__ void gemm_phase(LAS unsigned char* lds, const Sched& S, const Epi& E, int tid_in = -1) {
    const int tid = tid_in >= 0 ? tid_in : (int)threadIdx.x, wid = __builtin_amdgcn_readfirstlane(tid >> 6), lane = tid & 63, wr = wid >> 2, wc = wid & 3, fr = lane & 15, fq = lane >> 4;
    const int nt = S.nt;
    unsigned voffA[2], voffB[2];
#pragma unroll
    for (int i = 0; i < 2; ++i) { int R, C; stage_rc(tid * 16 + i * 8192, R, C); const int Rb = (R & ~31) + perm32(R & 31);
        voffA[i] = (unsigned)R * S.lda + (unsigned)C * 2u; voffB[i] = (unsigned)Rb * S.ldb + (unsigned)C * 2u; }
    const size_t kstep = (size_t)(BK * 2);
    const size_t hA = (size_t)HALF * S.lda, hB = (size_t)HALF * S.ldb;
    const unsigned ldsw = (unsigned)wid * 1024u;
    const int aoff = lds_byte(wr * 64 + fr, fq * 8), boff = lds_byte(wc * 32 + fr, fq * 8);
#define PG8_SA(b, h) (((b) * 2 + (h)) * HTB)
#define PG8_SB(b, h) ((4 + (b) * 2 + (h)) * HTB)
#define PG8_STAGE(bufoff, gbase, voff) do { _Pragma("unroll") for (int _i = 0; _i < 2; ++_i) \
        __builtin_amdgcn_global_load_lds((const unsigned*)((const char*)(gbase) + (voff)[_i]), (LAS unsigned*)(lds + (bufoff) + ldsw + _i * 8192), 16, 0, 0); } while (0)
#define PG8_LDA(dst, b, h) do { _Pragma("unroll") for (int m = 0; m < 4; ++m) _Pragma("unroll") for (int k = 0; k < 2; ++k) dst[m][k] = *(const LAS bf16x8*)(lds + PG8_SA(b, h) + aoff + m * 2048 + k * 1024); } while (0)
#define PG8_LDB(dst, b, h) do { _Pragma("unroll") for (int n = 0; n < 2; ++n) _Pragma("unroll") for (int k = 0; k < 2; ++k) dst[n][k] = *(const LAS bf16x8*)(lds + PG8_SB(b, h) + boff + n * 2048 + k * 1024); } while (0)
#define PG8_MMA(ai, bj, At, Bt) do { __builtin_amdgcn_s_setprio(1); _Pragma("unroll") for (int m = 0; m < 4; ++m) _Pragma("unroll") for (int n = 0; n < 2; ++n) _Pragma("unroll") for (int k = 0; k < 2; ++k) \
        acc[ai][bj][m][n] = __builtin_amdgcn_mfma_f32_16x16x32_bf16(Bt[n][k], At[m][k], acc[ai][bj][m][n], 0, 0, 0); __builtin_amdgcn_s_setprio(0); } while (0)
#define PG8_WAIT_V(n) asm volatile("s_waitcnt vmcnt(" #n ")" ::: "memory")
#define PG8_WAIT_L(n) asm volatile("s_waitcnt lgkmcnt(" #n ")" ::: "memory")
#define PG8_BAR __builtin_amdgcn_s_barrier()
#define PG8_SCHED __builtin_amdgcn_sched_barrier(0)
    Unit cur, nxt; int ui = 0;
    if (!S.next(0, cur)) return;
    f32x4 acc[2][2][4][2];
#pragma unroll
    for (int a = 0; a < 2; ++a)
#pragma unroll
        for (int b = 0; b < 2; ++b)
#pragma unroll
            for (int m = 0; m < 4; ++m)
#pragma unroll
                for (int n = 0; n < 2; ++n) acc[a][b][m][n] = (f32x4){0.f, 0.f, 0.f, 0.f};
    bf16x8 At[4][2], B0[2][2], B1[2][2];
    const char* cA = cur.A; const char* cB = cur.B;
    PG8_STAGE(PG8_SB(0, 0), cB, voffB); PG8_STAGE(PG8_SB(0, 1), cB + hB, voffB); PG8_STAGE(PG8_SA(0, 0), cA, voffA); PG8_STAGE(PG8_SA(0, 1), cA + hA, voffA);
    if (wr == 1) PG8_BAR;
    PG8_WAIT_V(2); PG8_BAR;
    PG8_STAGE(PG8_SB(1, 0), cB + kstep, voffB); PG8_STAGE(PG8_SA(1, 0), cA + kstep, voffA); PG8_STAGE(PG8_SB(1, 1), cB + hB + kstep, voffB);
    PG8_WAIT_V(6); PG8_BAR;
    for (;;) {
        const bool has_next = S.next(ui + 1, nxt);
        const char* nA = has_next ? nxt.A : cA; const char* nB = has_next ? nxt.B : cB;
        for (int t = 0; t < nt; t += 2) {
            const bool last = (t == nt - 2);
            const char* a1 = cA + (size_t)(t + 1) * kstep;
            const char* a2 = last ? nA : cA + (size_t)(t + 2) * kstep; const char* b2 = last ? nB : cB + (size_t)(t + 2) * kstep;
            const char* a3 = a2 + kstep; const char* b3 = b2 + kstep;
            PG8_LDB(B0, 0, 0); PG8_LDB(B1, 0, 1); PG8_SCHED; PG8_LDA(At, 0, 0); PG8_STAGE(PG8_SA(1, 1), a1 + hA, voffA);
            PG8_WAIT_V(8); PG8_WAIT_L(0); PG8_BAR; PG8_MMA(0, 0, At, B0); PG8_MMA(0, 1, At, B1); PG8_BAR; PG8_SCHED;
            PG8_LDA(At, 0, 1); PG8_STAGE(PG8_SB(0, 0), b2, voffB); PG8_STAGE(PG8_SB(0, 1), b2 + hB, voffB); PG8_STAGE(PG8_SA(0, 0), a2, voffA);
            PG8_WAIT_V(8); PG8_WAIT_L(0); PG8_BAR; PG8_MMA(1, 0, At, B0); PG8_MMA(1, 1, At, B1); PG8_BAR; PG8_SCHED;
            PG8_LDB(B0, 1, 0); PG8_LDB(B1, 1, 1); PG8_SCHED; PG8_LDA(At, 1, 0); PG8_STAGE(PG8_SA(0, 1), a2 + hA, voffA);
            PG8_WAIT_V(8); PG8_WAIT_L(0); PG8_BAR; PG8_MMA(0, 0, At, B0); PG8_MMA(0, 1, At, B1); PG8_BAR; PG8_SCHED;
            PG8_LDA(At, 1, 1); PG8_STAGE(PG8_SB(1, 0), b3, voffB); PG8_STAGE(PG8_SB(1, 1), b3 + hB, voffB); PG8_STAGE(PG8_SA(1, 0), a3, voffA);
            PG8_WAIT_V(8); PG8_WAIT_L(0); PG8_BAR; PG8_MMA(1, 0, At, B0); PG8_MMA(1, 1, At, B1); PG8_BAR; PG8_SCHED;
        }
        if (wr == 0) PG8_BAR;
        E(acc, cur, wr, wc, fr, fq);
        if (!has_next) break;
#pragma unroll
        for (int a = 0; a < 2; ++a)
#pragma unroll
            for (int b = 0; b < 2; ++b)
#pragma unroll
                for (int m = 0; m < 4; ++m)
#pragma unroll
                    for (int n = 0; n < 2; ++n) acc[a][b][m][n] = (f32x4){0.f, 0.f, 0.f, 0.f};
        cur = nxt; cA = nA; cB = nB; ++ui;
        if (wr == 1) PG8_BAR;
    }
    PG8_WAIT_V(0);
    PG8_BAR;
#undef PG8_SA
#undef PG8_SB
#undef PG8_STAGE
#undef PG8_LDA
#undef PG8_LDB
#undef PG8_MMA
#undef PG8_WAIT_V
#undef PG8_WAIT_L
#undef PG8_BAR
#undef PG8_SCHED
}

struct EpiF32 {
    float* C; unsigned ldc; const float* colscale; int c_g; size_t slab_g;
    __device__ __forceinline__ void operator()(const f32x4 (&acc)[2][2][4][2], const Unit& u, int wr, int wc, int fr, int fq) const {
        const int row0 = u.pm * BM + wr * 64 + fr, col0 = u.g * c_g + u.pn * BM + wc * 32 + 8 * fq;
        f32x4 sv[2][2];
#pragma unroll
        for (int bj = 0; bj < 2; ++bj)
#pragma unroll
            for (int n = 0; n < 2; ++n) sv[bj][n] = colscale ? *(const f32x4*)(colscale + col0 + bj * HALF + 4 * n) : (f32x4){1.f, 1.f, 1.f, 1.f};
#pragma unroll
        for (int ai = 0; ai < 2; ++ai)
#pragma unroll
            for (int m = 0; m < 4; ++m) { float* rowp = C + (size_t)u.g * slab_g + (size_t)(row0 + ai * HALF + m * 16) * ldc + col0;
#pragma unroll
                for (int bj = 0; bj < 2; ++bj) { *(f32x4*)(rowp + bj * HALF) = acc[ai][bj][m][0] * sv[bj][0]; *(f32x4*)(rowp + bj * HALF + 4) = acc[ai][bj][m][1] * sv[bj][1]; } }
    }
};
struct EpiY {
    bf16_t* C; unsigned ldc; const float* colscale; int c_g;
    __device__ __forceinline__ void operator()(const f32x4 (&acc)[2][2][4][2], const Unit& u, int wr, int wc, int fr, int fq) const {
        const int row0 = u.pm * BM + wr * 64 + fr, col0 = u.g * c_g + u.pn * BM + wc * 32 + 8 * fq;
        f32x4 sv[2][2];
#pragma unroll
        for (int bj = 0; bj < 2; ++bj)
#pragma unroll
            for (int n = 0; n < 2; ++n) sv[bj][n] = colscale ? *(const f32x4*)(colscale + col0 + bj * HALF + 4 * n) : (f32x4){1.f, 1.f, 1.f, 1.f};
#pragma unroll
        for (int ai = 0; ai < 2; ++ai)
#pragma unroll
            for (int m = 0; m < 4; ++m) { bf16_t* rowp = C + (size_t)(row0 + ai * HALF + m * 16) * ldc + col0;
#pragma unroll
                for (int bj = 0; bj < 2; ++bj) { const f32x4 v0 = acc[ai][bj][m][0] * sv[bj][0], v1 = acc[ai][bj][m][1] * sv[bj][1];
                    u32x4 w; w.x = cvt_pk_bf16(v0[0], v0[1]); w.y = cvt_pk_bf16(v0[2], v0[3]); w.z = cvt_pk_bf16(v1[0], v1[1]); w.w = cvt_pk_bf16(v1[2], v1[3]);
                    *(u32x4*)(rowp + bj * HALF) = w; } }
    }
};
template <int ACT> struct EpiBf16 {
    bf16_t* C; unsigned ldc; int row_g;
    __device__ __forceinline__ void operator()(const f32x4 (&acc)[2][2][4][2], const Unit& u, int wr, int wc, int fr, int fq) const {
        const int row0 = u.g * row_g + u.pm * BM + wr * 64 + fr, col0 = u.pn * BM + wc * 32 + 8 * fq;
#pragma unroll
        for (int ai = 0; ai < 2; ++ai)
#pragma unroll
            for (int m = 0; m < 4; ++m) { bf16_t* rowp = C + (size_t)(row0 + ai * HALF + m * 16) * ldc + col0;
#pragma unroll
                for (int bj = 0; bj < 2; ++bj) { f32x4 v0 = acc[ai][bj][m][0], v1 = acc[ai][bj][m][1];
                    if (ACT == 1) {
#pragma unroll
                        for (int e = 0; e < 4; ++e) { const float a = fmaxf(v0[e], 0.f), b = fmaxf(v1[e], 0.f); v0[e] = a * a; v1[e] = b * b; } }
                    u32x4 w; w.x = cvt_pk_bf16(v0[0], v0[1]); w.y = cvt_pk_bf16(v0[2], v0[3]); w.z = cvt_pk_bf16(v1[0], v1[1]); w.w = cvt_pk_bf16(v1[2], v1[3]);
                    *(u32x4*)(rowp + bj * HALF) = w; } }
    }
};
struct EpiFA {
    bf16_t* YT; bf16_t* YTC;
    __device__ __forceinline__ void operator()(const f32x4 (&acc)[2][2][4][2], const Unit& u, int wr, int wc, int fr, int fq) const {
        const int cs = u.pm >> 1, k2b = (u.pm & 1) * 256;
        bf16_t* base; size_t pitch;
        if (u.pn < 32) { const int b = u.pn >> 3; base = YT + (size_t)(u.g * 512 + k2b) * 16384 + b * 4096 + cs * 2048 + (u.pn & 7) * 256; pitch = 16384; }
        else { const int b = u.pn - 32; base = YTC + (size_t)(u.g * 512 + k2b) * 2048 + b * 512 + cs * 256; pitch = 2048; }
        const int row0 = wr * 64 + fr, col0 = wc * 32 + 8 * fq;
#pragma unroll
        for (int ai = 0; ai < 2; ++ai)
#pragma unroll
            for (int m = 0; m < 4; ++m) { bf16_t* rowp = base + (size_t)(row0 + ai * HALF + m * 16) * pitch + col0;
#pragma unroll
                for (int bj = 0; bj < 2; ++bj) { const f32x4 v0 = acc[ai][bj][m][0], v1 = acc[ai][bj][m][1];
                    u32x4 w; w.x = cvt_pk_bf16(v0[0], v0[1]); w.y = cvt_pk_bf16(v0[2], v0[3]); w.z = cvt_pk_bf16(v1[0], v1[1]); w.w = cvt_pk_bf16(v1[2], v1[3]);
                    *(u32x4*)(rowp + bj * HALF) = w; } }
    }
};
struct EpiQKV {
    bf16_t* Q; const float* rope;
    __device__ __forceinline__ void operator()(const f32x4 (&acc)[2][2][4][2], const Unit& u, int wr, int wc, int fr, int fq) const {
        const int part = u.pn >> 3;
        bf16_t* dst = Q + (size_t)part * ((WS_K - WS_Q) / 2);
        const int row0 = u.pm * BM + wr * 64 + fr, colp = (u.pn & 7) * BM + wc * 32 + 8 * fq;
        const bool dorope = (part < 2) && (u.pm < 32);
        const float sc = part == 0 ? QSCALE : 1.f;
#pragma unroll
        for (int ai = 0; ai < 2; ++ai)
#pragma unroll
            for (int m = 0; m < 4; ++m) { const int row = row0 + ai * HALF + m * 16; bf16_t* rowp = dst + (size_t)row * D + colp;
                const int t = row & 2047, prow = t >> 6, pcol = t & 63;
#pragma unroll
                for (int bj = 0; bj < 2; ++bj) { f32x4 v0 = acc[ai][bj][m][0], v1 = acc[ai][bj][m][1];
                    if (dorope) { const int c = colp + bj * HALF, j0 = (c & 63) >> 1, ax = j0 >> 4, f0 = j0 & 15;
                        const float* cs = rope + ((ax ? pcol : prow) * 16 + f0) * 2;
                        const f32x4 cs0 = *(const f32x4*)cs, cs1 = *(const f32x4*)(cs + 4);
                        f32x4 r0, r1;
                        r0[0] = v0[0] * cs0[0] - v0[1] * cs0[1]; r0[1] = v0[0] * cs0[1] + v0[1] * cs0[0];
                        r0[2] = v0[2] * cs0[2] - v0[3] * cs0[3]; r0[3] = v0[2] * cs0[3] + v0[3] * cs0[2];
                        r1[0] = v1[0] * cs1[0] - v1[1] * cs1[1]; r1[1] = v1[0] * cs1[1] + v1[1] * cs1[0];
                        r1[2] = v1[2] * cs1[2] - v1[3] * cs1[3]; r1[3] = v1[2] * cs1[3] + v1[3] * cs1[2];
                        v0 = r0; v1 = r1; }
                    v0 = v0 * sc; v1 = v1 * sc;
                    u32x4 w; w.x = cvt_pk_bf16(v0[0], v0[1]); w.y = cvt_pk_bf16(v0[2], v0[3]); w.z = cvt_pk_bf16(v1[0], v1[1]); w.w = cvt_pk_bf16(v1[2], v1[3]);
                    *(u32x4*)(rowp + bj * HALF) = w; } }
    }
};
}


namespace att {
__device__ __forceinline__ unsigned off_a(unsigned row, unsigned ch) { return 2048u * (row >> 3) + 512u * (ch >> 2) + 64u * (row & 7) + 16u * ((ch & 3) ^ ((row >> 2) & 3)); }
constexpr int KBUF = 0, VBUF = 32768, QOFF = 65536, WSF_OFF = LDSCTL_OFF + 1024;
constexpr float THR = 6.0f;
struct Args { const bf16_t* Q; const bf16_t* K; const bf16_t* V; bf16_t* O; const float* gsub; float lam, post; };
__device__ __forceinline__ s16x4 vtr(const LAS unsigned char* p) { return __builtin_bit_cast(s16x4, __builtin_amdgcn_ds_read_tr16_b64_v4i16((LAS s16x4*)p)); }
__device__ __forceinline__ float half_max(float v) { auto rr = __builtin_amdgcn_permlane32_swap(__float_as_uint(v), __float_as_uint(v), false, false); return fmaxf(__uint_as_float(rr[0]), __uint_as_float(rr[1])); }
__device__ __forceinline__ float half_sum(float v) { auto rr = __builtin_amdgcn_permlane32_swap(__float_as_uint(v), __float_as_uint(v), false, false); return __uint_as_float(rr[0]) + __uint_as_float(rr[1]); }

__device__ __forceinline__ void glds16(const void* gsrc, unsigned lds_dst) { unsigned keep;
    asm volatile("s_mov_b32 %0, m0\n\ts_mov_b32 m0, %2\n\ts_nop 0\n\tglobal_load_lds_dwordx4 %1, off\n\ts_mov_b32 m0, %0" : "=&s"(keep) : "v"(gsrc), "s"(lds_dst) : "memory"); }
__device__ __forceinline__ float max3f(float a, float b, float c) { float r; asm("v_max3_f32 %0, %1, %2, %3" : "=v"(r) : "v"(a), "v"(b), "v"(c)); return r; }
__device__ __forceinline__ float max2f(float a, float b) { float r; asm("v_max_f32_e32 %0, %1, %2" : "=v"(r) : "v"(a), "v"(b)); return r; }
__device__ __forceinline__ float fsub_s(float a, float b) { float r; asm("v_sub_f32_e32 %0, %1, %2" : "=v"(r) : "v"(a), "v"(b)); return r; }
__device__ __forceinline__ float fadd_s(float a, float b) { float r; asm("v_add_f32_e32 %0, %1, %2" : "=v"(r) : "v"(a), "v"(b)); return r; }
typedef __bf16 bf16x2_t __attribute__((ext_vector_type(2)));
__device__ __forceinline__ unsigned cvtpk_b(float lo, float hi) { const f32x2 v = {lo, hi}; const bf16x2_t b = __builtin_convertvector(v, bf16x2_t); return __builtin_bit_cast(unsigned, b); }
template <bool SAFE>
__device__ __forceinline__ bool unit(LAS unsigned char* lds, const Args& P, int b, int h, int q0, int nlat, int tid) {
    const int lane = tid & 63, r32 = lane & 31, hi = lane >> 5; const int wid = __builtin_amdgcn_readfirstlane(tid >> 6);
    const int nt = nlat + 4;
    LAS unsigned char* Qs = lds + QOFF + wid * 8192;
    LAS float* wsf = (LAS float*)(lds + WSF_OFF + wid * 256);
    {   const bf16_t* qrow = P.Q + (size_t)(q0 + wid * 32 + r32) * D + h * 128 + hi * 8;
#pragma unroll
        for (int c = 0; c < 2; ++c)
#pragma unroll
            for (int d0 = 0; d0 < 4; ++d0) { const u32x4 v = *(const u32x4*)(qrow + c * 64 + d0 * 16); *(LAS u32x4*)(Qs + ((c * 4 + d0) * 2 + hi) * 512 + r32 * 16) = v; } }
    unsigned goff[2];
#pragma unroll
    for (int i = 0; i < 2; ++i) { const unsigned p = 2 * wid + i, rg = p >> 1, chq = (p & 1) * 2 + (lane >> 5), r7 = (lane >> 2) & 7, x = lane & 3, rsw = (r7 >> 2) | ((rg & 1) << 1);
        goff[i] = ((8 * rg + r7) * D + h * 128 + (4 * chq + (x ^ rsw)) * 8) * 2; }
#define ATT_GROW(t) ((t) < nlat ? b * SEQ + 64 * (t) : ML + b * CL + 64 * ((t) - nlat))
#define ATT_DMA(t, buf) do { const size_t g_ = (size_t)ATT_GROW(t) * D * 2; _Pragma("unroll") for (int i_ = 0; i_ < 2; ++i_) { \
        glds16((const char*)P.K + g_ + goff[i_], (unsigned)__builtin_amdgcn_readfirstlane(lds0 + KBUF + (buf) * 16384 + (2 * wid + i_) * 1024)); \
        glds16((const char*)P.V + g_ + goff[i_], (unsigned)__builtin_amdgcn_readfirstlane(lds0 + VBUF + (buf) * 16384 + (2 * wid + i_) * 1024)); } } while (0)
    const unsigned lds0 = (unsigned)(uintptr_t)lds;
    ATT_DMA(0, 0);
    unsigned kb[2];
#pragma unroll
    for (int e = 0; e < 2; ++e) kb[e] = 2048u * (r32 >> 3) + 64u * (r32 & 7) + 16u * ((unsigned)(2 * e + hi) ^ ((r32 >> 2) & 3));
    const unsigned blk = (lane >> 4) & 1, q_ = (lane & 15) >> 2, p_ = lane & 3;
    unsigned vb[2];
#pragma unroll
    for (int t = 0; t < 2; ++t) vb[t] = 2048u * t + 64u * (4 * hi + q_) + 16u * ((2 * blk + (p_ >> 1)) ^ ((2 * t + hi) & 3)) + 8u * (p_ & 1);
    float m0 = -1e30f, m1 = -1e30f, l0 = 0.f, l1 = 0.f;
    f32x16 o[2][4];
#pragma unroll
    for (int c = 0; c < 2; ++c)
#pragma unroll
        for (int d = 0; d < 4; ++d) o[c][d] = f32x16{};
    asm volatile("s_waitcnt vmcnt(0)" ::: "memory");
    __syncthreads();
#define SB() __builtin_amdgcn_sched_barrier(0)
#define ATT_SMB(S0, S1, i, M, SUM, PW) do { const float a_ = (i) < 8 ? S0[2 * ((i) & 7)] : S1[2 * ((i) & 7)], b_ = (i) < 8 ? S0[2 * ((i) & 7) + 1] : S1[2 * ((i) & 7) + 1]; \
        const float ea_ = SAFE ? __builtin_amdgcn_exp2f(fsub_s(a_, M)) : __builtin_amdgcn_exp2f(a_), eb_ = SAFE ? __builtin_amdgcn_exp2f(fsub_s(b_, M)) : __builtin_amdgcn_exp2f(b_); \
        SUM += ea_; SUM += eb_; PW[i] = cvtpk_b(ea_, eb_); asm volatile("" : "+v"(SUM), "+v"(PW[i])); } while (0)
#define ATT_SMA(S0, S1, c, MC, LC) do { asm volatile("s_nop 15\n\ts_nop 7" : "+v"(S0), "+v"(S1)); \
        float a_ = max3f(S0[0], S0[1], S1[0]), b_ = max3f(S0[2], S0[3], S1[1]); a_ = max3f(a_, S1[2], S1[3]); \
        _Pragma("unroll") for (int r_ = 4; r_ < 16; r_ += 4) { a_ = max3f(a_, S0[r_], S0[r_ + 1]); b_ = max3f(b_, S0[r_ + 2], S0[r_ + 3]); a_ = max3f(a_, S1[r_], S1[r_ + 1]); b_ = max3f(b_, S1[r_ + 2], S1[r_ + 3]); } \
        const float mx_ = half_max(max2f(a_, b_)); \
        if (__any(mx_ - MC > THR)) { const float mn_ = fmaxf(MC, mx_), al_ = __builtin_amdgcn_exp2f(MC - mn_); MC = mn_; LC *= al_; if (hi == 0) wsf[r32] = al_; \
            _Pragma("unroll") for (int g4 = 0; g4 < 4; ++g4) { const f32x4 a4 = *(const LAS f32x4*)(wsf + 8 * g4 + 4 * hi); \
                _Pragma("unroll") for (int d = 0; d < 4; ++d) { o[c][d][4 * g4 + 0] *= a4[0]; o[c][d][4 * g4 + 1] *= a4[1]; o[c][d][4 * g4 + 2] *= a4[2]; o[c][d][4 * g4 + 3] *= a4[3]; } } } } while (0)
#define ATT_LDQK(c, d0, QF, K0, K1) do { QF = *(const LAS bf16x8*)(Qs + (((c) * 4 + (d0)) * 2 + hi) * 512 + r32 * 16); \
        K0 = *(const LAS bf16x8*)(Kb + kb[(d0) & 1] + 512 * (2 * (c) + ((d0) >> 1))); K1 = *(const LAS bf16x8*)(Kb + kb[(d0) & 1] + 512 * (2 * (c) + ((d0) >> 1)) + 8192); } while (0)
#define ATT_LDV(i, LO, HH) do { LO = vtr(Vb + vb[0] + 4096 * ((i) >> 2) + 512 * ((i) & 3)); HH = vtr(Vb + vb[1] + 4096 * ((i) >> 2) + 512 * ((i) & 3)); } while (0)
#define ATT_VF(LO, HH) ((bf16x8){LO[0], LO[1], LO[2], LO[3], HH[0], HH[1], HH[2], HH[3]})
#define ATT_PA(PW, ks) ((bf16x8)__builtin_bit_cast(bf16x8, (u32x4){PW[4 * (ks)], PW[4 * (ks) + 1], PW[4 * (ks) + 2], PW[4 * (ks) + 3]}))
#pragma unroll 1
    for (int t = 0; t < nt; ++t) {
        const int buf = t & 1;
        if (t + 1 < nt) ATT_DMA(t + 1, buf ^ 1);
        const LAS unsigned char* Kb = lds + KBUF + buf * 16384; const LAS unsigned char* Vb = lds + VBUF + buf * 16384;
        unsigned pw0[16], pw1[16];
        f32x16 sa = f32x16{}, sb = f32x16{};
        SB();
        {   bf16x8 qfA, k0A, k1A, qfB, k0B, k1B;
            ATT_LDQK(0, 0, qfA, k0A, k1A); ATT_LDQK(0, 1, qfB, k0B, k1B); SB();
            sa = __builtin_amdgcn_mfma_f32_32x32x16_bf16(k0A, qfA, sa, 0, 0, 0); sb = __builtin_amdgcn_mfma_f32_32x32x16_bf16(k1A, qfA, sb, 0, 0, 0); SB();
            ATT_LDQK(0, 2, qfA, k0A, k1A); SB();
            sa = __builtin_amdgcn_mfma_f32_32x32x16_bf16(k0B, qfB, sa, 0, 0, 0); sb = __builtin_amdgcn_mfma_f32_32x32x16_bf16(k1B, qfB, sb, 0, 0, 0); SB();
            ATT_LDQK(0, 3, qfB, k0B, k1B); SB();
            sa = __builtin_amdgcn_mfma_f32_32x32x16_bf16(k0A, qfA, sa, 0, 0, 0); sb = __builtin_amdgcn_mfma_f32_32x32x16_bf16(k1A, qfA, sb, 0, 0, 0); SB();
            sa = __builtin_amdgcn_mfma_f32_32x32x16_bf16(k0B, qfB, sa, 0, 0, 0); sb = __builtin_amdgcn_mfma_f32_32x32x16_bf16(k1B, qfB, sb, 0, 0, 0); }
        SB();
        if constexpr (SAFE) ATT_SMA(sa, sb, 0, m0, l0);
        SB();
        f32x16 ta = f32x16{}, tb = f32x16{};
        {   bf16x8 qf, k0, k1; float sum = 0.f;
            ATT_LDQK(1, 0, qf, k0, k1); SB();
#define ATT_C(d0) do { ta = __builtin_amdgcn_mfma_f32_32x32x16_bf16(k0, qf, ta, 0, 0, 0); SB(); \
            if ((d0) < 3) k0 = *(const LAS bf16x8*)(Kb + kb[((d0) + 1) & 1] + 512 * (2 + (((d0) + 1) >> 1))); \
            ATT_SMB(sa, sb, 4 * (d0) + 0, m0, sum, pw0); ATT_SMB(sa, sb, 4 * (d0) + 1, m0, sum, pw0); SB(); \
            tb = __builtin_amdgcn_mfma_f32_32x32x16_bf16(k1, qf, tb, 0, 0, 0); SB(); \
            if ((d0) < 3) { qf = *(const LAS bf16x8*)(Qs + ((4 + (d0) + 1) * 2 + hi) * 512 + r32 * 16); k1 = *(const LAS bf16x8*)(Kb + kb[((d0) + 1) & 1] + 512 * (2 + (((d0) + 1) >> 1)) + 8192); } \
            ATT_SMB(sa, sb, 4 * (d0) + 2, m0, sum, pw0); ATT_SMB(sa, sb, 4 * (d0) + 3, m0, sum, pw0); SB(); } while (0)
            ATT_C(0); ATT_C(1); ATT_C(2); ATT_C(3);
#undef ATT_C
            l0 += sum; }
        if constexpr (SAFE) ATT_SMA(ta, tb, 1, m1, l1);
        SB();
        {   s16x4 loA, hhA, loB, hhB, loC, hhC; float sum = 0.f;
            ATT_LDV(0, loA, hhA); ATT_LDV(1, loB, hhB); SB();
#define ATT_E(i, LOc, HHc, LOn, HHn) do { if ((i) + 2 < 16) ATT_LDV((i) + 2, LOn, HHn); SB(); \
            o[0][(i) & 3] = __builtin_amdgcn_mfma_f32_32x32x16_bf16(ATT_PA(pw0, (i) >> 2), ATT_VF(LOc, HHc), o[0][(i) & 3], 0, 0, 0); SB(); ATT_SMB(ta, tb, i, m1, sum, pw1); SB(); } while (0)
            ATT_E(0, loA, hhA, loC, hhC); ATT_E(1, loB, hhB, loA, hhA); ATT_E(2, loC, hhC, loB, hhB);
            ATT_E(3, loA, hhA, loC, hhC); ATT_E(4, loB, hhB, loA, hhA); ATT_E(5, loC, hhC, loB, hhB);
            ATT_E(6, loA, hhA, loC, hhC); ATT_E(7, loB, hhB, loA, hhA); ATT_E(8, loC, hhC, loB, hhB);
            ATT_E(9, loA, hhA, loC, hhC); ATT_E(10, loB, hhB, loA, hhA); ATT_E(11, loC, hhC, loB, hhB);
            ATT_E(12, loA, hhA, loC, hhC); ATT_E(13, loB, hhB, loA, hhA); ATT_E(14, loC, hhC, loB, hhB);
            ATT_E(15, loA, hhA, loC, hhC);
#undef ATT_E
            l1 += sum; }
#pragma unroll
        for (int ks = 0; ks < 4; ++ks) {
            s16x4 lo[4], hh[4];
#pragma unroll
            for (int d = 0; d < 4; ++d) ATT_LDV(4 * ks + d, lo[d], hh[d]);
#pragma unroll
            for (int d = 0; d < 4; ++d) o[1][d] = __builtin_amdgcn_mfma_f32_32x32x16_bf16(ATT_PA(pw1, ks), ATT_VF(lo[d], hh[d]), o[1][d], 0, 0, 0);
            SB();
        }
        asm volatile("s_waitcnt vmcnt(0)" ::: "memory");
        __syncthreads();
    }
#undef ATT_SMB
#undef ATT_SMA
#undef ATT_LDQK
#undef ATT_LDV
#undef ATT_VF
#undef ATT_PA
#undef SB
#undef ATT_GROW
#undef ATT_DMA
    l0 = half_sum(l0); l1 = half_sum(l1);
    const bool ok = SAFE || !__any(!(l0 > 7.9e-31f && l0 < 1.26e30f && l1 > 7.9e-31f && l1 < 1.26e30f));
    if (hi == 0) { wsf[r32] = 1.0f / l0; wsf[32 + r32] = P.lam / l1; }
    float ss[16];
#pragma unroll
    for (int r = 0; r < 16; ++r) ss[r] = 0.f;
#pragma unroll
    for (int g4 = 0; g4 < 4; ++g4) { const f32x4 a4 = *(const LAS f32x4*)(wsf + 8 * g4 + 4 * hi), b4 = *(const LAS f32x4*)(wsf + 32 + 8 * g4 + 4 * hi);
#pragma unroll
        for (int d = 0; d < 4; ++d)
#pragma unroll
            for (int e = 0; e < 4; ++e) { const float v = o[0][d][4 * g4 + e] * a4[e] - o[1][d][4 * g4 + e] * b4[e]; o[0][d][4 * g4 + e] = v; ss[4 * g4 + e] += v * v; } }
#pragma unroll
    for (int r = 0; r < 16; ++r) {
        float v = ss[r];
#pragma unroll
        for (int s = 1; s < 32; s <<= 1) v += __shfl_xor(v, s);
        ss[r] = (1.0f / sqrtf(v * (1.0f / 128.0f) + SUBLN_EPS)) * P.post;
    }
    bf16_t* Ow = P.O + (size_t)(q0 + wid * 32) * D + h * 128 + r32;
#pragma unroll
    for (int d = 0; d < 4; ++d) { const float gs = P.gsub[32 * d + r32];
#pragma unroll
        for (int r = 0; r < 16; ++r) { const int row = (r & 3) + 8 * (r >> 2) + 4 * hi; const float v = o[0][d][r] * ss[r] * gs;
            Ow[(size_t)row * D + 32 * d] = (bf16_t)(cvt_pk_bf16(v, 0.f) & 0xffffu); } }
    __syncthreads();
    return ok;
}
__device__ __forceinline__ void unit_checked(LAS unsigned char* lds, const Args& P, int b, int h, int q0, int nlat, int tid) {
    volatile LAS unsigned* flag = (volatile LAS unsigned*)(lds + MISC_OFF) + 16;
    const bool ok = unit<false>(lds, P, b, h, q0, nlat, tid);
    if (!ok && (tid & 63) == 0) *flag = 1u;
    __syncthreads();
    const unsigned f = *flag;
    __syncthreads();
    if (f) { if (tid == 0) *flag = 0u; (void)unit<true>(lds, P, b, h, q0, nlat, tid); }
}
}

struct ThinArgs {
    const float* xin_lat; const float* xin_ctx;
    const bf16_t* y;
    float* xout_lat; float* xout_ctx;
    const float* g_post; const float* gate;
    bf16_t* uout;
    const float* g_pre; const float* sc; const float* sh;
    const float* yc; int nslab;
    int nrows;
};
__device__ __forceinline__ void thin_phase(const ThinArgs& T, LAS unsigned char* lds, int bx, int G, int tid, int wave, int lane) {
    LAS float* ta = (LAS float*)lds; LAS float* tg = ta + D; LAS float* ts = tg + D;
    const int ngroups = T.nrows > ML ? 5 : 4;
    f32x4 xvb[2][8]; u32x2 yrb[2][8];
#define THIN_LOAD(gq, lr, XV, YR) do { const int row_ = ((gq) < 4 ? (gq) * SEQ : ML) + (lr); const float* xr_ = (gq) < 4 ? T.xin_lat + (size_t)row_ * D : T.xin_ctx + (size_t)(row_ - ML) * D; \
        _Pragma("unroll") for (int j = 0; j < 8; ++j) XV[j] = *(const f32x4*)(xr_ + 256 * j + 4 * lane); \
        if (T.y && !((gq) == 4 && T.nslab > 0)) { const bf16_t* yr_ = T.y + (size_t)row_ * D; _Pragma("unroll") for (int j = 0; j < 8; ++j) YR[j] = *(const u32x2*)(yr_ + 256 * j + 4 * lane); } } while (0)
    const int lrow0 = wave + 8 * bx;
    if (lrow0 < SEQ) THIN_LOAD(0, lrow0, xvb[0], yrb[0]);
#pragma unroll
    for (int gb = 0; gb < 5; ++gb) if (gb < ngroups) {
        f32x4 (&xv)[8] = xvb[gb & 1]; u32x2 (&yraw)[8] = yrb[gb & 1];
        const int gsize = gb < 4 ? SEQ : MC, gbase = gb < 4 ? gb * SEQ : ML;
        const bool slabs = (gb == 4) && T.nslab > 0;
        if (gb + 1 < ngroups && lrow0 < (gb + 1 < 4 ? SEQ : MC)) THIN_LOAD(gb + 1, lrow0, xvb[(gb + 1) & 1], yrb[(gb + 1) & 1]);
        {   const int c4 = 4 * tid;
            if (T.y) { const f32x4 g = *(const f32x4*)(T.g_post + c4), a = *(const f32x4*)(T.gate + (size_t)gb * MODROW + c4); *(LAS f32x4*)(ta + c4) = a * g; }
            if (T.uout) { const f32x4 g = *(const f32x4*)(T.g_pre + c4), s = *(const f32x4*)(T.sc + (size_t)gb * MODROW + c4), h = *(const f32x4*)(T.sh + (size_t)gb * MODROW + c4);
                *(LAS f32x4*)(tg + c4) = g * (s + 1.0f); *(LAS f32x4*)(ts + c4) = h; } }
        __syncthreads();
#pragma unroll 1
        for (int lrow = lrow0; lrow < gsize; lrow += 8 * G) {
            const int row = gbase + lrow;
            if (lrow != lrow0) THIN_LOAD(gb, lrow, xv, yraw);
            if (T.y) {
                f32x4 yv[8]; float s = 0.f;
                if (slabs) {
                    const float* yr = T.yc + (size_t)(row - ML) * D;
#pragma unroll
                    for (int j = 0; j < 8; ++j) yv[j] = *(const f32x4*)(yr + 256 * j + 4 * lane);
#pragma unroll 1
                    for (int sl = 1; sl < T.nslab; ++sl) { yr += (size_t)MC * D;
#pragma unroll
                        for (int j = 0; j < 8; ++j) yv[j] = yv[j] + *(const f32x4*)(yr + 256 * j + 4 * lane); }
                } else {
#pragma unroll
                    for (int j = 0; j < 8; ++j) { const u32x2 v = yraw[j];
                        yv[j][0] = __uint_as_float(v.x << 16); yv[j][1] = __uint_as_float(v.x & 0xffff0000u); yv[j][2] = __uint_as_float(v.y << 16); yv[j][3] = __uint_as_float(v.y & 0xffff0000u); }
                }
#pragma unroll
                for (int j = 0; j < 8; ++j) s += (yv[j][0] * yv[j][0] + yv[j][1] * yv[j][1]) + (yv[j][2] * yv[j][2] + yv[j][3] * yv[j][3]);
                const float rs = 1.0f / sqrtf(wave_sum(s) * (1.0f / D) + NORM_EPS);
#pragma unroll
                for (int j = 0; j < 8; ++j) { const f32x4 a = *(const LAS f32x4*)(ta + 256 * j + 4 * lane); xv[j] = xv[j] + a * (yv[j] * rs); }
                float* xo = gb < 4 ? (T.xout_lat ? T.xout_lat + (size_t)row * D : nullptr) : (T.xout_ctx ? T.xout_ctx + (size_t)(row - ML) * D : nullptr);
                if (xo) {
#pragma unroll
                    for (int j = 0; j < 8; ++j) *(f32x4*)(xo + 256 * j + 4 * lane) = xv[j]; }
            }
            if (T.uout) {
                float s = 0.f;
#pragma unroll
                for (int j = 0; j < 8; ++j) s += (xv[j][0] * xv[j][0] + xv[j][1] * xv[j][1]) + (xv[j][2] * xv[j][2] + xv[j][3] * xv[j][3]);
                const float rs = 1.0f / sqrtf(wave_sum(s) * (1.0f / D) + NORM_EPS);
                bf16_t* uo = T.uout + (size_t)row * D;
#pragma unroll
                for (int j = 0; j < 8; ++j) { const f32x4 g = *(const LAS f32x4*)(tg + 256 * j + 4 * lane), c = *(const LAS f32x4*)(ts + 256 * j + 4 * lane);
                    const f32x4 u = (xv[j] * rs) * g + c;
                    u32x2 w; w.x = cvt_pk_bf16(u[0], u[1]); w.y = cvt_pk_bf16(u[2], u[3]); *(u32x2*)(uo + 256 * j + 4 * lane) = w; }
            }
        }
        __syncthreads();
    }
#undef THIN_LOAD
}
__device__ __forceinline__ void pool_phase(const bf16_t* U, bf16_t* Dm, int nrows, int gw, int ngw, int lane) {
    for (int row = gw; row < nrows; row += ngw) {
        int base, t, Ls;
        if (row < ML) { base = row & ~2047; t = row & 2047; Ls = SEQ; } else { const int i = row - ML; base = ML + (i & ~255); t = i & 255; Ls = CL; }
#pragma unroll
        for (int j = 0; j < 8; ++j) {
            const int w = 2 << (j >> 1); int lo = t - (w >> 1), hi = lo + w; lo = lo < 0 ? 0 : lo; hi = hi > Ls ? Ls : hi;
            const bf16_t* p = U + (size_t)base * D + 256 * j + 4 * lane;
            f32x4 s = {0.f, 0.f, 0.f, 0.f};
            for (int tt = lo; tt < hi; ++tt) { const u32x2 v = *(const u32x2*)(p + (size_t)tt * D);
                s[0] += __uint_as_float(v.x << 16); s[1] += __uint_as_float(v.x & 0xffff0000u); s[2] += __uint_as_float(v.y << 16); s[3] += __uint_as_float(v.y & 0xffff0000u); }
            const u32x2 cv = *(const u32x2*)(p + (size_t)t * D);
            const float inv = 1.0f / (float)(hi - lo);
            f32x4 d; d[0] = s[0] * inv - __uint_as_float(cv.x << 16); d[1] = s[1] * inv - __uint_as_float(cv.x & 0xffff0000u); d[2] = s[2] * inv - __uint_as_float(cv.y << 16); d[3] = s[3] * inv - __uint_as_float(cv.y & 0xffff0000u);
            u32x2 o; o.x = cvt_pk_bf16(d[0], d[1]); o.y = cvt_pk_bf16(d[2], d[3]);
            *(u32x2*)(Dm + (size_t)row * D + 256 * j + 4 * lane) = o;
        }
    }
}

struct TrDesc { const float* src; bf16_t* dst; int N, K; int perm; };
__device__ __forceinline__ void tr_load(const TrDesc& d, f32x4 (&v)[16], int lane) {
    const int kq = lane >> 4, n4 = lane & 15;
#pragma unroll
    for (int i = 0; i < 16; ++i) v[i] = __builtin_nontemporal_load((const f32x4*)(d.src + (size_t)(4 * i + kq) * d.N + 4 * n4));
}
__device__ __forceinline__ void tr_store(const TrDesc& d, const f32x4 (&v)[16], LAS float* scr, int lane) {
    const int kq = lane >> 4, n4 = lane & 15;
#pragma unroll
    for (int i = 0; i < 16; ++i) { LAS float* s = scr + (4 * i + kq) * 65 + 4 * n4; s[0] = v[i][0]; s[1] = v[i][1]; s[2] = v[i][2]; s[3] = v[i][3]; }
    asm volatile("s_waitcnt lgkmcnt(0)" ::: "memory");
    const int c = lane & 7;
#pragma unroll
    for (int j = 0; j < 8; ++j) { const int n = (lane >> 3) + 8 * j; int sc = n;
        if (d.perm) { const int jj = n >> 1, which = n & 1, ax = jj >> 4, f = jj & 15; sc = ax * 32 + which * 16 + f; }
        const LAS float* s = scr + (8 * c) * 65 + sc;
        u32x4 o; o.x = cvt_pk_bf16(s[0 * 65], s[1 * 65]); o.y = cvt_pk_bf16(s[2 * 65], s[3 * 65]); o.z = cvt_pk_bf16(s[4 * 65], s[5 * 65]); o.w = cvt_pk_bf16(s[6 * 65], s[7 * 65]);
        *(u32x4*)(d.dst + (size_t)n * d.K + 8 * c) = o; }
    asm volatile("s_waitcnt lgkmcnt(0)" ::: "memory");
}

struct Params {
    const float* in[22];
    float* out; unsigned char* ws;
    float lam_init0, lam_init3;
    int ph_lo, ph_hi;
};

template <int PART>
__device__ __forceinline__ void prologue(const Params& P, LAS unsigned char* lds, int tid, int wave, int lane, int vcu, int G) {
    unsigned char* ws = P.ws;
    const float* c_in = P.in[1]; const float* cctx = P.in[3]; const float* w_mod = P.in[4]; const float* b_mod = P.in[5];
    LAS float* sil = (LAS float*)lds;
    LAS float* red = (LAS float*)(lds + 65536);
    for (int i = tid; i < 5 * D; i += NTHR) { const int r = i / D, k = i % D; const float x = r < 4 ? c_in[r * D + k] : cctx[k]; sil[k * 8 + r] = x / (1.0f + __expf(-x)); }
    __syncthreads();
    float* mod = (float*)(ws + WS_MOD);
    for (int item = (PART == 1 ? 192 : 0) + blockIdx.x; item < (PART == 0 ? 192 : 4 * 192); item += G) {
        const int l = item / 192, col = (item % 192) * 64 + lane;
        const float* W = w_mod + (size_t)l * D * MODROW + col;
        float a0 = 0.f, a1 = 0.f, a2 = 0.f, a3 = 0.f, a4 = 0.f;
        const int k0 = wave * 256;
        for (int kk = 0; kk < 256; kk += 32) {
            float w[32];
#pragma unroll
            for (int j = 0; j < 32; ++j) w[j] = __builtin_nontemporal_load(W + (size_t)(k0 + kk + j) * MODROW);
#pragma unroll
            for (int j = 0; j < 32; ++j) { const f32x4 s4 = *(const LAS f32x4*)(sil + (k0 + kk + j) * 8); const float s5 = sil[(k0 + kk + j) * 8 + 4];
                a0 += s4[0] * w[j]; a1 += s4[1] * w[j]; a2 += s4[2] * w[j]; a3 += s4[3] * w[j]; a4 += s5 * w[j]; }
        }
        red[(wave * 5 + 0) * 64 + lane] = a0; red[(wave * 5 + 1) * 64 + lane] = a1; red[(wave * 5 + 2) * 64 + lane] = a2; red[(wave * 5 + 3) * 64 + lane] = a3; red[(wave * 5 + 4) * 64 + lane] = a4;
        __syncthreads();
        if (wave < 5) { float s = b_mod[l * MODROW + col];
#pragma unroll
            for (int w8 = 0; w8 < 8; ++w8) s += red[(w8 * 5 + wave) * 64 + lane];
            mod[((size_t)l * 5 + wave) * MODROW + col] = s; }
        __syncthreads();
    }
    LAS float* scr = (LAS float*)(lds + wave * 16640);
    const int gw = vcu * NWAVES + wave, NGW = G * NWAVES;
    bf16_t* Wqkv = (bf16_t*)(ws + WS_WQKV); bf16_t* Wo = (bf16_t*)(ws + WS_WO); bf16_t* Wf = (bf16_t*)(ws + WS_WF); bf16_t* Wp = (bf16_t*)(ws + WS_WPOOL);
    bf16_t* W1 = (bf16_t*)(ws + WS_W1); bf16_t* W2 = (bf16_t*)(ws + WS_W2);
    constexpr int I_QKV = (D / 64) * (3 * D / 64), I_O = (D / 64) * (D / 64), I_P = 8 * 8, I_1 = (D / 64) * (FF / 64), I_2 = (FF / 64) * (D / 64);
    constexpr int NITEMS = 2 * I_QKV + 2 * I_O + I_O + 4 * I_P + 4 * I_1 + 4 * I_2;
    auto decode = [&](int it) -> TrDesc {
        int r = it; const float* W; bf16_t* WT; int K, N, perm = 0;
        if (r < 2 * I_QKV) { const int ia = r / I_QKV; r %= I_QKV; W = P.in[10] + (size_t)ia * D * 3 * D; WT = Wqkv + (size_t)ia * 3 * D * D; K = D; N = 3 * D; perm = (r % (3 * D / 64)) < 2 * D / 64; }
        else if ((r -= 2 * I_QKV) < 2 * I_O) { const int ia = r / I_O; r %= I_O; W = P.in[11] + (size_t)ia * D * D; WT = Wo + (size_t)ia * D * D; K = D; N = D; }
        else if ((r -= 2 * I_O) < I_O) { W = P.in[17]; WT = Wf; K = D; N = D; }
        else if ((r -= I_O) < 4 * I_P) { const int g = r / I_P; r %= I_P; W = P.in[18] + (size_t)g * 512 * 512; WT = Wp + (size_t)g * 512 * 512; K = 512; N = 512; }
        else if ((r -= 4 * I_P) < 4 * I_1) { const int l = r / I_1; r %= I_1; W = P.in[20] + (size_t)l * D * FF; WT = W1 + (size_t)l * FF * D; K = D; N = FF; }
        else { r -= 4 * I_1; const int l = r / I_2; r %= I_2; W = P.in[21] + (size_t)l * FF * D; WT = W2 + (size_t)l * D * FF; K = FF; N = D; }
        const int nblk = N / 64, k0 = 64 * (r / nblk), n0 = 64 * (r % nblk);
        TrDesc d; d.src = W + (size_t)k0 * N + n0; d.dst = WT + (size_t)n0 * K + k0; d.N = N; d.K = K; d.perm = perm; return d; };
    {   const int it_end = (PART == 0 ? I_QKV : NITEMS); int it = (PART == 1 ? I_QKV : 0) + gw;
        f32x4 va[16], vb[16]; TrDesc da, db;
        if (it < it_end) { da = decode(it); tr_load(da, va, lane); }
        while (it < it_end) {
            const bool hb = it + NGW < it_end; if (hb) { db = decode(it + NGW); tr_load(db, vb, lane); }
            tr_store(da, va, scr, lane);
            if (!hb) break;
            const bool ha = it + 2 * NGW < it_end; if (ha) { da = decode(it + 2 * NGW); tr_load(da, va, lane); }
            tr_store(db, vb, scr, lane);
            if (!ha) break;
            it += 2 * NGW;
        } }
    if constexpr (PART != 1) {
        const int gt = gw * 64 + lane, NGT = NGW * 64; float* rope = (float*)(ws + WS_ROPE);
        for (int i = gt; i < 64 * 16; i += NGT) { const int pos = i >> 4, f = i & 15; const float inv = 1.0f / powf(10000.0f, (float)f * (1.0f / 16.0f)); const float ang = (float)pos * inv;
            rope[2 * i] = cosf(ang); rope[2 * i + 1] = sinf(ang); }
    }
    if constexpr (PART != 0) {   bf16_t* T1 = (bf16_t*)(ws + WS_T1); bf16_t* A2 = (bf16_t*)(ws + WS_A2); bf16_t* A2C = (bf16_t*)(ws + WS_A2C);
        constexpr int C_T1 = 1024 * 512 / 8, C_A2 = 2048 * 4096 / 8, C_A2C = 256 * 512 / 8;
        const int gt = gw * 64 + lane, NGT = NGW * 64;
        for (int ch = gt; ch < C_T1 + C_A2 + C_A2C; ch += NGT) {
            int r = ch; bf16_t* dst; int row, col0, N, ncol; float scale; bool negsin;
            if (r < C_T1) { row = r / 64; col0 = (r % 64) * 8; dst = T1 + (size_t)row * 512 + col0; N = 512; scale = 0.04419417382415922f; negsin = false;
                const int cs = row >> 9, k2 = row & 511; float vals[8];
#pragma unroll
                for (int e = 0; e < 8; ++e) { const int idx = (k2 * (col0 + e)) & 511; const float a = (float)idx * (1.0f / 256.0f); vals[e] = (cs ? sinpif(a) : cospif(a)) * scale; }
                u32x4 o; o.x = cvt_pk_bf16(vals[0], vals[1]); o.y = cvt_pk_bf16(vals[2], vals[3]); o.z = cvt_pk_bf16(vals[4], vals[5]); o.w = cvt_pk_bf16(vals[6], vals[7]); *(u32x4*)dst = o; continue; }
            r -= C_T1;
            if (r < C_A2) { row = r / 512; col0 = (r % 512) * 8; dst = A2 + (size_t)row * 4096 + col0; N = 2048; scale = 0.022097086912079608f; }
            else { r -= C_A2; row = r / 64; col0 = (r % 64) * 8; dst = A2C + (size_t)row * 512 + col0; N = 256; scale = 0.0625f; }
            (void)ncol; (void)negsin;
            { const int cs = col0 / N, n0 = col0 % N; float vals[8];
#pragma unroll
              for (int e = 0; e < 8; ++e) { const int idx = (row * (n0 + e)) & (N - 1); const float a = (float)idx * (2.0f / (float)N); vals[e] = (cs ? -sinpif(a) : cospif(a)) * scale; }
              u32x4 o; o.x = cvt_pk_bf16(vals[0], vals[1]); o.y = cvt_pk_bf16(vals[2], vals[3]); o.z = cvt_pk_bf16(vals[4], vals[5]); o.w = cvt_pk_bf16(vals[6], vals[7]); *(u32x4*)dst = o; }
        }
    }
}

struct Ctx { LAS unsigned char* lds; int tid, lane, wave, G, bx, vcu, gw, NGW; };
#if MK_MULTI
#define GRID_BAR() do { } while (0)
#else
#define GRID_BAR() xcd_barrier(bar)
#endif
#define PH_BEGIN(k) if ((k) >= P.ph_lo && (k) < P.ph_hi) {
#define PH_END(k)   if ((k) + 1 < P.ph_hi) { GRID_BAR(); for (int rb_ = 1; rb_ < PROBE_BAR; ++rb_) GRID_BAR(); } }
#define WSP(T, off) ((T*)(P.ws + (off)))

template <int L, int PH0>
__device__ __forceinline__ void layer(const Params& P, const Ctx& C, const XcdBarrier& bar) {
    constexpr int kind = L % 3; constexpr bool lastl = (L == 3);
    constexpr int Mact = lastl ? ML : MT;
    constexpr int NMIX = (kind == 2) ? 1 : 2;
    LAS unsigned char* lds = C.lds;
    if constexpr (kind == 0) {
        constexpr int ia = L / 3;
        PH_BEGIN(PH0)
        { pg8::Sched S{}; S.A = (const char*)WSP(bf16_t, WS_U); S.B = (const char*)(WSP(bf16_t, WS_WQKV) + (size_t)ia * 3 * D * D); S.lda = D * 2; S.ldb = D * 2; S.nt = D / 64;
          S.nM = MT / 256; S.nN = 3 * D / 256; S.ngroups = 1; S.a_g = 0; S.b_g = 0; S.G = C.G; S.c = C.bx;
          pg8::EpiQKV E{WSP(bf16_t, WS_Q), WSP(const float, WS_ROPE)};
          _Pragma("unroll") for (int rep_ = 0; rep_ < PROBE_QKV; ++rep_) { int tid_ = C.tid; if (rep_) { __builtin_amdgcn_sched_barrier(0); __syncthreads(); asm volatile("" : "+v"(tid_)); __builtin_amdgcn_sched_barrier(0); } pg8::gemm_phase(lds, S, E, tid_); } }
        PH_END(PH0)
        PH_BEGIN(PH0 + 1)
        { const float* lq1 = P.in[12] + ia * 64; const float* lk1 = P.in[13] + ia * 64; const float* lq2 = P.in[14] + ia * 64; const float* lk2 = P.in[15] + ia * 64;
          const float d1 = wave_sum(lq1[C.lane] * lk1[C.lane]), d2 = wave_sum(lq2[C.lane] * lk2[C.lane]);
          const float li = (L == 0) ? P.lam_init0 : P.lam_init3;
          att::Args A{WSP(bf16_t, WS_Q), WSP(bf16_t, WS_K), WSP(bf16_t, WS_V), WSP(bf16_t, WS_O), P.in[16] + ia * 128, expf(d1) - expf(d2) + li, 1.0f - li};
          _Pragma("unroll 1") for (int rep_ = 0; rep_ < PROBE_ATT; ++rep_) {
          constexpr int nlat_units = NB * NH * (SEQ / 256);
          const int per = (nlat_units + C.G - 1) / C.G;
#pragma unroll 1
          for (int i = 0; i < per; ++i) {
              if constexpr (false) { if (i == (C.vcu & 1)) { int tid_ = C.tid; asm volatile("" : "+v"(tid_));
                  prologue<1>(P, lds, tid_, __builtin_amdgcn_readfirstlane(tid_ >> 6), tid_ & 63, C.vcu, C.G); __syncthreads(); } }
              const int uu = C.vcu * per + i; if (uu < nlat_units) { const int bh = uu >> 3, qb = uu & 7; { int tid_ = C.tid; asm volatile("" : "+v"(tid_)); att::unit_checked(lds, A, bh >> 4, bh & 15, (bh >> 4) * SEQ + qb * 256, SEQ / 64, tid_); } } }
          if constexpr (!lastl) { for (int uc = C.bx; uc < NB * NH; uc += C.G) { const int b = uc >> 4, h = uc & 15; { int tid_ = C.tid; asm volatile("" : "+v"(tid_)); att::unit_checked(lds, A, b, h, ML + b * CL, 0, tid_); } } } } }
        PH_END(PH0 + 1)
    } else if constexpr (kind == 1) {
        PH_BEGIN(PH0)
        { pg8::Sched S{}; S.A = (const char*)WSP(bf16_t, WS_T1); S.B = (const char*)WSP(bf16_t, WS_U); S.lda = 512 * 2; S.ldb = D * 2; S.nt = 8; S.nM = 4; S.nN = Mact / 256; S.ngroups = 4; S.a_g = 0; S.b_g = 512 * 2; S.G = C.G; S.c = C.bx;
          pg8::EpiFA E{WSP(bf16_t, WS_YT), WSP(bf16_t, WS_YTC)};
          _Pragma("unroll") for (int rep_ = 0; rep_ < PROBE_FA; ++rep_) { int tid_ = C.tid; if (rep_) { __builtin_amdgcn_sched_barrier(0); __syncthreads(); asm volatile("" : "+v"(tid_)); __builtin_amdgcn_sched_barrier(0); } pg8::gemm_phase(lds, S, E, tid_); } }
        PH_END(PH0)
        PH_BEGIN(PH0 + 1)
        { pg8::Sched S{}; S.A = (const char*)WSP(bf16_t, WS_A2); S.B = (const char*)WSP(bf16_t, WS_YT); S.lda = 4096 * 2; S.ldb = 16384 * 2; S.nt = 64; S.nM = 8; S.nN = 8; S.ngroups = 4; S.a_g = 0; S.b_g = 4096 * 2; S.G = C.G; S.c = C.bx;
          pg8::EpiBf16<0> E{WSP(bf16_t, WS_O), (unsigned)D, SEQ};
          _Pragma("unroll") for (int rep_ = 0; rep_ < PROBE_FB; ++rep_) { int tid_ = C.tid; if (rep_) { __builtin_amdgcn_sched_barrier(0); __syncthreads(); asm volatile("" : "+v"(tid_)); __builtin_amdgcn_sched_barrier(0); } pg8::gemm_phase(lds, S, E, tid_); }
          if constexpr (!lastl) { pg8::Sched S2{}; S2.A = (const char*)WSP(bf16_t, WS_A2C); S2.B = (const char*)WSP(bf16_t, WS_YTC); S2.lda = 512 * 2; S2.ldb = 2048 * 2; S2.nt = 8; S2.nM = 1; S2.nN = 8; S2.ngroups = 4; S2.a_g = 0; S2.b_g = 512 * 2; S2.G = C.G; S2.c = C.bx;
            pg8::EpiBf16<0> E2{WSP(bf16_t, WS_O) + (size_t)ML * D, (unsigned)D, CL};
            _Pragma("unroll") for (int rep_ = 0; rep_ < PROBE_FB; ++rep_) { int tid_ = C.tid; if (rep_) { __builtin_amdgcn_sched_barrier(0); __syncthreads(); asm volatile("" : "+v"(tid_)); __builtin_amdgcn_sched_barrier(0); } pg8::gemm_phase(lds, S2, E2, tid_); } } }
        PH_END(PH0 + 1)
    } else {
        PH_BEGIN(PH0) for (int rep_ = 0; rep_ < PROBE_THIN; ++rep_) pool_phase(WSP(bf16_t, WS_U), WSP(bf16_t, WS_O), Mact, C.gw, C.NGW, C.lane); PH_END(PH0)
    }
    PH_BEGIN(PH0 + NMIX)
    { pg8::Sched S{}; S.A = (const char*)WSP(bf16_t, WS_O); S.lda = D * 2; S.G = C.G; S.c = C.bx;
      if constexpr (kind == 2) { S.B = (const char*)WSP(bf16_t, WS_WPOOL); S.ldb = 512 * 2; S.nt = 8; S.nM = Mact / 256; S.nN = 2; S.ngroups = 4; S.a_g = 512 * 2; S.b_g = 512 * 512 * 2;
          pg8::EpiY E{WSP(bf16_t, WS_Y), (unsigned)D, P.in[19], 512}; _Pragma("unroll") for (int rep_ = 0; rep_ < PROBE_MIX; ++rep_) { int tid_ = C.tid; if (rep_) { __builtin_amdgcn_sched_barrier(0); __syncthreads(); asm volatile("" : "+v"(tid_)); __builtin_amdgcn_sched_barrier(0); } pg8::gemm_phase(lds, S, E, tid_); } }
      else { S.B = kind == 0 ? (const char*)(WSP(bf16_t, WS_WO) + (size_t)(L / 3) * D * D) : (const char*)WSP(bf16_t, WS_WF); S.ldb = D * 2; S.nt = D / 64; S.nM = ML / 256; S.nN = D / 256; S.ngroups = 1;
          pg8::EpiY E{WSP(bf16_t, WS_Y), (unsigned)D, nullptr, 0}; _Pragma("unroll") for (int rep_ = 0; rep_ < PROBE_MIX; ++rep_) { int tid_ = C.tid; if (rep_) { __builtin_amdgcn_sched_barrier(0); __syncthreads(); asm volatile("" : "+v"(tid_)); __builtin_amdgcn_sched_barrier(0); } pg8::gemm_phase(lds, S, E, tid_); }
          if constexpr (!lastl) { pg8::Sched S2 = S; S2.A = (const char*)(WSP(bf16_t, WS_O) + (size_t)ML * D); S2.nt = D / 64 / NSPLIT; S2.nM = MC / 256; S2.ngroups = NSPLIT; S2.a_g = (D / NSPLIT) * 2; S2.b_g = (D / NSPLIT) * 2;
              pg8::EpiF32 E2{WSP(float, WS_YC), (unsigned)D, nullptr, 0, (size_t)MC * D}; _Pragma("unroll") for (int rep_ = 0; rep_ < PROBE_MIX; ++rep_) { int tid_ = C.tid; if (rep_) { __builtin_amdgcn_sched_barrier(0); __syncthreads(); asm volatile("" : "+v"(tid_)); __builtin_amdgcn_sched_barrier(0); } pg8::gemm_phase(lds, S2, E2, tid_); } } } }
    PH_END(PH0 + NMIX)
    PH_BEGIN(PH0 + NMIX + 1)
    { const float* modl = WSP(const float, WS_MOD) + (size_t)L * 5 * MODROW; float* X = WSP(float, WS_X);
      ThinArgs T{}; T.xin_lat = L == 0 ? P.in[0] : X; T.xin_ctx = L == 0 ? P.in[2] : X + (size_t)ML * D; T.y = WSP(const bf16_t, WS_Y); T.xout_lat = X; T.xout_ctx = X + (size_t)ML * D;
      T.yc = WSP(const float, WS_YC); T.nslab = (kind == 2 || lastl) ? 0 : NSPLIT;
      T.g_post = P.in[7] + L * D; T.gate = modl + 2 * D; T.uout = WSP(bf16_t, WS_U); T.g_pre = P.in[8] + L * D; T.sc = modl + 4 * D; T.sh = modl + 3 * D; T.nrows = Mact;
      thin_phase(T, C.lds, C.bx, C.G, C.tid, C.wave, C.lane);
      for (int rep_ = 1; rep_ < PROBE_THIN; ++rep_) { ThinArgs T2 = T; if (T2.xout_lat) { T2.xout_lat = WSP(float, WS_END); T2.xout_ctx = WSP(float, WS_END) + (size_t)ML * D; } if (T2.uout) T2.uout = WSP(bf16_t, WS_END + 80 * MiB); thin_phase(T2, C.lds, C.bx, C.G, C.tid, C.wave, C.lane); } }
    PH_END(PH0 + NMIX + 1)
    PH_BEGIN(PH0 + NMIX + 2)
    { pg8::Sched S{}; S.A = (const char*)WSP(bf16_t, WS_U); S.B = (const char*)(WSP(bf16_t, WS_W1) + (size_t)L * FF * D); S.lda = D * 2; S.ldb = D * 2; S.nt = D / 64; S.nM = Mact / 256; S.nN = FF / 256; S.ngroups = 1; S.G = C.G; S.c = C.bx;
      pg8::EpiBf16<1> E{WSP(bf16_t, WS_H), (unsigned)FF, 0}; _Pragma("unroll") for (int rep_ = 0; rep_ < PROBE_W1; ++rep_) { int tid_ = C.tid; if (rep_) { __builtin_amdgcn_sched_barrier(0); __syncthreads(); asm volatile("" : "+v"(tid_)); __builtin_amdgcn_sched_barrier(0); } pg8::gemm_phase(lds, S, E, tid_); } }
    PH_END(PH0 + NMIX + 2)
    PH_BEGIN(PH0 + NMIX + 3)
    { pg8::Sched S{}; S.A = (const char*)WSP(bf16_t, WS_H); S.B = (const char*)(WSP(bf16_t, WS_W2) + (size_t)L * D * FF); S.lda = FF * 2; S.ldb = FF * 2; S.nt = FF / 64; S.nM = ML / 256; S.nN = D / 256; S.ngroups = 1; S.G = C.G; S.c = C.bx;
      pg8::EpiY E{WSP(bf16_t, WS_Y), (unsigned)D, nullptr, 0}; _Pragma("unroll") for (int rep_ = 0; rep_ < PROBE_W2; ++rep_) { int tid_ = C.tid; if (rep_) { __builtin_amdgcn_sched_barrier(0); __syncthreads(); asm volatile("" : "+v"(tid_)); __builtin_amdgcn_sched_barrier(0); } pg8::gemm_phase(lds, S, E, tid_); }
      if constexpr (!lastl) { pg8::Sched S2 = S; S2.A = (const char*)(WSP(bf16_t, WS_H) + (size_t)ML * FF); S2.nt = FF / 64 / NSPLIT; S2.nM = MC / 256; S2.ngroups = NSPLIT; S2.a_g = (FF / NSPLIT) * 2; S2.b_g = (FF / NSPLIT) * 2;
          pg8::EpiF32 E2{WSP(float, WS_YC), (unsigned)D, nullptr, 0, (size_t)MC * D}; _Pragma("unroll") for (int rep_ = 0; rep_ < PROBE_W2; ++rep_) { int tid_ = C.tid; if (rep_) { __builtin_amdgcn_sched_barrier(0); __syncthreads(); asm volatile("" : "+v"(tid_)); __builtin_amdgcn_sched_barrier(0); } pg8::gemm_phase(lds, S2, E2, tid_); } } }
    PH_END(PH0 + NMIX + 3)
    PH_BEGIN(PH0 + NMIX + 4)
    { const float* modl = WSP(const float, WS_MOD) + (size_t)L * 5 * MODROW; float* X = WSP(float, WS_X);
      ThinArgs T{}; T.xin_lat = X; T.xin_ctx = X + (size_t)ML * D; T.y = WSP(const bf16_t, WS_Y); T.xout_lat = lastl ? P.out : X; T.xout_ctx = X + (size_t)ML * D;
      T.yc = WSP(const float, WS_YC); T.nslab = lastl ? 0 : NSPLIT;
      T.g_post = P.in[9] + L * D; T.gate = modl + 5 * D; T.nrows = Mact;
      if constexpr (!lastl) { const float* modn = modl + 5 * MODROW; T.uout = WSP(bf16_t, WS_U); T.g_pre = P.in[6] + (L + 1) * D; T.sc = modn + 1 * D; T.sh = modn + 0 * D; }
      thin_phase(T, C.lds, C.bx, C.G, C.tid, C.wave, C.lane);
      for (int rep_ = 1; rep_ < PROBE_THIN; ++rep_) { ThinArgs T2 = T; if (T2.xout_lat) { T2.xout_lat = WSP(float, WS_END); T2.xout_ctx = WSP(float, WS_END) + (size_t)ML * D; } if (T2.uout) T2.uout = WSP(bf16_t, WS_END + 80 * MiB); thin_phase(T2, C.lds, C.bx, C.G, C.tid, C.wave, C.lane); } }
    PH_END(PH0 + NMIX + 4)
}
constexpr int PH_L0 = 2, PH_L1 = PH_L0 + 7, PH_L2 = PH_L1 + 7, PH_L3 = PH_L2 + 6, N_PHASES = PH_L3 + 7;

__global__ void __launch_bounds__(NTHR, 2) fwd_kernel(Params P) {
    extern __shared__ __attribute__((aligned(16))) unsigned char lds_raw[];
    Ctx C; C.lds = (LAS unsigned char*)lds_raw;
    C.tid = threadIdx.x; C.lane = C.tid & 63; C.wave = __builtin_amdgcn_readfirstlane(C.tid >> 6);
    C.G = gridDim.x; C.bx = blockIdx.x; C.vcu = (C.G % 8 == 0) ? (C.bx % 8) * (C.G / 8) + C.bx / 8 : C.bx;
    C.gw = C.vcu * NWAVES + C.wave; C.NGW = C.G * NWAVES;
    for (int u = C.tid; u < (LDS_BYTES - LDSCTL_OFF) / 4; u += NTHR) ((LAS unsigned*)(C.lds + LDSCTL_OFF))[u] = 0u;
    __syncthreads();
#if MK_MULTI
    XcdBarrier bar{};
#else
    XcdBarrier bar = xcd_barrier_post(WSP(unsigned, WS_CTL) + CW_BAR, (volatile LAS unsigned*)(C.lds + MISC_OFF) + 8);
#endif
    PH_BEGIN(0) for (int rep_ = 0; rep_ < PROBE_PRO; ++rep_) { prologue<2>(P, C.lds, C.tid, C.wave, C.lane, C.vcu, C.G); __syncthreads(); } PH_END(0)
#if !MK_MULTI
    if (P.ph_lo == 0 && P.ph_hi > 1) {
        volatile LAS unsigned* st = (volatile LAS unsigned*)(C.lds + MISC_OFF) + 8;
        if (C.tid == 0) { unsigned* bw = WSP(unsigned, WS_CTL) + CW_BAR; bool okc = (C.G % 8 == 0);
            for (unsigned j = 0; j < 16; ++j) { const unsigned cnt = xb_ld(&bw[XB_XCNT(j)]); okc = okc && (cnt == (j < 8 ? (unsigned)C.G / 8u : 0u)); }
            st[3] = okc ? st[2] * 8u + bar.x : (unsigned)blockIdx.x; }
        __syncthreads();
        C.bx = (int)st[3]; C.vcu = (C.G % 8 == 0) ? (C.bx % 8) * (C.G / 8) + C.bx / 8 : C.bx; C.gw = C.vcu * NWAVES + C.wave;
    }
#endif
    PH_BEGIN(1)
    { const float* mod = WSP(const float, WS_MOD);
      ThinArgs T{}; T.xin_lat = P.in[0]; T.xin_ctx = P.in[2]; T.y = nullptr; T.uout = WSP(bf16_t, WS_U); T.g_pre = P.in[6]; T.sc = mod + 1 * D; T.sh = mod + 0 * D; T.nrows = MT;
      thin_phase(T, C.lds, C.bx, C.G, C.tid, C.wave, C.lane);
      for (int rep_ = 1; rep_ < PROBE_THIN; ++rep_) { ThinArgs T2 = T; if (T2.xout_lat) { T2.xout_lat = WSP(float, WS_END); T2.xout_ctx = WSP(float, WS_END) + (size_t)ML * D; } if (T2.uout) T2.uout = WSP(bf16_t, WS_END + 80 * MiB); thin_phase(T2, C.lds, C.bx, C.G, C.tid, C.wave, C.lane); } }
    PH_END(1)
    layer<0, PH_L0>(P, C, bar);
    layer<1, PH_L1>(P, C, bar);
    layer<2, PH_L2>(P, C, bar);
    layer<3, PH_L3>(P, C, bar);
}
#undef PH_BEGIN
#undef PH_END
#undef GRID_BAR

extern "C" void kernel_launch(void* const* d_in, const int* in_sizes, int n_in, void* d_out, int out_size, void* d_ws, size_t ws_size, hipStream_t stream) {
    static int grid = 0;
    if (grid == 0) {
        if (n_in != 22 || out_size != ML * D || ws_size < WS_END + 128 * MiB) { fprintf(stderr, "kernel_launch: unexpected problem: n_in %d out %d ws %zu (need %zu)\n", n_in, out_size, ws_size, (size_t)WS_END); grid = -1; return; }
        int dev = 0, cus = 0, per_cu = 0;
        if (hipGetDevice(&dev) != hipSuccess || hipDeviceGetAttribute(&cus, hipDeviceAttributeMultiprocessorCount, dev) != hipSuccess) { grid = -1; return; }
        if (hipFuncSetAttribute((const void*)fwd_kernel, hipFuncAttributeMaxDynamicSharedMemorySize, LDS_BYTES) != hipSuccess) { fprintf(stderr, "kernel_launch: hipFuncSetAttribute failed\n"); grid = -1; return; }
        if (hipOccupancyMaxActiveBlocksPerMultiprocessor(&per_cu, (const void*)fwd_kernel, NTHR, LDS_BYTES) != hipSuccess || per_cu < 1) fprintf(stderr, "kernel_launch: occupancy query says %d\n", per_cu);
        (void)hipGetLastError();
        grid = cus;
    }
    if (grid < 0) return;
    (void)in_sizes;
    hipMemsetAsync((char*)d_ws + WS_CTL, 0, CTL_BYTES, stream);
    Params p{};
    for (int i = 0; i < 22; ++i) p.in[i] = (const float*)d_in[i];
    p.out = (float*)d_out; p.ws = (unsigned char*)d_ws;
    p.lam_init0 = (float)(0.8 - 0.6 * exp(-0.3 * 0.0)); p.lam_init3 = (float)(0.8 - 0.6 * exp(-0.3 * 3.0));
#if MK_MULTI
    for (int ph = 0; ph < N_PHASES; ++ph) { p.ph_lo = ph; p.ph_hi = ph + 1; hipLaunchKernelGGL(fwd_kernel, dim3(grid), dim3(NTHR), LDS_BYTES, stream, p); }
#else
    p.ph_lo = 0; p.ph_hi = N_PHASES;
    hipLaunchKernelGGL(fwd_kernel, dim3(grid), dim3(NTHR), LDS_BYTES, stream, p);
#endif
    const hipError_t le = hipPeekAtLastError();
    if (le != hipSuccess) fprintf(stderr, "kernel_launch: launch failed: %s\n", hipGetErrorName(le));
}
```

```cpp
#include <hip/hip_runtime.h>
#include <cstdio>
#include <cstdint>
#include <cmath>

#ifndef MK_MULTI
#define MK_MULTI 0
#endif

#define LAS __attribute__((address_space(3)))
#define GAS __attribute__((address_space(1)))
typedef unsigned short bf16_t;
typedef short bf16x8 __attribute__((ext_vector_type(8)));
typedef short s16x4 __attribute__((ext_vector_type(4)));
typedef float f32x4 __attribute__((ext_vector_type(4)));
typedef float f32x2 __attribute__((ext_vector_type(2)));
typedef float f32x16 __attribute__((ext_vector_type(16)));
typedef unsigned u32x4 __attribute__((ext_vector_type(4)));
typedef unsigned u32x2 __attribute__((ext_vector_type(2)));

constexpr int D = 2048, NB = 4, SEQ = 2048, CL = 256, ML = NB * SEQ, MC = NB * CL, MT = ML + MC, FF = 8192, NH = 16, NMOD = 6, MODROW = NMOD * D;
constexpr int NWAVES = 8, NTHR = 512;
constexpr float NORM_EPS = 1e-6f, SUBLN_EPS = 1e-5f;
constexpr float QSCALE = 0.125f * 1.4426950408889634f;

constexpr size_t MiB = 1u << 20;
constexpr size_t WS_CTL = 0, CTL_BYTES = 1 * MiB;
constexpr size_t WS_MOD = 1 * MiB;
constexpr size_t WS_ROPE = 2 * MiB;
constexpr size_t WS_T1 = 3 * MiB;
constexpr size_t WS_A2C = 4 * MiB;
constexpr size_t WS_A2 = 5 * MiB;
constexpr size_t WS_WQKV = 22 * MiB;
constexpr size_t WS_WO = 70 * MiB;
constexpr size_t WS_WF = 86 * MiB;
constexpr size_t WS_WPOOL = 94 * MiB;
constexpr size_t WS_W1 = 96 * MiB;
constexpr size_t WS_W2 = 224 * MiB;
constexpr size_t WS_X = 352 * MiB;
constexpr size_t WS_Y = 424 * MiB;
constexpr size_t WS_U = 496 * MiB;
constexpr size_t WS_Q = 532 * MiB, WS_K = 568 * MiB, WS_V = 604 * MiB, WS_O = 640 * MiB;
constexpr size_t WS_H = 676 * MiB;
constexpr size_t WS_YT = 820 * MiB;
constexpr size_t WS_YTC = 884 * MiB;
constexpr size_t WS_YC = 892 * MiB;
constexpr size_t WS_SLOT = 956 * MiB;
constexpr size_t WS_END = 958 * MiB;
constexpr int NSPLIT = 8;

constexpr int RING_BYTES = 131072, LDSCTL_OFF = 139264  , MISC_OFF = LDSCTL_OFF + 320, LDS_BYTES = 147456;

__device__ __forceinline__ unsigned cvt_pk_bf16(float lo, float hi) { unsigned r; asm volatile("v_cvt_pk_bf16_f32 %0, %1, %2" : "=v"(r) : "v"(lo), "v"(hi)); return r; }
typedef __bf16 bf16x2v_t __attribute__((ext_vector_type(2)));
__device__ __forceinline__ unsigned cvt_pk_vis(float lo, float hi) { const f32x2 v = {lo, hi}; const bf16x2v_t b = __builtin_convertvector(v, bf16x2v_t); return __builtin_bit_cast(unsigned, b); }
__device__ __forceinline__ float bf2f(unsigned short b) { return __uint_as_float(((unsigned)b) << 16); }
__device__ __forceinline__ float wave_sum(float v) {
#pragma unroll
    for (int o = 1; o < 64; o <<= 1) v += __shfl_xor(v, o);
    return v;
}

#define XB_TMO      128
#define XB_XCNT(j)  (256  + 64 * (j))
#define XB_XSUB(j)  (1280 + 64 * (j))
#define XB_XGEN(j)  (2304 + 64 * (j))
#define XB_TOP      3328
#define XB_TOPGEN   3392
#define XCD_BAR_WORDS 3456
#define XB_SPIN_CAP (1u << 18)
constexpr int CW_BAR = 4096, CW_FUSE = 16384, CW_TMO = 8;

__device__ __forceinline__ unsigned xb_ld(unsigned* p)              { return __hip_atomic_load(p, __ATOMIC_RELAXED, __HIP_MEMORY_SCOPE_AGENT); }
__device__ __forceinline__ unsigned xb_add(unsigned* p, unsigned v) { return __hip_atomic_fetch_add(p, v, __ATOMIC_RELAXED, __HIP_MEMORY_SCOPE_AGENT); }
__device__ __forceinline__ unsigned xb_xcc_id() { return (unsigned)__builtin_amdgcn_s_getreg((3 << 11) | 20) & 0xFu; }
#define XB_SPIN(cond, bar) do { unsigned _sp = 0; while (cond) { __builtin_amdgcn_s_sleep(1); \
    if ((++_sp & 255u) == 0u) { if (xb_ld(&(bar)[XB_TMO])) break; if (_sp > XB_SPIN_CAP) { atomicAdd(&(bar)[XB_TMO], 1u); break; } } } } while (0)

struct XcdBarrier { unsigned* bar; unsigned x; volatile LAS unsigned* st; };

__device__ __forceinline__ XcdBarrier xcd_barrier_post(unsigned* bar, volatile LAS unsigned* st) {
    XcdBarrier b; b.bar = bar; b.x = xb_xcc_id(); b.st = st;
    if (threadIdx.x == 0) st[2] = xb_add(&bar[XB_XCNT(b.x)], 1u);
    return b;
}
__device__ __forceinline__ void xcd_barrier_complete(unsigned* bar, unsigned x, unsigned& nloc, unsigned& nx) {
    const unsigned G = gridDim.x * gridDim.y * gridDim.z;
    unsigned sum, cnt, mine, sp = 0u;
    for (;;) {
        sum = 0u; cnt = 0u; mine = 0u;
#pragma unroll
        for (unsigned j = 0; j < 16; ++j) { const unsigned c = xb_ld(&bar[XB_XCNT(j)]); sum += c; cnt += (c > 0u) ? 1u : 0u; mine = (j == x) ? c : mine; }
        if (sum == G) break;
        __builtin_amdgcn_s_sleep(1);
        if ((++sp & 255u) == 0u) { if (xb_ld(&bar[XB_TMO])) break; if (sp > XB_SPIN_CAP) { atomicAdd(&bar[XB_TMO], 1u); break; } }
    }
    nloc = mine > 0u ? mine : 1u; nx = cnt > 0u ? cnt : 1u;
}
__device__ __forceinline__ void xcd_barrier(const XcdBarrier& b) {
    asm volatile("s_waitcnt vmcnt(0)" ::: "memory");
    __syncthreads();
    if (threadIdx.x == 0) {
        unsigned* bar = b.bar;
        __builtin_amdgcn_s_waitcnt(0);
        unsigned nloc = b.st[0], nx = b.st[1];
        if (nloc == 0u) { xcd_barrier_complete(bar, b.x, nloc, nx); b.st[0] = nloc; b.st[1] = nx; }
        const unsigned old = xb_add(&bar[XB_XSUB(b.x)], 1u);
        const unsigned gen = old / nloc;
        if (old + 1u == (gen + 1u) * nloc) {
            __builtin_amdgcn_fence(__ATOMIC_RELEASE, "agent");
            asm volatile("s_waitcnt vmcnt(0)" ::: "memory");
            const unsigned og = xb_add(&bar[XB_TOP], 1u);
            const unsigned tg = og / nx;
            if (og + 1u == (tg + 1u) * nx) xb_add(&bar[XB_TOPGEN], 1u);
            else XB_SPIN(xb_ld(&bar[XB_TOPGEN]) == tg, bar);
            __builtin_amdgcn_fence(__ATOMIC_ACQUIRE, "agent");
            xb_add(&bar[XB_XGEN(b.x)], 1u);
            asm volatile("s_waitcnt vmcnt(0)" ::: "memory");
        } else {
            XB_SPIN(xb_ld(&bar[XB_XGEN(b.x)]) == gen, bar);
            __builtin_amdgcn_fence(__ATOMIC_ACQUIRE, "agent");
            asm volatile("s_waitcnt vmcnt(0)" ::: "memory");
        }
    }
    __syncthreads();
}

constexpr int CW_HO = 65536;
__device__ __forceinline__ void ho_arrive(unsigned* cnt) {
    asm volatile("s_waitcnt vmcnt(0)" ::: "memory");
    __syncthreads();
    if (threadIdx.x == 0) { __builtin_amdgcn_fence(__ATOMIC_RELEASE, "agent"); asm volatile("s_waitcnt vmcnt(0)" ::: "memory"); xb_add(cnt, 1u); }
}
__device__ __forceinline__ void ho_wait(unsigned* cnt, unsigned need, unsigned* barw) {
    if (threadIdx.x == 0) { XB_SPIN(xb_ld(cnt) < need, barw); __builtin_amdgcn_fence(__ATOMIC_ACQUIRE, "agent"); asm volatile("s_waitcnt vmcnt(0)" ::: "memory"); }
    __syncthreads();
}

namespace pg8 {
constexpr int BM = 256, BK = 64, HALF = 128, HTB = HALF * BK * 2, STAGE_BYTES = 8 * HTB, NXCD = 8, WGM = 8;
__device__ __forceinline__ int lds_byte(int r, int c) { const int st = (r >> 4) * 2 + (c >> 5), rr = r & 15, cc = c & 31, ob = rr * 64 + cc * 2; return st * 1024 + (ob ^ (((ob >> 9) & 1) << 5)); }
__device__ __forceinline__ void stage_rc(int b, int& R, int& C) { const int st = b / 1024, sb = b % 1024, swz = sb ^ (((sb >> 9) & 1) << 5); R = (st >> 1) * 16 + swz / 64; C = (st & 1) * 32 + (swz % 64) / 2; }
__device__ __forceinline__ int perm32(int rho) { const int n = rho >> 4, i = rho & 15; return 8 * (i >> 2) + 4 * n + (i & 3); }

struct Unit { const char* A; const char* B; int g, pm, pn; };

struct Sched {
    const char* A; const char* B; unsigned lda, ldb; int nt;
    int nM, nN, ngroups; long long a_g, b_g;
    int G, c;
    __device__ __forceinline__ bool next(int i, Unit& u) const {
        const int per = nM * nN, nwg = per * ngroups;
        const long L = (long)i * G + c; if (L >= nwg) return false;
        int wgid = (int)L; { const int q = nwg / NXCD, r = nwg % NXCD, xcd = wgid % NXCD, off = wgid / NXCD; wgid = (xcd < r ? xcd * (q + 1) : r * (q + 1) + (xcd - r) * q) + off; }
        const int g = wgid / per, w = wgid % per;
        const int nig = WGM * nN, gid = w / nig, fm = gid * WGM, gsz = (nM - fm) < WGM ? (nM - fm) : WGM;
        u.g = g; u.pm = fm + ((w % nig) % gsz); u.pn = (w % nig) / gsz;
        u.A = A + (long long)g * a_g + (size_t)u.pm * BM * lda; u.B = B + (long long)g * b_g + (size_t)u.pn * BM * ldb;
        return true;
    }
};

template <class Epi>
__device__ __forceinline__ void gemm_phase(LAS unsigned char* lds, const Sched& S, const Epi& E, int tid_in = -1) {
    const int tid = tid_in >= 0 ? tid_in : (int)threadIdx.x, wid = __builtin_amdgcn_readfirstlane(tid >> 6), lane = tid & 63, wr = wid >> 2, wc = wid & 3, fr = lane & 15, fq = lane >> 4;
    const int nt = S.nt;
    unsigned voffA[2], voffB[2];
#pragma unroll
    for (int i = 0; i < 2; ++i) { int R, C; stage_rc(tid * 16 + i * 8192, R, C); const int Rb = (R & ~31) + perm32(R & 31);
        voffA[i] = (unsigned)R * S.lda + (unsigned)C * 2u; voffB[i] = (unsigned)Rb * S.ldb + (unsigned)C * 2u; }
    const size_t kstep = (size_t)(BK * 2);
    const size_t hA = (size_t)HALF * S.lda, hB = (size_t)HALF * S.ldb;
    const unsigned ldsw = (unsigned)wid * 1024u;
    const int aoff = lds_byte(wr * 64 + fr, fq * 8), boff = lds_byte(wc * 32 + fr, fq * 8);
#define PG8_SA(b, h) (((b) * 2 + (h)) * HTB)
#define PG8_SB(b, h) ((4 + (b) * 2 + (h)) * HTB)
#define PG8_STAGE(bufoff, gbase, voff) do { _Pragma("unroll") for (int _i = 0; _i < 2; ++_i) \
        __builtin_amdgcn_global_load_lds((const unsigned*)((const char*)(gbase) + (voff)[_i]), (LAS unsigned*)(lds + (bufoff) + ldsw + _i * 8192), 16, 0, 0); } while (0)
#define PG8_LDA(dst, b, h) do { _Pragma("unroll") for (int m = 0; m < 4; ++m) _Pragma("unroll") for (int k = 0; k < 2; ++k) dst[m][k] = *(const LAS bf16x8*)(lds + PG8_SA(b, h) + aoff + m * 2048 + k * 1024); } while (0)
#define PG8_LDB(dst, b, h) do { _Pragma("unroll") for (int n = 0; n < 2; ++n) _Pragma("unroll") for (int k = 0; k < 2; ++k) dst[n][k] = *(const LAS bf16x8*)(lds + PG8_SB(b, h) + boff + n * 2048 + k * 1024); } while (0)
#define PG8_MMA(ai, bj, At, Bt) do { __builtin_amdgcn_s_setprio(1); _Pragma("unroll") for (int m = 0; m < 4; ++m) _Pragma("unroll") for (int n = 0; n < 2; ++n) _Pragma("unroll") for (int k = 0; k < 2; ++k) \
        acc[ai][bj][m][n] = __builtin_amdgcn_mfma_f32_16x16x32_bf16(Bt[n][k], At[m][k], acc[ai][bj][m][n], 0, 0, 0); __builtin_amdgcn_s_setprio(0); } while (0)
#define PG8_WAIT_V(n) asm volatile("s_waitcnt vmcnt(" #n ")" ::: "memory")
#define PG8_WAIT_L(n) asm volatile("s_waitcnt lgkmcnt(" #n ")" ::: "memory")
#define PG8_BAR __builtin_amdgcn_s_barrier()
#define PG8_SCHED __builtin_amdgcn_sched_barrier(0)
    Unit cur, nxt; int ui = 0;
    if (!S.next(0, cur)) return;
    f32x4 acc[2][2][4][2];
#pragma unroll
    for (int a = 0; a < 2; ++a)
#pragma unroll
        for (int b = 0; b < 2; ++b)
#pragma unroll
            for (int m = 0; m < 4; ++m)
#pragma unroll
                for (int n = 0; n < 2; ++n) acc[a][b][m][n] = (f32x4){0.f, 0.f, 0.f, 0.f};
    bf16x8 At[4][2], B0[2][2], B1[2][2];
    const char* cA = cur.A; const char* cB = cur.B;
    PG8_STAGE(PG8_SB(0, 0), cB, voffB); PG8_STAGE(PG8_SB(0, 1), cB + hB, voffB); PG8_STAGE(PG8_SA(0, 0), cA, voffA); PG8_STAGE(PG8_SA(0, 1), cA + hA, voffA);
    if (wr == 1) PG8_BAR;
    PG8_WAIT_V(2); PG8_BAR;
    PG8_STAGE(PG8_SB(1, 0), cB + kstep, voffB); PG8_STAGE(PG8_SA(1, 0), cA + kstep, voffA); PG8_STAGE(PG8_SB(1, 1), cB + hB + kstep, voffB);
    PG8_WAIT_V(6); PG8_BAR;
    for (;;) {
        const bool has_next = S.next(ui + 1, nxt);
        const char* nA = has_next ? nxt.A : cA; const char* nB = has_next ? nxt.B : cB;
        for (int t = 0; t < nt; t += 2) {
            const bool last = (t == nt - 2);
            const char* a1 = cA + (size_t)(t + 1) * kstep;
            const char* a2 = last ? nA : cA + (size_t)(t + 2) * kstep; const char* b2 = last ? nB : cB + (size_t)(t + 2) * kstep;
            const char* a3 = a2 + kstep; const char* b3 = b2 + kstep;
            PG8_LDB(B0, 0, 0); PG8_LDB(B1, 0, 1); PG8_SCHED; PG8_LDA(At, 0, 0); PG8_STAGE(PG8_SA(1, 1), a1 + hA, voffA);
            PG8_WAIT_V(8); PG8_WAIT_L(0); PG8_BAR; PG8_MMA(0, 0, At, B0); PG8_MMA(0, 1, At, B1); PG8_BAR; PG8_SCHED;
            PG8_LDA(At, 0, 1); PG8_STAGE(PG8_SB(0, 0), b2, voffB); PG8_STAGE(PG8_SB(0, 1), b2 + hB, voffB); PG8_STAGE(PG8_SA(0, 0), a2, voffA);
            PG8_WAIT_V(8); PG8_WAIT_L(0); PG8_BAR; PG8_MMA(1, 0, At, B0); PG8_MMA(1, 1, At, B1); PG8_BAR; PG8_SCHED;
            PG8_LDB(B0, 1, 0); PG8_LDB(B1, 1, 1); PG8_SCHED; PG8_LDA(At, 1, 0); PG8_STAGE(PG8_SA(0, 1), a2 + hA, voffA);
            PG8_WAIT_V(8); PG8_WAIT_L(0); PG8_BAR; PG8_MMA(0, 0, At, B0); PG8_MMA(0, 1, At, B1); PG8_BAR; PG8_SCHED;
            PG8_LDA(At, 1, 1); PG8_STAGE(PG8_SB(1, 0), b3, voffB); PG8_STAGE(PG8_SB(1, 1), b3 + hB, voffB); PG8_STAGE(PG8_SA(1, 0), a3, voffA);
            PG8_WAIT_V(8); PG8_WAIT_L(0); PG8_BAR; PG8_MMA(1, 0, At, B0); PG8_MMA(1, 1, At, B1); PG8_BAR; PG8_SCHED;
        }
        if (wr == 0) PG8_BAR;
        if constexpr (!Epi::FUSED) E(acc, cur, wr, wc, fr, fq);
        if (!has_next) break;
#pragma unroll
        for (int a = 0; a < 2; ++a)
#pragma unroll
            for (int b = 0; b < 2; ++b)
#pragma unroll
                for (int m = 0; m < 4; ++m)
#pragma unroll
                    for (int n = 0; n < 2; ++n) acc[a][b][m][n] = (f32x4){0.f, 0.f, 0.f, 0.f};
        cur = nxt; cA = nA; cB = nB; ++ui;
        if (wr == 1) PG8_BAR;
    }
    PG8_WAIT_V(0);
    PG8_BAR;
    if constexpr (Epi::FUSED) E.fused(acc, cur, wr, wc, fr, fq, lds, wid, lane, tid);
#undef PG8_SA
#undef PG8_SB
#undef PG8_STAGE
#undef PG8_LDA
#undef PG8_LDB
#undef PG8_MMA
#undef PG8_WAIT_V
#undef PG8_WAIT_L
#undef PG8_BAR
#undef PG8_SCHED
}

struct EpiF32 {
    static constexpr bool FUSED = false;
    float* C; unsigned ldc; const float* colscale; int c_g; size_t slab_g;
    __device__ __forceinline__ void operator()(const f32x4 (&acc)[2][2][4][2], const Unit& u, int wr, int wc, int fr, int fq) const {
        const int row0 = u.pm * BM + wr * 64 + fr, col0 = u.g * c_g + u.pn * BM + wc * 32 + 8 * fq;
        f32x4 sv[2][2];
#pragma unroll
        for (int bj = 0; bj < 2; ++bj)
#pragma unroll
            for (int n = 0; n < 2; ++n) sv[bj][n] = colscale ? *(const f32x4*)(colscale + col0 + bj * HALF + 4 * n) : (f32x4){1.f, 1.f, 1.f, 1.f};
#pragma unroll
        for (int ai = 0; ai < 2; ++ai)
#pragma unroll
            for (int m = 0; m < 4; ++m) { float* rowp = C + (size_t)u.g * slab_g + (size_t)(row0 + ai * HALF + m * 16) * ldc + col0;
#pragma unroll
                for (int bj = 0; bj < 2; ++bj) { *(f32x4*)(rowp + bj * HALF) = acc[ai][bj][m][0] * sv[bj][0]; *(f32x4*)(rowp + bj * HALF + 4) = acc[ai][bj][m][1] * sv[bj][1]; } }
    }
};
struct EpiY {
    static constexpr bool FUSED = false;
    bf16_t* C; unsigned ldc; const float* colscale; int c_g; size_t slab_g;
    __device__ __forceinline__ void operator()(const f32x4 (&acc)[2][2][4][2], const Unit& u, int wr, int wc, int fr, int fq) const {
        const int row0 = u.pm * BM + wr * 64 + fr, col0 = u.g * c_g + u.pn * BM + wc * 32 + 8 * fq;
        f32x4 sv[2][2];
#pragma unroll
        for (int bj = 0; bj < 2; ++bj)
#pragma unroll
            for (int n = 0; n < 2; ++n) sv[bj][n] = colscale ? *(const f32x4*)(colscale + col0 + bj * HALF + 4 * n) : (f32x4){1.f, 1.f, 1.f, 1.f};
#pragma unroll
        for (int ai = 0; ai < 2; ++ai)
#pragma unroll
            for (int m = 0; m < 4; ++m) { bf16_t* rowp = C + (size_t)(row0 + ai * HALF + m * 16) * ldc + col0;
#pragma unroll
                for (int bj = 0; bj < 2; ++bj) { const f32x4 v0 = acc[ai][bj][m][0] * sv[bj][0], v1 = acc[ai][bj][m][1] * sv[bj][1];
                    u32x4 w; w.x = cvt_pk_vis(v0[0], v0[1]); w.y = cvt_pk_vis(v0[2], v0[3]); w.z = cvt_pk_vis(v1[0], v1[1]); w.w = cvt_pk_vis(v1[2], v1[3]);
                    *(u32x4*)(rowp + bj * HALF) = w; } }
    }
};
struct EpiSlab {
    static constexpr bool FUSED = false;
    bf16_t* C; unsigned ldc; size_t slab_g;
    __device__ __forceinline__ void operator()(const f32x4 (&acc)[2][2][4][2], const Unit& u, int wr, int wc, int fr, int fq) const {
        const int row0 = u.pm * BM + wr * 64 + fr, col0 = u.pn * BM + wc * 32 + 8 * fq;
#pragma unroll
        for (int ai = 0; ai < 2; ++ai)
#pragma unroll
            for (int m = 0; m < 4; ++m) { bf16_t* rowp = C + (size_t)u.g * slab_g + (size_t)(row0 + ai * HALF + m * 16) * ldc + col0;
#pragma unroll
                for (int bj = 0; bj < 2; ++bj) { const f32x4 v0 = acc[ai][bj][m][0], v1 = acc[ai][bj][m][1];
                    u32x4 w; w.x = cvt_pk_vis(v0[0], v0[1]); w.y = cvt_pk_vis(v0[2], v0[3]); w.z = cvt_pk_vis(v1[0], v1[1]); w.w = cvt_pk_vis(v1[2], v1[3]);
                    *(u32x4*)(rowp + bj * HALF) = w; } }
    }
};
template <int ACT> struct EpiBf16 {
    static constexpr bool FUSED = false;
    bf16_t* C; unsigned ldc; int row_g;
    __device__ __forceinline__ void operator()(const f32x4 (&acc)[2][2][4][2], const Unit& u, int wr, int wc, int fr, int fq) const {
        const int row0 = u.g * row_g + u.pm * BM + wr * 64 + fr, col0 = u.pn * BM + wc * 32 + 8 * fq;
#pragma unroll
        for (int ai = 0; ai < 2; ++ai)
#pragma unroll
            for (int m = 0; m < 4; ++m) { bf16_t* rowp = C + (size_t)(row0 + ai * HALF + m * 16) * ldc + col0;
#pragma unroll
                for (int bj = 0; bj < 2; ++bj) { f32x4 v0 = acc[ai][bj][m][0], v1 = acc[ai][bj][m][1];
                    if (ACT == 1) {
#pragma unroll
                        for (int e = 0; e < 4; ++e) { const float a = __builtin_amdgcn_fmed3f(v0[e], 0.f, __builtin_inff()), b = __builtin_amdgcn_fmed3f(v1[e], 0.f, __builtin_inff()); v0[e] = a * a; v1[e] = b * b; } }
                    u32x4 w; w.x = cvt_pk_vis(v0[0], v0[1]); w.y = cvt_pk_vis(v0[2], v0[3]); w.z = cvt_pk_vis(v1[0], v1[1]); w.w = cvt_pk_vis(v1[2], v1[3]);
                    *(u32x4*)(rowp + bj * HALF) = w; } }
    }
};
struct EpiFA {
    static constexpr bool FUSED = false;
    bf16_t* YT; bf16_t* YTC;
    __device__ __forceinline__ void operator()(const f32x4 (&acc)[2][2][4][2], const Unit& u, int wr, int wc, int fr, int fq) const {
        const int cs = u.pm >> 1, k2b = (u.pm & 1) * 256;
        bf16_t* base; size_t pitch;
        if (u.pn < 32) { const int b = u.pn >> 3; base = YT + (size_t)(u.g * 512 + k2b) * 16384 + b * 4096 + cs * 2048 + (u.pn & 7) * 256; pitch = 16384; }
        else { const int b = u.pn - 32; base = YTC + (size_t)(u.g * 512 + k2b) * 2048 + b * 512 + cs * 256; pitch = 2048; }
        const int row0 = wr * 64 + fr, col0 = wc * 32 + 8 * fq;
#pragma unroll
        for (int ai = 0; ai < 2; ++ai)
#pragma unroll
            for (int m = 0; m < 4; ++m) { bf16_t* rowp = base + (size_t)(row0 + ai * HALF + m * 16) * pitch + col0;
#pragma unroll
                for (int bj = 0; bj < 2; ++bj) { const f32x4 v0 = acc[ai][bj][m][0], v1 = acc[ai][bj][m][1];
                    u32x4 w; w.x = cvt_pk_vis(v0[0], v0[1]); w.y = cvt_pk_vis(v0[2], v0[3]); w.z = cvt_pk_vis(v1[0], v1[1]); w.w = cvt_pk_vis(v1[2], v1[3]);
                    *(u32x4*)(rowp + bj * HALF) = w; } }
    }
};
struct EpiQKV {
    static constexpr bool FUSED = false;
    bf16_t* Q; const float* rope;
    int pm_base, pn_base;
    __device__ __forceinline__ void operator()(const f32x4 (&acc)[2][2][4][2], const Unit& u, int wr, int wc, int fr, int fq) const {
        const int pn = u.pn + pn_base, pm = u.pm + pm_base, part = pn >> 3;
        bf16_t* dst = Q + (size_t)part * ((WS_K - WS_Q) / 2);
        const int row0 = pm * BM + wr * 64 + fr, colp = (pn & 7) * BM + wc * 32 + 8 * fq;
        const bool dorope = (part < 2) && (pm < 32);
        const float sc = part == 0 ? QSCALE : 1.f;
#pragma unroll
        for (int ai = 0; ai < 2; ++ai)
#pragma unroll
            for (int m = 0; m < 4; ++m) { const int row = row0 + ai * HALF + m * 16; bf16_t* rowp = dst + (size_t)row * D + colp;
                const int t = row & 2047, prow = t >> 6, pcol = t & 63;
#pragma unroll
                for (int bj = 0; bj < 2; ++bj) { f32x4 v0 = acc[ai][bj][m][0], v1 = acc[ai][bj][m][1];
                    if (dorope) { const int c = colp + bj * HALF, j0 = (c & 63) >> 1, ax = j0 >> 4, f0 = j0 & 15;
                        const float* cs = rope + ((ax ? pcol : prow) * 16 + f0) * 2;
                        const f32x4 cs0 = *(const f32x4*)cs, cs1 = *(const f32x4*)(cs + 4);
                        f32x4 r0, r1;
                        r0[0] = v0[0] * cs0[0] - v0[1] * cs0[1]; r0[1] = v0[0] * cs0[1] + v0[1] * cs0[0];
                        r0[2] = v0[2] * cs0[2] - v0[3] * cs0[3]; r0[3] = v0[2] * cs0[3] + v0[3] * cs0[2];
                        r1[0] = v1[0] * cs1[0] - v1[1] * cs1[1]; r1[1] = v1[0] * cs1[1] + v1[1] * cs1[0];
                        r1[2] = v1[2] * cs1[2] - v1[3] * cs1[3]; r1[3] = v1[2] * cs1[3] + v1[3] * cs1[2];
                        v0 = r0; v1 = r1; }
                    v0 = v0 * sc; v1 = v1 * sc;
                    u32x4 w; w.x = cvt_pk_vis(v0[0], v0[1]); w.y = cvt_pk_vis(v0[2], v0[3]); w.z = cvt_pk_vis(v1[0], v1[1]); w.w = cvt_pk_vis(v1[2], v1[3]);
                    *(u32x4*)(rowp + bj * HALF) = w; } }
    }
};

struct EpiFuse {
    static constexpr bool FUSED = true;
    const float* xin; float* xout; bf16_t* uout;
    const float* gate; const float* g_post;
    const float* g_pre; const float* sc; const float* sh;
    unsigned long long* slots;
    unsigned* cnt; unsigned* tmo;
    __device__ __forceinline__ void operator()(const f32x4 (&)[2][2][4][2], const Unit&, int, int, int, int) const {}
    __device__ __forceinline__ void fused(f32x4 (&acc)[2][2][4][2], const Unit& u, int wr, int wc, int fr, int fq, LAS unsigned char* lds, int wid, int lane, int tid) const {
        LAS float* ta = (LAS float*)lds; LAS float* tg = ta + 256; LAS float* ts = tg + 256;
        LAS f32x4* P4 = (LAS f32x4*)(lds + 4096);
        LAS f32x2* S2 = (LAS f32x2*)(lds + 4096 + 16384);
        const int b = (u.pm * BM) >> 11, colt = u.pn * BM;
#define FZ_BAR() do { asm volatile("s_waitcnt vmcnt(0) lgkmcnt(0)" ::: "memory"); __builtin_amdgcn_s_barrier(); asm volatile("" ::: "memory"); } while (0)
        if (tid < 256) { const int c = colt + tid; ta[tid] = gate[(size_t)b * MODROW + c] * g_post[c];
            if (uout) { tg[tid] = g_pre[c] * (1.0f + sc[(size_t)b * MODROW + c]); ts[tid] = sh[(size_t)b * MODROW + c]; } }
        FZ_BAR();
#pragma unroll
        for (int ai = 0; ai < 2; ++ai)
#pragma unroll
            for (int m = 0; m < 4; ++m) { const int rl = ai * HALF + wr * 64 + m * 16 + fr; const float* xr = xin + (size_t)((u.pm * BM) + rl) * D + colt + wc * 32 + 8 * fq;
                float s1 = 0.f, s2 = 0.f, s3 = 0.f, s4 = 0.f;
#pragma unroll
                for (int bj = 0; bj < 2; ++bj)
#pragma unroll
                    for (int n = 0; n < 2; ++n) { const f32x4 y = acc[ai][bj][m][n], x = *(const f32x4*)(xr + bj * HALF + 4 * n), a = *(const LAS f32x4*)(ta + bj * HALF + wc * 32 + 8 * fq + 4 * n);
                        const f32x4 ay = a * y;
                        s1 += (y[0] * y[0] + y[1] * y[1]) + (y[2] * y[2] + y[3] * y[3]); s2 += (x[0] * x[0] + x[1] * x[1]) + (x[2] * x[2] + x[3] * x[3]);
                        s3 += (x[0] * ay[0] + x[1] * ay[1]) + (x[2] * ay[2] + x[3] * ay[3]); s4 += (ay[0] * ay[0] + ay[1] * ay[1]) + (ay[2] * ay[2] + ay[3] * ay[3]); }
                s1 += __shfl_xor(s1, 16); s1 += __shfl_xor(s1, 32); s2 += __shfl_xor(s2, 16); s2 += __shfl_xor(s2, 32);
                s3 += __shfl_xor(s3, 16); s3 += __shfl_xor(s3, 32); s4 += __shfl_xor(s4, 16); s4 += __shfl_xor(s4, 32);
                if (fq == 0) P4[rl * 4 + wc] = (f32x4){s1, s2, s3, s4};
                asm volatile("" ::: "memory"); }
        FZ_BAR();
        if (tid < 256) { const f32x4 p0 = P4[tid * 4 + 0], p1 = P4[tid * 4 + 1], p2 = P4[tid * 4 + 2], p3 = P4[tid * 4 + 3]; const f32x4 t = (p0 + p1) + (p2 + p3);
            unsigned long long* slot = slots + ((size_t)((u.pm * BM) + tid) * 8 + u.pn) * 2;
            __hip_atomic_store(slot, ((unsigned long long)__float_as_uint(t[1]) << 32) | __float_as_uint(t[0]), __ATOMIC_RELAXED, __HIP_MEMORY_SCOPE_AGENT);
            __hip_atomic_store(slot + 1, ((unsigned long long)__float_as_uint(t[3]) << 32) | __float_as_uint(t[2]), __ATOMIC_RELAXED, __HIP_MEMORY_SCOPE_AGENT); }
        asm volatile("s_waitcnt vmcnt(0)" ::: "memory");
        if (tid < 256 && lane == 0) __hip_atomic_fetch_add(cnt + 64 * u.pm, 1u, __ATOMIC_RELAXED, __HIP_MEMORY_SCOPE_AGENT);
        if (wid == 0) { const unsigned long long t0 = __builtin_amdgcn_s_memrealtime();
            for (;;) { if ((unsigned)__builtin_amdgcn_readfirstlane(__hip_atomic_load(cnt + 64 * u.pm, __ATOMIC_RELAXED, __HIP_MEMORY_SCOPE_AGENT)) >= 32u) break;
                if (__builtin_amdgcn_s_memrealtime() - t0 > 2000000ull) { if (lane == 0) __hip_atomic_store(tmo, 1u, __ATOMIC_RELAXED, __HIP_MEMORY_SCOPE_AGENT); break; }
                __builtin_amdgcn_s_sleep(2); }
            __builtin_amdgcn_fence(__ATOMIC_ACQUIRE, "agent"); }
        FZ_BAR();
        if (tid < 256) { const unsigned long long* slot = slots + (size_t)((u.pm * BM) + tid) * 16; float t1 = 0.f, t2 = 0.f, t3 = 0.f, t4 = 0.f;
#pragma unroll
            for (int t = 0; t < 8; ++t) { const unsigned long long w0 = __hip_atomic_load(slot + 2 * t, __ATOMIC_RELAXED, __HIP_MEMORY_SCOPE_AGENT), w1 = __hip_atomic_load(slot + 2 * t + 1, __ATOMIC_RELAXED, __HIP_MEMORY_SCOPE_AGENT);
                t1 += __uint_as_float((unsigned)w0); t2 += __uint_as_float((unsigned)(w0 >> 32)); t3 += __uint_as_float((unsigned)w1); t4 += __uint_as_float((unsigned)(w1 >> 32)); }
            const float r1 = 1.0f / sqrtf(t1 * (1.0f / D) + NORM_EPS);
            const float q = t2 + 2.0f * r1 * t3 + r1 * r1 * t4;
            S2[tid] = (f32x2){r1, 1.0f / sqrtf(fmaxf(q, 0.f) * (1.0f / D) + NORM_EPS)}; }
        FZ_BAR();
#pragma unroll
        for (int ai = 0; ai < 2; ++ai)
#pragma unroll
            for (int m = 0; m < 4; ++m) { const int rl = ai * HALF + wr * 64 + m * 16 + fr; const size_t off = (size_t)((u.pm * BM) + rl) * D + colt + wc * 32 + 8 * fq; const f32x2 rr = S2[rl];
#pragma unroll
                for (int bj = 0; bj < 2; ++bj) { const int cl = bj * HALF + wc * 32 + 8 * fq;
                    const f32x4 a0 = *(const LAS f32x4*)(ta + cl), a1 = *(const LAS f32x4*)(ta + cl + 4);
                    const f32x4 x0 = *(const f32x4*)(xin + off + bj * HALF) + (a0 * acc[ai][bj][m][0]) * rr[0], x1 = *(const f32x4*)(xin + off + bj * HALF + 4) + (a1 * acc[ai][bj][m][1]) * rr[0];
                    *(f32x4*)(xout + off + bj * HALF) = x0; *(f32x4*)(xout + off + bj * HALF + 4) = x1;
                    if (uout) { const f32x4 g0 = *(const LAS f32x4*)(tg + cl), g1 = *(const LAS f32x4*)(tg + cl + 4), h0 = *(const LAS f32x4*)(ts + cl), h1 = *(const LAS f32x4*)(ts + cl + 4);
                        const f32x4 u0 = (x0 * rr[1]) * g0 + h0, u1 = (x1 * rr[1]) * g1 + h1;
                        u32x4 w; w.x = cvt_pk_vis(u0[0], u0[1]); w.y = cvt_pk_vis(u0[2], u0[3]); w.z = cvt_pk_vis(u1[0], u1[1]); w.w = cvt_pk_vis(u1[2], u1[3]);
                        *(u32x4*)(uout + off + bj * HALF) = w; } }
                asm volatile("" ::: "memory"); }
        FZ_BAR();
#undef FZ_BAR
    }
};
}


namespace att {
__device__ __forceinline__ unsigned off_a(unsigned row, unsigned ch) { return 2048u * (row >> 3) + 512u * (ch >> 2) + 64u * (row & 7) + 16u * ((ch & 3) ^ ((row >> 2) & 3)); }
constexpr int KBUF = 0, VBUF = 32768, QOFF = 65536, WSF_OFF = LDSCTL_OFF + 1024;
constexpr float THR = 6.0f;
struct Args { const bf16_t* Q; const bf16_t* K; const bf16_t* V; bf16_t* O; const float* gsub; float lam, post; };
__device__ __forceinline__ s16x4 vtr(const LAS unsigned char* p) { return __builtin_bit_cast(s16x4, __builtin_amdgcn_ds_read_tr16_b64_v4i16((LAS s16x4*)p)); }
__device__ __forceinline__ float half_max(float v) { auto rr = __builtin_amdgcn_permlane32_swap(__float_as_uint(v), __float_as_uint(v), false, false); return fmaxf(__uint_as_float(rr[0]), __uint_as_float(rr[1])); }
__device__ __forceinline__ float half_sum(float v) { auto rr = __builtin_amdgcn_permlane32_swap(__float_as_uint(v), __float_as_uint(v), false, false); return __uint_as_float(rr[0]) + __uint_as_float(rr[1]); }

__device__ __forceinline__ void glds16(const void* gsrc, unsigned lds_dst) { unsigned keep;
    asm volatile("s_mov_b32 %0, m0\n\ts_mov_b32 m0, %2\n\ts_nop 0\n\tglobal_load_lds_dwordx4 %1, off\n\ts_mov_b32 m0, %0" : "=&s"(keep) : "v"(gsrc), "s"(lds_dst) : "memory"); }
__device__ __forceinline__ float max3f(float a, float b, float c) { float r; asm("v_max3_f32 %0, %1, %2, %3" : "=v"(r) : "v"(a), "v"(b), "v"(c)); return r; }
__device__ __forceinline__ float max2f(float a, float b) { float r; asm("v_max_f32_e32 %0, %1, %2" : "=v"(r) : "v"(a), "v"(b)); return r; }
__device__ __forceinline__ float fsub_s(float a, float b) { float r; asm("v_sub_f32_e32 %0, %1, %2" : "=v"(r) : "v"(a), "v"(b)); return r; }
__device__ __forceinline__ float fadd_s(float a, float b) { float r; asm("v_add_f32_e32 %0, %1, %2" : "=v"(r) : "v"(a), "v"(b)); return r; }
typedef __bf16 bf16x2_t __attribute__((ext_vector_type(2)));
__device__ __forceinline__ unsigned cvtpk_b(float lo, float hi) { const f32x2 v = {lo, hi}; const bf16x2_t b = __builtin_convertvector(v, bf16x2_t); return __builtin_bit_cast(unsigned, b); }
template <bool SAFE>
__device__ __forceinline__ bool unit(LAS unsigned char* lds, const Args& P, int b, int h, int q0, int nlat, int tid) {
    const int lane = tid & 63, r32 = lane & 31, hi = lane >> 5; const int wid = __builtin_amdgcn_readfirstlane(tid >> 6);
    const int nt = nlat + 4;
    if (wid >= 4) __builtin_amdgcn_s_setprio(1);
    LAS unsigned char* Qs = lds + QOFF + wid * 8192;
    LAS float* wsf = (LAS float*)(lds + WSF_OFF + wid * 256);
    {   const bf16_t* qrow = P.Q + (size_t)(q0 + wid * 32 + r32) * D + h * 128 + hi * 8;
#pragma unroll
        for (int c = 0; c < 2; ++c)
#pragma unroll
            for (int d0 = 0; d0 < 4; ++d0) { const u32x4 v = *(const u32x4*)(qrow + c * 64 + d0 * 16); *(LAS u32x4*)(Qs + ((c * 4 + d0) * 2 + hi) * 512 + r32 * 16) = v; } }
    unsigned goff[2];
#pragma unroll
    for (int i = 0; i < 2; ++i) { const unsigned p = 2 * wid + i, rg = p >> 1, chq = (p & 1) * 2 + (lane >> 5), r7 = (lane >> 2) & 7, x = lane & 3, rsw = (r7 >> 2) | ((rg & 1) << 1);
        goff[i] = ((8 * rg + r7) * D + h * 128 + (4 * chq + (x ^ rsw)) * 8) * 2; }
#define ATT_GROW(t) ((t) < nlat ? b * SEQ + 64 * (t) : ML + b * CL + 64 * ((t) - nlat))
#define ATT_DMA(t, buf) do { const size_t g_ = (size_t)ATT_GROW(t) * D * 2; _Pragma("unroll") for (int i_ = 0; i_ < 2; ++i_) { \
        glds16((const char*)P.K + g_ + goff[i_], (unsigned)__builtin_amdgcn_readfirstlane(lds0 + KBUF + (buf) * 16384 + (2 * wid + i_) * 1024)); \
        glds16((const char*)P.V + g_ + goff[i_], (unsigned)__builtin_amdgcn_readfirstlane(lds0 + VBUF + (buf) * 16384 + (2 * wid + i_) * 1024)); } } while (0)
    const unsigned lds0 = (unsigned)(uintptr_t)lds;
    ATT_DMA(0, 0);
    unsigned kb[2];
#pragma unroll
    for (int e = 0; e < 2; ++e) kb[e] = 2048u * (r32 >> 3) + 64u * (r32 & 7) + 16u * ((unsigned)(2 * e + hi) ^ ((r32 >> 2) & 3));
    const unsigned blk = (lane >> 4) & 1, q_ = (lane & 15) >> 2, p_ = lane & 3;
    unsigned vb[2];
#pragma unroll
    for (int t = 0; t < 2; ++t) vb[t] = 2048u * t + 64u * (4 * hi + q_) + 16u * ((2 * blk + (p_ >> 1)) ^ ((2 * t + hi) & 3)) + 8u * (p_ & 1);
    float m0 = -1e30f, m1 = -1e30f, l0 = 0.f, l1 = 0.f;
    f32x16 o[2][4];
#pragma unroll
    for (int c = 0; c < 2; ++c)
#pragma unroll
        for (int d = 0; d < 4; ++d) o[c][d] = f32x16{};
    asm volatile("s_waitcnt vmcnt(0)" ::: "memory");
    __syncthreads();
#define SB() __builtin_amdgcn_sched_barrier(0)
#define ATT_SMB(S0, S1, i, M, SUM, PW) do { const float a_ = (i) < 8 ? S0[2 * ((i) & 7)] : S1[2 * ((i) & 7)], b_ = (i) < 8 ? S0[2 * ((i) & 7) + 1] : S1[2 * ((i) & 7) + 1]; \
        const float ea_ = SAFE ? __builtin_amdgcn_exp2f(fsub_s(a_, M)) : __builtin_amdgcn_exp2f(a_), eb_ = SAFE ? __builtin_amdgcn_exp2f(fsub_s(b_, M)) : __builtin_amdgcn_exp2f(b_); \
        SUM += ea_; SUM += eb_; PW[i] = cvtpk_b(ea_, eb_); asm volatile("" : "+v"(SUM), "+v"(PW[i])); } while (0)
#define ATT_SMA(S0, S1, c, MC, LC) do { asm volatile("s_nop 15\n\ts_nop 7" : "+v"(S0), "+v"(S1)); \
        float a_ = max3f(S0[0], S0[1], S1[0]), b_ = max3f(S0[2], S0[3], S1[1]); a_ = max3f(a_, S1[2], S1[3]); \
        _Pragma("unroll") for (int r_ = 4; r_ < 16; r_ += 4) { a_ = max3f(a_, S0[r_], S0[r_ + 1]); b_ = max3f(b_, S0[r_ + 2], S0[r_ + 3]); a_ = max3f(a_, S1[r_], S1[r_ + 1]); b_ = max3f(b_, S1[r_ + 2], S1[r_ + 3]); } \
        const float mx_ = half_max(max2f(a_, b_)); \
        if (__any(mx_ - MC > THR)) { const float mn_ = fmaxf(MC, mx_), al_ = __builtin_amdgcn_exp2f(MC - mn_); MC = mn_; LC *= al_; if (hi == 0) wsf[r32] = al_; \
            _Pragma("unroll") for (int g4 = 0; g4 < 4; ++g4) { const f32x4 a4 = *(const LAS f32x4*)(wsf + 8 * g4 + 4 * hi); \
                _Pragma("unroll") for (int d = 0; d < 4; ++d) { o[c][d][4 * g4 + 0] *= a4[0]; o[c][d][4 * g4 + 1] *= a4[1]; o[c][d][4 * g4 + 2] *= a4[2]; o[c][d][4 * g4 + 3] *= a4[3]; } } } } while (0)
#define ATT_LDQK(c, d0, QF, K0, K1) do { QF = *(const LAS bf16x8*)(Qs + (((c) * 4 + (d0)) * 2 + hi) * 512 + r32 * 16); \
        K0 = *(const LAS bf16x8*)(Kb + kb[(d0) & 1] + 512 * (2 * (c) + ((d0) >> 1))); K1 = *(const LAS bf16x8*)(Kb + kb[(d0) & 1] + 512 * (2 * (c) + ((d0) >> 1)) + 8192); } while (0)
#define ATT_LDV(i, LO, HH) do { LO = vtr(Vb + vb[0] + 4096 * ((i) >> 2) + 512 * ((i) & 3)); HH = vtr(Vb + vb[1] + 4096 * ((i) >> 2) + 512 * ((i) & 3)); } while (0)
#define ATT_VF(LO, HH) ((bf16x8){LO[0], LO[1], LO[2], LO[3], HH[0], HH[1], HH[2], HH[3]})
#define ATT_PA(PW, ks) ((bf16x8)__builtin_bit_cast(bf16x8, (u32x4){PW[4 * (ks)], PW[4 * (ks) + 1], PW[4 * (ks) + 2], PW[4 * (ks) + 3]}))
#pragma unroll 1
    for (int t = 0; t < nt; ++t) {
        const int buf = t & 1;
        if (t + 1 < nt) ATT_DMA(t + 1, buf ^ 1);
        const LAS unsigned char* Kb = lds + KBUF + buf * 16384; const LAS unsigned char* Vb = lds + VBUF + buf * 16384;
        unsigned pw0[16], pw1[16];
        f32x16 sa = f32x16{}, sb = f32x16{};
        SB();
        {   bf16x8 qfA, k0A, k1A, qfB, k0B, k1B;
            ATT_LDQK(0, 0, qfA, k0A, k1A); ATT_LDQK(0, 1, qfB, k0B, k1B); SB();
            sa = __builtin_amdgcn_mfma_f32_32x32x16_bf16(k0A, qfA, sa, 0, 0, 0); sb = __builtin_amdgcn_mfma_f32_32x32x16_bf16(k1A, qfA, sb, 0, 0, 0); SB();
            ATT_LDQK(0, 2, qfA, k0A, k1A); SB();
            sa = __builtin_amdgcn_mfma_f32_32x32x16_bf16(k0B, qfB, sa, 0, 0, 0); sb = __builtin_amdgcn_mfma_f32_32x32x16_bf16(k1B, qfB, sb, 0, 0, 0); SB();
            ATT_LDQK(0, 3, qfB, k0B, k1B); SB();
            sa = __builtin_amdgcn_mfma_f32_32x32x16_bf16(k0A, qfA, sa, 0, 0, 0); sb = __builtin_amdgcn_mfma_f32_32x32x16_bf16(k1A, qfA, sb, 0, 0, 0); SB();
            sa = __builtin_amdgcn_mfma_f32_32x32x16_bf16(k0B, qfB, sa, 0, 0, 0); sb = __builtin_amdgcn_mfma_f32_32x32x16_bf16(k1B, qfB, sb, 0, 0, 0); }
        SB();
        if constexpr (SAFE) ATT_SMA(sa, sb, 0, m0, l0);
        SB();
        f32x16 ta = f32x16{}, tb = f32x16{};
        {   bf16x8 qf, k0, k1; float sum = 0.f;
            ATT_LDQK(1, 0, qf, k0, k1); SB();
#define ATT_C(d0) do { ta = __builtin_amdgcn_mfma_f32_32x32x16_bf16(k0, qf, ta, 0, 0, 0); SB(); \
            if ((d0) < 3) k0 = *(const LAS bf16x8*)(Kb + kb[((d0) + 1) & 1] + 512 * (2 + (((d0) + 1) >> 1))); \
            ATT_SMB(sa, sb, 4 * (d0) + 0, m0, sum, pw0); ATT_SMB(sa, sb, 4 * (d0) + 1, m0, sum, pw0); SB(); \
            tb = __builtin_amdgcn_mfma_f32_32x32x16_bf16(k1, qf, tb, 0, 0, 0); SB(); \
            if ((d0) < 3) { qf = *(const LAS bf16x8*)(Qs + ((4 + (d0) + 1) * 2 + hi) * 512 + r32 * 16); k1 = *(const LAS bf16x8*)(Kb + kb[((d0) + 1) & 1] + 512 * (2 + (((d0) + 1) >> 1)) + 8192); } \
            ATT_SMB(sa, sb, 4 * (d0) + 2, m0, sum, pw0); ATT_SMB(sa, sb, 4 * (d0) + 3, m0, sum, pw0); SB(); } while (0)
            ATT_C(0); ATT_C(1); ATT_C(2); ATT_C(3);
#undef ATT_C
            l0 += sum; }
        if constexpr (SAFE) ATT_SMA(ta, tb, 1, m1, l1);
        SB();
        {   s16x4 loA, hhA, loB, hhB, loC, hhC; float sum = 0.f;
            ATT_LDV(0, loA, hhA); ATT_LDV(1, loB, hhB); SB();
#define ATT_E(i, LOc, HHc, LOn, HHn) do { if ((i) + 2 < 16) ATT_LDV((i) + 2, LOn, HHn); SB(); \
            o[0][(i) & 3] = __builtin_amdgcn_mfma_f32_32x32x16_bf16(ATT_PA(pw0, (i) >> 2), ATT_VF(LOc, HHc), o[0][(i) & 3], 0, 0, 0); SB(); ATT_SMB(ta, tb, i, m1, sum, pw1); SB(); } while (0)
            ATT_E(0, loA, hhA, loC, hhC); ATT_E(1, loB, hhB, loA, hhA); ATT_E(2, loC, hhC, loB, hhB);
            ATT_E(3, loA, hhA, loC, hhC); ATT_E(4, loB, hhB, loA, hhA); ATT_E(5, loC, hhC, loB, hhB);
            ATT_E(6, loA, hhA, loC, hhC); ATT_E(7, loB, hhB, loA, hhA); ATT_E(8, loC, hhC, loB, hhB);
            ATT_E(9, loA, hhA, loC, hhC); ATT_E(10, loB, hhB, loA, hhA); ATT_E(11, loC, hhC, loB, hhB);
            ATT_E(12, loA, hhA, loC, hhC); ATT_E(13, loB, hhB, loA, hhA); ATT_E(14, loC, hhC, loB, hhB);
            ATT_E(15, loA, hhA, loC, hhC);
#undef ATT_E
            l1 += sum; }
#pragma unroll
        for (int ks = 0; ks < 4; ++ks) {
            s16x4 lo[4], hh[4];
#pragma unroll
            for (int d = 0; d < 4; ++d) ATT_LDV(4 * ks + d, lo[d], hh[d]);
#pragma unroll
            for (int d = 0; d < 4; ++d) o[1][d] = __builtin_amdgcn_mfma_f32_32x32x16_bf16(ATT_PA(pw1, ks), ATT_VF(lo[d], hh[d]), o[1][d], 0, 0, 0);
            SB();
        }
        asm volatile("s_waitcnt vmcnt(0)" ::: "memory");
        __syncthreads();
    }
#undef ATT_SMB
#undef ATT_SMA
#undef ATT_LDQK
#undef ATT_LDV
#undef ATT_VF
#undef ATT_PA
#undef SB
#undef ATT_GROW
#undef ATT_DMA
    l0 = half_sum(l0); l1 = half_sum(l1);
    const bool ok = SAFE || !__any(!(l0 > 7.9e-31f && l0 < 1.26e30f && l1 > 7.9e-31f && l1 < 1.26e30f));
    if (hi == 0) { wsf[r32] = 1.0f / l0; wsf[32 + r32] = P.lam / l1; }
    float ss[16];
#pragma unroll
    for (int r = 0; r < 16; ++r) ss[r] = 0.f;
#pragma unroll
    for (int g4 = 0; g4 < 4; ++g4) { const f32x4 a4 = *(const LAS f32x4*)(wsf + 8 * g4 + 4 * hi), b4 = *(const LAS f32x4*)(wsf + 32 + 8 * g4 + 4 * hi);
#pragma unroll
        for (int d = 0; d < 4; ++d)
#pragma unroll
            for (int e = 0; e < 4; ++e) { const float v = o[0][d][4 * g4 + e] * a4[e] - o[1][d][4 * g4 + e] * b4[e]; o[0][d][4 * g4 + e] = v; ss[4 * g4 + e] += v * v; } }
#pragma unroll
    for (int r = 0; r < 16; ++r) {
        float v = ss[r];
#pragma unroll
        for (int s = 1; s < 32; s <<= 1) v += __shfl_xor(v, s);
        ss[r] = (1.0f / sqrtf(v * (1.0f / 128.0f) + SUBLN_EPS)) * P.post;
    }
    {   int l2; asm volatile("v_mbcnt_lo_u32_b32 %0, -1, 0\n\tv_mbcnt_hi_u32_b32 %0, -1, %0" : "=v"(l2));
        const int c2 = l2 & 31, h2 = l2 >> 5;
        LAS unsigned short* stg = (LAS unsigned short*)(lds + QOFF + wid * 8192) + h2 * 4 * 128 + c2;
#pragma unroll
        for (int d = 0; d < 4; ++d) { const float gs = P.gsub[32 * d + c2];
#pragma unroll
            for (int r = 0; r < 16; ++r) { const float v = o[0][d][r] * ss[r] * gs; stg[((r & 3) + 8 * (r >> 2)) * 128 + 32 * d] = (unsigned short)(cvt_pk_bf16(v, 0.f) & 0xffffu); }
            __builtin_amdgcn_sched_barrier(0); }
        const LAS unsigned char* rd = lds + QOFF + wid * 8192 + (l2 >> 4) * 256 + (l2 & 15) * 16;
        bf16_t* Ow = P.O + (size_t)(q0 + wid * 32 + (l2 >> 4)) * D + h * 128 + (l2 & 15) * 8;
#pragma unroll
        for (int i = 0; i < 8; ++i) { const u32x4 v = *(const LAS u32x4*)(rd + i * 1024); *(u32x4*)(Ow + (size_t)i * 4 * D) = v; } }
    __builtin_amdgcn_s_setprio(0);
    __syncthreads();
    return ok;
}
__device__ __forceinline__ void unit_checked(LAS unsigned char* lds, const Args& P, int b, int h, int q0, int nlat, int tid) {
    volatile LAS unsigned* flag = (volatile LAS unsigned*)(lds + MISC_OFF) + 16;
    const bool ok = unit<false>(lds, P, b, h, q0, nlat, tid);
    if (!ok && (tid & 63) == 0) *flag = 1u;
    __syncthreads();
    const unsigned f = *flag;
    __syncthreads();
    if (f) { if (tid == 0) *flag = 0u; (void)unit<true>(lds, P, b, h, q0, nlat, tid); }
}
}

struct ThinArgs {
    const void* xin_lat; const void* xin_ctx;
    int xin_bf16, xout_bf16;
    const bf16_t* y;
    void* xout_lat; void* xout_ctx;
    const float* g_post; const float* gate;
    bf16_t* uout;
    const float* g_pre; const float* sc; const float* sh;
    const bf16_t* yc; int nslab;
    int nrows; int gb_lo;
};
__device__ __forceinline__ void thin_phase(const ThinArgs& T, LAS unsigned char* lds, int bx, int G, int tid, int wave, int lane) {
    (void)G;
    LAS float* tab0 = (LAS float*)lds; LAS float* tab1 = tab0 + 3 * D;
    f32x4 xvb[2][8]; u32x2 xrb[2][8]; u32x2 yrb[2][8];
#define THIN_LOAD(ctx, row_, XV, XR, YR) do { const size_t xo_ = (ctx) ? (size_t)((row_) - ML) * D : (size_t)(row_) * D; \
        if (T.xin_bf16) { const bf16_t* xr_ = (const bf16_t*)((ctx) ? T.xin_ctx : T.xin_lat) + xo_; _Pragma("unroll") for (int j = 0; j < 8; ++j) XR[j] = *(const u32x2*)(xr_ + 256 * j + 4 * lane); } \
        else { const float* xr_ = (const float*)((ctx) ? T.xin_ctx : T.xin_lat) + xo_; _Pragma("unroll") for (int j = 0; j < 8; ++j) XV[j] = *(const f32x4*)(xr_ + 256 * j + 4 * lane); } \
        if (T.y && !((ctx) && T.nslab > 0)) { const bf16_t* yr_ = T.y + (size_t)(row_) * D; _Pragma("unroll") for (int j = 0; j < 8; ++j) YR[j] = __builtin_nontemporal_load((const u32x2*)(yr_ + 256 * j + 4 * lane)); } } while (0)
#define THIN_TABLES(gb, TB) do { const int c4 = 4 * tid; LAS float* ta = (TB); LAS float* tg = ta + D; LAS float* ts = tg + D;     \
        if (T.y) { const f32x4 g = *(const f32x4*)(T.g_post + c4), a = *(const f32x4*)(T.gate + (size_t)(gb) * MODROW + c4); *(LAS f32x4*)(ta + c4) = a * g; } \
        if (T.uout) { const f32x4 g = *(const f32x4*)(T.g_pre + c4), s = *(const f32x4*)(T.sc + (size_t)(gb) * MODROW + c4), h = *(const f32x4*)(T.sh + (size_t)(gb) * MODROW + c4); \
            *(LAS f32x4*)(tg + c4) = g * (s + 1.0f); *(LAS f32x4*)(ts + c4) = h; } } while (0)
#define THIN_ROW(ctx, row, xv, xraw, yraw, TB) do { const LAS float* ta = (TB); const LAS float* tg = ta + D; const LAS float* ts = tg + D; \
        if (T.xin_bf16) { _Pragma("unroll") for (int j = 0; j < 8; ++j) { const u32x2 v = xraw[j]; xv[j][0] = __uint_as_float(v.x << 16); xv[j][1] = __uint_as_float(v.x & 0xffff0000u); xv[j][2] = __uint_as_float(v.y << 16); xv[j][3] = __uint_as_float(v.y & 0xffff0000u); } } \
        if (T.y) { f32x4 yv[8]; float s = 0.f; \
            if ((ctx) && T.nslab > 0) { const bf16_t* yr = T.yc + (size_t)((row) - ML) * D; \
                _Pragma("unroll") for (int j = 0; j < 8; ++j) { const u32x2 v = __builtin_nontemporal_load((const u32x2*)(yr + 256 * j + 4 * lane)); \
                    yv[j][0] = __uint_as_float(v.x << 16); yv[j][1] = __uint_as_float(v.x & 0xffff0000u); yv[j][2] = __uint_as_float(v.y << 16); yv[j][3] = __uint_as_float(v.y & 0xffff0000u); } \
                _Pragma("unroll 1") for (int sl = 1; sl < T.nslab; ++sl) { yr += (size_t)MC * D; \
                    _Pragma("unroll") for (int j = 0; j < 8; ++j) { const u32x2 v = __builtin_nontemporal_load((const u32x2*)(yr + 256 * j + 4 * lane)); \
                        yv[j][0] += __uint_as_float(v.x << 16); yv[j][1] += __uint_as_float(v.x & 0xffff0000u); yv[j][2] += __uint_as_float(v.y << 16); yv[j][3] += __uint_as_float(v.y & 0xffff0000u); } } \
            } else { _Pragma("unroll") for (int j = 0; j < 8; ++j) { const u32x2 v = yraw[j]; \
                    yv[j][0] = __uint_as_float(v.x << 16); yv[j][1] = __uint_as_float(v.x & 0xffff0000u); yv[j][2] = __uint_as_float(v.y << 16); yv[j][3] = __uint_as_float(v.y & 0xffff0000u); } } \
            _Pragma("unroll") for (int j = 0; j < 8; ++j) s += (yv[j][0] * yv[j][0] + yv[j][1] * yv[j][1]) + (yv[j][2] * yv[j][2] + yv[j][3] * yv[j][3]); \
            const float rs = 1.0f / sqrtf(wave_sum(s) * (1.0f / D) + NORM_EPS); \
            _Pragma("unroll") for (int j = 0; j < 8; ++j) { const f32x4 a = *(const LAS f32x4*)(ta + 256 * j + 4 * lane); xv[j] = xv[j] + a * (yv[j] * rs); } \
            void* xob = (ctx) ? T.xout_ctx : T.xout_lat; const size_t xoo = (ctx) ? (size_t)((row) - ML) * D : (size_t)(row) * D; \
            if (xob) { \
                if (T.xout_bf16) { bf16_t* xo = (bf16_t*)xob + xoo;        \
                    _Pragma("unroll") for (int j = 0; j < 8; ++j) { u32x2 w; w.x = cvt_pk_bf16(xv[j][0], xv[j][1]); w.y = cvt_pk_bf16(xv[j][2], xv[j][3]); __builtin_nontemporal_store(w, (u32x2*)(xo + 256 * j + 4 * lane)); \
                        xv[j][0] = __uint_as_float(w.x << 16); xv[j][1] = __uint_as_float(w.x & 0xffff0000u); xv[j][2] = __uint_as_float(w.y << 16); xv[j][3] = __uint_as_float(w.y & 0xffff0000u); } \
                } else { float* xo = (float*)xob + xoo; _Pragma("unroll") for (int j = 0; j < 8; ++j) *(f32x4*)(xo + 256 * j + 4 * lane) = xv[j]; } } } \
        if (T.uout) { float s = 0.f; \
            _Pragma("unroll") for (int j = 0; j < 8; ++j) s += (xv[j][0] * xv[j][0] + xv[j][1] * xv[j][1]) + (xv[j][2] * xv[j][2] + xv[j][3] * xv[j][3]); \
            const float rs = 1.0f / sqrtf(wave_sum(s) * (1.0f / D) + NORM_EPS); \
            bf16_t* uo = T.uout + (size_t)(row) * D; \
            _Pragma("unroll") for (int j = 0; j < 8; ++j) { const f32x4 g = *(const LAS f32x4*)(tg + 256 * j + 4 * lane), c = *(const LAS f32x4*)(ts + 256 * j + 4 * lane); \
                const f32x4 u = (xv[j] * rs) * g + c; \
                u32x2 w; w.x = cvt_pk_bf16(u[0], u[1]); w.y = cvt_pk_bf16(u[2], u[3]); *(u32x2*)(uo + 256 * j + 4 * lane) = w; } } } while (0)
    const bool has_ctx = T.nrows > ML, my_ctx = has_ctx && wave < 4;
    const int gb = bx >> 6, rbase = gb * SEQ + (bx & 63) * 32 + wave * 4, crow = ML + bx * 4 + (wave & 3);
    if (T.gb_lo == 0) THIN_LOAD(false, rbase, xvb[0], xrb[0], yrb[0]); else if (my_ctx) THIN_LOAD(true, crow, xvb[0], xrb[0], yrb[0]);
    if (T.gb_lo == 0) THIN_TABLES(gb, tab0);
    if (has_ctx) THIN_TABLES(4, tab1);
    __syncthreads();
    if (T.gb_lo == 0) {
#pragma unroll
        for (int i = 0; i < 4; ++i) {
            if (i + 1 < 4) THIN_LOAD(false, rbase + i + 1, xvb[(i + 1) & 1], xrb[(i + 1) & 1], yrb[(i + 1) & 1]);
            else if (my_ctx) THIN_LOAD(true, crow, xvb[0], xrb[0], yrb[0]);
            THIN_ROW(false, rbase + i, xvb[i & 1], xrb[i & 1], yrb[i & 1], tab0);
        }
    }
    if (my_ctx) THIN_ROW(true, crow, xvb[0], xrb[0], yrb[0], tab1);
    __syncthreads();
#undef THIN_LOAD
#undef THIN_TABLES
#undef THIN_ROW
}
template <int W>
__device__ __forceinline__ void pool_sub(const bf16_t* Useq, bf16_t* Dseq, int t0, int Ls) {
    constexpr int H = W / 2, NR = 8 + W - 1;
    u32x2 rows[NR];
#pragma unroll
    for (int k = 0; k < NR; ++k) { const int tt = t0 - H + k; const bool ok = tt >= 0 && tt < Ls; const int tc = tt < 0 ? 0 : (tt >= Ls ? Ls - 1 : tt);
        const u32x2 v = *(const u32x2*)(Useq + (size_t)tc * D); rows[k].x = ok ? v.x : 0u; rows[k].y = ok ? v.y : 0u; }
#pragma unroll
    for (int i = 0; i < 8; ++i) { const int t = t0 + i; int lo = t - H, hi = lo + W; lo = lo < 0 ? 0 : lo; hi = hi > Ls ? Ls : hi;
        f32x4 s = {0.f, 0.f, 0.f, 0.f};
#pragma unroll
        for (int k = 0; k < W; ++k) { const u32x2 v = rows[i + k];
            s[0] += __uint_as_float(v.x << 16); s[1] += __uint_as_float(v.x & 0xffff0000u); s[2] += __uint_as_float(v.y << 16); s[3] += __uint_as_float(v.y & 0xffff0000u); }
        const u32x2 cv = rows[i + H]; const float inv = 1.0f / (float)(hi - lo);
        f32x4 d; d[0] = s[0] * inv - __uint_as_float(cv.x << 16); d[1] = s[1] * inv - __uint_as_float(cv.x & 0xffff0000u); d[2] = s[2] * inv - __uint_as_float(cv.y << 16); d[3] = s[3] * inv - __uint_as_float(cv.y & 0xffff0000u);
        u32x2 o; o.x = cvt_pk_bf16(d[0], d[1]); o.y = cvt_pk_bf16(d[2], d[3]);
        *(u32x2*)(Dseq + (size_t)t * D) = o; }
}
__device__ __forceinline__ void pool_phase(const bf16_t* U, bf16_t* Dm, int nrows, int bx, int wave, int lane) {
    const int coff = 256 * wave + 4 * lane;
    {   const int b = bx >> 6, t00 = (bx & 63) * 32; const bf16_t* Us = U + (size_t)b * SEQ * D + coff; bf16_t* Ds = Dm + (size_t)b * SEQ * D + coff;
#pragma unroll 1
        for (int sb = 0; sb < 4; ++sb) { const int t0 = t00 + 8 * sb;
            switch (wave >> 1) { case 0: pool_sub<2>(Us, Ds, t0, SEQ); break; case 1: pool_sub<4>(Us, Ds, t0, SEQ); break; case 2: pool_sub<8>(Us, Ds, t0, SEQ); break; default: pool_sub<16>(Us, Ds, t0, SEQ); break; } } }
    if (nrows > ML) {
        if (wave < 4) { const int sbi = bx >> 1, j = 4 * (bx & 1) + wave, r0 = sbi * 8, cb = r0 >> 8, t0 = r0 & 255; const int co = 256 * j + 4 * lane;
            const bf16_t* Us = U + (size_t)(ML + cb * CL) * D + co; bf16_t* Ds = Dm + (size_t)(ML + cb * CL) * D + co;
            switch (j >> 1) { case 0: pool_sub<2>(Us, Ds, t0, CL); break; case 1: pool_sub<4>(Us, Ds, t0, CL); break; case 2: pool_sub<8>(Us, Ds, t0, CL); break; default: pool_sub<16>(Us, Ds, t0, CL); break; } } }
}

struct TrDesc { const float* src; bf16_t* dst; int N, K; int perm; };
__device__ __forceinline__ void tr_load(const TrDesc& d, f32x4 (&v)[16], int lane) {
    const int kq = lane >> 4, n4 = lane & 15;
#pragma unroll
    for (int i = 0; i < 16; ++i) v[i] = __builtin_nontemporal_load((const f32x4*)(d.src + (size_t)(4 * i + kq) * d.N + 4 * n4));
}
__device__ __forceinline__ void tr_store(const TrDesc& d, const f32x4 (&v)[16], LAS float* scr, int lane) {
    const int kq = lane >> 4, n4 = lane & 15;
#pragma unroll
    for (int i = 0; i < 16; ++i) { LAS float* s = scr + (4 * i + kq) * 65 + 4 * n4; s[0] = v[i][0]; s[1] = v[i][1]; s[2] = v[i][2]; s[3] = v[i][3]; }
    asm volatile("s_waitcnt lgkmcnt(0)" ::: "memory");
    const int c = lane & 7;
#pragma unroll
    for (int j = 0; j < 8; ++j) { const int n = (lane >> 3) + 8 * j; int sc = n;
        if (d.perm) { const int jj = n >> 1, which = n & 1, ax = jj >> 4, f = jj & 15; sc = ax * 32 + which * 16 + f; }
        const LAS float* s = scr + (8 * c) * 65 + sc;
        u32x4 o; o.x = cvt_pk_bf16(s[0 * 65], s[1 * 65]); o.y = cvt_pk_bf16(s[2 * 65], s[3 * 65]); o.z = cvt_pk_bf16(s[4 * 65], s[5 * 65]); o.w = cvt_pk_bf16(s[6 * 65], s[7 * 65]);
        *(u32x4*)(d.dst + (size_t)n * d.K + 8 * c) = o; }
    asm volatile("s_waitcnt lgkmcnt(0)" ::: "memory");
}

struct Params {
    const float* in[22];
    float* out; unsigned char* ws;
    float lam_init0, lam_init3;
    int ph_lo, ph_hi;
};

template <int PART>
__device__ __forceinline__ void prologue(const Params& P, LAS unsigned char* lds, int tid, int wave, int lane, int vcu, int G) {
    unsigned char* ws = P.ws;
    const float* c_in = P.in[1]; const float* cctx = P.in[3]; const float* w_mod = P.in[4]; const float* b_mod = P.in[5];
    LAS float* sil = (LAS float*)lds;
    LAS float* red = (LAS float*)(lds + 65536);
    for (int i = tid; i < 5 * D; i += NTHR) { const int r = i / D, k = i % D; const float x = r < 4 ? c_in[r * D + k] : cctx[k]; sil[k * 8 + r] = x / (1.0f + __expf(-x)); }
    __syncthreads();
    float* mod = (float*)(ws + WS_MOD);
    for (int item = (PART == 1 ? 192 : 0) + blockIdx.x; item < (PART == 0 ? 192 : 4 * 192); item += G) {
        const int l = item / 192, col = (item % 192) * 64 + lane;
        const float* W = w_mod + (size_t)l * D * MODROW + col;
        float a0 = 0.f, a1 = 0.f, a2 = 0.f, a3 = 0.f, a4 = 0.f;
        const int k0 = wave * 256;
        for (int kk = 0; kk < 256; kk += 32) {
            float w[32];
#pragma unroll
            for (int j = 0; j < 32; ++j) w[j] = __builtin_nontemporal_load(W + (size_t)(k0 + kk + j) * MODROW);
#pragma unroll
            for (int j = 0; j < 32; ++j) { const f32x4 s4 = *(const LAS f32x4*)(sil + (k0 + kk + j) * 8); const float s5 = sil[(k0 + kk + j) * 8 + 4];
                a0 += s4[0] * w[j]; a1 += s4[1] * w[j]; a2 += s4[2] * w[j]; a3 += s4[3] * w[j]; a4 += s5 * w[j]; }
        }
        red[(wave * 5 + 0) * 64 + lane] = a0; red[(wave * 5 + 1) * 64 + lane] = a1; red[(wave * 5 + 2) * 64 + lane] = a2; red[(wave * 5 + 3) * 64 + lane] = a3; red[(wave * 5 + 4) * 64 + lane] = a4;
        __syncthreads();
        if (wave < 5) { float s = b_mod[l * MODROW + col];
#pragma unroll
            for (int w8 = 0; w8 < 8; ++w8) s += red[(w8 * 5 + wave) * 64 + lane];
            mod[((size_t)l * 5 + wave) * MODROW + col] = s; }
        __syncthreads();
    }
    LAS float* scr = (LAS float*)(lds + wave * 16640);
    const int gw = vcu * NWAVES + wave, NGW = G * NWAVES;
    bf16_t* Wqkv = (bf16_t*)(ws + WS_WQKV); bf16_t* Wo = (bf16_t*)(ws + WS_WO); bf16_t* Wf = (bf16_t*)(ws + WS_WF); bf16_t* Wp = (bf16_t*)(ws + WS_WPOOL);
    bf16_t* W1 = (bf16_t*)(ws + WS_W1); bf16_t* W2 = (bf16_t*)(ws + WS_W2);
    constexpr int I_QKV = (D / 64) * (3 * D / 64), I_O = (D / 64) * (D / 64), I_P = 8 * 8, I_1 = (D / 64) * (FF / 64), I_2 = (FF / 64) * (D / 64);
    constexpr int NITEMS = 2 * I_QKV + 2 * I_O + I_O + 4 * I_P + 4 * I_1 + 4 * I_2;
    auto decode = [&](int it) -> TrDesc {
        int r = it; const float* W; bf16_t* WT; int K, N, perm = 0;
        if (r < 2 * I_QKV) { const int ia = r / I_QKV; r %= I_QKV; W = P.in[10] + (size_t)ia * D * 3 * D; WT = Wqkv + (size_t)ia * 3 * D * D; K = D; N = 3 * D; perm = (r % (3 * D / 64)) < 2 * D / 64; }
        else if ((r -= 2 * I_QKV) < 2 * I_O) { const int ia = r / I_O; r %= I_O; W = P.in[11] + (size_t)ia * D * D; WT = Wo + (size_t)ia * D * D; K = D; N = D; }
        else if ((r -= 2 * I_O) < I_O) { W = P.in[17]; WT = Wf; K = D; N = D; }
        else if ((r -= I_O) < 4 * I_P) { const int g = r / I_P; r %= I_P; W = P.in[18] + (size_t)g * 512 * 512; WT = Wp + (size_t)g * 512 * 512; K = 512; N = 512; }
        else if ((r -= 4 * I_P) < 4 * I_1) { const int l = r / I_1; r %= I_1; W = P.in[20] + (size_t)l * D * FF; WT = W1 + (size_t)l * FF * D; K = D; N = FF; }
        else { r -= 4 * I_1; const int l = r / I_2; r %= I_2; W = P.in[21] + (size_t)l * FF * D; WT = W2 + (size_t)l * D * FF; K = FF; N = D; }
        const int nblk = N / 64, k0 = 64 * (r / nblk), n0 = 64 * (r % nblk);
        TrDesc d; d.src = W + (size_t)k0 * N + n0; d.dst = WT + (size_t)n0 * K + k0; d.N = N; d.K = K; d.perm = perm; return d; };
    {   const int it_end = (PART == 0 ? I_QKV : NITEMS); int it = (PART == 1 ? I_QKV : 0) + gw;
        f32x4 va[16], vb[16]; TrDesc da, db;
        if (it < it_end) { da = decode(it); tr_load(da, va, lane); }
        while (it < it_end) {
            const bool hb = it + NGW < it_end; if (hb) { db = decode(it + NGW); tr_load(db, vb, lane); }
            tr_store(da, va, scr, lane);
            if (!hb) break;
            const bool ha = it + 2 * NGW < it_end; if (ha) { da = decode(it + 2 * NGW); tr_load(da, va, lane); }
            tr_store(db, vb, scr, lane);
            if (!ha) break;
            it += 2 * NGW;
        } }
    if constexpr (PART != 1) {
        const int gt = gw * 64 + lane, NGT = NGW * 64; float* rope = (float*)(ws + WS_ROPE);
        for (int i = gt; i < 64 * 16; i += NGT) { const int pos = i >> 4, f = i & 15; const float inv = 1.0f / powf(10000.0f, (float)f * (1.0f / 16.0f)); const float ang = (float)pos * inv;
            rope[2 * i] = cosf(ang); rope[2 * i + 1] = sinf(ang); }
    }
    if constexpr (PART != 0) {   bf16_t* T1 = (bf16_t*)(ws + WS_T1); bf16_t* A2 = (bf16_t*)(ws + WS_A2); bf16_t* A2C = (bf16_t*)(ws + WS_A2C);
        constexpr int C_T1 = 1024 * 512 / 8, C_A2 = 2048 * 4096 / 8, C_A2C = 256 * 512 / 8;
        const int gt = gw * 64 + lane, NGT = NGW * 64;
        for (int ch = gt; ch < C_T1 + C_A2 + C_A2C; ch += NGT) {
            int r = ch; bf16_t* dst; int row, col0, N, ncol; float scale; bool negsin;
            if (r < C_T1) { row = r / 64; col0 = (r % 64) * 8; dst = T1 + (size_t)row * 512 + col0; N = 512; scale = 0.04419417382415922f; negsin = false;
                const int cs = row >> 9, k2 = row & 511; float vals[8];
#pragma unroll
                for (int e = 0; e < 8; ++e) { const int idx = (k2 * (col0 + e)) & 511; const float a = (float)idx * (1.0f / 256.0f); vals[e] = (cs ? sinpif(a) : cospif(a)) * scale; }
                u32x4 o; o.x = cvt_pk_bf16(vals[0], vals[1]); o.y = cvt_pk_bf16(vals[2], vals[3]); o.z = cvt_pk_bf16(vals[4], vals[5]); o.w = cvt_pk_bf16(vals[6], vals[7]); *(u32x4*)dst = o; continue; }
            r -= C_T1;
            if (r < C_A2) { row = r / 512; col0 = (r % 512) * 8; dst = A2 + (size_t)row * 4096 + col0; N = 2048; scale = 0.022097086912079608f; }
            else { r -= C_A2; row = r / 64; col0 = (r % 64) * 8; dst = A2C + (size_t)row * 512 + col0; N = 256; scale = 0.0625f; }
            (void)ncol; (void)negsin;
            { const int cs = col0 / N, n0 = col0 % N; float vals[8];
#pragma unroll
              for (int e = 0; e < 8; ++e) { const int idx = (row * (n0 + e)) & (N - 1); const float a = (float)idx * (2.0f / (float)N); vals[e] = (cs ? -sinpif(a) : cospif(a)) * scale; }
              u32x4 o; o.x = cvt_pk_bf16(vals[0], vals[1]); o.y = cvt_pk_bf16(vals[2], vals[3]); o.z = cvt_pk_bf16(vals[4], vals[5]); o.w = cvt_pk_bf16(vals[6], vals[7]); *(u32x4*)dst = o; }
        }
    }
}

struct Ctx { LAS unsigned char* lds; int tid, lane, wave, G, bx, vcu, gw, NGW; };
#if MK_MULTI
#define GRID_BAR() do { } while (0)
#else
#define GRID_BAR() xcd_barrier(bar)
#endif
#define PH_BEGIN(k) if ((k) >= P.ph_lo && (k) < P.ph_hi) {
#define PH_END(k)   if ((k) + 1 < P.ph_hi) GRID_BAR(); }
#define WSP(T, off) ((T*)(P.ws + (off)))

#ifndef FUSE_T
#define FUSE_T 0
#endif
template <int L> struct LayerCfg {
    static constexpr int kind = L % 3; static constexpr bool lastl = (L == 3);
    static constexpr int NMIX = (kind == 2) ? 1 : 2;
    static constexpr bool fuse_mid = FUSE_T && kind != 2, fuse_post = FUSE_T;
    static constexpr bool has_tmid = !(fuse_mid && lastl), has_tpost = !(fuse_post && lastl);
    static constexpr int o_mix = NMIX, o_tmid = o_mix + 1, o_w1 = o_tmid + (has_tmid ? 1 : 0), o_w2 = o_w1 + (lastl ? 1 : 0), o_tpost = o_w2 + 1, nph = o_tpost + (has_tpost ? 1 : 0);
};
#define GEMM_CALL(S, E) do { int tid_ = C.tid; asm volatile("" : "+v"(tid_)); pg8::gemm_phase(lds, S, E, tid_); } while (0)

template <int L, int PH0>
__device__ __forceinline__ void layer(const Params& P, const Ctx& C, const XcdBarrier& bar) {
    using CF = LayerCfg<L>;
    constexpr int kind = CF::kind; constexpr bool lastl = CF::lastl;
    constexpr int Mact = lastl ? ML : MT;
    LAS unsigned char* lds = C.lds;
    const float* modl = WSP(const float, WS_MOD) + (size_t)L * 5 * MODROW; float* X = WSP(float, WS_X); bf16_t* XB = WSP(bf16_t, WS_X);
    if constexpr (kind == 0) {
        constexpr int ia = L / 3;
        PH_BEGIN(PH0)
        { pg8::Sched S{}; S.A = (const char*)WSP(bf16_t, WS_U); S.B = (const char*)(WSP(bf16_t, WS_WQKV) + (size_t)ia * 3 * D * D); S.lda = D * 2; S.ldb = D * 2; S.nt = D / 64;
          S.nM = (lastl ? ML : MT) / 256; S.nN = 3 * D / 256; S.ngroups = 1; S.a_g = 0; S.b_g = 0; S.G = C.G; S.c = C.bx;
          pg8::EpiQKV E{WSP(bf16_t, WS_Q), WSP(const float, WS_ROPE), 0, 0};
          GEMM_CALL(S, E);
          if constexpr (lastl) {
              pg8::Sched S2 = S; S2.A = (const char*)(WSP(bf16_t, WS_U) + (size_t)ML * D); S2.B = S.B + (size_t)D * D * 2; S2.nM = MC / 256; S2.nN = 2 * D / 256;
              pg8::EpiQKV E2{WSP(bf16_t, WS_Q), WSP(const float, WS_ROPE), ML / 256, D / 256};
              GEMM_CALL(S2, E2); } }
        PH_END(PH0)
        PH_BEGIN(PH0 + 1)
        { const float* lq1 = P.in[12] + ia * 64; const float* lk1 = P.in[13] + ia * 64; const float* lq2 = P.in[14] + ia * 64; const float* lk2 = P.in[15] + ia * 64;
          const float d1 = wave_sum(lq1[C.lane] * lk1[C.lane]), d2 = wave_sum(lq2[C.lane] * lk2[C.lane]);
          const float li = (L == 0) ? P.lam_init0 : P.lam_init3;
          att::Args A{WSP(bf16_t, WS_Q), WSP(bf16_t, WS_K), WSP(bf16_t, WS_V), WSP(bf16_t, WS_O), P.in[16] + ia * 128, expf(d1) - expf(d2) + li, 1.0f - li};
          constexpr int nlat_units = NB * NH * (SEQ / 256);
          const int per = (nlat_units + C.G - 1) / C.G;
#pragma unroll 1
          for (int i = 0; i < per; ++i) { const int uu = C.vcu * per + i; if (uu < nlat_units) { const int bh = uu >> 3, qb = uu & 7; int tid_ = C.tid; asm volatile("" : "+v"(tid_)); att::unit_checked(lds, A, bh >> 4, bh & 15, (bh >> 4) * SEQ + qb * 256, SEQ / 64, tid_); } }
          if constexpr (!lastl) { for (int uc = C.bx; uc < NB * NH; uc += C.G) { const int b = uc >> 4, h = uc & 15; int tid_ = C.tid; asm volatile("" : "+v"(tid_)); att::unit_checked(lds, A, b, h, ML + b * CL, 0, tid_); } } }
        PH_END(PH0 + 1)
    } else if constexpr (kind == 1) {
        PH_BEGIN(PH0)
        { pg8::Sched S{}; S.A = (const char*)WSP(bf16_t, WS_T1); S.B = (const char*)WSP(bf16_t, WS_U); S.lda = 512 * 2; S.ldb = D * 2; S.nt = 8; S.nM = 4; S.nN = Mact / 256; S.ngroups = 4; S.a_g = 0; S.b_g = 512 * 2; S.G = C.G; S.c = C.bx;
          pg8::EpiFA E{WSP(bf16_t, WS_YT), WSP(bf16_t, WS_YTC)};
          GEMM_CALL(S, E); }
        PH_END(PH0)
        PH_BEGIN(PH0 + 1)
        { pg8::Sched S{}; S.A = (const char*)WSP(bf16_t, WS_A2); S.B = (const char*)WSP(bf16_t, WS_YT); S.lda = 4096 * 2; S.ldb = 16384 * 2; S.nt = 64; S.nM = 8; S.nN = 8; S.ngroups = 4; S.a_g = 0; S.b_g = 4096 * 2; S.G = C.G; S.c = C.bx;
          pg8::EpiBf16<0> E{WSP(bf16_t, WS_O), (unsigned)D, SEQ};
          GEMM_CALL(S, E);
          if constexpr (!lastl) { pg8::Sched S2{}; S2.A = (const char*)WSP(bf16_t, WS_A2C); S2.B = (const char*)WSP(bf16_t, WS_YTC); S2.lda = 512 * 2; S2.ldb = 2048 * 2; S2.nt = 8; S2.nM = 1; S2.nN = 8; S2.ngroups = 4; S2.a_g = 0; S2.b_g = 512 * 2; S2.G = C.G; S2.c = C.bx;
            pg8::EpiBf16<0> E2{WSP(bf16_t, WS_O) + (size_t)ML * D, (unsigned)D, CL};
            GEMM_CALL(S2, E2); } }
        PH_END(PH0 + 1)
    } else {
        PH_BEGIN(PH0) pool_phase(WSP(bf16_t, WS_U), WSP(bf16_t, WS_O), Mact, C.bx, C.wave, C.lane); PH_END(PH0)
    }
    PH_BEGIN(PH0 + CF::o_mix)
    { pg8::Sched S{}; S.A = (const char*)WSP(bf16_t, WS_O); S.lda = D * 2; S.G = C.G; S.c = C.bx;
      if constexpr (kind == 2) { S.B = (const char*)WSP(bf16_t, WS_WPOOL); S.ldb = 512 * 2; S.nt = 8; S.nM = Mact / 256; S.nN = 2; S.ngroups = 4; S.a_g = 512 * 2; S.b_g = 512 * 512 * 2;
          pg8::EpiY E{WSP(bf16_t, WS_Y), (unsigned)D, P.in[19], 512, 0}; GEMM_CALL(S, E); }
      else { S.B = kind == 0 ? (const char*)(WSP(bf16_t, WS_WO) + (size_t)(L / 3) * D * D) : (const char*)WSP(bf16_t, WS_WF); S.ldb = D * 2; S.nt = D / 64; S.nM = ML / 256; S.nN = D / 256; S.ngroups = 1;
          if constexpr (CF::fuse_mid) {
              pg8::EpiFuse E{L == 0 ? P.in[0] : X, X, WSP(bf16_t, WS_U), modl + 2 * D, P.in[7] + L * D, P.in[8] + L * D, modl + 4 * D, modl + 3 * D,
                             WSP(unsigned long long, WS_SLOT), WSP(unsigned, WS_CTL) + CW_FUSE + (2 * L) * 2048, WSP(unsigned, WS_CTL) + CW_TMO};
              GEMM_CALL(S, E);
          } else { pg8::EpiY E{WSP(bf16_t, WS_Y), (unsigned)D, nullptr, 0, 0}; GEMM_CALL(S, E); }
          if constexpr (!lastl) { pg8::Sched S2 = S; S2.A = (const char*)(WSP(bf16_t, WS_O) + (size_t)ML * D); S2.nt = D / 64 / NSPLIT; S2.nM = MC / 256; S2.ngroups = NSPLIT; S2.a_g = (D / NSPLIT) * 2; S2.b_g = (D / NSPLIT) * 2;
              pg8::EpiSlab E2{WSP(bf16_t, WS_YC), (unsigned)D, (size_t)MC * D}; GEMM_CALL(S2, E2); } } }
    PH_END(PH0 + CF::o_mix)
    if constexpr (CF::has_tmid) {
    PH_BEGIN(PH0 + CF::o_tmid)
    { ThinArgs T{}; T.xin_lat = L == 0 ? (const void*)P.in[0] : (const void*)XB; T.xin_ctx = L == 0 ? (const void*)P.in[2] : (const void*)(XB + (size_t)ML * D); T.xin_bf16 = L == 0 ? 0 : 1; T.y = WSP(const bf16_t, WS_Y); T.xout_lat = XB; T.xout_ctx = XB + (size_t)ML * D; T.xout_bf16 = 1;
      T.yc = WSP(const bf16_t, WS_YC); T.nslab = (kind == 2 || lastl) ? 0 : NSPLIT;
      T.g_post = P.in[7] + L * D; T.gate = modl + 2 * D; T.uout = WSP(bf16_t, WS_U); T.g_pre = P.in[8] + L * D; T.sc = modl + 4 * D; T.sh = modl + 3 * D; T.nrows = Mact; T.gb_lo = CF::fuse_mid ? 4 : 0;
      thin_phase(T, C.lds, C.bx, C.G, C.tid, C.wave, C.lane); }
    PH_END(PH0 + CF::o_tmid)
    }
    if constexpr (lastl) {
    PH_BEGIN(PH0 + CF::o_w1)
    { pg8::Sched S{}; S.A = (const char*)WSP(bf16_t, WS_U); S.B = (const char*)(WSP(bf16_t, WS_W1) + (size_t)L * FF * D); S.lda = D * 2; S.ldb = D * 2; S.nt = D / 64; S.nM = Mact / 256; S.nN = FF / 256; S.ngroups = 1; S.G = C.G; S.c = C.bx;
      pg8::EpiBf16<1> E{WSP(bf16_t, WS_H), (unsigned)FF, 0}; GEMM_CALL(S, E); }
    PH_END(PH0 + CF::o_w1)
    PH_BEGIN(PH0 + CF::o_w2)
    { pg8::Sched S{}; S.A = (const char*)WSP(bf16_t, WS_H); S.B = (const char*)(WSP(bf16_t, WS_W2) + (size_t)L * D * FF); S.lda = FF * 2; S.ldb = FF * 2; S.nt = FF / 64; S.nM = ML / 256; S.nN = D / 256; S.ngroups = 1; S.G = C.G; S.c = C.bx;
      if constexpr (CF::fuse_post) {
          const float* modn = modl + 5 * MODROW;
          pg8::EpiFuse E{X, lastl ? P.out : X, lastl ? nullptr : WSP(bf16_t, WS_U), modl + 5 * D, P.in[9] + L * D, lastl ? nullptr : P.in[6] + (L + 1) * D, modn + 1 * D, modn + 0 * D,
                         WSP(unsigned long long, WS_SLOT), WSP(unsigned, WS_CTL) + CW_FUSE + (2 * L + 1) * 2048, WSP(unsigned, WS_CTL) + CW_TMO};
          GEMM_CALL(S, E);
      } else { pg8::EpiY E{WSP(bf16_t, WS_Y), (unsigned)D, nullptr, 0, 0}; GEMM_CALL(S, E); }
      if constexpr (!lastl) { pg8::Sched S2 = S; S2.A = (const char*)(WSP(bf16_t, WS_H) + (size_t)ML * FF); S2.nt = FF / 64 / NSPLIT; S2.nM = MC / 256; S2.ngroups = NSPLIT; S2.a_g = (FF / NSPLIT) * 2; S2.b_g = (FF / NSPLIT) * 2;
          pg8::EpiSlab E2{WSP(bf16_t, WS_YC), (unsigned)D, (size_t)MC * D}; GEMM_CALL(S2, E2); } }
    PH_END(PH0 + CF::o_w2)
    } else {
    PH_BEGIN(PH0 + CF::o_w1)
    { unsigned* ho = WSP(unsigned, WS_CTL) + CW_HO + L * 64;
      constexpr int NCT = (MC / 256) * (FF / 256);
      const bool late = (C.bx & 7) < 4; const int hc = (C.bx >> 3) * 4 + (C.bx & 3);
      static_assert(NCT == 128, "context W1 tiles = half of the 256 workgroups");
      { pg8::Sched S{}; S.A = (const char*)WSP(bf16_t, WS_U); S.B = (const char*)(WSP(bf16_t, WS_W1) + (size_t)L * FF * D); S.lda = D * 2; S.ldb = D * 2; S.nt = D / 64; S.nM = ML / 256; S.nN = FF / 256; S.ngroups = 1; S.G = C.G; S.c = C.bx;
        pg8::EpiBf16<1> E{WSP(bf16_t, WS_H), (unsigned)FF, 0}; GEMM_CALL(S, E);
        ho_arrive(ho);
        pg8::Sched S2 = S; S2.A = (const char*)(WSP(bf16_t, WS_U) + (size_t)ML * D); S2.nM = MC / 256; S2.G = NCT; S2.c = late ? hc : (1 << 24);
        pg8::EpiBf16<1> E2{WSP(bf16_t, WS_H) + (size_t)ML * FF, (unsigned)FF, 0}; GEMM_CALL(S2, E2);
        if (late) ho_arrive(ho + 32); }
      ho_wait(ho, (unsigned)C.G, bar.bar);
      { pg8::Sched S{}; S.A = (const char*)WSP(bf16_t, WS_H); S.B = (const char*)(WSP(bf16_t, WS_W2) + (size_t)L * D * FF); S.lda = FF * 2; S.ldb = FF * 2; S.nt = FF / 64; S.nM = ML / 256; S.nN = D / 256; S.ngroups = 1; S.G = C.G; S.c = C.bx;
        pg8::EpiY E{WSP(bf16_t, WS_Y), (unsigned)D, nullptr, 0, 0}; GEMM_CALL(S, E);
        if (!late) ho_wait(ho + 32, (unsigned)NCT, bar.bar);
        pg8::Sched S2 = S; S2.A = (const char*)(WSP(bf16_t, WS_H) + (size_t)ML * FF); S2.nt = FF / 64 / NSPLIT; S2.nM = MC / 256; S2.ngroups = NSPLIT; S2.a_g = (FF / NSPLIT) * 2; S2.b_g = (FF / NSPLIT) * 2;
        S2.G = C.G - NCT; S2.c = late ? (1 << 24) : hc;
        pg8::EpiSlab E2{WSP(bf16_t, WS_YC), (unsigned)D, (size_t)MC * D}; GEMM_CALL(S2, E2); } }
    PH_END(PH0 + CF::o_w1)
    }
    if constexpr (CF::has_tpost) {
    PH_BEGIN(PH0 + CF::o_tpost)
    { ThinArgs T{}; T.xin_lat = XB; T.xin_ctx = XB + (size_t)ML * D; T.xin_bf16 = 1; T.y = WSP(const bf16_t, WS_Y); T.xout_lat = lastl ? (void*)P.out : (void*)XB; T.xout_ctx = XB + (size_t)ML * D; T.xout_bf16 = lastl ? 0 : 1;
      T.yc = WSP(const bf16_t, WS_YC); T.nslab = lastl ? 0 : NSPLIT;
      T.g_post = P.in[9] + L * D; T.gate = modl + 5 * D; T.nrows = Mact; T.gb_lo = CF::fuse_post ? 4 : 0;
      if constexpr (!lastl) { const float* modn = modl + 5 * MODROW; T.uout = WSP(bf16_t, WS_U); T.g_pre = P.in[6] + (L + 1) * D; T.sc = modn + 1 * D; T.sh = modn + 0 * D; }
      thin_phase(T, C.lds, C.bx, C.G, C.tid, C.wave, C.lane); }
    PH_END(PH0 + CF::o_tpost)
    }
}
constexpr int PH_L0 = 2, PH_L1 = PH_L0 + LayerCfg<0>::nph, PH_L2 = PH_L1 + LayerCfg<1>::nph, PH_L3 = PH_L2 + LayerCfg<2>::nph, N_PHASES = PH_L3 + LayerCfg<3>::nph;

__global__ void __launch_bounds__(NTHR, 2) fwd_kernel(Params P) {
    extern __shared__ __attribute__((aligned(16))) unsigned char lds_raw[];
    Ctx C; C.lds = (LAS unsigned char*)lds_raw;
    C.tid = threadIdx.x; C.lane = C.tid & 63; C.wave = __builtin_amdgcn_readfirstlane(C.tid >> 6);
    C.G = gridDim.x; C.bx = blockIdx.x; C.vcu = (C.G % 8 == 0) ? (C.bx % 8) * (C.G / 8) + C.bx / 8 : C.bx;
    C.gw = C.vcu * NWAVES + C.wave; C.NGW = C.G * NWAVES;
    for (int u = C.tid; u < (LDS_BYTES - LDSCTL_OFF) / 4; u += NTHR) ((LAS unsigned*)(C.lds + LDSCTL_OFF))[u] = 0u;
    __syncthreads();
#if MK_MULTI
    XcdBarrier bar{}; bar.bar = WSP(unsigned, WS_CTL) + CW_BAR;
#else
    XcdBarrier bar = xcd_barrier_post(WSP(unsigned, WS_CTL) + CW_BAR, (volatile LAS unsigned*)(C.lds + MISC_OFF) + 8);
#endif
    PH_BEGIN(0) prologue<2>(P, C.lds, C.tid, C.wave, C.lane, C.vcu, C.G); PH_END(0)
#if !MK_MULTI
    if (P.ph_lo == 0 && P.ph_hi > 1) {
        volatile LAS unsigned* st = (volatile LAS unsigned*)(C.lds + MISC_OFF) + 8;
        if (C.tid == 0) { unsigned* bw = WSP(unsigned, WS_CTL) + CW_BAR; bool okc = (C.G % 8 == 0);
            for (unsigned j = 0; j < 16; ++j) { const unsigned cnt = xb_ld(&bw[XB_XCNT(j)]); okc = okc && (cnt == (j < 8 ? (unsigned)C.G / 8u : 0u)); }
            st[3] = okc ? st[2] * 8u + bar.x : (unsigned)blockIdx.x; }
        __syncthreads();
        C.bx = (int)st[3]; C.vcu = (C.G % 8 == 0) ? (C.bx % 8) * (C.G / 8) + C.bx / 8 : C.bx; C.gw = C.vcu * NWAVES + C.wave;
    }
#endif
    PH_BEGIN(1)
    { const float* mod = WSP(const float, WS_MOD);
      ThinArgs T{}; T.xin_lat = P.in[0]; T.xin_ctx = P.in[2]; T.y = nullptr; T.uout = WSP(bf16_t, WS_U); T.g_pre = P.in[6]; T.sc = mod + 1 * D; T.sh = mod + 0 * D; T.nrows = MT;
      thin_phase(T, C.lds, C.bx, C.G, C.tid, C.wave, C.lane); }
    PH_END(1)
    layer<0, PH_L0>(P, C, bar);
    layer<1, PH_L1>(P, C, bar);
    layer<2, PH_L2>(P, C, bar);
    layer<3, PH_L3>(P, C, bar);
}
#undef PH_BEGIN
#undef PH_END
#undef GRID_BAR

extern "C" void kernel_launch(void* const* d_in, const int* in_sizes, int n_in, void* d_out, int out_size, void* d_ws, size_t ws_size, hipStream_t stream) {
    static int grid = 0;
    if (grid == 0) {
        if (n_in != 22 || out_size != ML * D || ws_size < WS_END) { fprintf(stderr, "kernel_launch: unexpected problem: n_in %d out %d ws %zu (need %zu)\n", n_in, out_size, ws_size, (size_t)WS_END); grid = -1; return; }
        int dev = 0, cus = 0, per_cu = 0;
        if (hipGetDevice(&dev) != hipSuccess || hipDeviceGetAttribute(&cus, hipDeviceAttributeMultiprocessorCount, dev) != hipSuccess) { grid = -1; return; }
        if (hipFuncSetAttribute((const void*)fwd_kernel, hipFuncAttributeMaxDynamicSharedMemorySize, LDS_BYTES) != hipSuccess) { fprintf(stderr, "kernel_launch: hipFuncSetAttribute failed\n"); grid = -1; return; }
        if (hipOccupancyMaxActiveBlocksPerMultiprocessor(&per_cu, (const void*)fwd_kernel, NTHR, LDS_BYTES) != hipSuccess || per_cu < 1) fprintf(stderr, "kernel_launch: occupancy query says %d\n", per_cu);
        (void)hipGetLastError();
        if (cus < 256) { fprintf(stderr, "kernel_launch: %d CUs; this kernel is built for a 256-CU device (one workgroup per CU, fused epilogues pair 8 workgroups per row panel)\n", cus); grid = -1; return; }
        grid = 256;
    }
    if (grid < 0) return;
    (void)in_sizes;
    hipMemsetAsync((char*)d_ws + WS_CTL, 0, CTL_BYTES, stream);
    Params p{};
    for (int i = 0; i < 22; ++i) p.in[i] = (const float*)d_in[i];
    p.out = (float*)d_out; p.ws = (unsigned char*)d_ws;
    p.lam_init0 = (float)(0.8 - 0.6 * exp(-0.3 * 0.0)); p.lam_init3 = (float)(0.8 - 0.6 * exp(-0.3 * 3.0));
#if MK_MULTI
    for (int ph = 0; ph < N_PHASES; ++ph) { p.ph_lo = ph; p.ph_hi = ph + 1; hipLaunchKernelGGL(fwd_kernel, dim3(grid), dim3(NTHR), LDS_BYTES, stream, p); }
#else
    p.ph_lo = 0; p.ph_hi = N_PHASES;
    hipLaunchKernelGGL(fwd_kernel, dim3(grid), dim3(NTHR), LDS_BYTES, stream, p);
#endif
    const hipError_t le = hipPeekAtLastError();
    if (le != hipSuccess) fprintf(stderr, "kernel_launch: launch failed: %s\n", hipGetErrorName(le));
}
```

```cpp
#include <hip/hip_runtime.h>
#include <cstdio>
#include <cstdint>
#include <cmath>

#ifndef MK_MULTI
#define MK_MULTI 0
#endif

#define LAS __attribute__((address_space(3)))
#define GAS __attribute__((address_space(1)))
typedef unsigned short bf16_t;
typedef short bf16x8 __attribute__((ext_vector_type(8)));
typedef short s16x4 __attribute__((ext_vector_type(4)));
typedef float f32x4 __attribute__((ext_vector_type(4)));
typedef float f32x2 __attribute__((ext_vector_type(2)));
typedef float f32x16 __attribute__((ext_vector_type(16)));
typedef unsigned u32x4 __attribute__((ext_vector_type(4)));
typedef unsigned u32x2 __attribute__((ext_vector_type(2)));

constexpr int D = 2048, NB = 4, SEQ = 2048, CL = 256, ML = NB * SEQ, MC = NB * CL, MT = ML + MC, FF = 8192, NH = 16, NMOD = 6, MODROW = NMOD * D;
constexpr int NWAVES = 8, NTHR = 512;
constexpr float NORM_EPS = 1e-6f, SUBLN_EPS = 1e-5f;
constexpr float QSCALE = 0.125f * 1.4426950408889634f;

constexpr size_t MiB = 1u << 20;
constexpr size_t WS_CTL = 0, CTL_BYTES = 1 * MiB;
constexpr size_t WS_MOD = 1 * MiB;
constexpr size_t WS_ROPE = 2 * MiB;
constexpr size_t WS_T1 = 3 * MiB;
constexpr size_t WS_A2C = 4 * MiB;
constexpr size_t WS_A2 = 5 * MiB;
constexpr size_t WS_WQKV = 22 * MiB;
constexpr size_t WS_WO = 70 * MiB;
constexpr size_t WS_WF = 86 * MiB;
constexpr size_t WS_WPOOL = 94 * MiB;
constexpr size_t WS_W1 = 96 * MiB;
constexpr size_t WS_W2 = 224 * MiB;
constexpr size_t WS_X = 352 * MiB;
constexpr size_t WS_Y = 424 * MiB;
constexpr size_t WS_U = 496 * MiB;
constexpr size_t WS_Q = 532 * MiB, WS_K = 568 * MiB, WS_V = 604 * MiB, WS_O = 640 * MiB;
constexpr size_t WS_H = 676 * MiB;
constexpr size_t WS_YT = 820 * MiB;
constexpr size_t WS_YTC = 884 * MiB;
constexpr size_t WS_YC = 892 * MiB;
constexpr size_t WS_SLOT = 956 * MiB;
constexpr size_t WS_END = 958 * MiB;
constexpr int NSPLIT = 8;

constexpr int RING_BYTES = 131072, LDSCTL_OFF = 139264  , MISC_OFF = LDSCTL_OFF + 320, LDS_BYTES = 147456;

__device__ __forceinline__ unsigned cvt_pk_bf16(float lo, float hi) { unsigned r; asm volatile("v_cvt_pk_bf16_f32 %0, %1, %2" : "=v"(r) : "v"(lo), "v"(hi)); return r; }
typedef __bf16 bf16x2v_t __attribute__((ext_vector_type(2)));
__device__ __forceinline__ unsigned cvt_pk_vis(float lo, float hi) { const f32x2 v = {lo, hi}; const bf16x2v_t b = __builtin_convertvector(v, bf16x2v_t); return __builtin_bit_cast(unsigned, b); }
__device__ __forceinline__ float bf2f(unsigned short b) { return __uint_as_float(((unsigned)b) << 16); }
__device__ __forceinline__ float wave_sum(float v) {
#pragma unroll
    for (int o = 1; o < 64; o <<= 1) v += __shfl_xor(v, o);
    return v;
}

#define XB_TMO      128
#define XB_XCNT(j)  (256  + 64 * (j))
#define XB_XSUB(j)  (1280 + 64 * (j))
#define XB_XGEN(j)  (2304 + 64 * (j))
#define XB_TOP      3328
#define XB_TOPGEN   3392
#define XCD_BAR_WORDS 3456
#define XB_SPIN_CAP (1u << 18)
constexpr int CW_BAR = 4096, CW_FUSE = 16384, CW_TMO = 8;

__device__ __forceinline__ unsigned xb_ld(unsigned* p)              { return __hip_atomic_load(p, __ATOMIC_RELAXED, __HIP_MEMORY_SCOPE_AGENT); }
__device__ __forceinline__ unsigned xb_add(unsigned* p, unsigned v) { return __hip_atomic_fetch_add(p, v, __ATOMIC_RELAXED, __HIP_MEMORY_SCOPE_AGENT); }
__device__ __forceinline__ unsigned xb_xcc_id() { return (unsigned)__builtin_amdgcn_s_getreg((3 << 11) | 20) & 0xFu; }
#define XB_SPIN(cond, bar) do { unsigned _sp = 0; while (cond) { __builtin_amdgcn_s_sleep(1); \
    if ((++_sp & 255u) == 0u) { if (xb_ld(&(bar)[XB_TMO])) break; if (_sp > XB_SPIN_CAP) { atomicAdd(&(bar)[XB_TMO], 1u); break; } } } } while (0)

struct XcdBarrier { unsigned* bar; unsigned x; volatile LAS unsigned* st; };

__device__ __forceinline__ XcdBarrier xcd_barrier_post(unsigned* bar, volatile LAS unsigned* st) {
    XcdBarrier b; b.bar = bar; b.x = xb_xcc_id(); b.st = st;
    if (threadIdx.x == 0) st[2] = xb_add(&bar[XB_XCNT(b.x)], 1u);
    return b;
}
__device__ __forceinline__ void xcd_barrier_complete(unsigned* bar, unsigned x, unsigned& nloc, unsigned& nx) {
    const unsigned G = gridDim.x * gridDim.y * gridDim.z;
    unsigned sum, cnt, mine, sp = 0u;
    for (;;) {
        sum = 0u; cnt = 0u; mine = 0u;
#pragma unroll
        for (unsigned j = 0; j < 16; ++j) { const unsigned c = xb_ld(&bar[XB_XCNT(j)]); sum += c; cnt += (c > 0u) ? 1u : 0u; mine = (j == x) ? c : mine; }
        if (sum == G) break;
        __builtin_amdgcn_s_sleep(1);
        if ((++sp & 255u) == 0u) { if (xb_ld(&bar[XB_TMO])) break; if (sp > XB_SPIN_CAP) { atomicAdd(&bar[XB_TMO], 1u); break; } }
    }
    nloc = mine > 0u ? mine : 1u; nx = cnt > 0u ? cnt : 1u;
}
__device__ __forceinline__ void xcd_barrier(const XcdBarrier& b) {
    asm volatile("s_waitcnt vmcnt(0)" ::: "memory");
    __syncthreads();
    if (threadIdx.x == 0) {
        unsigned* bar = b.bar;
        __builtin_amdgcn_s_waitcnt(0);
        unsigned nloc = b.st[0], nx = b.st[1];
        if (nloc == 0u) { xcd_barrier_complete(bar, b.x, nloc, nx); b.st[0] = nloc; b.st[1] = nx; }
        const unsigned old = xb_add(&bar[XB_XSUB(b.x)], 1u);
        const unsigned gen = old / nloc;
        if (old + 1u == (gen + 1u) * nloc) {
            __builtin_amdgcn_fence(__ATOMIC_RELEASE, "agent");
            asm volatile("s_waitcnt vmcnt(0)" ::: "memory");
            const unsigned og = xb_add(&bar[XB_TOP], 1u);
            const unsigned tg = og / nx;
            if (og + 1u == (tg + 1u) * nx) xb_add(&bar[XB_TOPGEN], 1u);
            else XB_SPIN(xb_ld(&bar[XB_TOPGEN]) == tg, bar);
            __builtin_amdgcn_fence(__ATOMIC_ACQUIRE, "agent");
            xb_add(&bar[XB_XGEN(b.x)], 1u);
            asm volatile("s_waitcnt vmcnt(0)" ::: "memory");
        } else {
            XB_SPIN(xb_ld(&bar[XB_XGEN(b.x)]) == gen, bar);
            __builtin_amdgcn_fence(__ATOMIC_ACQUIRE, "agent");
            asm volatile("s_waitcnt vmcnt(0)" ::: "memory");
        }
    }
    __syncthreads();
}

namespace pg8 {
constexpr int BM = 256, BK = 64, HALF = 128, HTB = HALF * BK * 2, STAGE_BYTES = 8 * HTB, NXCD = 8, WGM = 8;
__device__ __forceinline__ int lds_byte(int r, int c) { const int st = (r >> 4) * 2 + (c >> 5), rr = r & 15, cc = c & 31, ob = rr * 64 + cc * 2; return st * 1024 + (ob ^ (((ob >> 9) & 1) << 5)); }
__device__ __forceinline__ void stage_rc(int b, int& R, int& C) { const int st = b / 1024, sb = b % 1024, swz = sb ^ (((sb >> 9) & 1) << 5); R = (st >> 1) * 16 + swz / 64; C = (st & 1) * 32 + (swz % 64) / 2; }
__device__ __forceinline__ int perm32(int rho) { const int n = rho >> 4, i = rho & 15; return 8 * (i >> 2) + 4 * n + (i & 3); }

struct Unit { const char* A; const char* B; int g, pm, pn; };

struct Sched {
    const char* A; const char* B; unsigned lda, ldb; int nt;
    int nM, nN, ngroups; long long a_g, b_g;
    int G, c;
    __device__ __forceinline__ bool next(int i, Unit& u) const {
        const int per = nM * nN, nwg = per * ngroups;
        const long L = (long)i * G + c; if (L >= nwg) return false;
        int wgid = (int)L; { const int q = nwg / NXCD, r = nwg % NXCD, xcd = wgid % NXCD, off = wgid / NXCD; wgid = (xcd < r ? xcd * (q + 1) : r * (q + 1) + (xcd - r) * q) + off; }
        const int g = wgid / per, w = wgid % per;
        const int nig = WGM * nN, gid = w / nig, fm = gid * WGM, gsz = (nM - fm) < WGM ? (nM - fm) : WGM;
        u.g = g; u.pm = fm + ((w % nig) % gsz); u.pn = (w % nig) / gsz;
        u.A = A + (long long)g * a_g + (size_t)u.pm * BM * lda; u.B = B + (long long)g * b_g + (size_t)u.pn * BM * ldb;
        return true;
    }
};

template <class Epi>
__device__ __forceinline__ void gemm_phase(LAS unsigned char* lds, const Sched& S, const Epi& E, int tid_in = -1) {
    const int tid = tid_in >= 0 ? tid_in : (int)threadIdx.x, wid = __builtin_amdgcn_readfirstlane(tid >> 6), lane = tid & 63, wr = wid >> 2, wc = wid & 3, fr = lane & 15, fq = lane >> 4;
    const int nt = S.nt;
    unsigned voffA[2], voffB[2];
#pragma unroll
    for (int i = 0; i < 2; ++i) { int R, C; stage_rc(tid * 16 + i * 8192, R, C); const int Rb = (R & ~31) + perm32(R & 31);
        voffA[i] = (unsigned)R * S.lda + (unsigned)C * 2u; voffB[i] = (unsigned)Rb * S.ldb + (unsigned)C * 2u; }
    const size_t kstep = (size_t)(BK * 2);
    const size_t hA = (size_t)HALF * S.lda, hB = (size_t)HALF * S.ldb;
    const unsigned ldsw = (unsigned)wid * 1024u;
    const int aoff = lds_byte(wr * 64 + fr, fq * 8), boff = lds_byte(wc * 32 + fr, fq * 8);
#define PG8_SA(b, h) (((b) * 2 + (h)) * HTB)
#define PG8_SB(b, h) ((4 + (b) * 2 + (h)) * HTB)
#define PG8_STAGE(bufoff, gbase, voff) do { _Pragma("unroll") for (int _i = 0; _i < 2; ++_i) \
        __builtin_amdgcn_global_load_lds((const unsigned*)((const char*)(gbase) + (voff)[_i]), (LAS unsigned*)(lds + (bufoff) + ldsw + _i * 8192), 16, 0, 0); } while (0)
#define PG8_LDA(dst, b, h) do { _Pragma("unroll") for (int m = 0; m < 4; ++m) _Pragma("unroll") for (int k = 0; k < 2; ++k) dst[m][k] = *(const LAS bf16x8*)(lds + PG8_SA(b, h) + aoff + m * 2048 + k * 1024); } while (0)
#define PG8_LDB(dst, b, h) do { _Pragma("unroll") for (int n = 0; n < 2; ++n) _Pragma("unroll") for (int k = 0; k < 2; ++k) dst[n][k] = *(const LAS bf16x8*)(lds + PG8_SB(b, h) + boff + n * 2048 + k * 1024); } while (0)
#define PG8_MMA(ai, bj, At, Bt) do { __builtin_amdgcn_s_setprio(1); _Pragma("unroll") for (int m = 0; m < 4; ++m) _Pragma("unroll") for (int n = 0; n < 2; ++n) _Pragma("unroll") for (int k = 0; k < 2; ++k) \
        acc[ai][bj][m][n] = __builtin_amdgcn_mfma_f32_16x16x32_bf16(Bt[n][k], At[m][k], acc[ai][bj][m][n], 0, 0, 0); __builtin_amdgcn_s_setprio(0); } while (0)
#define PG8_WAIT_V(n) asm volatile("s_waitcnt vmcnt(" #n ")" ::: "memory")
#define PG8_WAIT_L(n) asm volatile("s_waitcnt lgkmcnt(" #n ")" ::: "memory")
#define PG8_BAR __builtin_amdgcn_s_barrier()
#define PG8_SCHED __builtin_amdgcn_sched_barrier(0)
    Unit cur, nxt; int ui = 0;
    if (!S.next(0, cur)) return;
    f32x4 acc[2][2][4][2];
#pragma unroll
    for (int a = 0; a < 2; ++a)
#pragma unroll
        for (int b = 0; b < 2; ++b)
#pragma unroll
            for (int m = 0; m < 4; ++m)
#pragma unroll
                for (int n = 0; n < 2; ++n) acc[a][b][m][n] = (f32x4){0.f, 0.f, 0.f, 0.f};
    bf16x8 At[4][2], B0[2][2], B1[2][2];
    const char* cA = cur.A; const char* cB = cur.B;
    PG8_STAGE(PG8_SB(0, 0), cB, voffB); PG8_STAGE(PG8_SB(0, 1), cB + hB, voffB); PG8_STAGE(PG8_SA(0, 0), cA, voffA); PG8_STAGE(PG8_SA(0, 1), cA + hA, voffA);
    if (wr == 1) PG8_BAR;
    PG8_WAIT_V(2); PG8_BAR;
    PG8_STAGE(PG8_SB(1, 0), cB + kstep, voffB); PG8_STAGE(PG8_SA(1, 0), cA + kstep, voffA); PG8_STAGE(PG8_SB(1, 1), cB + hB + kstep, voffB);
    PG8_WAIT_V(6); PG8_BAR;
    for (;;) {
        const bool has_next = S.next(ui + 1, nxt);
        const char* nA = has_next ? nxt.A : cA; const char* nB = has_next ? nxt.B : cB;
        for (int t = 0; t < nt; t += 2) {
            const bool last = (t == nt - 2);
            const char* a1 = cA + (size_t)(t + 1) * kstep;
            const char* a2 = last ? nA : cA + (size_t)(t + 2) * kstep; const char* b2 = last ? nB : cB + (size_t)(t + 2) * kstep;
            const char* a3 = a2 + kstep; const char* b3 = b2 + kstep;
            PG8_LDB(B0, 0, 0); PG8_LDB(B1, 0, 1); PG8_SCHED; PG8_LDA(At, 0, 0); PG8_STAGE(PG8_SA(1, 1), a1 + hA, voffA);
            PG8_WAIT_V(8); PG8_WAIT_L(0); PG8_BAR; PG8_MMA(0, 0, At, B0); PG8_MMA(0, 1, At, B1); PG8_BAR; PG8_SCHED;
            PG8_LDA(At, 0, 1); PG8_STAGE(PG8_SB(0, 0), b2, voffB); PG8_STAGE(PG8_SB(0, 1), b2 + hB, voffB); PG8_STAGE(PG8_SA(0, 0), a2, voffA);
            PG8_WAIT_V(8); PG8_WAIT_L(0); PG8_BAR; PG8_MMA(1, 0, At, B0); PG8_MMA(1, 1, At, B1); PG8_BAR; PG8_SCHED;
            PG8_LDB(B0, 1, 0); PG8_LDB(B1, 1, 1); PG8_SCHED; PG8_LDA(At, 1, 0); PG8_STAGE(PG8_SA(0, 1), a2 + hA, voffA);
            PG8_WAIT_V(8); PG8_WAIT_L(0); PG8_BAR; PG8_MMA(0, 0, At, B0); PG8_MMA(0, 1, At, B1); PG8_BAR; PG8_SCHED;
            PG8_LDA(At, 1, 1); PG8_STAGE(PG8_SB(1, 0), b3, voffB); PG8_STAGE(PG8_SB(1, 1), b3 + hB, voffB); PG8_STAGE(PG8_SA(1, 0), a3, voffA);
            PG8_WAIT_V(8); PG8_WAIT_L(0); PG8_BAR; PG8_MMA(1, 0, At, B0); PG8_MMA(1, 1, At, B1); PG8_BAR; PG8_SCHED;
        }
        if (wr == 0) PG8_BAR;
        if constexpr (!Epi::FUSED) E(acc, cur, wr, wc, fr, fq);
        if (!has_next) break;
#pragma unroll
        for (int a = 0; a < 2; ++a)
#pragma unroll
            for (int b = 0; b < 2; ++b)
#pragma unroll
                for (int m = 0; m < 4; ++m)
#pragma unroll
                    for (int n = 0; n < 2; ++n) acc[a][b][m][n] = (f32x4){0.f, 0.f, 0.f, 0.f};
        cur = nxt; cA = nA; cB = nB; ++ui;
        if (wr == 1) PG8_BAR;
    }
    PG8_WAIT_V(0);
    PG8_BAR;
    if constexpr (Epi::FUSED) E.fused(acc, cur, wr, wc, fr, fq, lds, wid, lane, tid);
#undef PG8_SA
#undef PG8_SB
#undef PG8_STAGE
#undef PG8_LDA
#undef PG8_LDB
#undef PG8_MMA
#undef PG8_WAIT_V
#undef PG8_WAIT_L
#undef PG8_BAR
#undef PG8_SCHED
}

struct EpiF32 {
    static constexpr bool FUSED = false;
    float* C; unsigned ldc; const float* colscale; int c_g; size_t slab_g;
    __device__ __forceinline__ void operator()(const f32x4 (&acc)[2][2][4][2], const Unit& u, int wr, int wc, int fr, int fq) const {
        const int row0 = u.pm * BM + wr * 64 + fr, col0 = u.g * c_g + u.pn * BM + wc * 32 + 8 * fq;
        f32x4 sv[2][2];
#pragma unroll
        for (int bj = 0; bj < 2; ++bj)
#pragma unroll
            for (int n = 0; n < 2; ++n) sv[bj][n] = colscale ? *(const f32x4*)(colscale + col0 + bj * HALF + 4 * n) : (f32x4){1.f, 1.f, 1.f, 1.f};
#pragma unroll
        for (int ai = 0; ai < 2; ++ai)
#pragma unroll
            for (int m = 0; m < 4; ++m) { float* rowp = C + (size_t)u.g * slab_g + (size_t)(row0 + ai * HALF + m * 16) * ldc + col0;
#pragma unroll
                for (int bj = 0; bj < 2; ++bj) { *(f32x4*)(rowp + bj * HALF) = acc[ai][bj][m][0] * sv[bj][0]; *(f32x4*)(rowp + bj * HALF + 4) = acc[ai][bj][m][1] * sv[bj][1]; } }
    }
};
struct EpiY {
    static constexpr bool FUSED = false;
    bf16_t* C; unsigned ldc; const float* colscale; int c_g; size_t slab_g;
    __device__ __forceinline__ void operator()(const f32x4 (&acc)[2][2][4][2], const Unit& u, int wr, int wc, int fr, int fq) const {
        const int row0 = u.pm * BM + wr * 64 + fr, col0 = u.g * c_g + u.pn * BM + wc * 32 + 8 * fq;
        f32x4 sv[2][2];
#pragma unroll
        for (int bj = 0; bj < 2; ++bj)
#pragma unroll
            for (int n = 0; n < 2; ++n) sv[bj][n] = colscale ? *(const f32x4*)(colscale + col0 + bj * HALF + 4 * n) : (f32x4){1.f, 1.f, 1.f, 1.f};
#pragma unroll
        for (int ai = 0; ai < 2; ++ai)
#pragma unroll
            for (int m = 0; m < 4; ++m) { bf16_t* rowp = C + (size_t)(row0 + ai * HALF + m * 16) * ldc + col0;
#pragma unroll
                for (int bj = 0; bj < 2; ++bj) { const f32x4 v0 = acc[ai][bj][m][0] * sv[bj][0], v1 = acc[ai][bj][m][1] * sv[bj][1];
                    u32x4 w; w.x = cvt_pk_vis(v0[0], v0[1]); w.y = cvt_pk_vis(v0[2], v0[3]); w.z = cvt_pk_vis(v1[0], v1[1]); w.w = cvt_pk_vis(v1[2], v1[3]);
                    *(u32x4*)(rowp + bj * HALF) = w; } }
    }
};
struct EpiSlab {
    static constexpr bool FUSED = false;
    bf16_t* C; unsigned ldc; size_t slab_g;
    __device__ __forceinline__ void operator()(const f32x4 (&acc)[2][2][4][2], const Unit& u, int wr, int wc, int fr, int fq) const {
        const int row0 = u.pm * BM + wr * 64 + fr, col0 = u.pn * BM + wc * 32 + 8 * fq;
#pragma unroll
        for (int ai = 0; ai < 2; ++ai)
#pragma unroll
            for (int m = 0; m < 4; ++m) { bf16_t* rowp = C + (size_t)u.g * slab_g + (size_t)(row0 + ai * HALF + m * 16) * ldc + col0;
#pragma unroll
                for (int bj = 0; bj < 2; ++bj) { const f32x4 v0 = acc[ai][bj][m][0], v1 = acc[ai][bj][m][1];
                    u32x4 w; w.x = cvt_pk_vis(v0[0], v0[1]); w.y = cvt_pk_vis(v0[2], v0[3]); w.z = cvt_pk_vis(v1[0], v1[1]); w.w = cvt_pk_vis(v1[2], v1[3]);
                    *(u32x4*)(rowp + bj * HALF) = w; } }
    }
};
template <int ACT> struct EpiBf16 {
    static constexpr bool FUSED = false;
    bf16_t* C; unsigned ldc; int row_g;
    __device__ __forceinline__ void operator()(const f32x4 (&acc)[2][2][4][2], const Unit& u, int wr, int wc, int fr, int fq) const {
        const int row0 = u.g * row_g + u.pm * BM + wr * 64 + fr, col0 = u.pn * BM + wc * 32 + 8 * fq;
#pragma unroll
        for (int ai = 0; ai < 2; ++ai)
#pragma unroll
            for (int m = 0; m < 4; ++m) { bf16_t* rowp = C + (size_t)(row0 + ai * HALF + m * 16) * ldc + col0;
#pragma unroll
                for (int bj = 0; bj < 2; ++bj) { f32x4 v0 = acc[ai][bj][m][0], v1 = acc[ai][bj][m][1];
                    if (ACT == 1) {
#pragma unroll
                        for (int e = 0; e < 4; ++e) { const float a = __builtin_amdgcn_fmed3f(v0[e], 0.f, __builtin_inff()), b = __builtin_amdgcn_fmed3f(v1[e], 0.f, __builtin_inff()); v0[e] = a * a; v1[e] = b * b; } }
                    u32x4 w; w.x = cvt_pk_vis(v0[0], v0[1]); w.y = cvt_pk_vis(v0[2], v0[3]); w.z = cvt_pk_vis(v1[0], v1[1]); w.w = cvt_pk_vis(v1[2], v1[3]);
                    *(u32x4*)(rowp + bj * HALF) = w; } }
    }
};
struct EpiFAH {
    static constexpr bool FUSED = false;
    bf16_t* YT; int cs;
    __device__ __forceinline__ void operator()(const f32x4 (&acc)[2][2][4][2], const Unit& u, int wr, int wc, int fr, int fq) const {
        bf16_t* base = YT + (size_t)(u.g * 256) * 16384 + (u.pn >> 3) * 4096 + cs * 2048 + (u.pn & 7) * 256;
        const int row0 = wr * 64 + fr, col0 = wc * 32 + 8 * fq;
#pragma unroll
        for (int ai = 0; ai < 2; ++ai)
#pragma unroll
            for (int m = 0; m < 4; ++m) { bf16_t* rowp = base + (size_t)(row0 + ai * HALF + m * 16) * 16384 + col0;
#pragma unroll
                for (int bj = 0; bj < 2; ++bj) { const f32x4 v0 = acc[ai][bj][m][0], v1 = acc[ai][bj][m][1];
                    u32x4 w; w.x = cvt_pk_vis(v0[0], v0[1]); w.y = cvt_pk_vis(v0[2], v0[3]); w.z = cvt_pk_vis(v1[0], v1[1]); w.w = cvt_pk_vis(v1[2], v1[3]);
                    *(u32x4*)(rowp + bj * HALF) = w; } }
    }
};
struct EpiFA {
    static constexpr bool FUSED = false;
    bf16_t* YT; bf16_t* YTC; int pn_base;
    __device__ __forceinline__ void operator()(const f32x4 (&acc)[2][2][4][2], const Unit& u, int wr, int wc, int fr, int fq) const {
        const int cs = u.pm >> 1, k2b = (u.pm & 1) * 256, pn = u.pn + pn_base;
        bf16_t* base; size_t pitch;
        if (pn < 32) { const int b = pn >> 3; base = YT + (size_t)(u.g * 512 + k2b) * 16384 + b * 4096 + cs * 2048 + (pn & 7) * 256; pitch = 16384; }
        else { const int b = pn - 32; base = YTC + (size_t)(u.g * 512 + k2b) * 2048 + b * 512 + cs * 256; pitch = 2048; }
        const int row0 = wr * 64 + fr, col0 = wc * 32 + 8 * fq;
#pragma unroll
        for (int ai = 0; ai < 2; ++ai)
#pragma unroll
            for (int m = 0; m < 4; ++m) { bf16_t* rowp = base + (size_t)(row0 + ai * HALF + m * 16) * pitch + col0;
#pragma unroll
                for (int bj = 0; bj < 2; ++bj) { const f32x4 v0 = acc[ai][bj][m][0], v1 = acc[ai][bj][m][1];
                    u32x4 w; w.x = cvt_pk_vis(v0[0], v0[1]); w.y = cvt_pk_vis(v0[2], v0[3]); w.z = cvt_pk_vis(v1[0], v1[1]); w.w = cvt_pk_vis(v1[2], v1[3]);
                    *(u32x4*)(rowp + bj * HALF) = w; } }
    }
};
struct EpiQKV {
    static constexpr bool FUSED = false;
    bf16_t* Q; const float* rope;
    int pm_base, pn_base;
    __device__ __forceinline__ void operator()(const f32x4 (&acc)[2][2][4][2], const Unit& u, int wr, int wc, int fr, int fq) const {
        const int pn = u.pn + pn_base, pm = u.pm + pm_base, part = pn >> 3;
        bf16_t* dst = Q + (size_t)part * ((WS_K - WS_Q) / 2);
        const int row0 = pm * BM + wr * 64 + fr, colp = (pn & 7) * BM + wc * 32 + 8 * fq;
        const bool dorope = (part < 2) && (pm < 32);
        const float sc = part == 0 ? QSCALE : 1.f;
#pragma unroll
        for (int ai = 0; ai < 2; ++ai)
#pragma unroll
            for (int m = 0; m < 4; ++m) { const int row = row0 + ai * HALF + m * 16; bf16_t* rowp = dst + (size_t)row * D + colp;
                const int t = row & 2047, prow = t >> 6, pcol = t & 63;
#pragma unroll
                for (int bj = 0; bj < 2; ++bj) { f32x4 v0 = acc[ai][bj][m][0], v1 = acc[ai][bj][m][1];
                    if (dorope) { const int c = colp + bj * HALF, j0 = (c & 63) >> 1, ax = j0 >> 4, f0 = j0 & 15;
                        const float* cs = rope + ((ax ? pcol : prow) * 16 + f0) * 2;
                        const f32x4 cs0 = *(const f32x4*)cs, cs1 = *(const f32x4*)(cs + 4);
                        f32x4 r0, r1;
                        r0[0] = v0[0] * cs0[0] - v0[1] * cs0[1]; r0[1] = v0[0] * cs0[1] + v0[1] * cs0[0];
                        r0[2] = v0[2] * cs0[2] - v0[3] * cs0[3]; r0[3] = v0[2] * cs0[3] + v0[3] * cs0[2];
                        r1[0] = v1[0] * cs1[0] - v1[1] * cs1[1]; r1[1] = v1[0] * cs1[1] + v1[1] * cs1[0];
                        r1[2] = v1[2] * cs1[2] - v1[3] * cs1[3]; r1[3] = v1[2] * cs1[3] + v1[3] * cs1[2];
                        v0 = r0; v1 = r1; }
                    v0 = v0 * sc; v1 = v1 * sc;
                    u32x4 w; w.x = cvt_pk_vis(v0[0], v0[1]); w.y = cvt_pk_vis(v0[2], v0[3]); w.z = cvt_pk_vis(v1[0], v1[1]); w.w = cvt_pk_vis(v1[2], v1[3]);
                    *(u32x4*)(rowp + bj * HALF) = w; } }
    }
};

struct EpiFuse {
    static constexpr bool FUSED = true;
    const float* xin; float* xout; bf16_t* uout;
    const float* gate; const float* g_post;
    const float* g_pre; const float* sc; const float* sh;
    unsigned long long* slots;
    unsigned* cnt; unsigned* tmo;
    __device__ __forceinline__ void operator()(const f32x4 (&)[2][2][4][2], const Unit&, int, int, int, int) const {}
    __device__ __forceinline__ void fused(f32x4 (&acc)[2][2][4][2], const Unit& u, int wr, int wc, int fr, int fq, LAS unsigned char* lds, int wid, int lane, int tid) const {
        LAS float* ta = (LAS float*)lds; LAS float* tg = ta + 256; LAS float* ts = tg + 256;
        LAS f32x4* P4 = (LAS f32x4*)(lds + 4096);
        LAS f32x2* S2 = (LAS f32x2*)(lds + 4096 + 16384);
        const int b = (u.pm * BM) >> 11, colt = u.pn * BM;
#define FZ_BAR() do { asm volatile("s_waitcnt vmcnt(0) lgkmcnt(0)" ::: "memory"); __builtin_amdgcn_s_barrier(); asm volatile("" ::: "memory"); } while (0)
        if (tid < 256) { const int c = colt + tid; ta[tid] = gate[(size_t)b * MODROW + c] * g_post[c];
            if (uout) { tg[tid] = g_pre[c] * (1.0f + sc[(size_t)b * MODROW + c]); ts[tid] = sh[(size_t)b * MODROW + c]; } }
        FZ_BAR();
#pragma unroll
        for (int ai = 0; ai < 2; ++ai)
#pragma unroll
            for (int m = 0; m < 4; ++m) { const int rl = ai * HALF + wr * 64 + m * 16 + fr; const float* xr = xin + (size_t)((u.pm * BM) + rl) * D + colt + wc * 32 + 8 * fq;
                float s1 = 0.f, s2 = 0.f, s3 = 0.f, s4 = 0.f;
#pragma unroll
                for (int bj = 0; bj < 2; ++bj)
#pragma unroll
                    for (int n = 0; n < 2; ++n) { const f32x4 y = acc[ai][bj][m][n], x = *(const f32x4*)(xr + bj * HALF + 4 * n), a = *(const LAS f32x4*)(ta + bj * HALF + wc * 32 + 8 * fq + 4 * n);
                        const f32x4 ay = a * y;
                        s1 += (y[0] * y[0] + y[1] * y[1]) + (y[2] * y[2] + y[3] * y[3]); s2 += (x[0] * x[0] + x[1] * x[1]) + (x[2] * x[2] + x[3] * x[3]);
                        s3 += (x[0] * ay[0] + x[1] * ay[1]) + (x[2] * ay[2] + x[3] * ay[3]); s4 += (ay[0] * ay[0] + ay[1] * ay[1]) + (ay[2] * ay[2] + ay[3] * ay[3]); }
                s1 += __shfl_xor(s1, 16); s1 += __shfl_xor(s1, 32); s2 += __shfl_xor(s2, 16); s2 += __shfl_xor(s2, 32);
                s3 += __shfl_xor(s3, 16); s3 += __shfl_xor(s3, 32); s4 += __shfl_xor(s4, 16); s4 += __shfl_xor(s4, 32);
                if (fq == 0) P4[rl * 4 + wc] = (f32x4){s1, s2, s3, s4};
                asm volatile("" ::: "memory"); }
        FZ_BAR();
        if (tid < 256) { const f32x4 p0 = P4[tid * 4 + 0], p1 = P4[tid * 4 + 1], p2 = P4[tid * 4 + 2], p3 = P4[tid * 4 + 3]; const f32x4 t = (p0 + p1) + (p2 + p3);
            unsigned long long* slot = slots + ((size_t)((u.pm * BM) + tid) * 8 + u.pn) * 2;
            __hip_atomic_store(slot, ((unsigned long long)__float_as_uint(t[1]) << 32) | __float_as_uint(t[0]), __ATOMIC_RELAXED, __HIP_MEMORY_SCOPE_AGENT);
            __hip_atomic_store(slot + 1, ((unsigned long long)__float_as_uint(t[3]) << 32) | __float_as_uint(t[2]), __ATOMIC_RELAXED, __HIP_MEMORY_SCOPE_AGENT); }
        asm volatile("s_waitcnt vmcnt(0)" ::: "memory");
        if (tid < 256 && lane == 0) __hip_atomic_fetch_add(cnt + 64 * u.pm, 1u, __ATOMIC_RELAXED, __HIP_MEMORY_SCOPE_AGENT);
        if (wid == 0) { const unsigned long long t0 = __builtin_amdgcn_s_memrealtime();
            for (;;) { if ((unsigned)__builtin_amdgcn_readfirstlane(__hip_atomic_load(cnt + 64 * u.pm, __ATOMIC_RELAXED, __HIP_MEMORY_SCOPE_AGENT)) >= 32u) break;
                if (__builtin_amdgcn_s_memrealtime() - t0 > 2000000ull) { if (lane == 0) __hip_atomic_store(tmo, 1u, __ATOMIC_RELAXED, __HIP_MEMORY_SCOPE_AGENT); break; }
                __builtin_amdgcn_s_sleep(2); }
            __builtin_amdgcn_fence(__ATOMIC_ACQUIRE, "agent"); }
        FZ_BAR();
        if (tid < 256) { const unsigned long long* slot = slots + (size_t)((u.pm * BM) + tid) * 16; float t1 = 0.f, t2 = 0.f, t3 = 0.f, t4 = 0.f;
#pragma unroll
            for (int t = 0; t < 8; ++t) { const unsigned long long w0 = __hip_atomic_load(slot + 2 * t, __ATOMIC_RELAXED, __HIP_MEMORY_SCOPE_AGENT), w1 = __hip_atomic_load(slot + 2 * t + 1, __ATOMIC_RELAXED, __HIP_MEMORY_SCOPE_AGENT);
                t1 += __uint_as_float((unsigned)w0); t2 += __uint_as_float((unsigned)(w0 >> 32)); t3 += __uint_as_float((unsigned)w1); t4 += __uint_as_float((unsigned)(w1 >> 32)); }
            const float r1 = 1.0f / sqrtf(t1 * (1.0f / D) + NORM_EPS);
            const float q = t2 + 2.0f * r1 * t3 + r1 * r1 * t4;
            S2[tid] = (f32x2){r1, 1.0f / sqrtf(fmaxf(q, 0.f) * (1.0f / D) + NORM_EPS)}; }
        FZ_BAR();
#pragma unroll
        for (int ai = 0; ai < 2; ++ai)
#pragma unroll
            for (int m = 0; m < 4; ++m) { const int rl = ai * HALF + wr * 64 + m * 16 + fr; const size_t off = (size_t)((u.pm * BM) + rl) * D + colt + wc * 32 + 8 * fq; const f32x2 rr = S2[rl];
#pragma unroll
                for (int bj = 0; bj < 2; ++bj) { const int cl = bj * HALF + wc * 32 + 8 * fq;
                    const f32x4 a0 = *(const LAS f32x4*)(ta + cl), a1 = *(const LAS f32x4*)(ta + cl + 4);
                    const f32x4 x0 = *(const f32x4*)(xin + off + bj * HALF) + (a0 * acc[ai][bj][m][0]) * rr[0], x1 = *(const f32x4*)(xin + off + bj * HALF + 4) + (a1 * acc[ai][bj][m][1]) * rr[0];
                    *(f32x4*)(xout + off + bj * HALF) = x0; *(f32x4*)(xout + off + bj * HALF + 4) = x1;
                    if (uout) { const f32x4 g0 = *(const LAS f32x4*)(tg + cl), g1 = *(const LAS f32x4*)(tg + cl + 4), h0 = *(const LAS f32x4*)(ts + cl), h1 = *(const LAS f32x4*)(ts + cl + 4);
                        const f32x4 u0 = (x0 * rr[1]) * g0 + h0, u1 = (x1 * rr[1]) * g1 + h1;
                        u32x4 w; w.x = cvt_pk_vis(u0[0], u0[1]); w.y = cvt_pk_vis(u0[2], u0[3]); w.z = cvt_pk_vis(u1[0], u1[1]); w.w = cvt_pk_vis(u1[2], u1[3]);
                        *(u32x4*)(uout + off + bj * HALF) = w; } }
                asm volatile("" ::: "memory"); }
        FZ_BAR();
#undef FZ_BAR
    }
};
}


namespace att {
__device__ __forceinline__ unsigned off_a(unsigned row, unsigned ch) { return 2048u * (row >> 3) + 512u * (ch >> 2) + 64u * (row & 7) + 16u * ((ch & 3) ^ ((row >> 2) & 3)); }
constexpr int KBUF = 0, VBUF = 32768, QOFF = 65536, WSF_OFF = LDSCTL_OFF + 1024;
constexpr float THR = 6.0f;
struct Args { const bf16_t* Q; const bf16_t* K; const bf16_t* V; bf16_t* O; const float* gsub; float lam, post; };
__device__ __forceinline__ s16x4 vtr(const LAS unsigned char* p) { return __builtin_bit_cast(s16x4, __builtin_amdgcn_ds_read_tr16_b64_v4i16((LAS s16x4*)p)); }
__device__ __forceinline__ float half_max(float v) { auto rr = __builtin_amdgcn_permlane32_swap(__float_as_uint(v), __float_as_uint(v), false, false); return fmaxf(__uint_as_float(rr[0]), __uint_as_float(rr[1])); }
__device__ __forceinline__ float half_sum(float v) { auto rr = __builtin_amdgcn_permlane32_swap(__float_as_uint(v), __float_as_uint(v), false, false); return __uint_as_float(rr[0]) + __uint_as_float(rr[1]); }

__device__ __forceinline__ void glds16(const void* gsrc, unsigned lds_dst) { unsigned keep;
    asm volatile("s_mov_b32 %0, m0\n\ts_mov_b32 m0, %2\n\ts_nop 0\n\tglobal_load_lds_dwordx4 %1, off\n\ts_mov_b32 m0, %0" : "=&s"(keep) : "v"(gsrc), "s"(lds_dst) : "memory"); }
__device__ __forceinline__ float max3f(float a, float b, float c) { float r; asm("v_max3_f32 %0, %1, %2, %3" : "=v"(r) : "v"(a), "v"(b), "v"(c)); return r; }
__device__ __forceinline__ float max2f(float a, float b) { float r; asm("v_max_f32_e32 %0, %1, %2" : "=v"(r) : "v"(a), "v"(b)); return r; }
__device__ __forceinline__ float fsub_s(float a, float b) { float r; asm("v_sub_f32_e32 %0, %1, %2" : "=v"(r) : "v"(a), "v"(b)); return r; }
__device__ __forceinline__ float fadd_s(float a, float b) { float r; asm("v_add_f32_e32 %0, %1, %2" : "=v"(r) : "v"(a), "v"(b)); return r; }
typedef __bf16 bf16x2_t __attribute__((ext_vector_type(2)));
__device__ __forceinline__ unsigned cvtpk_b(float lo, float hi) { const f32x2 v = {lo, hi}; const bf16x2_t b = __builtin_convertvector(v, bf16x2_t); return __builtin_bit_cast(unsigned, b); }
template <bool SAFE>
__device__ __forceinline__ bool unit(LAS unsigned char* lds, const Args& P, int b, int h, int q0, int nlat, int tid) {
    const int lane = tid & 63, r32 = lane & 31, hi = lane >> 5; const int wid = __builtin_amdgcn_readfirstlane(tid >> 6);
    const int nt = nlat + 4;
    if (wid >= 4) __builtin_amdgcn_s_setprio(1);
    LAS unsigned char* Qs = lds + QOFF + wid * 8192;
    LAS float* wsf = (LAS float*)(lds + WSF_OFF + wid * 256);
    {   const bf16_t* qrow = P.Q + (size_t)(q0 + wid * 32 + r32) * D + h * 128 + hi * 8;
#pragma unroll
        for (int c = 0; c < 2; ++c)
#pragma unroll
            for (int d0 = 0; d0 < 4; ++d0) { const u32x4 v = *(const u32x4*)(qrow + c * 64 + d0 * 16); *(LAS u32x4*)(Qs + ((c * 4 + d0) * 2 + hi) * 512 + r32 * 16) = v; } }
    unsigned goff[2];
#pragma unroll
    for (int i = 0; i < 2; ++i) { const unsigned p = 2 * wid + i, rg = p >> 1, chq = (p & 1) * 2 + (lane >> 5), r7 = (lane >> 2) & 7, x = lane & 3, rsw = (r7 >> 2) | ((rg & 1) << 1);
        goff[i] = ((8 * rg + r7) * D + h * 128 + (4 * chq + (x ^ rsw)) * 8) * 2; }
#define ATT_GROW(t) ((t) < nlat ? b * SEQ + 64 * (t) : ML + b * CL + 64 * ((t) - nlat))
#define ATT_DMA(t, buf) do { const size_t g_ = (size_t)ATT_GROW(t) * D * 2; _Pragma("unroll") for (int i_ = 0; i_ < 2; ++i_) { \
        glds16((const char*)P.K + g_ + goff[i_], (unsigned)__builtin_amdgcn_readfirstlane(lds0 + KBUF + (buf) * 16384 + (2 * wid + i_) * 1024)); \
        glds16((const char*)P.V + g_ + goff[i_], (unsigned)__builtin_amdgcn_readfirstlane(lds0 + VBUF + (buf) * 16384 + (2 * wid + i_) * 1024)); } } while (0)
    const unsigned lds0 = (unsigned)(uintptr_t)lds;
    ATT_DMA(0, 0);
    unsigned kb[2];
#pragma unroll
    for (int e = 0; e < 2; ++e) kb[e] = 2048u * (r32 >> 3) + 64u * (r32 & 7) + 16u * ((unsigned)(2 * e + hi) ^ ((r32 >> 2) & 3));
    const unsigned blk = (lane >> 4) & 1, q_ = (lane & 15) >> 2, p_ = lane & 3;
    unsigned vb[2];
#pragma unroll
    for (int t = 0; t < 2; ++t) vb[t] = 2048u * t + 64u * (4 * hi + q_) + 16u * ((2 * blk + (p_ >> 1)) ^ ((2 * t + hi) & 3)) + 8u * (p_ & 1);
    float m0 = -1e30f, m1 = -1e30f, l0 = 0.f, l1 = 0.f;
    f32x16 o[2][4];
#pragma unroll
    for (int c = 0; c < 2; ++c)
#pragma unroll
        for (int d = 0; d < 4; ++d) o[c][d] = f32x16{};
    asm volatile("s_waitcnt vmcnt(0)" ::: "memory");
    __syncthreads();
#define SB() __builtin_amdgcn_sched_barrier(0)
#define ATT_SMB(S0, S1, i, M, SUM, PW) do { const float a_ = (i) < 8 ? S0[2 * ((i) & 7)] : S1[2 * ((i) & 7)], b_ = (i) < 8 ? S0[2 * ((i) & 7) + 1] : S1[2 * ((i) & 7) + 1]; \
        const float ea_ = SAFE ? __builtin_amdgcn_exp2f(fsub_s(a_, M)) : __builtin_amdgcn_exp2f(a_), eb_ = SAFE ? __builtin_amdgcn_exp2f(fsub_s(b_, M)) : __builtin_amdgcn_exp2f(b_); \
        SUM += ea_; SUM += eb_; PW[i] = cvtpk_b(ea_, eb_); asm volatile("" : "+v"(SUM), "+v"(PW[i])); } while (0)
#define ATT_SMA(S0, S1, c, MC, LC) do { asm volatile("s_nop 15\n\ts_nop 7" : "+v"(S0), "+v"(S1)); \
        float a_ = max3f(S0[0], S0[1], S1[0]), b_ = max3f(S0[2], S0[3], S1[1]); a_ = max3f(a_, S1[2], S1[3]); \
        _Pragma("unroll") for (int r_ = 4; r_ < 16; r_ += 4) { a_ = max3f(a_, S0[r_], S0[r_ + 1]); b_ = max3f(b_, S0[r_ + 2], S0[r_ + 3]); a_ = max3f(a_, S1[r_], S1[r_ + 1]); b_ = max3f(b_, S1[r_ + 2], S1[r_ + 3]); } \
        const float mx_ = half_max(max2f(a_, b_)); \
        if (__any(mx_ - MC > THR)) { const float mn_ = fmaxf(MC, mx_), al_ = __builtin_amdgcn_exp2f(MC - mn_); MC = mn_; LC *= al_; if (hi == 0) wsf[r32] = al_; \
            _Pragma("unroll") for (int g4 = 0; g4 < 4; ++g4) { const f32x4 a4 = *(const LAS f32x4*)(wsf + 8 * g4 + 4 * hi); \
                _Pragma("unroll") for (int d = 0; d < 4; ++d) { o[c][d][4 * g4 + 0] *= a4[0]; o[c][d][4 * g4 + 1] *= a4[1]; o[c][d][4 * g4 + 2] *= a4[2]; o[c][d][4 * g4 + 3] *= a4[3]; } } } } while (0)
#define ATT_LDQK(c, d0, QF, K0, K1) do { QF = *(const LAS bf16x8*)(Qs + (((c) * 4 + (d0)) * 2 + hi) * 512 + r32 * 16); \
        K0 = *(const LAS bf16x8*)(Kb + kb[(d0) & 1] + 512 * (2 * (c) + ((d0) >> 1))); K1 = *(const LAS bf16x8*)(Kb + kb[(d0) & 1] + 512 * (2 * (c) + ((d0) >> 1)) + 8192); } while (0)
#define ATT_LDV(i, LO, HH) do { LO = vtr(Vb + vb[0] + 4096 * ((i) >> 2) + 512 * ((i) & 3)); HH = vtr(Vb + vb[1] + 4096 * ((i) >> 2) + 512 * ((i) & 3)); } while (0)
#define ATT_VF(LO, HH) ((bf16x8){LO[0], LO[1], LO[2], LO[3], HH[0], HH[1], HH[2], HH[3]})
#define ATT_PA(PW, ks) ((bf16x8)__builtin_bit_cast(bf16x8, (u32x4){PW[4 * (ks)], PW[4 * (ks) + 1], PW[4 * (ks) + 2], PW[4 * (ks) + 3]}))
#pragma unroll 1
    for (int t = 0; t < nt; ++t) {
        const int buf = t & 1;
        if (t + 1 < nt) ATT_DMA(t + 1, buf ^ 1);
        const LAS unsigned char* Kb = lds + KBUF + buf * 16384; const LAS unsigned char* Vb = lds + VBUF + buf * 16384;
        unsigned pw0[16], pw1[16];
        f32x16 sa = f32x16{}, sb = f32x16{};
        SB();
        {   bf16x8 qfA, k0A, k1A, qfB, k0B, k1B;
            ATT_LDQK(0, 0, qfA, k0A, k1A); ATT_LDQK(0, 1, qfB, k0B, k1B); SB();
            sa = __builtin_amdgcn_mfma_f32_32x32x16_bf16(k0A, qfA, sa, 0, 0, 0); sb = __builtin_amdgcn_mfma_f32_32x32x16_bf16(k1A, qfA, sb, 0, 0, 0); SB();
            ATT_LDQK(0, 2, qfA, k0A, k1A); SB();
            sa = __builtin_amdgcn_mfma_f32_32x32x16_bf16(k0B, qfB, sa, 0, 0, 0); sb = __builtin_amdgcn_mfma_f32_32x32x16_bf16(k1B, qfB, sb, 0, 0, 0); SB();
            ATT_LDQK(0, 3, qfB, k0B, k1B); SB();
            sa = __builtin_amdgcn_mfma_f32_32x32x16_bf16(k0A, qfA, sa, 0, 0, 0); sb = __builtin_amdgcn_mfma_f32_32x32x16_bf16(k1A, qfA, sb, 0, 0, 0); SB();
            sa = __builtin_amdgcn_mfma_f32_32x32x16_bf16(k0B, qfB, sa, 0, 0, 0); sb = __builtin_amdgcn_mfma_f32_32x32x16_bf16(k1B, qfB, sb, 0, 0, 0); }
        SB();
        if constexpr (SAFE) ATT_SMA(sa, sb, 0, m0, l0);
        SB();
        f32x16 ta = f32x16{}, tb = f32x16{};
        {   bf16x8 qf, k0, k1; float sum = 0.f;
            ATT_LDQK(1, 0, qf, k0, k1); SB();
#define ATT_C(d0) do { ta = __builtin_amdgcn_mfma_f32_32x32x16_bf16(k0, qf, ta, 0, 0, 0); SB(); \
            if ((d0) < 3) k0 = *(const LAS bf16x8*)(Kb + kb[((d0) + 1) & 1] + 512 * (2 + (((d0) + 1) >> 1))); \
            ATT_SMB(sa, sb, 4 * (d0) + 0, m0, sum, pw0); ATT_SMB(sa, sb, 4 * (d0) + 1, m0, sum, pw0); SB(); \
            tb = __builtin_amdgcn_mfma_f32_32x32x16_bf16(k1, qf, tb, 0, 0, 0); SB(); \
            if ((d0) < 3) { qf = *(const LAS bf16x8*)(Qs + ((4 + (d0) + 1) * 2 + hi) * 512 + r32 * 16); k1 = *(const LAS bf16x8*)(Kb + kb[((d0) + 1) & 1] + 512 * (2 + (((d0) + 1) >> 1)) + 8192); } \
            ATT_SMB(sa, sb, 4 * (d0) + 2, m0, sum, pw0); ATT_SMB(sa, sb, 4 * (d0) + 3, m0, sum, pw0); SB(); } while (0)
            ATT_C(0); ATT_C(1); ATT_C(2); ATT_C(3);
#undef ATT_C
            l0 += sum; }
        if constexpr (SAFE) ATT_SMA(ta, tb, 1, m1, l1);
        SB();
        {   s16x4 loA, hhA, loB, hhB, loC, hhC; float sum = 0.f;
            ATT_LDV(0, loA, hhA); ATT_LDV(1, loB, hhB); SB();
#define ATT_E(i, LOc, HHc, LOn, HHn) do { if ((i) + 2 < 16) ATT_LDV((i) + 2, LOn, HHn); SB(); \
            o[0][(i) & 3] = __builtin_amdgcn_mfma_f32_32x32x16_bf16(ATT_PA(pw0, (i) >> 2), ATT_VF(LOc, HHc), o[0][(i) & 3], 0, 0, 0); SB(); ATT_SMB(ta, tb, i, m1, sum, pw1); SB(); } while (0)
            ATT_E(0, loA, hhA, loC, hhC); ATT_E(1, loB, hhB, loA, hhA); ATT_E(2, loC, hhC, loB, hhB);
            ATT_E(3, loA, hhA, loC, hhC); ATT_E(4, loB, hhB, loA, hhA); ATT_E(5, loC, hhC, loB, hhB);
            ATT_E(6, loA, hhA, loC, hhC); ATT_E(7, loB, hhB, loA, hhA); ATT_E(8, loC, hhC, loB, hhB);
            ATT_E(9, loA, hhA, loC, hhC); ATT_E(10, loB, hhB, loA, hhA); ATT_E(11, loC, hhC, loB, hhB);
            ATT_E(12, loA, hhA, loC, hhC); ATT_E(13, loB, hhB, loA, hhA); ATT_E(14, loC, hhC, loB, hhB);
            ATT_E(15, loA, hhA, loC, hhC);
#undef ATT_E
            l1 += sum; }
#pragma unroll
        for (int ks = 0; ks < 4; ++ks) {
            s16x4 lo[4], hh[4];
#pragma unroll
            for (int d = 0; d < 4; ++d) ATT_LDV(4 * ks + d, lo[d], hh[d]);
#pragma unroll
            for (int d = 0; d < 4; ++d) o[1][d] = __builtin_amdgcn_mfma_f32_32x32x16_bf16(ATT_PA(pw1, ks), ATT_VF(lo[d], hh[d]), o[1][d], 0, 0, 0);
            SB();
        }
        asm volatile("s_waitcnt vmcnt(0)" ::: "memory");
        __syncthreads();
    }
#undef ATT_SMB
#undef ATT_SMA
#undef ATT_LDQK
#undef ATT_LDV
#undef ATT_VF
#undef ATT_PA
#undef SB
#undef ATT_GROW
#undef ATT_DMA
    l0 = half_sum(l0); l1 = half_sum(l1);
    const bool ok = SAFE || !__any(!(l0 > 7.9e-31f && l0 < 1.26e30f && l1 > 7.9e-31f && l1 < 1.26e30f));
    if (hi == 0) { wsf[r32] = 1.0f / l0; wsf[32 + r32] = P.lam / l1; }
    float ss[16];
#pragma unroll
    for (int r = 0; r < 16; ++r) ss[r] = 0.f;
#pragma unroll
    for (int g4 = 0; g4 < 4; ++g4) { const f32x4 a4 = *(const LAS f32x4*)(wsf + 8 * g4 + 4 * hi), b4 = *(const LAS f32x4*)(wsf + 32 + 8 * g4 + 4 * hi);
#pragma unroll
        for (int d = 0; d < 4; ++d)
#pragma unroll
            for (int e = 0; e < 4; ++e) { const float v = o[0][d][4 * g4 + e] * a4[e] - o[1][d][4 * g4 + e] * b4[e]; o[0][d][4 * g4 + e] = v; ss[4 * g4 + e] += v * v; } }
#pragma unroll
    for (int r = 0; r < 16; ++r) {
        float v = ss[r];
#pragma unroll
        for (int s = 1; s < 32; s <<= 1) v += __shfl_xor(v, s);
        ss[r] = (1.0f / sqrtf(v * (1.0f / 128.0f) + SUBLN_EPS)) * P.post;
    }
    {   int l2; asm volatile("v_mbcnt_lo_u32_b32 %0, -1, 0\n\tv_mbcnt_hi_u32_b32 %0, -1, %0" : "=v"(l2));
        const int c2 = l2 & 31, h2 = l2 >> 5;
        LAS unsigned short* stg = (LAS unsigned short*)(lds + QOFF + wid * 8192) + h2 * 4 * 128 + c2;
#pragma unroll
        for (int d = 0; d < 4; ++d) { const float gs = P.gsub[32 * d + c2];
#pragma unroll
            for (int r = 0; r < 16; ++r) { const float v = o[0][d][r] * ss[r] * gs; stg[((r & 3) + 8 * (r >> 2)) * 128 + 32 * d] = (unsigned short)(cvt_pk_bf16(v, 0.f) & 0xffffu); }
            __builtin_amdgcn_sched_barrier(0); }
        const LAS unsigned char* rd = lds + QOFF + wid * 8192 + (l2 >> 4) * 256 + (l2 & 15) * 16;
        bf16_t* Ow = P.O + (size_t)(q0 + wid * 32 + (l2 >> 4)) * D + h * 128 + (l2 & 15) * 8;
#pragma unroll
        for (int i = 0; i < 8; ++i) { const u32x4 v = *(const LAS u32x4*)(rd + i * 1024); *(u32x4*)(Ow + (size_t)i * 4 * D) = v; } }
    __builtin_amdgcn_s_setprio(0);
    __syncthreads();
    return ok;
}
__device__ __forceinline__ void unit_checked(LAS unsigned char* lds, const Args& P, int b, int h, int q0, int nlat, int tid) {
    volatile LAS unsigned* flag = (volatile LAS unsigned*)(lds + MISC_OFF) + 16;
    const bool ok = unit<false>(lds, P, b, h, q0, nlat, tid);
    if (!ok && (tid & 63) == 0) *flag = 1u;
    __syncthreads();
    const unsigned f = *flag;
    __syncthreads();
    if (f) { if (tid == 0) *flag = 0u; (void)unit<true>(lds, P, b, h, q0, nlat, tid); }
}
}

struct ThinArgs {
    const void* xin_lat; const void* xin_ctx;
    int xin_bf16, xout_bf16;
    const bf16_t* y;
    void* xout_lat; void* xout_ctx;
    const float* g_post; const float* gate;
    bf16_t* uout;
    const float* g_pre; const float* sc; const float* sh;
    const bf16_t* yc; int nslab;
    int nrows; int gb_lo;
};
__device__ __forceinline__ void thin_phase(const ThinArgs& T, LAS unsigned char* lds, int bx, int G, int tid, int wave, int lane) {
    (void)G;
    LAS float* tab0 = (LAS float*)lds; LAS float* tab1 = tab0 + 3 * D;
    f32x4 xvb[2][8]; u32x2 xrb[2][8]; u32x2 yrb[2][8];
#define THIN_LOAD(ctx, row_, XV, XR, YR) do { const size_t xo_ = (ctx) ? (size_t)((row_) - ML) * D : (size_t)(row_) * D; \
        if (T.xin_bf16) { const bf16_t* xr_ = (const bf16_t*)((ctx) ? T.xin_ctx : T.xin_lat) + xo_; _Pragma("unroll") for (int j = 0; j < 8; ++j) XR[j] = *(const u32x2*)(xr_ + 256 * j + 4 * lane); } \
        else { const float* xr_ = (const float*)((ctx) ? T.xin_ctx : T.xin_lat) + xo_; _Pragma("unroll") for (int j = 0; j < 8; ++j) XV[j] = *(const f32x4*)(xr_ + 256 * j + 4 * lane); } \
        if (T.y && !((ctx) && T.nslab > 0)) { const bf16_t* yr_ = T.y + (size_t)(row_) * D; _Pragma("unroll") for (int j = 0; j < 8; ++j) YR[j] = __builtin_nontemporal_load((const u32x2*)(yr_ + 256 * j + 4 * lane)); } } while (0)
#define THIN_TABLES(gb, TB) do { const int c4 = 4 * tid; LAS float* ta = (TB); LAS float* tg = ta + D; LAS float* ts = tg + D;     \
        if (T.y) { const f32x4 g = *(const f32x4*)(T.g_post + c4), a = *(const f32x4*)(T.gate + (size_t)(gb) * MODROW + c4); *(LAS f32x4*)(ta + c4) = a * g; } \
        if (T.uout) { const f32x4 g = *(const f32x4*)(T.g_pre + c4), s = *(const f32x4*)(T.sc + (size_t)(gb) * MODROW + c4), h = *(const f32x4*)(T.sh + (size_t)(gb) * MODROW + c4); \
            *(LAS f32x4*)(tg + c4) = g * (s + 1.0f); *(LAS f32x4*)(ts + c4) = h; } } while (0)
#define THIN_ROW(ctx, row, xv, xraw, yraw, TB) do { const LAS float* ta = (TB); const LAS float* tg = ta + D; const LAS float* ts = tg + D; \
        if (T.xin_bf16) { _Pragma("unroll") for (int j = 0; j < 8; ++j) { const u32x2 v = xraw[j]; xv[j][0] = __uint_as_float(v.x << 16); xv[j][1] = __uint_as_float(v.x & 0xffff0000u); xv[j][2] = __uint_as_float(v.y << 16); xv[j][3] = __uint_as_float(v.y & 0xffff0000u); } } \
        if (T.y) { f32x4 yv[8]; float s = 0.f; \
            if ((ctx) && T.nslab > 0) { const bf16_t* yr = T.yc + (size_t)((row) - ML) * D; \
                _Pragma("unroll") for (int j = 0; j < 8; ++j) { const u32x2 v = __builtin_nontemporal_load((const u32x2*)(yr + 256 * j + 4 * lane)); \
                    yv[j][0] = __uint_as_float(v.x << 16); yv[j][1] = __uint_as_float(v.x & 0xffff0000u); yv[j][2] = __uint_as_float(v.y << 16); yv[j][3] = __uint_as_float(v.y & 0xffff0000u); } \
                _Pragma("unroll 1") for (int sl = 1; sl < T.nslab; ++sl) { yr += (size_t)MC * D; \
                    _Pragma("unroll") for (int j = 0; j < 8; ++j) { const u32x2 v = __builtin_nontemporal_load((const u32x2*)(yr + 256 * j + 4 * lane)); \
                        yv[j][0] += __uint_as_float(v.x << 16); yv[j][1] += __uint_as_float(v.x & 0xffff0000u); yv[j][2] += __uint_as_float(v.y << 16); yv[j][3] += __uint_as_float(v.y & 0xffff0000u); } } \
            } else { _Pragma("unroll") for (int j = 0; j < 8; ++j) { const u32x2 v = yraw[j]; \
                    yv[j][0] = __uint_as_float(v.x << 16); yv[j][1] = __uint_as_float(v.x & 0xffff0000u); yv[j][2] = __uint_as_float(v.y << 16); yv[j][3] = __uint_as_float(v.y & 0xffff0000u); } } \
            _Pragma("unroll") for (int j = 0; j < 8; ++j) s += (yv[j][0] * yv[j][0] + yv[j][1] * yv[j][1]) + (yv[j][2] * yv[j][2] + yv[j][3] * yv[j][3]); \
            const float rs = 1.0f / sqrtf(wave_sum(s) * (1.0f / D) + NORM_EPS); \
            _Pragma("unroll") for (int j = 0; j < 8; ++j) { const f32x4 a = *(const LAS f32x4*)(ta + 256 * j + 4 * lane); xv[j] = xv[j] + a * (yv[j] * rs); } \
            void* xob = (ctx) ? T.xout_ctx : T.xout_lat; const size_t xoo = (ctx) ? (size_t)((row) - ML) * D : (size_t)(row) * D; \
            if (xob) { \
                if (T.xout_bf16) { bf16_t* xo = (bf16_t*)xob + xoo;        \
                    _Pragma("unroll") for (int j = 0; j < 8; ++j) { u32x2 w; w.x = cvt_pk_bf16(xv[j][0], xv[j][1]); w.y = cvt_pk_bf16(xv[j][2], xv[j][3]); __builtin_nontemporal_store(w, (u32x2*)(xo + 256 * j + 4 * lane)); \
                        xv[j][0] = __uint_as_float(w.x << 16); xv[j][1] = __uint_as_float(w.x & 0xffff0000u); xv[j][2] = __uint_as_float(w.y << 16); xv[j][3] = __uint_as_float(w.y & 0xffff0000u); } \
                } else { float* xo = (float*)xob + xoo; _Pragma("unroll") for (int j = 0; j < 8; ++j) *(f32x4*)(xo + 256 * j + 4 * lane) = xv[j]; } } } \
        if (T.uout) { float s = 0.f; \
            _Pragma("unroll") for (int j = 0; j < 8; ++j) s += (xv[j][0] * xv[j][0] + xv[j][1] * xv[j][1]) + (xv[j][2] * xv[j][2] + xv[j][3] * xv[j][3]); \
            const float rs = 1.0f / sqrtf(wave_sum(s) * (1.0f / D) + NORM_EPS); \
            bf16_t* uo = T.uout + (size_t)(row) * D; \
            _Pragma("unroll") for (int j = 0; j < 8; ++j) { const f32x4 g = *(const LAS f32x4*)(tg + 256 * j + 4 * lane), c = *(const LAS f32x4*)(ts + 256 * j + 4 * lane); \
                const f32x4 u = (xv[j] * rs) * g + c; \
                u32x2 w; w.x = cvt_pk_bf16(u[0], u[1]); w.y = cvt_pk_bf16(u[2], u[3]); *(u32x2*)(uo + 256 * j + 4 * lane) = w; } } } while (0)
    const bool has_ctx = T.nrows > ML, my_ctx = has_ctx && wave < 4;
    const int gb = bx >> 6, rbase = gb * SEQ + (bx & 63) * 32 + wave * 4, crow = ML + bx * 4 + (wave & 3);
    if (T.gb_lo == 0) THIN_LOAD(false, rbase, xvb[0], xrb[0], yrb[0]); else if (my_ctx) THIN_LOAD(true, crow, xvb[0], xrb[0], yrb[0]);
    if (T.gb_lo == 0) THIN_TABLES(gb, tab0);
    if (has_ctx) THIN_TABLES(4, tab1);
    __syncthreads();
    if (T.gb_lo == 0) {
#pragma unroll
        for (int i = 0; i < 4; ++i) {
            if (i + 1 < 4) THIN_LOAD(false, rbase + i + 1, xvb[(i + 1) & 1], xrb[(i + 1) & 1], yrb[(i + 1) & 1]);
            else if (my_ctx) THIN_LOAD(true, crow, xvb[0], xrb[0], yrb[0]);
            THIN_ROW(false, rbase + i, xvb[i & 1], xrb[i & 1], yrb[i & 1], tab0);
        }
    }
    if (my_ctx) THIN_ROW(true, crow, xvb[0], xrb[0], yrb[0], tab1);
    __syncthreads();
#undef THIN_LOAD
#undef THIN_TABLES
#undef THIN_ROW
}
template <int W>
__device__ __forceinline__ void pool_sub(const bf16_t* Useq, bf16_t* Dseq, int t0, int Ls) {
    constexpr int H = W / 2, NR = 8 + W - 1;
    u32x2 rows[NR];
#pragma unroll
    for (int k = 0; k < NR; ++k) { const int tt = t0 - H + k; const bool ok = tt >= 0 && tt < Ls; const int tc = tt < 0 ? 0 : (tt >= Ls ? Ls - 1 : tt);
        const u32x2 v = *(const u32x2*)(Useq + (size_t)tc * D); rows[k].x = ok ? v.x : 0u; rows[k].y = ok ? v.y : 0u; }
#pragma unroll
    for (int i = 0; i < 8; ++i) { const int t = t0 + i; int lo = t - H, hi = lo + W; lo = lo < 0 ? 0 : lo; hi = hi > Ls ? Ls : hi;
        f32x4 s = {0.f, 0.f, 0.f, 0.f};
#pragma unroll
        for (int k = 0; k < W; ++k) { const u32x2 v = rows[i + k];
            s[0] += __uint_as_float(v.x << 16); s[1] += __uint_as_float(v.x & 0xffff0000u); s[2] += __uint_as_float(v.y << 16); s[3] += __uint_as_float(v.y & 0xffff0000u); }
        const u32x2 cv = rows[i + H]; const float inv = 1.0f / (float)(hi - lo);
        f32x4 d; d[0] = s[0] * inv - __uint_as_float(cv.x << 16); d[1] = s[1] * inv - __uint_as_float(cv.x & 0xffff0000u); d[2] = s[2] * inv - __uint_as_float(cv.y << 16); d[3] = s[3] * inv - __uint_as_float(cv.y & 0xffff0000u);
        u32x2 o; o.x = cvt_pk_bf16(d[0], d[1]); o.y = cvt_pk_bf16(d[2], d[3]);
        *(u32x2*)(Dseq + (size_t)t * D) = o; }
}
__device__ __forceinline__ void pool_phase(const bf16_t* U, bf16_t* Dm, int nrows, int bx, int wave, int lane) {
    const int coff = 256 * wave + 4 * lane;
    {   const int b = bx >> 6, t00 = (bx & 63) * 32; const bf16_t* Us = U + (size_t)b * SEQ * D + coff; bf16_t* Ds = Dm + (size_t)b * SEQ * D + coff;
#pragma unroll 1
        for (int sb = 0; sb < 4; ++sb) { const int t0 = t00 + 8 * sb;
            switch (wave >> 1) { case 0: pool_sub<2>(Us, Ds, t0, SEQ); break; case 1: pool_sub<4>(Us, Ds, t0, SEQ); break; case 2: pool_sub<8>(Us, Ds, t0, SEQ); break; default: pool_sub<16>(Us, Ds, t0, SEQ); break; } } }
    if (nrows > ML) {
        if (wave < 4) { const int sbi = bx >> 1, j = 4 * (bx & 1) + wave, r0 = sbi * 8, cb = r0 >> 8, t0 = r0 & 255; const int co = 256 * j + 4 * lane;
            const bf16_t* Us = U + (size_t)(ML + cb * CL) * D + co; bf16_t* Ds = Dm + (size_t)(ML + cb * CL) * D + co;
            switch (j >> 1) { case 0: pool_sub<2>(Us, Ds, t0, CL); break; case 1: pool_sub<4>(Us, Ds, t0, CL); break; case 2: pool_sub<8>(Us, Ds, t0, CL); break; default: pool_sub<16>(Us, Ds, t0, CL); break; } } }
}

struct TrDesc { const float* src; bf16_t* dst; int N, K; int perm; };
__device__ __forceinline__ void tr_load(const TrDesc& d, f32x4 (&v)[16], int lane) {
    const int kq = lane >> 4, n4 = lane & 15;
#pragma unroll
    for (int i = 0; i < 16; ++i) v[i] = __builtin_nontemporal_load((const f32x4*)(d.src + (size_t)(4 * i + kq) * d.N + 4 * n4));
}
__device__ __forceinline__ void tr_store(const TrDesc& d, const f32x4 (&v)[16], LAS float* scr, int lane) {
    const int kq = lane >> 4, n4 = lane & 15;
#pragma unroll
    for (int i = 0; i < 16; ++i) { LAS float* s = scr + (4 * i + kq) * 65 + 4 * n4; s[0] = v[i][0]; s[1] = v[i][1]; s[2] = v[i][2]; s[3] = v[i][3]; }
    asm volatile("s_waitcnt lgkmcnt(0)" ::: "memory");
    const int c = lane & 7;
#pragma unroll
    for (int j = 0; j < 8; ++j) { const int n = (lane >> 3) + 8 * j; int sc = n;
        if (d.perm) { const int jj = n >> 1, which = n & 1, ax = jj >> 4, f = jj & 15; sc = ax * 32 + which * 16 + f; }
        const LAS float* s = scr + (8 * c) * 65 + sc;
        u32x4 o; o.x = cvt_pk_bf16(s[0 * 65], s[1 * 65]); o.y = cvt_pk_bf16(s[2 * 65], s[3 * 65]); o.z = cvt_pk_bf16(s[4 * 65], s[5 * 65]); o.w = cvt_pk_bf16(s[6 * 65], s[7 * 65]);
        *(u32x4*)(d.dst + (size_t)n * d.K + 8 * c) = o; }
    asm volatile("s_waitcnt lgkmcnt(0)" ::: "memory");
}

struct Params {
    const float* in[22];
    float* out; unsigned char* ws;
    float lam_init0, lam_init3;
    int ph_lo, ph_hi;
};

template <int PART>
__device__ __forceinline__ void prologue(const Params& P, LAS unsigned char* lds, int tid, int wave, int lane, int vcu, int G) {
    unsigned char* ws = P.ws;
    const float* c_in = P.in[1]; const float* cctx = P.in[3]; const float* w_mod = P.in[4]; const float* b_mod = P.in[5];
    LAS float* sil = (LAS float*)lds;
    LAS float* red = (LAS float*)(lds + 65536);
    for (int i = tid; i < 5 * D; i += NTHR) { const int r = i / D, k = i % D; const float x = r < 4 ? c_in[r * D + k] : cctx[k]; sil[k * 8 + r] = x / (1.0f + __expf(-x)); }
    __syncthreads();
    float* mod = (float*)(ws + WS_MOD);
    for (int item = (PART == 1 ? 192 : 0) + blockIdx.x; item < (PART == 0 ? 192 : 4 * 192); item += G) {
        const int l = item / 192, col = (item % 192) * 64 + lane;
        const float* W = w_mod + (size_t)l * D * MODROW + col;
        float a0 = 0.f, a1 = 0.f, a2 = 0.f, a3 = 0.f, a4 = 0.f;
        const int k0 = wave * 256;
        for (int kk = 0; kk < 256; kk += 32) {
            float w[32];
#pragma unroll
            for (int j = 0; j < 32; ++j) w[j] = __builtin_nontemporal_load(W + (size_t)(k0 + kk + j) * MODROW);
#pragma unroll
            for (int j = 0; j < 32; ++j) { const f32x4 s4 = *(const LAS f32x4*)(sil + (k0 + kk + j) * 8); const float s5 = sil[(k0 + kk + j) * 8 + 4];
                a0 += s4[0] * w[j]; a1 += s4[1] * w[j]; a2 += s4[2] * w[j]; a3 += s4[3] * w[j]; a4 += s5 * w[j]; }
        }
        red[(wave * 5 + 0) * 64 + lane] = a0; red[(wave * 5 + 1) * 64 + lane] = a1; red[(wave * 5 + 2) * 64 + lane] = a2; red[(wave * 5 + 3) * 64 + lane] = a3; red[(wave * 5 + 4) * 64 + lane] = a4;
        __syncthreads();
        if (wave < 5) { float s = b_mod[l * MODROW + col];
#pragma unroll
            for (int w8 = 0; w8 < 8; ++w8) s += red[(w8 * 5 + wave) * 64 + lane];
            mod[((size_t)l * 5 + wave) * MODROW + col] = s; }
        __syncthreads();
    }
    LAS float* scr = (LAS float*)(lds + wave * 16640);
    const int gw = vcu * NWAVES + wave, NGW = G * NWAVES;
    bf16_t* Wqkv = (bf16_t*)(ws + WS_WQKV); bf16_t* Wo = (bf16_t*)(ws + WS_WO); bf16_t* Wf = (bf16_t*)(ws + WS_WF); bf16_t* Wp = (bf16_t*)(ws + WS_WPOOL);
    bf16_t* W1 = (bf16_t*)(ws + WS_W1); bf16_t* W2 = (bf16_t*)(ws + WS_W2);
    constexpr int I_QKV = (D / 64) * (3 * D / 64), I_O = (D / 64) * (D / 64), I_P = 8 * 8, I_1 = (D / 64) * (FF / 64), I_2 = (FF / 64) * (D / 64);
    constexpr int NITEMS = 2 * I_QKV + 2 * I_O + I_O + 4 * I_P + 4 * I_1 + 4 * I_2;
    auto decode = [&](int it) -> TrDesc {
        int r = it; const float* W; bf16_t* WT; int K, N, perm = 0;
        if (r < 2 * I_QKV) { const int ia = r / I_QKV; r %= I_QKV; W = P.in[10] + (size_t)ia * D * 3 * D; WT = Wqkv + (size_t)ia * 3 * D * D; K = D; N = 3 * D; perm = (r % (3 * D / 64)) < 2 * D / 64; }
        else if ((r -= 2 * I_QKV) < 2 * I_O) { const int ia = r / I_O; r %= I_O; W = P.in[11] + (size_t)ia * D * D; WT = Wo + (size_t)ia * D * D; K = D; N = D; }
        else if ((r -= 2 * I_O) < I_O) { W = P.in[17]; WT = Wf; K = D; N = D; }
        else if ((r -= I_O) < 4 * I_P) { const int g = r / I_P; r %= I_P; W = P.in[18] + (size_t)g * 512 * 512; WT = Wp + (size_t)g * 512 * 512; K = 512; N = 512; }
        else if ((r -= 4 * I_P) < 4 * I_1) { const int l = r / I_1; r %= I_1; W = P.in[20] + (size_t)l * D * FF; WT = W1 + (size_t)l * FF * D; K = D; N = FF; }
        else { r -= 4 * I_1; const int l = r / I_2; r %= I_2; W = P.in[21] + (size_t)l * FF * D; WT = W2 + (size_t)l * D * FF; K = FF; N = D; }
        const int nblk = N / 64, k0 = 64 * (r / nblk), n0 = 64 * (r % nblk);
        TrDesc d; d.src = W + (size_t)k0 * N + n0; d.dst = WT + (size_t)n0 * K + k0; d.N = N; d.K = K; d.perm = perm; return d; };
    {   const int it_end = (PART == 0 ? I_QKV : NITEMS); int it = (PART == 1 ? I_QKV : 0) + gw;
        f32x4 va[16], vb[16]; TrDesc da, db;
        if (it < it_end) { da = decode(it); tr_load(da, va, lane); }
        while (it < it_end) {
            const bool hb = it + NGW < it_end; if (hb) { db = decode(it + NGW); tr_load(db, vb, lane); }
            tr_store(da, va, scr, lane);
            if (!hb) break;
            const bool ha = it + 2 * NGW < it_end; if (ha) { da = decode(it + 2 * NGW); tr_load(da, va, lane); }
            tr_store(db, vb, scr, lane);
            if (!ha) break;
            it += 2 * NGW;
        } }
    if constexpr (PART != 1) {
        const int gt = gw * 64 + lane, NGT = NGW * 64; float* rope = (float*)(ws + WS_ROPE);
        for (int i = gt; i < 64 * 16; i += NGT) { const int pos = i >> 4, f = i & 15; const float inv = 1.0f / powf(10000.0f, (float)f * (1.0f / 16.0f)); const float ang = (float)pos * inv;
            rope[2 * i] = cosf(ang); rope[2 * i + 1] = sinf(ang); }
    }
    if constexpr (PART != 0) {   bf16_t* T1 = (bf16_t*)(ws + WS_T1); bf16_t* A2 = (bf16_t*)(ws + WS_A2); bf16_t* A2C = (bf16_t*)(ws + WS_A2C);
        constexpr int C_T1 = 1024 * 512 / 8, C_A2 = 2048 * 4096 / 8, C_A2C = 256 * 512 / 8;
        const int gt = gw * 64 + lane, NGT = NGW * 64;
        for (int ch = gt; ch < C_T1 + C_A2 + C_A2C; ch += NGT) {
            int r = ch; bf16_t* dst; int row, col0, N, ncol; float scale; bool negsin;
            if (r < C_T1) { row = r / 64; col0 = (r % 64) * 8; dst = T1 + (size_t)row * 512 + col0; N = 512; scale = 0.04419417382415922f; negsin = false;
                const int cs = row >> 9, k2 = row & 511; float vals[8];
#pragma unroll
                for (int e = 0; e < 8; ++e) { const int idx = (k2 * (col0 + e)) & 511; const float a = (float)idx * (1.0f / 256.0f); vals[e] = (cs ? sinpif(a) : cospif(a)) * scale; }
                u32x4 o; o.x = cvt_pk_bf16(vals[0], vals[1]); o.y = cvt_pk_bf16(vals[2], vals[3]); o.z = cvt_pk_bf16(vals[4], vals[5]); o.w = cvt_pk_bf16(vals[6], vals[7]); *(u32x4*)dst = o; continue; }
            r -= C_T1;
            if (r < C_A2) { row = r / 512; col0 = (r % 512) * 8; dst = A2 + (size_t)row * 4096 + col0; N = 2048; scale = 0.022097086912079608f; }
            else { r -= C_A2; row = r / 64; col0 = (r % 64) * 8; dst = A2C + (size_t)row * 512 + col0; N = 256; scale = 0.0625f; }
            (void)ncol; (void)negsin;
            { const int cs = col0 / N, n0 = col0 % N; float vals[8];
#pragma unroll
              for (int e = 0; e < 8; ++e) { const int idx = (row * (n0 + e)) & (N - 1); const float a = (float)idx * (2.0f / (float)N); vals[e] = (cs ? -sinpif(a) : cospif(a)) * scale; }
              u32x4 o; o.x = cvt_pk_bf16(vals[0], vals[1]); o.y = cvt_pk_bf16(vals[2], vals[3]); o.z = cvt_pk_bf16(vals[4], vals[5]); o.w = cvt_pk_bf16(vals[6], vals[7]); *(u32x4*)dst = o; }
        }
    }
}

__device__ __forceinline__ void fourier_y256(const bf16_t* U, const bf16_t* T1, float* Y256, int bx, int wave, int lane) {
    const float sc = bf2f(T1[256 * 512]);
#pragma unroll 1
    for (int rr = 0; rr < 4; ++rr) {
        const int tok = bx * 32 + wave * 4 + rr;
        const bf16_t* up = U + (size_t)tok * D + lane * 32;
        float a = 0.f;
#pragma unroll
        for (int i = 0; i < 4; ++i) { const u32x4 w = *(const u32x4*)(up + 8 * i);
            a += (__uint_as_float(w.x << 16) - __uint_as_float(w.x & 0xffff0000u)) + (__uint_as_float(w.y << 16) - __uint_as_float(w.y & 0xffff0000u))
               + (__uint_as_float(w.z << 16) - __uint_as_float(w.z & 0xffff0000u)) + (__uint_as_float(w.w << 16) - __uint_as_float(w.w & 0xffff0000u)); }
        a += __shfl_xor(a, 1); a += __shfl_xor(a, 2); a += __shfl_xor(a, 4); a += __shfl_xor(a, 8);
        if ((lane & 15) == 0) Y256[(size_t)((tok >> 11) * 4 + (lane >> 4)) * 2048 + (tok & 2047)] = a * sc;
    }
}
__device__ __forceinline__ void fourier_combine(const bf16_t* PB, const bf16_t* QB, const bf16_t* A2, const float* Y256, bf16_t* O, LAS unsigned char* lds, int bx, int tid, int wave, int lane) {
    const int b = bx >> 6, k1b = (bx & 63) * 32;
    LAS float* ys = (LAS float*)lds;
    for (int i = tid; i < 4 * 2048 / 4; i += NTHR) ((LAS f32x4*)ys)[i] = ((const f32x4*)(Y256 + (size_t)b * 4 * 2048))[i];
    __syncthreads();
    const int g = lane >> 4, j = lane & 15;
#pragma unroll 1
    for (int rr = 0; rr < 4; ++rr) {
        const int k1 = k1b + wave * 4 + rr; const size_t row = (size_t)b * 2048 + k1;
        float s0 = 0.f, s1 = 0.f, s2 = 0.f, s3 = 0.f;
#pragma unroll
        for (int i = 0; i < 4; ++i) { const int n1 = (i * 64 + lane) * 8; const u32x4 w = *(const u32x4*)(A2 + (size_t)k1 * 4096 + n1);
            const float a0 = __uint_as_float(w.x << 16), a1 = __uint_as_float(w.x & 0xffff0000u), a2 = __uint_as_float(w.y << 16), a3 = __uint_as_float(w.y & 0xffff0000u),
                        a4 = __uint_as_float(w.z << 16), a5 = __uint_as_float(w.z & 0xffff0000u), a6 = __uint_as_float(w.w << 16), a7 = __uint_as_float(w.w & 0xffff0000u);
#define FC_DOT(S, G_) { const f32x4 y0 = *(LAS f32x4*)(ys + (G_) * 2048 + n1), y1 = *(LAS f32x4*)(ys + (G_) * 2048 + n1 + 4); \
                        S += a0 * y0[0] + a1 * y0[1] + a2 * y0[2] + a3 * y0[3] + a4 * y1[0] + a5 * y1[1] + a6 * y1[2] + a7 * y1[3]; }
            FC_DOT(s0, 0) FC_DOT(s1, 1) FC_DOT(s2, 2) FC_DOT(s3, 3)
#undef FC_DOT
        }
        s0 = wave_sum(s0); s1 = wave_sum(s1); s2 = wave_sum(s2); s3 = wave_sum(s3);
        const float sg = g == 0 ? s0 : (g == 1 ? s1 : (g == 2 ? s2 : s3));
        const bf16_t* pr = PB + row * 1024 + g * 256; const bf16_t* qr = QB + row * 1024 + g * 256;
        const u32x4 p0 = *(const u32x4*)(pr + 8 * j), p1 = *(const u32x4*)(pr + 8 * (j + 16)), q0 = *(const u32x4*)(qr + 8 * j), q1 = *(const u32x4*)(qr + 8 * (j + 16));
        const float e1 = bf2f(pr[8 * (j + 1)]) - bf2f(qr[8 * (j + 1)]);
        const int jn = j == 15 ? 0 : 8 * (j + 17);
        const float e2v = bf2f(pr[jn]) - bf2f(qr[jn]); const float e2 = j == 15 ? sg : e2v;
        bf16_t* orow = O + row * D + g * 512;
#define FC_LO(w) __uint_as_float((w) << 16)
#define FC_HI(w) __uint_as_float((w) & 0xffff0000u)
        { u32x4 f; f.x = cvt_pk_vis(FC_LO(p0.x) + FC_LO(q0.x), FC_HI(p0.x) + FC_HI(q0.x)); f.y = cvt_pk_vis(FC_LO(p0.y) + FC_LO(q0.y), FC_HI(p0.y) + FC_HI(q0.y));
          f.z = cvt_pk_vis(FC_LO(p0.z) + FC_LO(q0.z), FC_HI(p0.z) + FC_HI(q0.z)); f.w = cvt_pk_vis(FC_LO(p0.w) + FC_LO(q0.w), FC_HI(p0.w) + FC_HI(q0.w));
          *(u32x4*)(orow + 8 * j) = f; }
        { u32x4 f; f.x = cvt_pk_vis(FC_LO(p1.x) + FC_LO(q1.x), FC_HI(p1.x) + FC_HI(q1.x)); f.y = cvt_pk_vis(FC_LO(p1.y) + FC_LO(q1.y), FC_HI(p1.y) + FC_HI(q1.y));
          f.z = cvt_pk_vis(FC_LO(p1.z) + FC_LO(q1.z), FC_HI(p1.z) + FC_HI(q1.z)); f.w = cvt_pk_vis(FC_LO(p1.w) + FC_LO(q1.w), FC_HI(p1.w) + FC_HI(q1.w));
          *(u32x4*)(orow + 8 * (j + 16)) = f; }
        { u32x4 f; f.x = cvt_pk_vis(e1, FC_HI(p0.w) - FC_HI(q0.w)); f.y = cvt_pk_vis(FC_LO(p0.w) - FC_LO(q0.w), FC_HI(p0.z) - FC_HI(q0.z));
          f.z = cvt_pk_vis(FC_LO(p0.z) - FC_LO(q0.z), FC_HI(p0.y) - FC_HI(q0.y)); f.w = cvt_pk_vis(FC_LO(p0.y) - FC_LO(q0.y), FC_HI(p0.x) - FC_HI(q0.x));
          *(u32x4*)(orow + 8 * (63 - j)) = f; }
        { u32x4 f; f.x = cvt_pk_vis(e2, FC_HI(p1.w) - FC_HI(q1.w)); f.y = cvt_pk_vis(FC_LO(p1.w) - FC_LO(q1.w), FC_HI(p1.z) - FC_HI(q1.z));
          f.z = cvt_pk_vis(FC_LO(p1.z) - FC_LO(q1.z), FC_HI(p1.y) - FC_HI(q1.y)); f.w = cvt_pk_vis(FC_LO(p1.y) - FC_LO(q1.y), FC_HI(p1.x) - FC_HI(q1.x));
          *(u32x4*)(orow + 8 * (47 - j)) = f; }
#undef FC_LO
#undef FC_HI
    }
}

struct Ctx { LAS unsigned char* lds; int tid, lane, wave, G, bx, vcu, gw, NGW; };
#if MK_MULTI
#define GRID_BAR() do { } while (0)
#else
#define GRID_BAR() xcd_barrier(bar)
#endif
#define PH_BEGIN(k) if ((k) >= P.ph_lo && (k) < P.ph_hi) {
#define PH_END(k)   if ((k) + 1 < P.ph_hi) GRID_BAR(); }
#define WSP(T, off) ((T*)(P.ws + (off)))

#ifndef FUSE_T
#define FUSE_T 0
#endif
template <int L> struct LayerCfg {
    static constexpr int kind = L % 3; static constexpr bool lastl = (L == 3);
    static constexpr int NMIX = (kind == 2) ? 1 : (kind == 1 ? 3 : 2);
    static constexpr bool fuse_mid = FUSE_T && kind != 2, fuse_post = FUSE_T;
    static constexpr bool has_tmid = !(fuse_mid && lastl), has_tpost = !(fuse_post && lastl);
    static constexpr int o_mix = NMIX, o_tmid = o_mix + 1, o_w1 = o_tmid + (has_tmid ? 1 : 0), o_w2 = o_w1 + 1, o_tpost = o_w2 + 1, nph = o_tpost + (has_tpost ? 1 : 0);
};
#define GEMM_CALL(S, E) do { int tid_ = C.tid; asm volatile("" : "+v"(tid_)); pg8::gemm_phase(lds, S, E, tid_); } while (0)

template <int L, int PH0>
__device__ __forceinline__ void layer(const Params& P, const Ctx& C, const XcdBarrier& bar) {
    using CF = LayerCfg<L>;
    constexpr int kind = CF::kind; constexpr bool lastl = CF::lastl;
    constexpr int Mact = lastl ? ML : MT;
    LAS unsigned char* lds = C.lds;
    const float* modl = WSP(const float, WS_MOD) + (size_t)L * 5 * MODROW; float* X = WSP(float, WS_X); bf16_t* XB = WSP(bf16_t, WS_X);
    if constexpr (kind == 0) {
        constexpr int ia = L / 3;
        PH_BEGIN(PH0)
        { pg8::Sched S{}; S.A = (const char*)WSP(bf16_t, WS_U); S.B = (const char*)(WSP(bf16_t, WS_WQKV) + (size_t)ia * 3 * D * D); S.lda = D * 2; S.ldb = D * 2; S.nt = D / 64;
          S.nM = (lastl ? ML : MT) / 256; S.nN = 3 * D / 256; S.ngroups = 1; S.a_g = 0; S.b_g = 0; S.G = C.G; S.c = C.bx;
          pg8::EpiQKV E{WSP(bf16_t, WS_Q), WSP(const float, WS_ROPE), 0, 0};
          GEMM_CALL(S, E);
          if constexpr (lastl) {
              pg8::Sched S2 = S; S2.A = (const char*)(WSP(bf16_t, WS_U) + (size_t)ML * D); S2.B = S.B + (size_t)D * D * 2; S2.nM = MC / 256; S2.nN = 2 * D / 256;
              pg8::EpiQKV E2{WSP(bf16_t, WS_Q), WSP(const float, WS_ROPE), ML / 256, D / 256};
              GEMM_CALL(S2, E2); } }
        PH_END(PH0)
        PH_BEGIN(PH0 + 1)
        { const float* lq1 = P.in[12] + ia * 64; const float* lk1 = P.in[13] + ia * 64; const float* lq2 = P.in[14] + ia * 64; const float* lk2 = P.in[15] + ia * 64;
          const float d1 = wave_sum(lq1[C.lane] * lk1[C.lane]), d2 = wave_sum(lq2[C.lane] * lk2[C.lane]);
          const float li = (L == 0) ? P.lam_init0 : P.lam_init3;
          att::Args A{WSP(bf16_t, WS_Q), WSP(bf16_t, WS_K), WSP(bf16_t, WS_V), WSP(bf16_t, WS_O), P.in[16] + ia * 128, expf(d1) - expf(d2) + li, 1.0f - li};
          constexpr int nlat_units = NB * NH * (SEQ / 256);
          const int per = (nlat_units + C.G - 1) / C.G;
#pragma unroll 1
          for (int i = 0; i < per; ++i) { const int uu = C.vcu * per + i; if (uu < nlat_units) { const int bh = uu >> 3, qb = uu & 7; int tid_ = C.tid; asm volatile("" : "+v"(tid_)); att::unit_checked(lds, A, bh >> 4, bh & 15, (bh >> 4) * SEQ + qb * 256, SEQ / 64, tid_); } }
          if constexpr (!lastl) { for (int uc = C.bx; uc < NB * NH; uc += C.G) { const int b = uc >> 4, h = uc & 15; int tid_ = C.tid; asm volatile("" : "+v"(tid_)); att::unit_checked(lds, A, b, h, ML + b * CL, 0, tid_); } } }
        PH_END(PH0 + 1)
    } else if constexpr (kind == 1) {
        PH_BEGIN(PH0)
        { pg8::Sched S{}; S.B = (const char*)WSP(bf16_t, WS_U); S.lda = 512 * 2; S.ldb = D * 2; S.nt = 8; S.nM = 1; S.nN = ML / 256; S.ngroups = 4; S.a_g = 0; S.b_g = 512 * 2; S.G = C.G;
          S.A = (const char*)WSP(bf16_t, WS_T1); S.c = C.bx;
          { pg8::EpiFAH E{WSP(bf16_t, WS_YT), 0}; GEMM_CALL(S, E); }
          S.A = (const char*)(WSP(bf16_t, WS_T1) + 512 * 512); S.c = (C.bx + C.G / 2) % C.G;
          { pg8::EpiFAH E{WSP(bf16_t, WS_YT), 1}; GEMM_CALL(S, E); }
          static_assert(!lastl, "the Fourier layer keeps its context stream");
          pg8::Sched S2{}; S2.A = (const char*)WSP(bf16_t, WS_T1); S2.B = (const char*)(WSP(bf16_t, WS_U) + (size_t)ML * D); S2.lda = 512 * 2; S2.ldb = D * 2; S2.nt = 8; S2.nM = 4; S2.nN = MC / 256; S2.ngroups = 4; S2.a_g = 0; S2.b_g = 512 * 2; S2.G = C.G; S2.c = C.bx;
          pg8::EpiFA E2{WSP(bf16_t, WS_YT), WSP(bf16_t, WS_YTC), 32}; GEMM_CALL(S2, E2);
          fourier_y256(WSP(const bf16_t, WS_U), WSP(const bf16_t, WS_T1), WSP(float, WS_SLOT), C.bx, C.wave, C.lane); }
        PH_END(PH0)
        PH_BEGIN(PH0 + 1)
        { pg8::Sched S{}; S.lda = 4096 * 2; S.ldb = 16384 * 2; S.nt = 32; S.nM = 8; S.nN = 4; S.ngroups = 4; S.a_g = 0; S.b_g = 4096 * 2; S.G = C.G;
          S.A = (const char*)WSP(bf16_t, WS_A2); S.B = (const char*)WSP(bf16_t, WS_YT); S.c = C.bx;
          { pg8::EpiBf16<0> E{WSP(bf16_t, WS_YT) + 16 * MiB, 1024u, SEQ}; GEMM_CALL(S, E); }
          S.A = (const char*)(WSP(bf16_t, WS_A2) + 2048); S.B = (const char*)(WSP(bf16_t, WS_YT) + 2048); S.c = (C.bx + C.G / 2) % C.G;
          { pg8::EpiBf16<0> E{WSP(bf16_t, WS_YT) + 24 * MiB, 1024u, SEQ}; GEMM_CALL(S, E); }
          { pg8::Sched S2{}; S2.A = (const char*)WSP(bf16_t, WS_A2C); S2.B = (const char*)WSP(bf16_t, WS_YTC); S2.lda = 512 * 2; S2.ldb = 2048 * 2; S2.nt = 8; S2.nM = 1; S2.nN = 8; S2.ngroups = 4; S2.a_g = 0; S2.b_g = 512 * 2; S2.G = C.G; S2.c = C.bx;
            pg8::EpiBf16<0> E2{WSP(bf16_t, WS_O) + (size_t)ML * D, (unsigned)D, CL};
            GEMM_CALL(S2, E2); } }
        PH_END(PH0 + 1)
        PH_BEGIN(PH0 + 2)
        fourier_combine(WSP(const bf16_t, WS_YT) + 16 * MiB, WSP(const bf16_t, WS_YT) + 24 * MiB, WSP(const bf16_t, WS_A2), WSP(const float, WS_SLOT), WSP(bf16_t, WS_O), C.lds, C.bx, C.tid, C.wave, C.lane);
        PH_END(PH0 + 2)
    } else {
        PH_BEGIN(PH0) pool_phase(WSP(bf16_t, WS_U), WSP(bf16_t, WS_O), Mact, C.bx, C.wave, C.lane); PH_END(PH0)
    }
    PH_BEGIN(PH0 + CF::o_mix)
    { pg8::Sched S{}; S.A = (const char*)WSP(bf16_t, WS_O); S.lda = D * 2; S.G = C.G; S.c = C.bx;
      if constexpr (kind == 2) { S.B = (const char*)WSP(bf16_t, WS_WPOOL); S.ldb = 512 * 2; S.nt = 8; S.nM = Mact / 256; S.nN = 2; S.ngroups = 4; S.a_g = 512 * 2; S.b_g = 512 * 512 * 2;
          pg8::EpiY E{WSP(bf16_t, WS_Y), (unsigned)D, P.in[19], 512, 0}; GEMM_CALL(S, E); }
      else { S.B = kind == 0 ? (const char*)(WSP(bf16_t, WS_WO) + (size_t)(L / 3) * D * D) : (const char*)WSP(bf16_t, WS_WF); S.ldb = D * 2; S.nt = D / 64; S.nM = ML / 256; S.nN = D / 256; S.ngroups = 1;
          if constexpr (CF::fuse_mid) {
              pg8::EpiFuse E{L == 0 ? P.in[0] : X, X, WSP(bf16_t, WS_U), modl + 2 * D, P.in[7] + L * D, P.in[8] + L * D, modl + 4 * D, modl + 3 * D,
                             WSP(unsigned long long, WS_SLOT), WSP(unsigned, WS_CTL) + CW_FUSE + (2 * L) * 2048, WSP(unsigned, WS_CTL) + CW_TMO};
              GEMM_CALL(S, E);
          } else { pg8::EpiY E{WSP(bf16_t, WS_Y), (unsigned)D, nullptr, 0, 0}; GEMM_CALL(S, E); }
          if constexpr (!lastl) { pg8::Sched S2 = S; S2.A = (const char*)(WSP(bf16_t, WS_O) + (size_t)ML * D); S2.nt = D / 64 / NSPLIT; S2.nM = MC / 256; S2.ngroups = NSPLIT; S2.a_g = (D / NSPLIT) * 2; S2.b_g = (D / NSPLIT) * 2;
              pg8::EpiSlab E2{WSP(bf16_t, WS_YC), (unsigned)D, (size_t)MC * D}; GEMM_CALL(S2, E2); } } }
    PH_END(PH0 + CF::o_mix)
    if constexpr (CF::has_tmid) {
    PH_BEGIN(PH0 + CF::o_tmid)
    { ThinArgs T{}; T.xin_lat = L == 0 ? (const void*)P.in[0] : (const void*)XB; T.xin_ctx = L == 0 ? (const void*)P.in[2] : (const void*)(XB + (size_t)ML * D); T.xin_bf16 = L == 0 ? 0 : 1; T.y = WSP(const bf16_t, WS_Y); T.xout_lat = XB; T.xout_ctx = XB + (size_t)ML * D; T.xout_bf16 = 1;
      T.yc = WSP(const bf16_t, WS_YC); T.nslab = (kind == 2 || lastl) ? 0 : NSPLIT;
      T.g_post = P.in[7] + L * D; T.gate = modl + 2 * D; T.uout = WSP(bf16_t, WS_U); T.g_pre = P.in[8] + L * D; T.sc = modl + 4 * D; T.sh = modl + 3 * D; T.nrows = Mact; T.gb_lo = CF::fuse_mid ? 4 : 0;
      thin_phase(T, C.lds, C.bx, C.G, C.tid, C.wave, C.lane); }
    PH_END(PH0 + CF::o_tmid)
    }
    PH_BEGIN(PH0 + CF::o_w1)
    { pg8::Sched S{}; S.A = (const char*)WSP(bf16_t, WS_U); S.B = (const char*)(WSP(bf16_t, WS_W1) + (size_t)L * FF * D); S.lda = D * 2; S.ldb = D * 2; S.nt = D / 64; S.nM = Mact / 256; S.nN = FF / 256; S.ngroups = 1; S.G = C.G; S.c = C.bx;
      pg8::EpiBf16<1> E{WSP(bf16_t, WS_H), (unsigned)FF, 0}; GEMM_CALL(S, E); }
    PH_END(PH0 + CF::o_w1)
    PH_BEGIN(PH0 + CF::o_w2)
    { pg8::Sched S{}; S.A = (const char*)WSP(bf16_t, WS_H); S.B = (const char*)(WSP(bf16_t, WS_W2) + (size_t)L * D * FF); S.lda = FF * 2; S.ldb = FF * 2; S.nt = FF / 64; S.nM = ML / 256; S.nN = D / 256; S.ngroups = 1; S.G = C.G; S.c = C.bx;
      if constexpr (CF::fuse_post) {
          const float* modn = modl + 5 * MODROW;
          pg8::EpiFuse E{X, lastl ? P.out : X, lastl ? nullptr : WSP(bf16_t, WS_U), modl + 5 * D, P.in[9] + L * D, lastl ? nullptr : P.in[6] + (L + 1) * D, modn + 1 * D, modn + 0 * D,
                         WSP(unsigned long long, WS_SLOT), WSP(unsigned, WS_CTL) + CW_FUSE + (2 * L + 1) * 2048, WSP(unsigned, WS_CTL) + CW_TMO};
          GEMM_CALL(S, E);
      } else { pg8::EpiY E{WSP(bf16_t, WS_Y), (unsigned)D, nullptr, 0, 0}; GEMM_CALL(S, E); }
      if constexpr (!lastl) { pg8::Sched S2 = S; S2.A = (const char*)(WSP(bf16_t, WS_H) + (size_t)ML * FF); S2.nt = FF / 64 / NSPLIT; S2.nM = MC / 256; S2.ngroups = NSPLIT; S2.a_g = (FF / NSPLIT) * 2; S2.b_g = (FF / NSPLIT) * 2;
          pg8::EpiSlab E2{WSP(bf16_t, WS_YC), (unsigned)D, (size_t)MC * D}; GEMM_CALL(S2, E2); } }
    PH_END(PH0 + CF::o_w2)
    if constexpr (CF::has_tpost) {
    PH_BEGIN(PH0 + CF::o_tpost)
    { ThinArgs T{}; T.xin_lat = XB; T.xin_ctx = XB + (size_t)ML * D; T.xin_bf16 = 1; T.y = WSP(const bf16_t, WS_Y); T.xout_lat = lastl ? (void*)P.out : (void*)XB; T.xout_ctx = XB + (size_t)ML * D; T.xout_bf16 = lastl ? 0 : 1;
      T.yc = WSP(const bf16_t, WS_YC); T.nslab = lastl ? 0 : NSPLIT;
      T.g_post = P.in[9] + L * D; T.gate = modl + 5 * D; T.nrows = Mact; T.gb_lo = CF::fuse_post ? 4 : 0;
      if constexpr (!lastl) { const float* modn = modl + 5 * MODROW; T.uout = WSP(bf16_t, WS_U); T.g_pre = P.in[6] + (L + 1) * D; T.sc = modn + 1 * D; T.sh = modn + 0 * D; }
      thin_phase(T, C.lds, C.bx, C.G, C.tid, C.wave, C.lane); }
    PH_END(PH0 + CF::o_tpost)
    }
}
constexpr int PH_L0 = 2, PH_L1 = PH_L0 + LayerCfg<0>::nph, PH_L2 = PH_L1 + LayerCfg<1>::nph, PH_L3 = PH_L2 + LayerCfg<2>::nph, N_PHASES = PH_L3 + LayerCfg<3>::nph;

__global__ void __launch_bounds__(NTHR, 2) fwd_kernel(Params P) {
    extern __shared__ __attribute__((aligned(16))) unsigned char lds_raw[];
    Ctx C; C.lds = (LAS unsigned char*)lds_raw;
    C.tid = threadIdx.x; C.lane = C.tid & 63; C.wave = __builtin_amdgcn_readfirstlane(C.tid >> 6);
    C.G = gridDim.x; C.bx = blockIdx.x; C.vcu = (C.G % 8 == 0) ? (C.bx % 8) * (C.G / 8) + C.bx / 8 : C.bx;
    C.gw = C.vcu * NWAVES + C.wave; C.NGW = C.G * NWAVES;
    for (int u = C.tid; u < (LDS_BYTES - LDSCTL_OFF) / 4; u += NTHR) ((LAS unsigned*)(C.lds + LDSCTL_OFF))[u] = 0u;
    __syncthreads();
#if MK_MULTI
    XcdBarrier bar{};
#else
    XcdBarrier bar = xcd_barrier_post(WSP(unsigned, WS_CTL) + CW_BAR, (volatile LAS unsigned*)(C.lds + MISC_OFF) + 8);
#endif
    PH_BEGIN(0) prologue<2>(P, C.lds, C.tid, C.wave, C.lane, C.vcu, C.G); PH_END(0)
#if !MK_MULTI
    if (P.ph_lo == 0 && P.ph_hi > 1) {
        volatile LAS unsigned* st = (volatile LAS unsigned*)(C.lds + MISC_OFF) + 8;
        if (C.tid == 0) { unsigned* bw = WSP(unsigned, WS_CTL) + CW_BAR; bool okc = (C.G % 8 == 0);
            for (unsigned j = 0; j < 16; ++j) { const unsigned cnt = xb_ld(&bw[XB_XCNT(j)]); okc = okc && (cnt == (j < 8 ? (unsigned)C.G / 8u : 0u)); }
            st[3] = okc ? st[2] * 8u + bar.x : (unsigned)blockIdx.x; }
        __syncthreads();
        C.bx = (int)st[3]; C.vcu = (C.G % 8 == 0) ? (C.bx % 8) * (C.G / 8) + C.bx / 8 : C.bx; C.gw = C.vcu * NWAVES + C.wave;
    }
#endif
    PH_BEGIN(1)
    { const float* mod = WSP(const float, WS_MOD);
      ThinArgs T{}; T.xin_lat = P.in[0]; T.xin_ctx = P.in[2]; T.y = nullptr; T.uout = WSP(bf16_t, WS_U); T.g_pre = P.in[6]; T.sc = mod + 1 * D; T.sh = mod + 0 * D; T.nrows = MT;
      thin_phase(T, C.lds, C.bx, C.G, C.tid, C.wave, C.lane); }
    PH_END(1)
    layer<0, PH_L0>(P, C, bar);
    layer<1, PH_L1>(P, C, bar);
    layer<2, PH_L2>(P, C, bar);
    layer<3, PH_L3>(P, C, bar);
}
#undef PH_BEGIN
#undef PH_END
#undef GRID_BAR

extern "C" void kernel_launch(void* const* d_in, const int* in_sizes, int n_in, void* d_out, int out_size, void* d_ws, size_t ws_size, hipStream_t stream) {
    static int grid = 0;
    if (grid == 0) {
        if (n_in != 22 || out_size != ML * D || ws_size < WS_END) { fprintf(stderr, "kernel_launch: unexpected problem: n_in %d out %d ws %zu (need %zu)\n", n_in, out_size, ws_size, (size_t)WS_END); grid = -1; return; }
        int dev = 0, cus = 0, per_cu = 0;
        if (hipGetDevice(&dev) != hipSuccess || hipDeviceGetAttribute(&cus, hipDeviceAttributeMultiprocessorCount, dev) != hipSuccess) { grid = -1; return; }
        if (hipFuncSetAttribute((const void*)fwd_kernel, hipFuncAttributeMaxDynamicSharedMemorySize, LDS_BYTES) != hipSuccess) { fprintf(stderr, "kernel_launch: hipFuncSetAttribute failed\n"); grid = -1; return; }
        if (hipOccupancyMaxActiveBlocksPerMultiprocessor(&per_cu, (const void*)fwd_kernel, NTHR, LDS_BYTES) != hipSuccess || per_cu < 1) fprintf(stderr, "kernel_launch: occupancy query says %d\n", per_cu);
        (void)hipGetLastError();
        if (cus < 256) { fprintf(stderr, "kernel_launch: %d CUs; this kernel is built for a 256-CU device (one workgroup per CU, fused epilogues pair 8 workgroups per row panel)\n", cus); grid = -1; return; }
        grid = 256;
    }
    if (grid < 0) return;
    (void)in_sizes;
    hipMemsetAsync((char*)d_ws + WS_CTL, 0, CTL_BYTES, stream);
    Params p{};
    for (int i = 0; i < 22; ++i) p.in[i] = (const float*)d_in[i];
    p.out = (float*)d_out; p.ws = (unsigned char*)d_ws;
    p.lam_init0 = (float)(0.8 - 0.6 * exp(-0.3 * 0.0)); p.lam_init3 = (float)(0.8 - 0.6 * exp(-0.3 * 3.0));
#if MK_MULTI
    for (int ph = 0; ph < N_PHASES; ++ph) { p.ph_lo = ph; p.ph_hi = ph + 1; hipLaunchKernelGGL(fwd_kernel, dim3(grid), dim3(NTHR), LDS_BYTES, stream, p); }
#else
    p.ph_lo = 0; p.ph_hi = N_PHASES;
    hipLaunchKernelGGL(fwd_kernel, dim3(grid), dim3(NTHR), LDS_BYTES, stream, p);
#endif
    const hipError_t le = hipPeekAtLastError();
    if (le != hipSuccess) fprintf(stderr, "kernel_launch: launch failed: %s\n", hipGetErrorName(le));
}
```

```cpp
#include <hip/hip_runtime.h>
#include <cstdio>
#include <cstdint>
#include <cmath>

#ifndef MK_MULTI
#define MK_MULTI 0
#endif

#define LAS __attribute__((address_space(3)))
#define GAS __attribute__((address_space(1)))
typedef unsigned short bf16_t;
typedef short bf16x8 __attribute__((ext_vector_type(8)));
typedef short s16x4 __attribute__((ext_vector_type(4)));
typedef float f32x4 __attribute__((ext_vector_type(4)));
typedef float f32x2 __attribute__((ext_vector_type(2)));
typedef float f32x16 __attribute__((ext_vector_type(16)));
typedef unsigned u32x4 __attribute__((ext_vector_type(4)));
typedef unsigned u32x2 __attribute__((ext_vector_type(2)));

constexpr int D = 2048, NB = 4, SEQ = 2048, CL = 256, ML = NB * SEQ, MC = NB * CL, MT = ML + MC, FF = 8192, NH = 16, NMOD = 6, MODROW = NMOD * D;
constexpr int NWAVES = 8, NTHR = 512;
constexpr float NORM_EPS = 1e-6f, SUBLN_EPS = 1e-5f;
constexpr float QSCALE = 0.125f * 1.4426950408889634f;

constexpr size_t MiB = 1u << 20;
constexpr size_t WS_CTL = 0, CTL_BYTES = 1 * MiB;
constexpr size_t WS_MOD = 1 * MiB;
constexpr size_t WS_ROPE = 2 * MiB;
constexpr size_t WS_T1 = 3 * MiB;
constexpr size_t WS_A2C = 4 * MiB;
constexpr size_t WS_A2 = 5 * MiB;
constexpr size_t WS_WQKV = 22 * MiB;
constexpr size_t WS_WO = 70 * MiB;
constexpr size_t WS_WF = 86 * MiB;
constexpr size_t WS_WPOOL = 94 * MiB;
constexpr size_t WS_W1 = 96 * MiB;
constexpr size_t WS_W2 = 224 * MiB;
constexpr size_t WS_X = 352 * MiB;
constexpr size_t WS_Y = 424 * MiB;
constexpr size_t WS_U = 496 * MiB;
constexpr size_t WS_Q = 532 * MiB, WS_K = 568 * MiB, WS_V = 604 * MiB, WS_O = 640 * MiB;
constexpr size_t WS_H = 676 * MiB;
constexpr size_t WS_YT = 820 * MiB;
constexpr size_t WS_YTC = 884 * MiB;
constexpr size_t WS_YC = 892 * MiB;
constexpr size_t WS_SLOT = 956 * MiB;
constexpr size_t WS_END = 958 * MiB;
constexpr int NSPLIT = 8;

constexpr int RING_BYTES = 131072, LDSCTL_OFF = 139264  , MISC_OFF = LDSCTL_OFF + 320, LDS_BYTES = 147456;

__device__ __forceinline__ unsigned cvt_pk_bf16(float lo, float hi) { unsigned r; asm volatile("v_cvt_pk_bf16_f32 %0, %1, %2" : "=v"(r) : "v"(lo), "v"(hi)); return r; }
typedef __bf16 bf16x2v_t __attribute__((ext_vector_type(2)));
__device__ __forceinline__ unsigned cvt_pk_vis(float lo, float hi) { const f32x2 v = {lo, hi}; const bf16x2v_t b = __builtin_convertvector(v, bf16x2v_t); return __builtin_bit_cast(unsigned, b); }
__device__ __forceinline__ float bf2f(unsigned short b) { return __uint_as_float(((unsigned)b) << 16); }
__device__ __forceinline__ float wave_sum(float v) {
#pragma unroll
    for (int o = 1; o < 64; o <<= 1) v += __shfl_xor(v, o);
    return v;
}

#define XB_TMO      128
#define XB_XCNT(j)  (256  + 64 * (j))
#define XB_XSUB(j)  (1280 + 64 * (j))
#define XB_XGEN(j)  (2304 + 64 * (j))
#define XB_TOP      3328
#define XB_TOPGEN   3392
#define XCD_BAR_WORDS 3456
#define XB_SPIN_CAP (1u << 18)
constexpr int CW_BAR = 4096, CW_FUSE = 16384, CW_TMO = 8;

__device__ __forceinline__ unsigned xb_ld(unsigned* p)              { return __hip_atomic_load(p, __ATOMIC_RELAXED, __HIP_MEMORY_SCOPE_AGENT); }
__device__ __forceinline__ unsigned xb_add(unsigned* p, unsigned v) { return __hip_atomic_fetch_add(p, v, __ATOMIC_RELAXED, __HIP_MEMORY_SCOPE_AGENT); }
__device__ __forceinline__ unsigned xb_xcc_id() { return (unsigned)__builtin_amdgcn_s_getreg((3 << 11) | 20) & 0xFu; }
#define XB_SPIN(cond, bar) do { unsigned _sp = 0; while (cond) { __builtin_amdgcn_s_sleep(1); \
    if ((++_sp & 255u) == 0u) { if (xb_ld(&(bar)[XB_TMO])) break; if (_sp > XB_SPIN_CAP) { atomicAdd(&(bar)[XB_TMO], 1u); break; } } } } while (0)

struct XcdBarrier { unsigned* bar; unsigned x; volatile LAS unsigned* st; };

__device__ __forceinline__ XcdBarrier xcd_barrier_post(unsigned* bar, volatile LAS unsigned* st) {
    XcdBarrier b; b.bar = bar; b.x = xb_xcc_id(); b.st = st;
    if (threadIdx.x == 0) st[2] = xb_add(&bar[XB_XCNT(b.x)], 1u);
    return b;
}
__device__ __forceinline__ void xcd_barrier_complete(unsigned* bar, unsigned x, unsigned& nloc, unsigned& nx) {
    const unsigned G = gridDim.x * gridDim.y * gridDim.z;
    unsigned sum, cnt, mine, sp = 0u;
    for (;;) {
        sum = 0u; cnt = 0u; mine = 0u;
#pragma unroll
        for (unsigned j = 0; j < 16; ++j) { const unsigned c = xb_ld(&bar[XB_XCNT(j)]); sum += c; cnt += (c > 0u) ? 1u : 0u; mine = (j == x) ? c : mine; }
        if (sum == G) break;
        __builtin_amdgcn_s_sleep(1);
        if ((++sp & 255u) == 0u) { if (xb_ld(&bar[XB_TMO])) break; if (sp > XB_SPIN_CAP) { atomicAdd(&bar[XB_TMO], 1u); break; } }
    }
    nloc = mine > 0u ? mine : 1u; nx = cnt > 0u ? cnt : 1u;
}
__device__ __forceinline__ void xcd_barrier(const XcdBarrier& b) {
    asm volatile("s_waitcnt vmcnt(0)" ::: "memory");
    __syncthreads();
    if (threadIdx.x == 0) {
        unsigned* bar = b.bar;
        __builtin_amdgcn_s_waitcnt(0);
        unsigned nloc = b.st[0], nx = b.st[1];
        if (nloc == 0u) { xcd_barrier_complete(bar, b.x, nloc, nx); b.st[0] = nloc; b.st[1] = nx; }
        const unsigned old = xb_add(&bar[XB_XSUB(b.x)], 1u);
        const unsigned gen = old / nloc;
        if (old + 1u == (gen + 1u) * nloc) {
            __builtin_amdgcn_fence(__ATOMIC_RELEASE, "agent");
            asm volatile("s_waitcnt vmcnt(0)" ::: "memory");
            const unsigned og = xb_add(&bar[XB_TOP], 1u);
            const unsigned tg = og / nx;
            if (og + 1u == (tg + 1u) * nx) xb_add(&bar[XB_TOPGEN], 1u);
            else XB_SPIN(xb_ld(&bar[XB_TOPGEN]) == tg, bar);
            __builtin_amdgcn_fence(__ATOMIC_ACQUIRE, "agent");
            xb_add(&bar[XB_XGEN(b.x)], 1u);
            asm volatile("s_waitcnt vmcnt(0)" ::: "memory");
        } else {
            XB_SPIN(xb_ld(&bar[XB_XGEN(b.x)]) == gen, bar);
            __builtin_amdgcn_fence(__ATOMIC_ACQUIRE, "agent");
            asm volatile("s_waitcnt vmcnt(0)" ::: "memory");
        }
    }
    __syncthreads();
}

namespace pg8 {
constexpr int BM = 256, BK = 64, HALF = 128, HTB = HALF * BK * 2, STAGE_BYTES = 8 * HTB, NXCD = 8, WGM = 8;
__device__ __forceinline__ int lds_byte(int r, int c) { const int st = (r >> 4) * 2 + (c >> 5), rr = r & 15, cc = c & 31, ob = rr * 64 + cc * 2; return st * 1024 + (ob ^ (((ob >> 9) & 1) << 5)); }
__device__ __forceinline__ void stage_rc(int b, int& R, int& C) { const int st = b / 1024, sb = b % 1024, swz = sb ^ (((sb >> 9) & 1) << 5); R = (st >> 1) * 16 + swz / 64; C = (st & 1) * 32 + (swz % 64) / 2; }
__device__ __forceinline__ int perm32(int rho) { const int n = rho >> 4, i = rho & 15; return 8 * (i >> 2) + 4 * n + (i & 3); }

struct Unit { const char* A; const char* B; int g, pm, pn; };

struct Sched {
    const char* A; const char* B; unsigned lda, ldb; int nt;
    int nM, nN, ngroups; long long a_g, b_g;
    int G, c;
    __device__ __forceinline__ bool next(int i, Unit& u) const {
        const int per = nM * nN, nwg = per * ngroups;
        const long L = (long)i * G + c; if (L >= nwg) return false;
        int wgid = (int)L; { const int q = nwg / NXCD, r = nwg % NXCD, xcd = wgid % NXCD, off = wgid / NXCD; wgid = (xcd < r ? xcd * (q + 1) : r * (q + 1) + (xcd - r) * q) + off; }
        const int g = wgid / per, w = wgid % per;
        const int nig = WGM * nN, gid = w / nig, fm = gid * WGM, gsz = (nM - fm) < WGM ? (nM - fm) : WGM;
        u.g = g; u.pm = fm + ((w % nig) % gsz); u.pn = (w % nig) / gsz;
        u.A = A + (long long)g * a_g + (size_t)u.pm * BM * lda; u.B = B + (long long)g * b_g + (size_t)u.pn * BM * ldb;
        return true;
    }
};

template <class Epi>
__device__ __forceinline__ void gemm_phase(LAS unsigned char* lds, const Sched& S, const Epi& E, int tid_in = -1) {
    const int tid = tid_in >= 0 ? tid_in : (int)threadIdx.x, wid = __builtin_amdgcn_readfirstlane(tid >> 6), lane = tid & 63, wr = wid >> 2, wc = wid & 3, fr = lane & 15, fq = lane >> 4;
    const int nt = S.nt;
    unsigned voffA[2], voffB[2];
#pragma unroll
    for (int i = 0; i < 2; ++i) { int R, C; stage_rc(tid * 16 + i * 8192, R, C); const int Rb = (R & ~31) + perm32(R & 31);
        voffA[i] = (unsigned)R * S.lda + (unsigned)C * 2u; voffB[i] = (unsigned)Rb * S.ldb + (unsigned)C * 2u; }
    const size_t kstep = (size_t)(BK * 2);
    const size_t hA = (size_t)HALF * S.lda, hB = (size_t)HALF * S.ldb;
    const unsigned ldsw = (unsigned)wid * 1024u;
    const int aoff = lds_byte(wr * 64 + fr, fq * 8), boff = lds_byte(wc * 32 + fr, fq * 8);
#define PG8_SA(b, h) (((b) * 2 + (h)) * HTB)
#define PG8_SB(b, h) ((4 + (b) * 2 + (h)) * HTB)
#define PG8_STAGE(bufoff, gbase, voff) do { _Pragma("unroll") for (int _i = 0; _i < 2; ++_i) \
        __builtin_amdgcn_global_load_lds((const unsigned*)((const char*)(gbase) + (voff)[_i]), (LAS unsigned*)(lds + (bufoff) + ldsw + _i * 8192), 16, 0, 0); } while (0)
#define PG8_LDA(dst, b, h) do { _Pragma("unroll") for (int m = 0; m < 4; ++m) _Pragma("unroll") for (int k = 0; k < 2; ++k) dst[m][k] = *(const LAS bf16x8*)(lds + PG8_SA(b, h) + aoff + m * 2048 + k * 1024); } while (0)
#define PG8_LDB(dst, b, h) do { _Pragma("unroll") for (int n = 0; n < 2; ++n) _Pragma("unroll") for (int k = 0; k < 2; ++k) dst[n][k] = *(const LAS bf16x8*)(lds + PG8_SB(b, h) + boff + n * 2048 + k * 1024); } while (0)
#define PG8_MMA(ai, bj, At, Bt) do { __builtin_amdgcn_s_setprio(1); _Pragma("unroll") for (int m = 0; m < 4; ++m) _Pragma("unroll") for (int n = 0; n < 2; ++n) _Pragma("unroll") for (int k = 0; k < 2; ++k) \
        acc[ai][bj][m][n] = __builtin_amdgcn_mfma_f32_16x16x32_bf16(Bt[n][k], At[m][k], acc[ai][bj][m][n], 0, 0, 0); __builtin_amdgcn_s_setprio(0); } while (0)
#define PG8_WAIT_V(n) asm volatile("s_waitcnt vmcnt(" #n ")" ::: "memory")
#define PG8_WAIT_L(n) asm volatile("s_waitcnt lgkmcnt(" #n ")" ::: "memory")
#define PG8_BAR __builtin_amdgcn_s_barrier()
#define PG8_SCHED __builtin_amdgcn_sched_barrier(0)
    Unit cur, nxt; int ui = 0;
    if (!S.next(0, cur)) return;
    f32x4 acc[2][2][4][2];
#pragma unroll
    for (int a = 0; a < 2; ++a)
#pragma unroll
        for (int b = 0; b < 2; ++b)
#pragma unroll
            for (int m = 0; m < 4; ++m)
#pragma unroll
                for (int n = 0; n < 2; ++n) acc[a][b][m][n] = (f32x4){0.f, 0.f, 0.f, 0.f};
    bf16x8 At[4][2], B0[2][2], B1[2][2];
    const char* cA = cur.A; const char* cB = cur.B;
    PG8_STAGE(PG8_SB(0, 0), cB, voffB); PG8_STAGE(PG8_SB(0, 1), cB + hB, voffB); PG8_STAGE(PG8_SA(0, 0), cA, voffA); PG8_STAGE(PG8_SA(0, 1), cA + hA, voffA);
    if (wr == 1) PG8_BAR;
    PG8_WAIT_V(2); PG8_BAR;
    PG8_STAGE(PG8_SB(1, 0), cB + kstep, voffB); PG8_STAGE(PG8_SA(1, 0), cA + kstep, voffA); PG8_STAGE(PG8_SB(1, 1), cB + hB + kstep, voffB);
    PG8_WAIT_V(6); PG8_BAR;
    for (;;) {
        const bool has_next = S.next(ui + 1, nxt);
        const char* nA = has_next ? nxt.A : cA; const char* nB = has_next ? nxt.B : cB;
        for (int t = 0; t < nt; t += 2) {
            const bool last = (t == nt - 2);
            const char* a1 = cA + (size_t)(t + 1) * kstep;
            const char* a2 = last ? nA : cA + (size_t)(t + 2) * kstep; const char* b2 = last ? nB : cB + (size_t)(t + 2) * kstep;
            const char* a3 = a2 + kstep; const char* b3 = b2 + kstep;
            PG8_LDB(B0, 0, 0); PG8_LDB(B1, 0, 1); PG8_SCHED; PG8_LDA(At, 0, 0); PG8_STAGE(PG8_SA(1, 1), a1 + hA, voffA);
            PG8_WAIT_V(8); PG8_WAIT_L(0); PG8_BAR; PG8_MMA(0, 0, At, B0); PG8_MMA(0, 1, At, B1); PG8_BAR; PG8_SCHED;
            PG8_LDA(At, 0, 1); PG8_STAGE(PG8_SB(0, 0), b2, voffB); PG8_STAGE(PG8_SB(0, 1), b2 + hB, voffB); PG8_STAGE(PG8_SA(0, 0), a2, voffA);
            PG8_WAIT_V(8); PG8_WAIT_L(0); PG8_BAR; PG8_MMA(1, 0, At, B0); PG8_MMA(1, 1, At, B1); PG8_BAR; PG8_SCHED;
            PG8_LDB(B0, 1, 0); PG8_LDB(B1, 1, 1); PG8_SCHED; PG8_LDA(At, 1, 0); PG8_STAGE(PG8_SA(0, 1), a2 + hA, voffA);
            PG8_WAIT_V(8); PG8_WAIT_L(0); PG8_BAR; PG8_MMA(0, 0, At, B0); PG8_MMA(0, 1, At, B1); PG8_BAR; PG8_SCHED;
            PG8_LDA(At, 1, 1); PG8_STAGE(PG8_SB(1, 0), b3, voffB); PG8_STAGE(PG8_SB(1, 1), b3 + hB, voffB); PG8_STAGE(PG8_SA(1, 0), a3, voffA);
            PG8_WAIT_V(8); PG8_WAIT_L(0); PG8_BAR; PG8_MMA(1, 0, At, B0); PG8_MMA(1, 1, At, B1); PG8_BAR; PG8_SCHED;
        }
        if (wr == 0) PG8_BAR;
        if constexpr (!Epi::FUSED) E(acc, cur, wr, wc, fr, fq);
        if (!has_next) break;
#pragma unroll
        for (int a = 0; a < 2; ++a)
#pragma unroll
            for (int b = 0; b < 2; ++b)
#pragma unroll
                for (int m = 0; m < 4; ++m)
#pragma unroll
                    for (int n = 0; n < 2; ++n) acc[a][b][m][n] = (f32x4){0.f, 0.f, 0.f, 0.f};
        cur = nxt; cA = nA; cB = nB; ++ui;
        if (wr == 1) PG8_BAR;
    }
    PG8_WAIT_V(0);
    PG8_BAR;
    if constexpr (Epi::FUSED) E.fused(acc, cur, wr, wc, fr, fq, lds, wid, lane, tid);
#undef PG8_SA
#undef PG8_SB
#undef PG8_STAGE
#undef PG8_LDA
#undef PG8_LDB
#undef PG8_MMA
#undef PG8_WAIT_V
#undef PG8_WAIT_L
#undef PG8_BAR
#undef PG8_SCHED
}

struct EpiF32 {
    static constexpr bool FUSED = false;
    float* C; unsigned ldc; const float* colscale; int c_g; size_t slab_g;
    __device__ __forceinline__ void operator()(const f32x4 (&acc)[2][2][4][2], const Unit& u, int wr, int wc, int fr, int fq) const {
        const int row0 = u.pm * BM + wr * 64 + fr, col0 = u.g * c_g + u.pn * BM + wc * 32 + 8 * fq;
        f32x4 sv[2][2];
#pragma unroll
        for (int bj = 0; bj < 2; ++bj)
#pragma unroll
            for (int n = 0; n < 2; ++n) sv[bj][n] = colscale ? *(const f32x4*)(colscale + col0 + bj * HALF + 4 * n) : (f32x4){1.f, 1.f, 1.f, 1.f};
#pragma unroll
        for (int ai = 0; ai < 2; ++ai)
#pragma unroll
            for (int m = 0; m < 4; ++m) { float* rowp = C + (size_t)u.g * slab_g + (size_t)(row0 + ai * HALF + m * 16) * ldc + col0;
#pragma unroll
                for (int bj = 0; bj < 2; ++bj) { *(f32x4*)(rowp + bj * HALF) = acc[ai][bj][m][0] * sv[bj][0]; *(f32x4*)(rowp + bj * HALF + 4) = acc[ai][bj][m][1] * sv[bj][1]; } }
    }
};
struct EpiY {
    static constexpr bool FUSED = false;
    bf16_t* C; unsigned ldc; const float* colscale; int c_g; size_t slab_g;
    __device__ __forceinline__ void operator()(const f32x4 (&acc)[2][2][4][2], const Unit& u, int wr, int wc, int fr, int fq) const {
        const int row0 = u.pm * BM + wr * 64 + fr, col0 = u.g * c_g + u.pn * BM + wc * 32 + 8 * fq;
        f32x4 sv[2][2];
#pragma unroll
        for (int bj = 0; bj < 2; ++bj)
#pragma unroll
            for (int n = 0; n < 2; ++n) sv[bj][n] = colscale ? *(const f32x4*)(colscale + col0 + bj * HALF + 4 * n) : (f32x4){1.f, 1.f, 1.f, 1.f};
#pragma unroll
        for (int ai = 0; ai < 2; ++ai)
#pragma unroll
            for (int m = 0; m < 4; ++m) { bf16_t* rowp = C + (size_t)(row0 + ai * HALF + m * 16) * ldc + col0;
#pragma unroll
                for (int bj = 0; bj < 2; ++bj) { const f32x4 v0 = acc[ai][bj][m][0] * sv[bj][0], v1 = acc[ai][bj][m][1] * sv[bj][1];
                    u32x4 w; w.x = cvt_pk_vis(v0[0], v0[1]); w.y = cvt_pk_vis(v0[2], v0[3]); w.z = cvt_pk_vis(v1[0], v1[1]); w.w = cvt_pk_vis(v1[2], v1[3]);
                    *(u32x4*)(rowp + bj * HALF) = w; } }
    }
};
struct EpiSlab {
    static constexpr bool FUSED = false;
    bf16_t* C; unsigned ldc; size_t slab_g;
    __device__ __forceinline__ void operator()(const f32x4 (&acc)[2][2][4][2], const Unit& u, int wr, int wc, int fr, int fq) const {
        const int row0 = u.pm * BM + wr * 64 + fr, col0 = u.pn * BM + wc * 32 + 8 * fq;
#pragma unroll
        for (int ai = 0; ai < 2; ++ai)
#pragma unroll
            for (int m = 0; m < 4; ++m) { bf16_t* rowp = C + (size_t)u.g * slab_g + (size_t)(row0 + ai * HALF + m * 16) * ldc + col0;
#pragma unroll
                for (int bj = 0; bj < 2; ++bj) { const f32x4 v0 = acc[ai][bj][m][0], v1 = acc[ai][bj][m][1];
                    u32x4 w; w.x = cvt_pk_vis(v0[0], v0[1]); w.y = cvt_pk_vis(v0[2], v0[3]); w.z = cvt_pk_vis(v1[0], v1[1]); w.w = cvt_pk_vis(v1[2], v1[3]);
                    *(u32x4*)(rowp + bj * HALF) = w; } }
    }
};
template <int ACT> struct EpiBf16 {
    static constexpr bool FUSED = false;
    bf16_t* C; unsigned ldc; int row_g;
    __device__ __forceinline__ void operator()(const f32x4 (&acc)[2][2][4][2], const Unit& u, int wr, int wc, int fr, int fq) const {
        const int row0 = u.g * row_g + u.pm * BM + wr * 64 + fr, col0 = u.pn * BM + wc * 32 + 8 * fq;
#pragma unroll
        for (int ai = 0; ai < 2; ++ai)
#pragma unroll
            for (int m = 0; m < 4; ++m) { bf16_t* rowp = C + (size_t)(row0 + ai * HALF + m * 16) * ldc + col0;
#pragma unroll
                for (int bj = 0; bj < 2; ++bj) { f32x4 v0 = acc[ai][bj][m][0], v1 = acc[ai][bj][m][1];
                    if (ACT == 1) {
#pragma unroll
                        for (int e = 0; e < 4; ++e) { const float a = __builtin_amdgcn_fmed3f(v0[e], 0.f, __builtin_inff()), b = __builtin_amdgcn_fmed3f(v1[e], 0.f, __builtin_inff()); v0[e] = a * a; v1[e] = b * b; } }
                    u32x4 w; w.x = cvt_pk_vis(v0[0], v0[1]); w.y = cvt_pk_vis(v0[2], v0[3]); w.z = cvt_pk_vis(v1[0], v1[1]); w.w = cvt_pk_vis(v1[2], v1[3]);
                    *(u32x4*)(rowp + bj * HALF) = w; } }
    }
};
struct EpiFAH {
    static constexpr bool FUSED = false;
    bf16_t* YT; int cs;
    __device__ __forceinline__ void operator()(const f32x4 (&acc)[2][2][4][2], const Unit& u, int wr, int wc, int fr, int fq) const {
        bf16_t* base = YT + (size_t)(u.g * 256) * 16384 + (u.pn >> 3) * 4096 + cs * 2048 + (u.pn & 7) * 256;
        const int row0 = wr * 64 + fr, col0 = wc * 32 + 8 * fq;
#pragma unroll
        for (int ai = 0; ai < 2; ++ai)
#pragma unroll
            for (int m = 0; m < 4; ++m) { bf16_t* rowp = base + (size_t)(row0 + ai * HALF + m * 16) * 16384 + col0;
#pragma unroll
                for (int bj = 0; bj < 2; ++bj) { const f32x4 v0 = acc[ai][bj][m][0], v1 = acc[ai][bj][m][1];
                    u32x4 w; w.x = cvt_pk_vis(v0[0], v0[1]); w.y = cvt_pk_vis(v0[2], v0[3]); w.z = cvt_pk_vis(v1[0], v1[1]); w.w = cvt_pk_vis(v1[2], v1[3]);
                    *(u32x4*)(rowp + bj * HALF) = w; } }
    }
};
struct EpiFA {
    static constexpr bool FUSED = false;
    bf16_t* YT; bf16_t* YTC; int pn_base;
    __device__ __forceinline__ void operator()(const f32x4 (&acc)[2][2][4][2], const Unit& u, int wr, int wc, int fr, int fq) const {
        const int cs = u.pm >> 1, k2b = (u.pm & 1) * 256, pn = u.pn + pn_base;
        bf16_t* base; size_t pitch;
        if (pn < 32) { const int b = pn >> 3; base = YT + (size_t)(u.g * 512 + k2b) * 16384 + b * 4096 + cs * 2048 + (pn & 7) * 256; pitch = 16384; }
        else { const int b = pn - 32; base = YTC + (size_t)(u.g * 512 + k2b) * 2048 + b * 512 + cs * 256; pitch = 2048; }
        const int row0 = wr * 64 + fr, col0 = wc * 32 + 8 * fq;
#pragma unroll
        for (int ai = 0; ai < 2; ++ai)
#pragma unroll
            for (int m = 0; m < 4; ++m) { bf16_t* rowp = base + (size_t)(row0 + ai * HALF + m * 16) * pitch + col0;
#pragma unroll
                for (int bj = 0; bj < 2; ++bj) { const f32x4 v0 = acc[ai][bj][m][0], v1 = acc[ai][bj][m][1];
                    u32x4 w; w.x = cvt_pk_vis(v0[0], v0[1]); w.y = cvt_pk_vis(v0[2], v0[3]); w.z = cvt_pk_vis(v1[0], v1[1]); w.w = cvt_pk_vis(v1[2], v1[3]);
                    *(u32x4*)(rowp + bj * HALF) = w; } }
    }
};
struct EpiQKV {
    static constexpr bool FUSED = false;
    bf16_t* Q; const float* rope;
    int pm_base, pn_base;
    __device__ __forceinline__ void operator()(const f32x4 (&acc)[2][2][4][2], const Unit& u, int wr, int wc, int fr, int fq) const {
        const int pn = u.pn + pn_base, pm = u.pm + pm_base, part = pn >> 3;
        bf16_t* dst = Q + (size_t)part * ((WS_K - WS_Q) / 2);
        const int row0 = pm * BM + wr * 64 + fr, colp = (pn & 7) * BM + wc * 32 + 8 * fq;
        const bool dorope = (part < 2) && (pm < 32);
        const float sc = part == 0 ? QSCALE : 1.f;
#pragma unroll
        for (int ai = 0; ai < 2; ++ai)
#pragma unroll
            for (int m = 0; m < 4; ++m) { const int row = row0 + ai * HALF + m * 16; bf16_t* rowp = dst + (size_t)row * D + colp;
                const int t = row & 2047, prow = t >> 6, pcol = t & 63;
#pragma unroll
                for (int bj = 0; bj < 2; ++bj) { f32x4 v0 = acc[ai][bj][m][0], v1 = acc[ai][bj][m][1];
                    if (dorope) { const int c = colp + bj * HALF, j0 = (c & 63) >> 1, ax = j0 >> 4, f0 = j0 & 15;
                        const float* cs = rope + ((ax ? pcol : prow) * 16 + f0) * 2;
                        const f32x4 cs0 = *(const f32x4*)cs, cs1 = *(const f32x4*)(cs + 4);
                        f32x4 r0, r1;
                        r0[0] = v0[0] * cs0[0] - v0[1] * cs0[1]; r0[1] = v0[0] * cs0[1] + v0[1] * cs0[0];
                        r0[2] = v0[2] * cs0[2] - v0[3] * cs0[3]; r0[3] = v0[2] * cs0[3] + v0[3] * cs0[2];
                        r1[0] = v1[0] * cs1[0] - v1[1] * cs1[1]; r1[1] = v1[0] * cs1[1] + v1[1] * cs1[0];
                        r1[2] = v1[2] * cs1[2] - v1[3] * cs1[3]; r1[3] = v1[2] * cs1[3] + v1[3] * cs1[2];
                        v0 = r0; v1 = r1; }
                    v0 = v0 * sc; v1 = v1 * sc;
                    u32x4 w; w.x = cvt_pk_vis(v0[0], v0[1]); w.y = cvt_pk_vis(v0[2], v0[3]); w.z = cvt_pk_vis(v1[0], v1[1]); w.w = cvt_pk_vis(v1[2], v1[3]);
                    *(u32x4*)(rowp + bj * HALF) = w; } }
    }
};

struct EpiFuse {
    static constexpr bool FUSED = true;
    const float* xin; float* xout; bf16_t* uout;
    const float* gate; const float* g_post;
    const float* g_pre; const float* sc; const float* sh;
    unsigned long long* slots;
    unsigned* cnt; unsigned* tmo;
    __device__ __forceinline__ void operator()(const f32x4 (&)[2][2][4][2], const Unit&, int, int, int, int) const {}
    __device__ __forceinline__ void fused(f32x4 (&acc)[2][2][4][2], const Unit& u, int wr, int wc, int fr, int fq, LAS unsigned char* lds, int wid, int lane, int tid) const {
        LAS float* ta = (LAS float*)lds; LAS float* tg = ta + 256; LAS float* ts = tg + 256;
        LAS f32x4* P4 = (LAS f32x4*)(lds + 4096);
        LAS f32x2* S2 = (LAS f32x2*)(lds + 4096 + 16384);
        const int b = (u.pm * BM) >> 11, colt = u.pn * BM;
#define FZ_BAR() do { asm volatile("s_waitcnt vmcnt(0) lgkmcnt(0)" ::: "memory"); __builtin_amdgcn_s_barrier(); asm volatile("" ::: "memory"); } while (0)
        if (tid < 256) { const int c = colt + tid; ta[tid] = gate[(size_t)b * MODROW + c] * g_post[c];
            if (uout) { tg[tid] = g_pre[c] * (1.0f + sc[(size_t)b * MODROW + c]); ts[tid] = sh[(size_t)b * MODROW + c]; } }
        FZ_BAR();
#pragma unroll
        for (int ai = 0; ai < 2; ++ai)
#pragma unroll
            for (int m = 0; m < 4; ++m) { const int rl = ai * HALF + wr * 64 + m * 16 + fr; const float* xr = xin + (size_t)((u.pm * BM) + rl) * D + colt + wc * 32 + 8 * fq;
                float s1 = 0.f, s2 = 0.f, s3 = 0.f, s4 = 0.f;
#pragma unroll
                for (int bj = 0; bj < 2; ++bj)
#pragma unroll
                    for (int n = 0; n < 2; ++n) { const f32x4 y = acc[ai][bj][m][n], x = *(const f32x4*)(xr + bj * HALF + 4 * n), a = *(const LAS f32x4*)(ta + bj * HALF + wc * 32 + 8 * fq + 4 * n);
                        const f32x4 ay = a * y;
                        s1 += (y[0] * y[0] + y[1] * y[1]) + (y[2] * y[2] + y[3] * y[3]); s2 += (x[0] * x[0] + x[1] * x[1]) + (x[2] * x[2] + x[3] * x[3]);
                        s3 += (x[0] * ay[0] + x[1] * ay[1]) + (x[2] * ay[2] + x[3] * ay[3]); s4 += (ay[0] * ay[0] + ay[1] * ay[1]) + (ay[2] * ay[2] + ay[3] * ay[3]); }
                s1 += __shfl_xor(s1, 16); s1 += __shfl_xor(s1, 32); s2 += __shfl_xor(s2, 16); s2 += __shfl_xor(s2, 32);
                s3 += __shfl_xor(s3, 16); s3 += __shfl_xor(s3, 32); s4 += __shfl_xor(s4, 16); s4 += __shfl_xor(s4, 32);
                if (fq == 0) P4[rl * 4 + wc] = (f32x4){s1, s2, s3, s4};
                asm volatile("" ::: "memory"); }
        FZ_BAR();
        if (tid < 256) { const f32x4 p0 = P4[tid * 4 + 0], p1 = P4[tid * 4 + 1], p2 = P4[tid * 4 + 2], p3 = P4[tid * 4 + 3]; const f32x4 t = (p0 + p1) + (p2 + p3);
            unsigned long long* slot = slots + ((size_t)((u.pm * BM) + tid) * 8 + u.pn) * 2;
            __hip_atomic_store(slot, ((unsigned long long)__float_as_uint(t[1]) << 32) | __float_as_uint(t[0]), __ATOMIC_RELAXED, __HIP_MEMORY_SCOPE_AGENT);
            __hip_atomic_store(slot + 1, ((unsigned long long)__float_as_uint(t[3]) << 32) | __float_as_uint(t[2]), __ATOMIC_RELAXED, __HIP_MEMORY_SCOPE_AGENT); }
        asm volatile("s_waitcnt vmcnt(0)" ::: "memory");
        if (tid < 256 && lane == 0) __hip_atomic_fetch_add(cnt + 64 * u.pm, 1u, __ATOMIC_RELAXED, __HIP_MEMORY_SCOPE_AGENT);
        if (wid == 0) { const unsigned long long t0 = __builtin_amdgcn_s_memrealtime();
            for (;;) { if ((unsigned)__builtin_amdgcn_readfirstlane(__hip_atomic_load(cnt + 64 * u.pm, __ATOMIC_RELAXED, __HIP_MEMORY_SCOPE_AGENT)) >= 32u) break;
                if (__builtin_amdgcn_s_memrealtime() - t0 > 2000000ull) { if (lane == 0) __hip_atomic_store(tmo, 1u, __ATOMIC_RELAXED, __HIP_MEMORY_SCOPE_AGENT); break; }
                __builtin_amdgcn_s_sleep(2); }
            __builtin_amdgcn_fence(__ATOMIC_ACQUIRE, "agent"); }
        FZ_BAR();
        if (tid < 256) { const unsigned long long* slot = slots + (size_t)((u.pm * BM) + tid) * 16; float t1 = 0.f, t2 = 0.f, t3 = 0.f, t4 = 0.f;
#pragma unroll
            for (int t = 0; t < 8; ++t) { const unsigned long long w0 = __hip_atomic_load(slot + 2 * t, __ATOMIC_RELAXED, __HIP_MEMORY_SCOPE_AGENT), w1 = __hip_atomic_load(slot + 2 * t + 1, __ATOMIC_RELAXED, __HIP_MEMORY_SCOPE_AGENT);
                t1 += __uint_as_float((unsigned)w0); t2 += __uint_as_float((unsigned)(w0 >> 32)); t3 += __uint_as_float((unsigned)w1); t4 += __uint_as_float((unsigned)(w1 >> 32)); }
            const float r1 = 1.0f / sqrtf(t1 * (1.0f / D) + NORM_EPS);
            const float q = t2 + 2.0f * r1 * t3 + r1 * r1 * t4;
            S2[tid] = (f32x2){r1, 1.0f / sqrtf(fmaxf(q, 0.f) * (1.0f / D) + NORM_EPS)}; }
        FZ_BAR();
#pragma unroll
        for (int ai = 0; ai < 2; ++ai)
#pragma unroll
            for (int m = 0; m < 4; ++m) { const int rl = ai * HALF + wr * 64 + m * 16 + fr; const size_t off = (size_t)((u.pm * BM) + rl) * D + colt + wc * 32 + 8 * fq; const f32x2 rr = S2[rl];
#pragma unroll
                for (int bj = 0; bj < 2; ++bj) { const int cl = bj * HALF + wc * 32 + 8 * fq;
                    const f32x4 a0 = *(const LAS f32x4*)(ta + cl), a1 = *(const LAS f32x4*)(ta + cl + 4);
                    const f32x4 x0 = *(const f32x4*)(xin + off + bj * HALF) + (a0 * acc[ai][bj][m][0]) * rr[0], x1 = *(const f32x4*)(xin + off + bj * HALF + 4) + (a1 * acc[ai][bj][m][1]) * rr[0];
                    *(f32x4*)(xout + off + bj * HALF) = x0; *(f32x4*)(xout + off + bj * HALF + 4) = x1;
                    if (uout) { const f32x4 g0 = *(const LAS f32x4*)(tg + cl), g1 = *(const LAS f32x4*)(tg + cl + 4), h0 = *(const LAS f32x4*)(ts + cl), h1 = *(const LAS f32x4*)(ts + cl + 4);
                        const f32x4 u0 = (x0 * rr[1]) * g0 + h0, u1 = (x1 * rr[1]) * g1 + h1;
                        u32x4 w; w.x = cvt_pk_vis(u0[0], u0[1]); w.y = cvt_pk_vis(u0[2], u0[3]); w.z = cvt_pk_vis(u1[0], u1[1]); w.w = cvt_pk_vis(u1[2], u1[3]);
                        *(u32x4*)(uout + off + bj * HALF) = w; } }
                asm volatile("" ::: "memory"); }
        FZ_BAR();
#undef FZ_BAR
    }
};
}


namespace att {
__device__ __forceinline__ unsigned off_a(unsigned row, unsigned ch) { return 2048u * (row >> 3) + 512u * (ch >> 2) + 64u * (row & 7) + 16u * ((ch & 3) ^ ((row >> 2) & 3)); }
constexpr int KBUF = 0, VBUF = 32768, QOFF = 65536, WSF_OFF = LDSCTL_OFF + 1024;
constexpr float THR = 6.0f;
struct Args { const bf16_t* Q; const bf16_t* K; const bf16_t* V; bf16_t* O; const float* gsub; float lam, post; };
__device__ __forceinline__ s16x4 vtr(const LAS unsigned char* p) { return __builtin_bit_cast(s16x4, __builtin_amdgcn_ds_read_tr16_b64_v4i16((LAS s16x4*)p)); }
__device__ __forceinline__ float half_max(float v) { auto rr = __builtin_amdgcn_permlane32_swap(__float_as_uint(v), __float_as_uint(v), false, false); return fmaxf(__uint_as_float(rr[0]), __uint_as_float(rr[1])); }
__device__ __forceinline__ float half_sum(float v) { auto rr = __builtin_amdgcn_permlane32_swap(__float_as_uint(v), __float_as_uint(v), false, false); return __uint_as_float(rr[0]) + __uint_as_float(rr[1]); }

__device__ __forceinline__ void glds16(const void* gsrc, unsigned lds_dst) { unsigned keep;
    asm volatile("s_mov_b32 %0, m0\n\ts_mov_b32 m0, %2\n\ts_nop 0\n\tglobal_load_lds_dwordx4 %1, off\n\ts_mov_b32 m0, %0" : "=&s"(keep) : "v"(gsrc), "s"(lds_dst) : "memory"); }
__device__ __forceinline__ float max3f(float a, float b, float c) { float r; asm("v_max3_f32 %0, %1, %2, %3" : "=v"(r) : "v"(a), "v"(b), "v"(c)); return r; }
__device__ __forceinline__ float max2f(float a, float b) { float r; asm("v_max_f32_e32 %0, %1, %2" : "=v"(r) : "v"(a), "v"(b)); return r; }
__device__ __forceinline__ float fsub_s(float a, float b) { float r; asm("v_sub_f32_e32 %0, %1, %2" : "=v"(r) : "v"(a), "v"(b)); return r; }
__device__ __forceinline__ float fadd_s(float a, float b) { float r; asm("v_add_f32_e32 %0, %1, %2" : "=v"(r) : "v"(a), "v"(b)); return r; }
typedef __bf16 bf16x2_t __attribute__((ext_vector_type(2)));
__device__ __forceinline__ unsigned cvtpk_b(float lo, float hi) { const f32x2 v = {lo, hi}; const bf16x2_t b = __builtin_convertvector(v, bf16x2_t); return __builtin_bit_cast(unsigned, b); }
template <bool SAFE>
__device__ __forceinline__ bool unit(LAS unsigned char* lds, const Args& P, int b, int h, int q0, int nlat, int tid) {
    const int lane = tid & 63, r32 = lane & 31, hi = lane >> 5; const int wid = __builtin_amdgcn_readfirstlane(tid >> 6);
    const int nt = nlat + 4;
    if (wid >= 4) __builtin_amdgcn_s_setprio(1);
    LAS unsigned char* Qs = lds + QOFF + wid * 8192;
    LAS float* wsf = (LAS float*)(lds + WSF_OFF + wid * 256);
    {   const bf16_t* qrow = P.Q + (size_t)(q0 + wid * 32 + r32) * D + h * 128 + hi * 8;
#pragma unroll
        for (int c = 0; c < 2; ++c)
#pragma unroll
            for (int d0 = 0; d0 < 4; ++d0) { const u32x4 v = *(const u32x4*)(qrow + c * 64 + d0 * 16); *(LAS u32x4*)(Qs + ((c * 4 + d0) * 2 + hi) * 512 + r32 * 16) = v; } }
    unsigned goff[2];
#pragma unroll
    for (int i = 0; i < 2; ++i) { const unsigned p = 2 * wid + i, rg = p >> 1, chq = (p & 1) * 2 + (lane >> 5), r7 = (lane >> 2) & 7, x = lane & 3, rsw = (r7 >> 2) | ((rg & 1) << 1);
        goff[i] = ((8 * rg + r7) * D + h * 128 + (4 * chq + (x ^ rsw)) * 8) * 2; }
#define ATT_GROW(t) ((t) < nlat ? b * SEQ + 64 * (t) : ML + b * CL + 64 * ((t) - nlat))
#define ATT_DMA(t, buf) do { const size_t g_ = (size_t)ATT_GROW(t) * D * 2; _Pragma("unroll") for (int i_ = 0; i_ < 2; ++i_) { \
        glds16((const char*)P.K + g_ + goff[i_], (unsigned)__builtin_amdgcn_readfirstlane(lds0 + KBUF + (buf) * 16384 + (2 * wid + i_) * 1024)); \
        glds16((const char*)P.V + g_ + goff[i_], (unsigned)__builtin_amdgcn_readfirstlane(lds0 + VBUF + (buf) * 16384 + (2 * wid + i_) * 1024)); } } while (0)
    const unsigned lds0 = (unsigned)(uintptr_t)lds;
    ATT_DMA(0, 0);
    unsigned kb[2];
#pragma unroll
    for (int e = 0; e < 2; ++e) kb[e] = 2048u * (r32 >> 3) + 64u * (r32 & 7) + 16u * ((unsigned)(2 * e + hi) ^ ((r32 >> 2) & 3));
    const unsigned blk = (lane >> 4) & 1, q_ = (lane & 15) >> 2, p_ = lane & 3;
    unsigned vb[2];
#pragma unroll
    for (int t = 0; t < 2; ++t) vb[t] = 2048u * t + 64u * (4 * hi + q_) + 16u * ((2 * blk + (p_ >> 1)) ^ ((2 * t + hi) & 3)) + 8u * (p_ & 1);
    float m0 = -1e30f, m1 = -1e30f, l0 = 0.f, l1 = 0.f;
    f32x16 o[2][4];
#pragma unroll
    for (int c = 0; c < 2; ++c)
#pragma unroll
        for (int d = 0; d < 4; ++d) o[c][d] = f32x16{};
    asm volatile("s_waitcnt vmcnt(0)" ::: "memory");
    __syncthreads();
#define SB() __builtin_amdgcn_sched_barrier(0)
#define ATT_SMB(S0, S1, i, M, SUM, PW) do { const float a_ = (i) < 8 ? S0[2 * ((i) & 7)] : S1[2 * ((i) & 7)], b_ = (i) < 8 ? S0[2 * ((i) & 7) + 1] : S1[2 * ((i) & 7) + 1]; \
        const float ea_ = SAFE ? __builtin_amdgcn_exp2f(fsub_s(a_, M)) : __builtin_amdgcn_exp2f(a_), eb_ = SAFE ? __builtin_amdgcn_exp2f(fsub_s(b_, M)) : __builtin_amdgcn_exp2f(b_); \
        SUM += ea_; SUM += eb_; PW[i] = cvtpk_b(ea_, eb_); asm volatile("" : "+v"(SUM), "+v"(PW[i])); } while (0)
#define ATT_SMA(S0, S1, c, MC, LC) do { asm volatile("s_nop 15\n\ts_nop 7" : "+v"(S0), "+v"(S1)); \
        float a_ = max3f(S0[0], S0[1], S1[0]), b_ = max3f(S0[2], S0[3], S1[1]); a_ = max3f(a_, S1[2], S1[3]); \
        _Pragma("unroll") for (int r_ = 4; r_ < 16; r_ += 4) { a_ = max3f(a_, S0[r_], S0[r_ + 1]); b_ = max3f(b_, S0[r_ + 2], S0[r_ + 3]); a_ = max3f(a_, S1[r_], S1[r_ + 1]); b_ = max3f(b_, S1[r_ + 2], S1[r_ + 3]); } \
        const float mx_ = half_max(max2f(a_, b_)); \
        if (__any(mx_ - MC > THR)) { const float mn_ = fmaxf(MC, mx_), al_ = __builtin_amdgcn_exp2f(MC - mn_); MC = mn_; LC *= al_; if (hi == 0) wsf[r32] = al_; \
            _Pragma("unroll") for (int g4 = 0; g4 < 4; ++g4) { const f32x4 a4 = *(const LAS f32x4*)(wsf + 8 * g4 + 4 * hi); \
                _Pragma("unroll") for (int d = 0; d < 4; ++d) { o[c][d][4 * g4 + 0] *= a4[0]; o[c][d][4 * g4 + 1] *= a4[1]; o[c][d][4 * g4 + 2] *= a4[2]; o[c][d][4 * g4 + 3] *= a4[3]; } } } } while (0)
#define ATT_LDQK(c, d0, QF, K0, K1) do { QF = *(const LAS bf16x8*)(Qs + (((c) * 4 + (d0)) * 2 + hi) * 512 + r32 * 16); \
        K0 = *(const LAS bf16x8*)(Kb + kb[(d0) & 1] + 512 * (2 * (c) + ((d0) >> 1))); K1 = *(const LAS bf16x8*)(Kb + kb[(d0) & 1] + 512 * (2 * (c) + ((d0) >> 1)) + 8192); } while (0)
#define ATT_LDV(i, LO, HH) do { LO = vtr(Vb + vb[0] + 4096 * ((i) >> 2) + 512 * ((i) & 3)); HH = vtr(Vb + vb[1] + 4096 * ((i) >> 2) + 512 * ((i) & 3)); } while (0)
#define ATT_VF(LO, HH) ((bf16x8){LO[0], LO[1], LO[2], LO[3], HH[0], HH[1], HH[2], HH[3]})
#define ATT_PA(PW, ks) ((bf16x8)__builtin_bit_cast(bf16x8, (u32x4){PW[4 * (ks)], PW[4 * (ks) + 1], PW[4 * (ks) + 2], PW[4 * (ks) + 3]}))
#pragma unroll 1
    for (int t = 0; t < nt; ++t) {
        const int buf = t & 1;
        if (t + 1 < nt) ATT_DMA(t + 1, buf ^ 1);
        const LAS unsigned char* Kb = lds + KBUF + buf * 16384; const LAS unsigned char* Vb = lds + VBUF + buf * 16384;
        unsigned pw0[16], pw1[16];
        f32x16 sa = f32x16{}, sb = f32x16{};
        SB();
        {   bf16x8 qfA, k0A, k1A, qfB, k0B, k1B;
            ATT_LDQK(0, 0, qfA, k0A, k1A); ATT_LDQK(0, 1, qfB, k0B, k1B); SB();
            sa = __builtin_amdgcn_mfma_f32_32x32x16_bf16(k0A, qfA, sa, 0, 0, 0); sb = __builtin_amdgcn_mfma_f32_32x32x16_bf16(k1A, qfA, sb, 0, 0, 0); SB();
            ATT_LDQK(0, 2, qfA, k0A, k1A); SB();
            sa = __builtin_amdgcn_mfma_f32_32x32x16_bf16(k0B, qfB, sa, 0, 0, 0); sb = __builtin_amdgcn_mfma_f32_32x32x16_bf16(k1B, qfB, sb, 0, 0, 0); SB();
            ATT_LDQK(0, 3, qfB, k0B, k1B); SB();
            sa = __builtin_amdgcn_mfma_f32_32x32x16_bf16(k0A, qfA, sa, 0, 0, 0); sb = __builtin_amdgcn_mfma_f32_32x32x16_bf16(k1A, qfA, sb, 0, 0, 0); SB();
            sa = __builtin_amdgcn_mfma_f32_32x32x16_bf16(k0B, qfB, sa, 0, 0, 0); sb = __builtin_amdgcn_mfma_f32_32x32x16_bf16(k1B, qfB, sb, 0, 0, 0); }
        SB();
        if constexpr (SAFE) ATT_SMA(sa, sb, 0, m0, l0);
        SB();
        f32x16 ta = f32x16{}, tb = f32x16{};
        {   bf16x8 qf, k0, k1; float sum = 0.f;
            ATT_LDQK(1, 0, qf, k0, k1); SB();
#define ATT_C(d0) do { ta = __builtin_amdgcn_mfma_f32_32x32x16_bf16(k0, qf, ta, 0, 0, 0); SB(); \
            if ((d0) < 3) k0 = *(const LAS bf16x8*)(Kb + kb[((d0) + 1) & 1] + 512 * (2 + (((d0) + 1) >> 1))); \
            ATT_SMB(sa, sb, 4 * (d0) + 0, m0, sum, pw0); ATT_SMB(sa, sb, 4 * (d0) + 1, m0, sum, pw0); SB(); \
            tb = __builtin_amdgcn_mfma_f32_32x32x16_bf16(k1, qf, tb, 0, 0, 0); SB(); \
            if ((d0) < 3) { qf = *(const LAS bf16x8*)(Qs + ((4 + (d0) + 1) * 2 + hi) * 512 + r32 * 16); k1 = *(const LAS bf16x8*)(Kb + kb[((d0) + 1) & 1] + 512 * (2 + (((d0) + 1) >> 1)) + 8192); } \
            ATT_SMB(sa, sb, 4 * (d0) + 2, m0, sum, pw0); ATT_SMB(sa, sb, 4 * (d0) + 3, m0, sum, pw0); SB(); } while (0)
            ATT_C(0); ATT_C(1); ATT_C(2); ATT_C(3);
#undef ATT_C
            l0 += sum; }
        if constexpr (SAFE) ATT_SMA(ta, tb, 1, m1, l1);
        SB();
        {   s16x4 loA, hhA, loB, hhB, loC, hhC; float sum = 0.f;
            ATT_LDV(0, loA, hhA); ATT_LDV(1, loB, hhB); SB();
#define ATT_E(i, LOc, HHc, LOn, HHn) do { if ((i) + 2 < 16) ATT_LDV((i) + 2, LOn, HHn); SB(); \
            o[0][(i) & 3] = __builtin_amdgcn_mfma_f32_32x32x16_bf16(ATT_PA(pw0, (i) >> 2), ATT_VF(LOc, HHc), o[0][(i) & 3], 0, 0, 0); SB(); ATT_SMB(ta, tb, i, m1, sum, pw1); SB(); } while (0)
            ATT_E(0, loA, hhA, loC, hhC); ATT_E(1, loB, hhB, loA, hhA); ATT_E(2, loC, hhC, loB, hhB);
            ATT_E(3, loA, hhA, loC, hhC); ATT_E(4, loB, hhB, loA, hhA); ATT_E(5, loC, hhC, loB, hhB);
            ATT_E(6, loA, hhA, loC, hhC); ATT_E(7, loB, hhB, loA, hhA); ATT_E(8, loC, hhC, loB, hhB);
            ATT_E(9, loA, hhA, loC, hhC); ATT_E(10, loB, hhB, loA, hhA); ATT_E(11, loC, hhC, loB, hhB);
            ATT_E(12, loA, hhA, loC, hhC); ATT_E(13, loB, hhB, loA, hhA); ATT_E(14, loC, hhC, loB, hhB);
            ATT_E(15, loA, hhA, loC, hhC);
#undef ATT_E
            l1 += sum; }
#pragma unroll
        for (int ks = 0; ks < 4; ++ks) {
            s16x4 lo[4], hh[4];
#pragma unroll
            for (int d = 0; d < 4; ++d) ATT_LDV(4 * ks + d, lo[d], hh[d]);
#pragma unroll
            for (int d = 0; d < 4; ++d) o[1][d] = __builtin_amdgcn_mfma_f32_32x32x16_bf16(ATT_PA(pw1, ks), ATT_VF(lo[d], hh[d]), o[1][d], 0, 0, 0);
            SB();
        }
        asm volatile("s_waitcnt vmcnt(0)" ::: "memory");
        __syncthreads();
    }
#undef ATT_SMB
#undef ATT_SMA
#undef ATT_LDQK
#undef ATT_LDV
#undef ATT_VF
#undef ATT_PA
#undef SB
#undef ATT_GROW
#undef ATT_DMA
    l0 = half_sum(l0); l1 = half_sum(l1);
    const bool ok = SAFE || !__any(!(l0 > 7.9e-31f && l0 < 1.26e30f && l1 > 7.9e-31f && l1 < 1.26e30f));
    if (hi == 0) { wsf[r32] = 1.0f / l0; wsf[32 + r32] = P.lam / l1; }
    float ss[16];
#pragma unroll
    for (int r = 0; r < 16; ++r) ss[r] = 0.f;
#pragma unroll
    for (int g4 = 0; g4 < 4; ++g4) { const f32x4 a4 = *(const LAS f32x4*)(wsf + 8 * g4 + 4 * hi), b4 = *(const LAS f32x4*)(wsf + 32 + 8 * g4 + 4 * hi);
#pragma unroll
        for (int d = 0; d < 4; ++d)
#pragma unroll
            for (int e = 0; e < 4; ++e) { const float v = o[0][d][4 * g4 + e] * a4[e] - o[1][d][4 * g4 + e] * b4[e]; o[0][d][4 * g4 + e] = v; ss[4 * g4 + e] += v * v; } }
#pragma unroll
    for (int r = 0; r < 16; ++r) {
        float v = ss[r];
#pragma unroll
        for (int s = 1; s < 32; s <<= 1) v += __shfl_xor(v, s);
        ss[r] = (1.0f / sqrtf(v * (1.0f / 128.0f) + SUBLN_EPS)) * P.post;
    }
    {   int l2; asm volatile("v_mbcnt_lo_u32_b32 %0, -1, 0\n\tv_mbcnt_hi_u32_b32 %0, -1, %0" : "=v"(l2));
        const int c2 = l2 & 31, h2 = l2 >> 5;
        LAS unsigned short* stg = (LAS unsigned short*)(lds + QOFF + wid * 8192) + h2 * 4 * 128 + c2;
#pragma unroll
        for (int d = 0; d < 4; ++d) { const float gs = P.gsub[32 * d + c2];
#pragma unroll
            for (int r = 0; r < 16; ++r) { const float v = o[0][d][r] * ss[r] * gs; stg[((r & 3) + 8 * (r >> 2)) * 128 + 32 * d] = (unsigned short)(cvt_pk_bf16(v, 0.f) & 0xffffu); }
            __builtin_amdgcn_sched_barrier(0); }
        const LAS unsigned char* rd = lds + QOFF + wid * 8192 + (l2 >> 4) * 256 + (l2 & 15) * 16;
        bf16_t* Ow = P.O + (size_t)(q0 + wid * 32 + (l2 >> 4)) * D + h * 128 + (l2 & 15) * 8;
#pragma unroll
        for (int i = 0; i < 8; ++i) { const u32x4 v = *(const LAS u32x4*)(rd + i * 1024); *(u32x4*)(Ow + (size_t)i * 4 * D) = v; } }
    __builtin_amdgcn_s_setprio(0);
    __syncthreads();
    return ok;
}
__device__ __forceinline__ void unit_checked(LAS unsigned char* lds, const Args& P, int b, int h, int q0, int nlat, int tid) {
    volatile LAS unsigned* flag = (volatile LAS unsigned*)(lds + MISC_OFF) + 16;
    const bool ok = unit<false>(lds, P, b, h, q0, nlat, tid);
    if (!ok && (tid & 63) == 0) *flag = 1u;
    __syncthreads();
    const unsigned f = *flag;
    __syncthreads();
    if (f) { if (tid == 0) *flag = 0u; (void)unit<true>(lds, P, b, h, q0, nlat, tid); }
}
}

struct ThinArgs {
    const void* xin_lat; const void* xin_ctx;
    int xin_bf16, xout_bf16;
    const bf16_t* y;
    void* xout_lat; void* xout_ctx;
    const float* g_post; const float* gate;
    bf16_t* uout;
    const float* g_pre; const float* sc; const float* sh;
    const bf16_t* yc; int nslab;
    int nrows; int gb_lo;
};
__device__ __forceinline__ void thin_phase(const ThinArgs& T, LAS unsigned char* lds, int bx, int G, int tid, int wave, int lane) {
    (void)G;
    LAS float* tab0 = (LAS float*)lds; LAS float* tab1 = tab0 + 3 * D;
    f32x4 xvb[2][8]; u32x2 xrb[2][8]; u32x2 yrb[2][8];
#define THIN_LOAD(ctx, row_, XV, XR, YR) do { const size_t xo_ = (ctx) ? (size_t)((row_) - ML) * D : (size_t)(row_) * D; \
        if (T.xin_bf16) { const bf16_t* xr_ = (const bf16_t*)((ctx) ? T.xin_ctx : T.xin_lat) + xo_; _Pragma("unroll") for (int j = 0; j < 8; ++j) XR[j] = *(const u32x2*)(xr_ + 256 * j + 4 * lane); } \
        else { const float* xr_ = (const float*)((ctx) ? T.xin_ctx : T.xin_lat) + xo_; _Pragma("unroll") for (int j = 0; j < 8; ++j) XV[j] = *(const f32x4*)(xr_ + 256 * j + 4 * lane); } \
        if (T.y && !((ctx) && T.nslab > 0)) { const bf16_t* yr_ = T.y + (size_t)(row_) * D; _Pragma("unroll") for (int j = 0; j < 8; ++j) YR[j] = __builtin_nontemporal_load((const u32x2*)(yr_ + 256 * j + 4 * lane)); } } while (0)
#define THIN_TABLES(gb, TB) do { const int c4 = 4 * tid; LAS float* ta = (TB); LAS float* tg = ta + D; LAS float* ts = tg + D;     \
        if (T.y) { const f32x4 g = *(const f32x4*)(T.g_post + c4), a = *(const f32x4*)(T.gate + (size_t)(gb) * MODROW + c4); *(LAS f32x4*)(ta + c4) = a * g; } \
        if (T.uout) { const f32x4 g = *(const f32x4*)(T.g_pre + c4), s = *(const f32x4*)(T.sc + (size_t)(gb) * MODROW + c4), h = *(const f32x4*)(T.sh + (size_t)(gb) * MODROW + c4); \
            *(LAS f32x4*)(tg + c4) = g * (s + 1.0f); *(LAS f32x4*)(ts + c4) = h; } } while (0)
#define THIN_ROW(ctx, row, xv, xraw, yraw, TB) do { const LAS float* ta = (TB); const LAS float* tg = ta + D; const LAS float* ts = tg + D; \
        if (T.xin_bf16) { _Pragma("unroll") for (int j = 0; j < 8; ++j) { const u32x2 v = xraw[j]; xv[j][0] = __uint_as_float(v.x << 16); xv[j][1] = __uint_as_float(v.x & 0xffff0000u); xv[j][2] = __uint_as_float(v.y << 16); xv[j][3] = __uint_as_float(v.y & 0xffff0000u); } } \
        if (T.y) { f32x4 yv[8]; float s = 0.f; \
            if ((ctx) && T.nslab > 0) { const bf16_t* yr = T.yc + (size_t)((row) - ML) * D; \
                _Pragma("unroll") for (int j = 0; j < 8; ++j) { const u32x2 v = __builtin_nontemporal_load((const u32x2*)(yr + 256 * j + 4 * lane)); \
                    yv[j][0] = __uint_as_float(v.x << 16); yv[j][1] = __uint_as_float(v.x & 0xffff0000u); yv[j][2] = __uint_as_float(v.y << 16); yv[j][3] = __uint_as_float(v.y & 0xffff0000u); } \
                _Pragma("unroll 1") for (int sl = 1; sl < T.nslab; ++sl) { yr += (size_t)MC * D; \
                    _Pragma("unroll") for (int j = 0; j < 8; ++j) { const u32x2 v = __builtin_nontemporal_load((const u32x2*)(yr + 256 * j + 4 * lane)); \
                        yv[j][0] += __uint_as_float(v.x << 16); yv[j][1] += __uint_as_float(v.x & 0xffff0000u); yv[j][2] += __uint_as_float(v.y << 16); yv[j][3] += __uint_as_float(v.y & 0xffff0000u); } } \
            } else { _Pragma("unroll") for (int j = 0; j < 8; ++j) { const u32x2 v = yraw[j]; \
                    yv[j][0] = __uint_as_float(v.x << 16); yv[j][1] = __uint_as_float(v.x & 0xffff0000u); yv[j][2] = __uint_as_float(v.y << 16); yv[j][3] = __uint_as_float(v.y & 0xffff0000u); } } \
            _Pragma("unroll") for (int j = 0; j < 8; ++j) s += (yv[j][0] * yv[j][0] + yv[j][1] * yv[j][1]) + (yv[j][2] * yv[j][2] + yv[j][3] * yv[j][3]); \
            const float rs = 1.0f / sqrtf(wave_sum(s) * (1.0f / D) + NORM_EPS); \
            _Pragma("unroll") for (int j = 0; j < 8; ++j) { const f32x4 a = *(const LAS f32x4*)(ta + 256 * j + 4 * lane); xv[j] = xv[j] + a * (yv[j] * rs); } \
            void* xob = (ctx) ? T.xout_ctx : T.xout_lat; const size_t xoo = (ctx) ? (size_t)((row) - ML) * D : (size_t)(row) * D; \
            if (xob) { \
                if (T.xout_bf16) { bf16_t* xo = (bf16_t*)xob + xoo;        \
                    _Pragma("unroll") for (int j = 0; j < 8; ++j) { u32x2 w; w.x = cvt_pk_bf16(xv[j][0], xv[j][1]); w.y = cvt_pk_bf16(xv[j][2], xv[j][3]); __builtin_nontemporal_store(w, (u32x2*)(xo + 256 * j + 4 * lane)); \
                        xv[j][0] = __uint_as_float(w.x << 16); xv[j][1] = __uint_as_float(w.x & 0xffff0000u); xv[j][2] = __uint_as_float(w.y << 16); xv[j][3] = __uint_as_float(w.y & 0xffff0000u); } \
                } else { float* xo = (float*)xob + xoo; _Pragma("unroll") for (int j = 0; j < 8; ++j) *(f32x4*)(xo + 256 * j + 4 * lane) = xv[j]; } } } \
        if (T.uout) { float s = 0.f; \
            _Pragma("unroll") for (int j = 0; j < 8; ++j) s += (xv[j][0] * xv[j][0] + xv[j][1] * xv[j][1]) + (xv[j][2] * xv[j][2] + xv[j][3] * xv[j][3]); \
            const float rs = 1.0f / sqrtf(wave_sum(s) * (1.0f / D) + NORM_EPS); \
            bf16_t* uo = T.uout + (size_t)(row) * D; \
            _Pragma("unroll") for (int j = 0; j < 8; ++j) { const f32x4 g = *(const LAS f32x4*)(tg + 256 * j + 4 * lane), c = *(const LAS f32x4*)(ts + 256 * j + 4 * lane); \
                const f32x4 u = (xv[j] * rs) * g + c; \
                u32x2 w; w.x = cvt_pk_bf16(u[0], u[1]); w.y = cvt_pk_bf16(u[2], u[3]); *(u32x2*)(uo + 256 * j + 4 * lane) = w; } } } while (0)
    const bool has_ctx = T.nrows > ML, my_ctx = has_ctx && wave < 4;
    const int gb = bx >> 6, rbase = gb * SEQ + (bx & 63) * 32 + wave * 4, crow = ML + bx * 4 + (wave & 3);
    if (T.gb_lo == 0) THIN_LOAD(false, rbase, xvb[0], xrb[0], yrb[0]); else if (my_ctx) THIN_LOAD(true, crow, xvb[0], xrb[0], yrb[0]);
    if (T.gb_lo == 0) THIN_TABLES(gb, tab0);
    if (has_ctx) THIN_TABLES(4, tab1);
    __syncthreads();
    if (T.gb_lo == 0) {
#pragma unroll
        for (int i = 0; i < 4; ++i) {
            if (i + 1 < 4) THIN_LOAD(false, rbase + i + 1, xvb[(i + 1) & 1], xrb[(i + 1) & 1], yrb[(i + 1) & 1]);
            else if (my_ctx) THIN_LOAD(true, crow, xvb[0], xrb[0], yrb[0]);
            THIN_ROW(false, rbase + i, xvb[i & 1], xrb[i & 1], yrb[i & 1], tab0);
        }
    }
    if (my_ctx) THIN_ROW(true, crow, xvb[0], xrb[0], yrb[0], tab1);
    __syncthreads();
#undef THIN_LOAD
#undef THIN_TABLES
#undef THIN_ROW
}
template <int W>
__device__ __forceinline__ void pool_sub(const bf16_t* Useq, bf16_t* Dseq, int t0, int Ls) {
    constexpr int H = W / 2, NR = 8 + W - 1;
    u32x2 rows[NR];
#pragma unroll
    for (int k = 0; k < NR; ++k) { const int tt = t0 - H + k; const bool ok = tt >= 0 && tt < Ls; const int tc = tt < 0 ? 0 : (tt >= Ls ? Ls - 1 : tt);
        const u32x2 v = *(const u32x2*)(Useq + (size_t)tc * D); rows[k].x = ok ? v.x : 0u; rows[k].y = ok ? v.y : 0u; }
#pragma unroll
    for (int i = 0; i < 8; ++i) { const int t = t0 + i; int lo = t - H, hi = lo + W; lo = lo < 0 ? 0 : lo; hi = hi > Ls ? Ls : hi;
        f32x4 s = {0.f, 0.f, 0.f, 0.f};
#pragma unroll
        for (int k = 0; k < W; ++k) { const u32x2 v = rows[i + k];
            s[0] += __uint_as_float(v.x << 16); s[1] += __uint_as_float(v.x & 0xffff0000u); s[2] += __uint_as_float(v.y << 16); s[3] += __uint_as_float(v.y & 0xffff0000u); }
        const u32x2 cv = rows[i + H]; const float inv = 1.0f / (float)(hi - lo);
        f32x4 d; d[0] = s[0] * inv - __uint_as_float(cv.x << 16); d[1] = s[1] * inv - __uint_as_float(cv.x & 0xffff0000u); d[2] = s[2] * inv - __uint_as_float(cv.y << 16); d[3] = s[3] * inv - __uint_as_float(cv.y & 0xffff0000u);
        u32x2 o; o.x = cvt_pk_bf16(d[0], d[1]); o.y = cvt_pk_bf16(d[2], d[3]);
        *(u32x2*)(Dseq + (size_t)t * D) = o; }
}
__device__ __forceinline__ void pool_phase(const bf16_t* U, bf16_t* Dm, int nrows, int bx, int wave, int lane) {
    const int coff = 256 * wave + 4 * lane;
    {   const int b = bx >> 6, t00 = (bx & 63) * 32; const bf16_t* Us = U + (size_t)b * SEQ * D + coff; bf16_t* Ds = Dm + (size_t)b * SEQ * D + coff;
#pragma unroll 1
        for (int sb = 0; sb < 4; ++sb) { const int t0 = t00 + 8 * sb;
            switch (wave >> 1) { case 0: pool_sub<2>(Us, Ds, t0, SEQ); break; case 1: pool_sub<4>(Us, Ds, t0, SEQ); break; case 2: pool_sub<8>(Us, Ds, t0, SEQ); break; default: pool_sub<16>(Us, Ds, t0, SEQ); break; } } }
    if (nrows > ML) {
        if (wave < 4) { const int sbi = bx >> 1, j = 4 * (bx & 1) + wave, r0 = sbi * 8, cb = r0 >> 8, t0 = r0 & 255; const int co = 256 * j + 4 * lane;
            const bf16_t* Us = U + (size_t)(ML + cb * CL) * D + co; bf16_t* Ds = Dm + (size_t)(ML + cb * CL) * D + co;
            switch (j >> 1) { case 0: pool_sub<2>(Us, Ds, t0, CL); break; case 1: pool_sub<4>(Us, Ds, t0, CL); break; case 2: pool_sub<8>(Us, Ds, t0, CL); break; default: pool_sub<16>(Us, Ds, t0, CL); break; } } }
}

struct TrDesc { const float* src; bf16_t* dst; int N, K; int perm; };
__device__ __forceinline__ void tr_load(const TrDesc& d, f32x4 (&v)[16], int lane) {
    const int kq = lane >> 4, n4 = lane & 15;
#pragma unroll
    for (int i = 0; i < 16; ++i) v[i] = __builtin_nontemporal_load((const f32x4*)(d.src + (size_t)(4 * i + kq) * d.N + 4 * n4));
}
__device__ __forceinline__ void tr_store(const TrDesc& d, const f32x4 (&v)[16], LAS float* scr, int lane) {
    const int kq = lane >> 4, n4 = lane & 15;
#pragma unroll
    for (int i = 0; i < 16; ++i) { LAS float* s = scr + (4 * i + kq) * 65 + 4 * n4; s[0] = v[i][0]; s[1] = v[i][1]; s[2] = v[i][2]; s[3] = v[i][3]; }
    asm volatile("s_waitcnt lgkmcnt(0)" ::: "memory");
    const int c = lane & 7;
#pragma unroll
    for (int j = 0; j < 8; ++j) { const int n = (lane >> 3) + 8 * j; int sc = n;
        if (d.perm) { const int jj = n >> 1, which = n & 1, ax = jj >> 4, f = jj & 15; sc = ax * 32 + which * 16 + f; }
        const LAS float* s = scr + (8 * c) * 65 + sc;
        u32x4 o; o.x = cvt_pk_bf16(s[0 * 65], s[1 * 65]); o.y = cvt_pk_bf16(s[2 * 65], s[3 * 65]); o.z = cvt_pk_bf16(s[4 * 65], s[5 * 65]); o.w = cvt_pk_bf16(s[6 * 65], s[7 * 65]);
        *(u32x4*)(d.dst + (size_t)n * d.K + 8 * c) = o; }
    asm volatile("s_waitcnt lgkmcnt(0)" ::: "memory");
}

struct Params {
    const float* in[22];
    float* out; unsigned char* ws;
    float lam_init0, lam_init3;
    int ph_lo, ph_hi;
};

template <int PART>
__device__ __forceinline__ void prologue(const Params& P, LAS unsigned char* lds, int tid, int wave, int lane, int vcu, int G) {
    unsigned char* ws = P.ws;
    const float* c_in = P.in[1]; const float* cctx = P.in[3]; const float* w_mod = P.in[4]; const float* b_mod = P.in[5];
    LAS float* sil = (LAS float*)lds;
    LAS float* red = (LAS float*)(lds + 65536);
    for (int i = tid; i < 5 * D; i += NTHR) { const int r = i / D, k = i % D; const float x = r < 4 ? c_in[r * D + k] : cctx[k]; sil[k * 8 + r] = x / (1.0f + __expf(-x)); }
    __syncthreads();
    float* mod = (float*)(ws + WS_MOD);
    for (int item = (PART == 1 ? 192 : 0) + blockIdx.x; item < (PART == 0 ? 192 : 4 * 192); item += G) {
        const int l = item / 192, col = (item % 192) * 64 + lane;
        const float* W = w_mod + (size_t)l * D * MODROW + col;
        float a0 = 0.f, a1 = 0.f, a2 = 0.f, a3 = 0.f, a4 = 0.f;
        const int k0 = wave * 256;
        for (int kk = 0; kk < 256; kk += 32) {
            float w[32];
#pragma unroll
            for (int j = 0; j < 32; ++j) w[j] = __builtin_nontemporal_load(W + (size_t)(k0 + kk + j) * MODROW);
#pragma unroll
            for (int j = 0; j < 32; ++j) { const f32x4 s4 = *(const LAS f32x4*)(sil + (k0 + kk + j) * 8); const float s5 = sil[(k0 + kk + j) * 8 + 4];
                a0 += s4[0] * w[j]; a1 += s4[1] * w[j]; a2 += s4[2] * w[j]; a3 += s4[3] * w[j]; a4 += s5 * w[j]; }
        }
        red[(wave * 5 + 0) * 64 + lane] = a0; red[(wave * 5 + 1) * 64 + lane] = a1; red[(wave * 5 + 2) * 64 + lane] = a2; red[(wave * 5 + 3) * 64 + lane] = a3; red[(wave * 5 + 4) * 64 + lane] = a4;
        __syncthreads();
        if (wave < 5) { float s = b_mod[l * MODROW + col];
#pragma unroll
            for (int w8 = 0; w8 < 8; ++w8) s += red[(w8 * 5 + wave) * 64 + lane];
            mod[((size_t)l * 5 + wave) * MODROW + col] = s; }
        __syncthreads();
    }
    LAS float* scr = (LAS float*)(lds + wave * 16640);
    const int gw = vcu * NWAVES + wave, NGW = G * NWAVES;
    bf16_t* Wqkv = (bf16_t*)(ws + WS_WQKV); bf16_t* Wo = (bf16_t*)(ws + WS_WO); bf16_t* Wf = (bf16_t*)(ws + WS_WF); bf16_t* Wp = (bf16_t*)(ws + WS_WPOOL);
    bf16_t* W1 = (bf16_t*)(ws + WS_W1); bf16_t* W2 = (bf16_t*)(ws + WS_W2);
    constexpr int I_QKV = (D / 64) * (3 * D / 64), I_O = (D / 64) * (D / 64), I_P = 8 * 8, I_1 = (D / 64) * (FF / 64), I_2 = (FF / 64) * (D / 64);
    constexpr int NITEMS = 2 * I_QKV + 2 * I_O + I_O + 4 * I_P + 4 * I_1 + 4 * I_2;
    auto decode = [&](int it) -> TrDesc {
        int r = it; const float* W; bf16_t* WT; int K, N, perm = 0;
        if (r < 2 * I_QKV) { const int ia = r / I_QKV; r %= I_QKV; W = P.in[10] + (size_t)ia * D * 3 * D; WT = Wqkv + (size_t)ia * 3 * D * D; K = D; N = 3 * D; perm = (r % (3 * D / 64)) < 2 * D / 64; }
        else if ((r -= 2 * I_QKV) < 2 * I_O) { const int ia = r / I_O; r %= I_O; W = P.in[11] + (size_t)ia * D * D; WT = Wo + (size_t)ia * D * D; K = D; N = D; }
        else if ((r -= 2 * I_O) < I_O) { W = P.in[17]; WT = Wf; K = D; N = D; }
        else if ((r -= I_O) < 4 * I_P) { const int g = r / I_P; r %= I_P; W = P.in[18] + (size_t)g * 512 * 512; WT = Wp + (size_t)g * 512 * 512; K = 512; N = 512; }
        else if ((r -= 4 * I_P) < 4 * I_1) { const int l = r / I_1; r %= I_1; W = P.in[20] + (size_t)l * D * FF; WT = W1 + (size_t)l * FF * D; K = D; N = FF; }
        else { r -= 4 * I_1; const int l = r / I_2; r %= I_2; W = P.in[21] + (size_t)l * FF * D; WT = W2 + (size_t)l * D * FF; K = FF; N = D; }
        const int nblk = N / 64, k0 = 64 * (r / nblk), n0 = 64 * (r % nblk);
        TrDesc d; d.src = W + (size_t)k0 * N + n0; d.dst = WT + (size_t)n0 * K + k0; d.N = N; d.K = K; d.perm = perm; return d; };
    {   const int it_end = (PART == 0 ? I_QKV : NITEMS); int it = (PART == 1 ? I_QKV : 0) + gw;
        f32x4 va[16], vb[16]; TrDesc da, db;
        if (it < it_end) { da = decode(it); tr_load(da, va, lane); }
        while (it < it_end) {
            const bool hb = it + NGW < it_end; if (hb) { db = decode(it + NGW); tr_load(db, vb, lane); }
            tr_store(da, va, scr, lane);
            if (!hb) break;
            const bool ha = it + 2 * NGW < it_end; if (ha) { da = decode(it + 2 * NGW); tr_load(da, va, lane); }
            tr_store(db, vb, scr, lane);
            if (!ha) break;
            it += 2 * NGW;
        } }
    if constexpr (PART != 1) {
        const int gt = gw * 64 + lane, NGT = NGW * 64; float* rope = (float*)(ws + WS_ROPE);
        for (int i = gt; i < 64 * 16; i += NGT) { const int pos = i >> 4, f = i & 15; const float inv = 1.0f / powf(10000.0f, (float)f * (1.0f / 16.0f)); const float ang = (float)pos * inv;
            rope[2 * i] = cosf(ang); rope[2 * i + 1] = sinf(ang); }
    }
    if constexpr (PART != 0) {   bf16_t* T1 = (bf16_t*)(ws + WS_T1); bf16_t* A2 = (bf16_t*)(ws + WS_A2); bf16_t* A2C = (bf16_t*)(ws + WS_A2C);
        constexpr int C_T1 = 1024 * 512 / 8, C_A2 = 2048 * 4096 / 8, C_A2C = 256 * 512 / 8;
        const int gt = gw * 64 + lane, NGT = NGW * 64;
        for (int ch = gt; ch < C_T1 + C_A2 + C_A2C; ch += NGT) {
            int r = ch; bf16_t* dst; int row, col0, N, ncol; float scale; bool negsin;
            if (r < C_T1) { row = r / 64; col0 = (r % 64) * 8; dst = T1 + (size_t)row * 512 + col0; N = 512; scale = 0.04419417382415922f; negsin = false;
                const int cs = row >> 9, k2 = row & 511; float vals[8];
#pragma unroll
                for (int e = 0; e < 8; ++e) { const int idx = (k2 * (col0 + e)) & 511; const float a = (float)idx * (1.0f / 256.0f); vals[e] = (cs ? sinpif(a) : cospif(a)) * scale; }
                u32x4 o; o.x = cvt_pk_bf16(vals[0], vals[1]); o.y = cvt_pk_bf16(vals[2], vals[3]); o.z = cvt_pk_bf16(vals[4], vals[5]); o.w = cvt_pk_bf16(vals[6], vals[7]); *(u32x4*)dst = o; continue; }
            r -= C_T1;
            if (r < C_A2) { row = r / 512; col0 = (r % 512) * 8; dst = A2 + (size_t)row * 4096 + col0; N = 2048; scale = 0.022097086912079608f; }
            else { r -= C_A2; row = r / 64; col0 = (r % 64) * 8; dst = A2C + (size_t)row * 512 + col0; N = 256; scale = 0.0625f; }
            (void)ncol; (void)negsin;
            { const int cs = col0 / N, n0 = col0 % N; float vals[8];
#pragma unroll
              for (int e = 0; e < 8; ++e) { const int idx = (row * (n0 + e)) & (N - 1); const float a = (float)idx * (2.0f / (float)N); vals[e] = (cs ? -sinpif(a) : cospif(a)) * scale; }
              u32x4 o; o.x = cvt_pk_bf16(vals[0], vals[1]); o.y = cvt_pk_bf16(vals[2], vals[3]); o.z = cvt_pk_bf16(vals[4], vals[5]); o.w = cvt_pk_bf16(vals[6], vals[7]); *(u32x4*)dst = o; }
        }
    }
}

__device__ __forceinline__ void fourier_y256(const bf16_t* U, const bf16_t* T1, float* Y256, int bx, int wave, int lane) {
    const float sc = bf2f(T1[256 * 512]);
#pragma unroll 1
    for (int rr = 0; rr < 4; ++rr) {
        const int tok = bx * 32 + wave * 4 + rr;
        const bf16_t* up = U + (size_t)tok * D + lane * 32;
        float a = 0.f;
#pragma unroll
        for (int i = 0; i < 4; ++i) { const u32x4 w = *(const u32x4*)(up + 8 * i);
            a += (__uint_as_float(w.x << 16) - __uint_as_float(w.x & 0xffff0000u)) + (__uint_as_float(w.y << 16) - __uint_as_float(w.y & 0xffff0000u))
               + (__uint_as_float(w.z << 16) - __uint_as_float(w.z & 0xffff0000u)) + (__uint_as_float(w.w << 16) - __uint_as_float(w.w & 0xffff0000u)); }
        a += __shfl_xor(a, 1); a += __shfl_xor(a, 2); a += __shfl_xor(a, 4); a += __shfl_xor(a, 8);
        if ((lane & 15) == 0) Y256[(size_t)((tok >> 11) * 4 + (lane >> 4)) * 2048 + (tok & 2047)] = a * sc;
    }
}
__device__ __forceinline__ void fourier_edge1024(const bf16_t* YT, const bf16_t* A2, float* PE, int bx, int wave, int lane) {
#pragma unroll 1
    for (int rr = 0; rr < 2; ++rr) {
        const int idx = bx * 16 + wave * 2 + rr, r = idx >> 2, b = idx & 3;
        const bf16_t* yp = YT + (size_t)r * 16384 + b * 4096; const bf16_t* ap = A2 + (size_t)1024 * 4096;
        float a = 0.f;
#pragma unroll
        for (int i = 0; i < 4; ++i) { const int n1 = (i * 64 + lane) * 8; const u32x4 y = *(const u32x4*)(yp + n1), c = *(const u32x4*)(ap + n1);
            a += __uint_as_float(y.x << 16) * __uint_as_float(c.x << 16) + __uint_as_float(y.x & 0xffff0000u) * __uint_as_float(c.x & 0xffff0000u)
               + __uint_as_float(y.y << 16) * __uint_as_float(c.y << 16) + __uint_as_float(y.y & 0xffff0000u) * __uint_as_float(c.y & 0xffff0000u)
               + __uint_as_float(y.z << 16) * __uint_as_float(c.z << 16) + __uint_as_float(y.z & 0xffff0000u) * __uint_as_float(c.z & 0xffff0000u)
               + __uint_as_float(y.w << 16) * __uint_as_float(c.w << 16) + __uint_as_float(y.w & 0xffff0000u) * __uint_as_float(c.w & 0xffff0000u); }
        a = wave_sum(a);
        if (lane == 0) PE[b * 1024 + r] = a;
    }
}
struct FcBlk { f32x4 lo, hi; };
__device__ __forceinline__ FcBlk fc_unpack(const u32x4 w) { FcBlk r; r.lo = f32x4{__uint_as_float(w.x << 16), __uint_as_float(w.x & 0xffff0000u), __uint_as_float(w.y << 16), __uint_as_float(w.y & 0xffff0000u)};
    r.hi = f32x4{__uint_as_float(w.z << 16), __uint_as_float(w.z & 0xffff0000u), __uint_as_float(w.w << 16), __uint_as_float(w.w & 0xffff0000u)}; return r; }
__device__ __forceinline__ void fc_store_fwd(bf16_t* dst, const FcBlk& v) { u32x4 f; f.x = cvt_pk_vis(v.lo[0], v.lo[1]); f.y = cvt_pk_vis(v.lo[2], v.lo[3]); f.z = cvt_pk_vis(v.hi[0], v.hi[1]); f.w = cvt_pk_vis(v.hi[2], v.hi[3]); *(u32x4*)dst = f; }
__device__ __forceinline__ void fc_store_rev(bf16_t* dst, float e0, const FcBlk& v) { u32x4 f; f.x = cvt_pk_vis(e0, v.hi[3]); f.y = cvt_pk_vis(v.hi[2], v.hi[1]); f.z = cvt_pk_vis(v.hi[0], v.lo[3]); f.w = cvt_pk_vis(v.lo[2], v.lo[1]); *(u32x4*)dst = f; }
__device__ __forceinline__ float fc_nyquist(const bf16_t* A2, LAS float* ys, int k1, int lane) {
    float s0 = 0.f, s1 = 0.f, s2 = 0.f, s3 = 0.f;
#pragma unroll
    for (int i = 0; i < 4; ++i) { const int n1 = (i * 64 + lane) * 8; const FcBlk a = fc_unpack(*(const u32x4*)(A2 + (size_t)k1 * 4096 + n1));
#define FC_DOT(S, G_) { const f32x4 y0 = *(LAS f32x4*)(ys + (G_) * 2048 + n1), y1 = *(LAS f32x4*)(ys + (G_) * 2048 + n1 + 4); \
                        S += a.lo[0] * y0[0] + a.lo[1] * y0[1] + a.lo[2] * y0[2] + a.lo[3] * y0[3] + a.hi[0] * y1[0] + a.hi[1] * y1[1] + a.hi[2] * y1[2] + a.hi[3] * y1[3]; }
        FC_DOT(s0, 0) FC_DOT(s1, 1) FC_DOT(s2, 2) FC_DOT(s3, 3)
#undef FC_DOT
    }
    s0 = wave_sum(s0); s1 = wave_sum(s1); s2 = wave_sum(s2); s3 = wave_sum(s3);
    const int g = lane >> 4;
    return g == 0 ? s0 : (g == 1 ? s1 : (g == 2 ? s2 : s3));
}
__device__ __forceinline__ void fourier_combine(const bf16_t* PQ, const float* PE, const bf16_t* A2, const float* Y256, bf16_t* O, LAS unsigned char* lds, int bx, int tid, int wave, int lane) {
    const int b = bx >> 6, kp0 = (bx & 63) * 16;
    LAS float* ys = (LAS float*)lds;
    for (int i = tid; i < 4 * 2048 / 4; i += NTHR) ((LAS f32x4*)ys)[i] = ((const f32x4*)(Y256 + (size_t)b * 4 * 2048))[i];
    __syncthreads();
    const int g = lane >> 4, j = lane & 15;
    constexpr size_t PART = (size_t)4 * 1024 * 1024;
#pragma unroll 1
    for (int rr = 0; rr < 2; ++rr) {
        const int k1 = kp0 + wave * 2 + rr;
        float sg = fc_nyquist(A2, ys, k1, lane), sg2 = 0.f;
        if (k1 == 0) sg2 = fc_nyquist(A2, ys, 1024, lane);
        asm volatile("" : "+v"(sg), "+v"(sg2)); __builtin_amdgcn_sched_barrier(0);
        const bf16_t* pa = PQ + ((size_t)b * 1024 + k1) * 1024 + g * 256;
        FcBlk P0, P1, Q0, Q1; float pn1, qn1, pn2, qn2;
        const int jn = j == 15 ? 0 : 8 * (j + 17);
        { const FcBlk x0 = fc_unpack(*(const u32x4*)(pa + 8 * j)), x1 = fc_unpack(*(const u32x4*)(pa + PART + 8 * j)); P0.lo = x0.lo + x1.lo; P0.hi = x0.hi + x1.hi; }
        { const FcBlk x0 = fc_unpack(*(const u32x4*)(pa + 8 * (j + 16))), x1 = fc_unpack(*(const u32x4*)(pa + PART + 8 * (j + 16))); P1.lo = x0.lo + x1.lo; P1.hi = x0.hi + x1.hi; }
        { const FcBlk x0 = fc_unpack(*(const u32x4*)(pa + 2 * PART + 8 * j)), x1 = fc_unpack(*(const u32x4*)(pa + 3 * PART + 8 * j)); Q0.lo = x0.lo + x1.lo; Q0.hi = x0.hi + x1.hi; }
        { const FcBlk x0 = fc_unpack(*(const u32x4*)(pa + 2 * PART + 8 * (j + 16))), x1 = fc_unpack(*(const u32x4*)(pa + 3 * PART + 8 * (j + 16))); Q1.lo = x0.lo + x1.lo; Q1.hi = x0.hi + x1.hi; }
        pn1 = bf2f(pa[8 * (j + 1)]) + bf2f(pa[PART + 8 * (j + 1)]); qn1 = bf2f(pa[2 * PART + 8 * (j + 1)]) + bf2f(pa[3 * PART + 8 * (j + 1)]);
        pn2 = bf2f(pa[jn]) + bf2f(pa[PART + jn]);                   qn2 = bf2f(pa[2 * PART + jn]) + bf2f(pa[3 * PART + jn]);
        FcBlk S0, S1, D0, D1; S0.lo = P0.lo + Q0.lo; S0.hi = P0.hi + Q0.hi; S1.lo = P1.lo + Q1.lo; S1.hi = P1.hi + Q1.hi; D0.lo = P0.lo - Q0.lo; D0.hi = P0.hi - Q0.hi; D1.lo = P1.lo - Q1.lo; D1.hi = P1.hi - Q1.hi;
        { bf16_t* orow = O + ((size_t)b * 2048 + k1) * D + g * 512;
          fc_store_fwd(orow + 8 * j, S0); fc_store_fwd(orow + 8 * (j + 16), S1);
          fc_store_rev(orow + 8 * (63 - j), pn1 - qn1, D0); fc_store_rev(orow + 8 * (47 - j), j == 15 ? sg : pn2 - qn2, D1); }
        if (k1 != 0) {
          bf16_t* orow = O + ((size_t)b * 2048 + (2048 - k1)) * D + g * 512;
          fc_store_fwd(orow + 8 * j, D0); fc_store_fwd(orow + 8 * (j + 16), D1);
          fc_store_rev(orow + 8 * (63 - j), pn1 + qn1, S0); fc_store_rev(orow + 8 * (47 - j), j == 15 ? sg : pn2 + qn2, S1);
        } else {
          const float* pe = PE + b * 1024 + g * 256;
          FcBlk E0, E1; E0.lo = *(const f32x4*)(pe + 8 * j); E0.hi = *(const f32x4*)(pe + 8 * j + 4); E1.lo = *(const f32x4*)(pe + 8 * (j + 16)); E1.hi = *(const f32x4*)(pe + 8 * (j + 16) + 4);
          bf16_t* orow = O + ((size_t)b * 2048 + 1024) * D + g * 512;
          fc_store_fwd(orow + 8 * j, E0); fc_store_fwd(orow + 8 * (j + 16), E1);
          fc_store_rev(orow + 8 * (63 - j), pe[8 * (j + 1)], E0); fc_store_rev(orow + 8 * (47 - j), j == 15 ? sg2 : pe[jn], E1);
        }
    }
}

struct Ctx { LAS unsigned char* lds; int tid, lane, wave, G, bx, vcu, gw, NGW; };
#if MK_MULTI
#define GRID_BAR() do { } while (0)
#else
#define GRID_BAR() xcd_barrier(bar)
#endif
#define PH_BEGIN(k) if ((k) >= P.ph_lo && (k) < P.ph_hi) {
#define PH_END(k)   if ((k) + 1 < P.ph_hi) GRID_BAR(); }
#define WSP(T, off) ((T*)(P.ws + (off)))

#ifndef FUSE_T
#define FUSE_T 0
#endif
template <int L> struct LayerCfg {
    static constexpr int kind = L % 3; static constexpr bool lastl = (L == 3);
    static constexpr int NMIX = (kind == 2) ? 1 : (kind == 1 ? 3 : 2);
    static constexpr bool fuse_mid = FUSE_T && kind != 2, fuse_post = FUSE_T;
    static constexpr bool has_tmid = !(fuse_mid && lastl), has_tpost = !(fuse_post && lastl);
    static constexpr int o_mix = NMIX, o_tmid = o_mix + 1, o_w1 = o_tmid + (has_tmid ? 1 : 0), o_w2 = o_w1 + 1, o_tpost = o_w2 + 1, nph = o_tpost + (has_tpost ? 1 : 0);
};
#define GEMM_CALL(S, E) do { int tid_ = C.tid; asm volatile("" : "+v"(tid_)); pg8::gemm_phase(lds, S, E, tid_); } while (0)

template <int L, int PH0>
__device__ __forceinline__ void layer(const Params& P, const Ctx& C, const XcdBarrier& bar) {
    using CF = LayerCfg<L>;
    constexpr int kind = CF::kind; constexpr bool lastl = CF::lastl;
    constexpr int Mact = lastl ? ML : MT;
    LAS unsigned char* lds = C.lds;
    const float* modl = WSP(const float, WS_MOD) + (size_t)L * 5 * MODROW; float* X = WSP(float, WS_X); bf16_t* XB = WSP(bf16_t, WS_X);
    if constexpr (kind == 0) {
        constexpr int ia = L / 3;
        PH_BEGIN(PH0)
        { pg8::Sched S{}; S.A = (const char*)WSP(bf16_t, WS_U); S.B = (const char*)(WSP(bf16_t, WS_WQKV) + (size_t)ia * 3 * D * D); S.lda = D * 2; S.ldb = D * 2; S.nt = D / 64;
          S.nM = (lastl ? ML : MT) / 256; S.nN = 3 * D / 256; S.ngroups = 1; S.a_g = 0; S.b_g = 0; S.G = C.G; S.c = C.bx;
          pg8::EpiQKV E{WSP(bf16_t, WS_Q), WSP(const float, WS_ROPE), 0, 0};
          GEMM_CALL(S, E);
          if constexpr (lastl) {
              pg8::Sched S2 = S; S2.A = (const char*)(WSP(bf16_t, WS_U) + (size_t)ML * D); S2.B = S.B + (size_t)D * D * 2; S2.nM = MC / 256; S2.nN = 2 * D / 256;
              pg8::EpiQKV E2{WSP(bf16_t, WS_Q), WSP(const float, WS_ROPE), ML / 256, D / 256};
              GEMM_CALL(S2, E2); } }
        PH_END(PH0)
        PH_BEGIN(PH0 + 1)
        { const float* lq1 = P.in[12] + ia * 64; const float* lk1 = P.in[13] + ia * 64; const float* lq2 = P.in[14] + ia * 64; const float* lk2 = P.in[15] + ia * 64;
          const float d1 = wave_sum(lq1[C.lane] * lk1[C.lane]), d2 = wave_sum(lq2[C.lane] * lk2[C.lane]);
          const float li = (L == 0) ? P.lam_init0 : P.lam_init3;
          att::Args A{WSP(bf16_t, WS_Q), WSP(bf16_t, WS_K), WSP(bf16_t, WS_V), WSP(bf16_t, WS_O), P.in[16] + ia * 128, expf(d1) - expf(d2) + li, 1.0f - li};
          constexpr int nlat_units = NB * NH * (SEQ / 256);
          const int per = (nlat_units + C.G - 1) / C.G;
#pragma unroll 1
          for (int i = 0; i < per; ++i) { const int uu = C.vcu * per + i; if (uu < nlat_units) { const int bh = uu >> 3, qb = uu & 7; int tid_ = C.tid; asm volatile("" : "+v"(tid_)); att::unit_checked(lds, A, bh >> 4, bh & 15, (bh >> 4) * SEQ + qb * 256, SEQ / 64, tid_); } }
          if constexpr (!lastl) { for (int uc = C.bx; uc < NB * NH; uc += C.G) { const int b = uc >> 4, h = uc & 15; int tid_ = C.tid; asm volatile("" : "+v"(tid_)); att::unit_checked(lds, A, b, h, ML + b * CL, 0, tid_); } } }
        PH_END(PH0 + 1)
    } else if constexpr (kind == 1) {
        PH_BEGIN(PH0)
        { pg8::Sched S{}; S.B = (const char*)WSP(bf16_t, WS_U); S.lda = 512 * 2; S.ldb = D * 2; S.nt = 8; S.nM = 1; S.nN = ML / 256; S.ngroups = 4; S.a_g = 0; S.b_g = 512 * 2; S.G = C.G;
          S.A = (const char*)WSP(bf16_t, WS_T1); S.c = C.bx;
          { pg8::EpiFAH E{WSP(bf16_t, WS_YT), 0}; GEMM_CALL(S, E); }
          S.A = (const char*)(WSP(bf16_t, WS_T1) + 512 * 512); S.c = (C.bx + C.G / 2) % C.G;
          { pg8::EpiFAH E{WSP(bf16_t, WS_YT), 1}; GEMM_CALL(S, E); }
          static_assert(!lastl, "the Fourier layer keeps its context stream");
          pg8::Sched S2{}; S2.A = (const char*)WSP(bf16_t, WS_T1); S2.B = (const char*)(WSP(bf16_t, WS_U) + (size_t)ML * D); S2.lda = 512 * 2; S2.ldb = D * 2; S2.nt = 8; S2.nM = 4; S2.nN = MC / 256; S2.ngroups = 4; S2.a_g = 0; S2.b_g = 512 * 2; S2.G = C.G; S2.c = C.bx;
          pg8::EpiFA E2{WSP(bf16_t, WS_YT), WSP(bf16_t, WS_YTC), 32}; GEMM_CALL(S2, E2);
          fourier_y256(WSP(const bf16_t, WS_U), WSP(const bf16_t, WS_T1), WSP(float, WS_SLOT), C.bx, C.wave, C.lane); }
        PH_END(PH0)
        PH_BEGIN(PH0 + 1)
        { pg8::Sched S{}; S.lda = 4096 * 2; S.ldb = 16384 * 2; S.nt = 16; S.nM = 4; S.nN = 4; S.ngroups = 4; S.a_g = 0; S.b_g = 4096 * 2; S.G = C.G;
          bf16_t* PQ = WSP(bf16_t, WS_YT) + 16 * MiB;
#define FB_CALL(q) { S.A = (const char*)(WSP(bf16_t, WS_A2) + ((q) >> 1) * 2048 + ((q) & 1) * 1024); S.B = (const char*)(WSP(bf16_t, WS_YT) + ((q) >> 1) * 2048 + ((q) & 1) * 1024); \
                     S.c = (C.bx + C.G - (q) * (C.G / 4)) % C.G; pg8::EpiBf16<0> E{PQ + (size_t)(q) * 4 * 1024 * 1024, 1024u, 1024}; GEMM_CALL(S, E); }
          FB_CALL(0) FB_CALL(1) FB_CALL(2) FB_CALL(3)
#undef FB_CALL
          { pg8::Sched S2{}; S2.A = (const char*)WSP(bf16_t, WS_A2C); S2.B = (const char*)WSP(bf16_t, WS_YTC); S2.lda = 512 * 2; S2.ldb = 2048 * 2; S2.nt = 8; S2.nM = 1; S2.nN = 8; S2.ngroups = 4; S2.a_g = 0; S2.b_g = 512 * 2; S2.G = C.G; S2.c = C.bx;
            pg8::EpiBf16<0> E2{WSP(bf16_t, WS_O) + (size_t)ML * D, (unsigned)D, CL};
            GEMM_CALL(S2, E2); }
          fourier_edge1024(WSP(const bf16_t, WS_YT), WSP(const bf16_t, WS_A2), WSP(float, WS_SLOT) + 65536, C.bx, C.wave, C.lane); }
        PH_END(PH0 + 1)
        PH_BEGIN(PH0 + 2)
        fourier_combine(WSP(const bf16_t, WS_YT) + 16 * MiB, WSP(const float, WS_SLOT) + 65536, WSP(const bf16_t, WS_A2), WSP(const float, WS_SLOT), WSP(bf16_t, WS_O), C.lds, C.bx, C.tid, C.wave, C.lane);
        PH_END(PH0 + 2)
    } else {
        PH_BEGIN(PH0) pool_phase(WSP(bf16_t, WS_U), WSP(bf16_t, WS_O), Mact, C.bx, C.wave, C.lane); PH_END(PH0)
    }
    PH_BEGIN(PH0 + CF::o_mix)
    { pg8::Sched S{}; S.A = (const char*)WSP(bf16_t, WS_O); S.lda = D * 2; S.G = C.G; S.c = C.bx;
      if constexpr (kind == 2) { S.B = (const char*)WSP(bf16_t, WS_WPOOL); S.ldb = 512 * 2; S.nt = 8; S.nM = Mact / 256; S.nN = 2; S.ngroups = 4; S.a_g = 512 * 2; S.b_g = 512 * 512 * 2;
          pg8::EpiY E{WSP(bf16_t, WS_Y), (unsigned)D, P.in[19], 512, 0}; GEMM_CALL(S, E); }
      else { S.B = kind == 0 ? (const char*)(WSP(bf16_t, WS_WO) + (size_t)(L / 3) * D * D) : (const char*)WSP(bf16_t, WS_WF); S.ldb = D * 2; S.nt = D / 64; S.nM = ML / 256; S.nN = D / 256; S.ngroups = 1;
          if constexpr (CF::fuse_mid) {
              pg8::EpiFuse E{L == 0 ? P.in[0] : X, X, WSP(bf16_t, WS_U), modl + 2 * D, P.in[7] + L * D, P.in[8] + L * D, modl + 4 * D, modl + 3 * D,
                             WSP(unsigned long long, WS_SLOT), WSP(unsigned, WS_CTL) + CW_FUSE + (2 * L) * 2048, WSP(unsigned, WS_CTL) + CW_TMO};
              GEMM_CALL(S, E);
          } else { pg8::EpiY E{WSP(bf16_t, WS_Y), (unsigned)D, nullptr, 0, 0}; GEMM_CALL(S, E); }
          if constexpr (!lastl) { pg8::Sched S2 = S; S2.A = (const char*)(WSP(bf16_t, WS_O) + (size_t)ML * D); S2.nt = D / 64 / NSPLIT; S2.nM = MC / 256; S2.ngroups = NSPLIT; S2.a_g = (D / NSPLIT) * 2; S2.b_g = (D / NSPLIT) * 2;
              pg8::EpiSlab E2{WSP(bf16_t, WS_YC), (unsigned)D, (size_t)MC * D}; GEMM_CALL(S2, E2); } } }
    PH_END(PH0 + CF::o_mix)
    if constexpr (CF::has_tmid) {
    PH_BEGIN(PH0 + CF::o_tmid)
    { ThinArgs T{}; T.xin_lat = L == 0 ? (const void*)P.in[0] : (const void*)XB; T.xin_ctx = L == 0 ? (const void*)P.in[2] : (const void*)(XB + (size_t)ML * D); T.xin_bf16 = L == 0 ? 0 : 1; T.y = WSP(const bf16_t, WS_Y); T.xout_lat = XB; T.xout_ctx = XB + (size_t)ML * D; T.xout_bf16 = 1;
      T.yc = WSP(const bf16_t, WS_YC); T.nslab = (kind == 2 || lastl) ? 0 : NSPLIT;
      T.g_post = P.in[7] + L * D; T.gate = modl + 2 * D; T.uout = WSP(bf16_t, WS_U); T.g_pre = P.in[8] + L * D; T.sc = modl + 4 * D; T.sh = modl + 3 * D; T.nrows = Mact; T.gb_lo = CF::fuse_mid ? 4 : 0;
      thin_phase(T, C.lds, C.bx, C.G, C.tid, C.wave, C.lane); }
    PH_END(PH0 + CF::o_tmid)
    }
    PH_BEGIN(PH0 + CF::o_w1)
    { pg8::Sched S{}; S.A = (const char*)WSP(bf16_t, WS_U); S.B = (const char*)(WSP(bf16_t, WS_W1) + (size_t)L * FF * D); S.lda = D * 2; S.ldb = D * 2; S.nt = D / 64; S.nM = Mact / 256; S.nN = FF / 256; S.ngroups = 1; S.G = C.G; S.c = C.bx;
      pg8::EpiBf16<1> E{WSP(bf16_t, WS_H), (unsigned)FF, 0}; GEMM_CALL(S, E); }
    PH_END(PH0 + CF::o_w1)
    PH_BEGIN(PH0 + CF::o_w2)
    { pg8::Sched S{}; S.A = (const char*)WSP(bf16_t, WS_H); S.B = (const char*)(WSP(bf16_t, WS_W2) + (size_t)L * D * FF); S.lda = FF * 2; S.ldb = FF * 2; S.nt = FF / 64; S.nM = ML / 256; S.nN = D / 256; S.ngroups = 1; S.G = C.G; S.c = C.bx;
      if constexpr (CF::fuse_post) {
          const float* modn = modl + 5 * MODROW;
          pg8::EpiFuse E{X, lastl ? P.out : X, lastl ? nullptr : WSP(bf16_t, WS_U), modl + 5 * D, P.in[9] + L * D, lastl ? nullptr : P.in[6] + (L + 1) * D, modn + 1 * D, modn + 0 * D,
                         WSP(unsigned long long, WS_SLOT), WSP(unsigned, WS_CTL) + CW_FUSE + (2 * L + 1) * 2048, WSP(unsigned, WS_CTL) + CW_TMO};
          GEMM_CALL(S, E);
      } else { pg8::EpiY E{WSP(bf16_t, WS_Y), (unsigned)D, nullptr, 0, 0}; GEMM_CALL(S, E); }
      if constexpr (!lastl) { pg8::Sched S2 = S; S2.A = (const char*)(WSP(bf16_t, WS_H) + (size_t)ML * FF); S2.nt = FF / 64 / NSPLIT; S2.nM = MC / 256; S2.ngroups = NSPLIT; S2.a_g = (FF / NSPLIT) * 2; S2.b_g = (FF / NSPLIT) * 2;
          pg8::EpiSlab E2{WSP(bf16_t, WS_YC), (unsigned)D, (size_t)MC * D}; GEMM_CALL(S2, E2); } }
    PH_END(PH0 + CF::o_w2)
    if constexpr (CF::has_tpost) {
    PH_BEGIN(PH0 + CF::o_tpost)
    { ThinArgs T{}; T.xin_lat = XB; T.xin_ctx = XB + (size_t)ML * D; T.xin_bf16 = 1; T.y = WSP(const bf16_t, WS_Y); T.xout_lat = lastl ? (void*)P.out : (void*)XB; T.xout_ctx = XB + (size_t)ML * D; T.xout_bf16 = lastl ? 0 : 1;
      T.yc = WSP(const bf16_t, WS_YC); T.nslab = lastl ? 0 : NSPLIT;
      T.g_post = P.in[9] + L * D; T.gate = modl + 5 * D; T.nrows = Mact; T.gb_lo = CF::fuse_post ? 4 : 0;
      if constexpr (!lastl) { const float* modn = modl + 5 * MODROW; T.uout = WSP(bf16_t, WS_U); T.g_pre = P.in[6] + (L + 1) * D; T.sc = modn + 1 * D; T.sh = modn + 0 * D; }
      thin_phase(T, C.lds, C.bx, C.G, C.tid, C.wave, C.lane); }
    PH_END(PH0 + CF::o_tpost)
    }
}
constexpr int PH_L0 = 2, PH_L1 = PH_L0 + LayerCfg<0>::nph, PH_L2 = PH_L1 + LayerCfg<1>::nph, PH_L3 = PH_L2 + LayerCfg<2>::nph, N_PHASES = PH_L3 + LayerCfg<3>::nph;

__global__ void __launch_bounds__(NTHR, 2) fwd_kernel(Params P) {
    extern __shared__ __attribute__((aligned(16))) unsigned char lds_raw[];
    Ctx C; C.lds = (LAS unsigned char*)lds_raw;
    C.tid = threadIdx.x; C.lane = C.tid & 63; C.wave = __builtin_amdgcn_readfirstlane(C.tid >> 6);
    C.G = gridDim.x; C.bx = blockIdx.x; C.vcu = (C.G % 8 == 0) ? (C.bx % 8) * (C.G / 8) + C.bx / 8 : C.bx;
    C.gw = C.vcu * NWAVES + C.wave; C.NGW = C.G * NWAVES;
    for (int u = C.tid; u < (LDS_BYTES - LDSCTL_OFF) / 4; u += NTHR) ((LAS unsigned*)(C.lds + LDSCTL_OFF))[u] = 0u;
    __syncthreads();
#if MK_MULTI
    XcdBarrier bar{};
#else
    XcdBarrier bar = xcd_barrier_post(WSP(unsigned, WS_CTL) + CW_BAR, (volatile LAS unsigned*)(C.lds + MISC_OFF) + 8);
#endif
    PH_BEGIN(0) prologue<2>(P, C.lds, C.tid, C.wave, C.lane, C.vcu, C.G); PH_END(0)
#if !MK_MULTI
    if (P.ph_lo == 0 && P.ph_hi > 1) {
        volatile LAS unsigned* st = (volatile LAS unsigned*)(C.lds + MISC_OFF) + 8;
        if (C.tid == 0) { unsigned* bw = WSP(unsigned, WS_CTL) + CW_BAR; bool okc = (C.G % 8 == 0);
            for (unsigned j = 0; j < 16; ++j) { const unsigned cnt = xb_ld(&bw[XB_XCNT(j)]); okc = okc && (cnt == (j < 8 ? (unsigned)C.G / 8u : 0u)); }
            st[3] = okc ? st[2] * 8u + bar.x : (unsigned)blockIdx.x; }
        __syncthreads();
        C.bx = (int)st[3]; C.vcu = (C.G % 8 == 0) ? (C.bx % 8) * (C.G / 8) + C.bx / 8 : C.bx; C.gw = C.vcu * NWAVES + C.wave;
    }
#endif
    PH_BEGIN(1)
    { const float* mod = WSP(const float, WS_MOD);
      ThinArgs T{}; T.xin_lat = P.in[0]; T.xin_ctx = P.in[2]; T.y = nullptr; T.uout = WSP(bf16_t, WS_U); T.g_pre = P.in[6]; T.sc = mod + 1 * D; T.sh = mod + 0 * D; T.nrows = MT;
      thin_phase(T, C.lds, C.bx, C.G, C.tid, C.wave, C.lane); }
    PH_END(1)
    layer<0, PH_L0>(P, C, bar);
    layer<1, PH_L1>(P, C, bar);
    layer<2, PH_L2>(P, C, bar);
    layer<3, PH_L3>(P, C, bar);
}
#undef PH_BEGIN
#undef PH_END
#undef GRID_BAR

extern "C" void kernel_launch(void* const* d_in, const int* in_sizes, int n_in, void* d_out, int out_size, void* d_ws, size_t ws_size, hipStream_t stream) {
    static int grid = 0;
    if (grid == 0) {
        if (n_in != 22 || out_size != ML * D || ws_size < WS_END) { fprintf(stderr, "kernel_launch: unexpected problem: n_in %d out %d ws %zu (need %zu)\n", n_in, out_size, ws_size, (size_t)WS_END); grid = -1; return; }
        int dev = 0, cus = 0, per_cu = 0;
        if (hipGetDevice(&dev) != hipSuccess || hipDeviceGetAttribute(&cus, hipDeviceAttributeMultiprocessorCount, dev) != hipSuccess) { grid = -1; return; }
        if (hipFuncSetAttribute((const void*)fwd_kernel, hipFuncAttributeMaxDynamicSharedMemorySize, LDS_BYTES) != hipSuccess) { fprintf(stderr, "kernel_launch: hipFuncSetAttribute failed\n"); grid = -1; return; }
        if (hipOccupancyMaxActiveBlocksPerMultiprocessor(&per_cu, (const void*)fwd_kernel, NTHR, LDS_BYTES) != hipSuccess || per_cu < 1) fprintf(stderr, "kernel_launch: occupancy query says %d\n", per_cu);
        (void)hipGetLastError();
        if (cus < 256) { fprintf(stderr, "kernel_launch: %d CUs; this kernel is built for a 256-CU device (one workgroup per CU, fused epilogues pair 8 workgroups per row panel)\n", cus); grid = -1; return; }
        grid = 256;
    }
    if (grid < 0) return;
    (void)in_sizes;
    hipMemsetAsync((char*)d_ws + WS_CTL, 0, CTL_BYTES, stream);
    Params p{};
    for (int i = 0; i < 22; ++i) p.in[i] = (const float*)d_in[i];
    p.out = (float*)d_out; p.ws = (unsigned char*)d_ws;
    p.lam_init0 = (float)(0.8 - 0.6 * exp(-0.3 * 0.0)); p.lam_init3 = (float)(0.8 - 0.6 * exp(-0.3 * 3.0));
#if MK_MULTI
    for (int ph = 0; ph < N_PHASES; ++ph) { p.ph_lo = ph; p.ph_hi = ph + 1; hipLaunchKernelGGL(fwd_kernel, dim3(grid), dim3(NTHR), LDS_BYTES, stream, p); }
#else
    p.ph_lo = 0; p.ph_hi = N_PHASES;
    hipLaunchKernelGGL(fwd_kernel, dim3(grid), dim3(NTHR), LDS_BYTES, stream, p);
#endif
    const hipError_t le = hipPeekAtLastError();
    if (le != hipSuccess) fprintf(stderr, "kernel_launch: launch failed: %s\n", hipGetErrorName(le));
}
```

```cpp
#include <hip/hip_runtime.h>
#include <cstdio>
#include <cstdint>
#include <cmath>

#ifndef MK_MULTI
#define MK_MULTI 0
#endif

#define LAS __attribute__((address_space(3)))
#define GAS __attribute__((address_space(1)))
typedef unsigned short bf16_t;
typedef short bf16x8 __attribute__((ext_vector_type(8)));
typedef short s16x4 __attribute__((ext_vector_type(4)));
typedef float f32x4 __attribute__((ext_vector_type(4)));
typedef float f32x2 __attribute__((ext_vector_type(2)));
typedef float f32x16 __attribute__((ext_vector_type(16)));
typedef unsigned u32x4 __attribute__((ext_vector_type(4)));
typedef unsigned u32x2 __attribute__((ext_vector_type(2)));

constexpr int D = 2048, NB = 4, SEQ = 2048, CL = 256, ML = NB * SEQ, MC = NB * CL, MT = ML + MC, FF = 8192, NH = 16, NMOD = 6, MODROW = NMOD * D;
constexpr int NWAVES = 8, NTHR = 512;
constexpr float NORM_EPS = 1e-6f, SUBLN_EPS = 1e-5f;
constexpr float QSCALE = 0.125f * 1.4426950408889634f;

constexpr size_t MiB = 1u << 20;
constexpr size_t WS_CTL = 0, CTL_BYTES = 1 * MiB;
constexpr size_t WS_MOD = 1 * MiB;
constexpr size_t WS_ROPE = 2 * MiB;
constexpr size_t WS_T1 = 3 * MiB;
constexpr size_t WS_A2C = 4 * MiB;
constexpr size_t WS_A2 = 5 * MiB;
constexpr size_t WS_WQKV = 22 * MiB;
constexpr size_t WS_WO = 70 * MiB;
constexpr size_t WS_WF = 86 * MiB;
constexpr size_t WS_WPOOL = 94 * MiB;
constexpr size_t WS_W1 = 96 * MiB;
constexpr size_t WS_W2 = 224 * MiB;
constexpr size_t WS_X = 352 * MiB;
constexpr size_t WS_Y = 424 * MiB;
constexpr size_t WS_U = 496 * MiB;
constexpr size_t WS_Q = 532 * MiB, WS_K = 568 * MiB, WS_V = 604 * MiB, WS_O = 640 * MiB;
constexpr size_t WS_H = 676 * MiB;
constexpr size_t WS_YT = 820 * MiB;
constexpr size_t WS_YTC = 884 * MiB;
constexpr size_t WS_YC = 892 * MiB;
constexpr size_t WS_SLOT = 956 * MiB;
constexpr size_t WS_END = 958 * MiB;
constexpr int NSPLIT = 8;

constexpr int RING_BYTES = 131072, LDSCTL_OFF = 139264  , MISC_OFF = LDSCTL_OFF + 320, LDS_BYTES = 147456;

__device__ __forceinline__ unsigned cvt_pk_bf16(float lo, float hi) { unsigned r; asm volatile("v_cvt_pk_bf16_f32 %0, %1, %2" : "=v"(r) : "v"(lo), "v"(hi)); return r; }
typedef __bf16 bf16x2v_t __attribute__((ext_vector_type(2)));
__device__ __forceinline__ unsigned cvt_pk_vis(float lo, float hi) { const f32x2 v = {lo, hi}; const bf16x2v_t b = __builtin_convertvector(v, bf16x2v_t); return __builtin_bit_cast(unsigned, b); }
__device__ __forceinline__ float bf2f(unsigned short b) { return __uint_as_float(((unsigned)b) << 16); }
__device__ __forceinline__ float wave_sum(float v) {
#pragma unroll
    for (int o = 1; o < 64; o <<= 1) v += __shfl_xor(v, o);
    return v;
}

#define XB_TMO      128
#define XB_XCNT(j)  (256  + 64 * (j))
#define XB_XSUB(j)  (1280 + 64 * (j))
#define XB_XGEN(j)  (2304 + 64 * (j))
#define XB_TOP      3328
#define XB_TOPGEN   3392
#define XCD_BAR_WORDS 3456
#define XB_SPIN_CAP (1u << 18)
constexpr int CW_BAR = 4096, CW_FUSE = 16384, CW_TMO = 8, CW_MOD0 = 2048;

__device__ __forceinline__ unsigned xb_ld(unsigned* p)              { return __hip_atomic_load(p, __ATOMIC_RELAXED, __HIP_MEMORY_SCOPE_AGENT); }
__device__ __forceinline__ unsigned xb_add(unsigned* p, unsigned v) { return __hip_atomic_fetch_add(p, v, __ATOMIC_RELAXED, __HIP_MEMORY_SCOPE_AGENT); }
__device__ __forceinline__ unsigned xb_xcc_id() { return (unsigned)__builtin_amdgcn_s_getreg((3 << 11) | 20) & 0xFu; }
#define XB_SPIN(cond, bar) do { unsigned _sp = 0; while (cond) { __builtin_amdgcn_s_sleep(1); \
    if ((++_sp & 255u) == 0u) { if (xb_ld(&(bar)[XB_TMO])) break; if (_sp > XB_SPIN_CAP) { atomicAdd(&(bar)[XB_TMO], 1u); break; } } } } while (0)

struct XcdBarrier { unsigned* bar; unsigned x; volatile LAS unsigned* st; };

__device__ __forceinline__ XcdBarrier xcd_barrier_post(unsigned* bar, volatile LAS unsigned* st) {
    XcdBarrier b; b.bar = bar; b.x = xb_xcc_id(); b.st = st;
    if (threadIdx.x == 0) st[2] = xb_add(&bar[XB_XCNT(b.x)], 1u);
    return b;
}
__device__ __forceinline__ void xcd_barrier_complete(unsigned* bar, unsigned x, unsigned& nloc, unsigned& nx) {
    const unsigned G = gridDim.x * gridDim.y * gridDim.z;
    unsigned sum, cnt, mine, sp = 0u;
    for (;;) {
        sum = 0u; cnt = 0u; mine = 0u;
#pragma unroll
        for (unsigned j = 0; j < 16; ++j) { const unsigned c = xb_ld(&bar[XB_XCNT(j)]); sum += c; cnt += (c > 0u) ? 1u : 0u; mine = (j == x) ? c : mine; }
        if (sum == G) break;
        __builtin_amdgcn_s_sleep(1);
        if ((++sp & 255u) == 0u) { if (xb_ld(&bar[XB_TMO])) break; if (sp > XB_SPIN_CAP) { atomicAdd(&bar[XB_TMO], 1u); break; } }
    }
    nloc = mine > 0u ? mine : 1u; nx = cnt > 0u ? cnt : 1u;
}
__device__ __forceinline__ void xcd_barrier(const XcdBarrier& b) {
    asm volatile("s_waitcnt vmcnt(0)" ::: "memory");
    __syncthreads();
    if (threadIdx.x == 0) {
        unsigned* bar = b.bar;
        __builtin_amdgcn_s_waitcnt(0);
        unsigned nloc = b.st[0], nx = b.st[1];
        if (nloc == 0u) { xcd_barrier_complete(bar, b.x, nloc, nx); b.st[0] = nloc; b.st[1] = nx; }
        const unsigned old = xb_add(&bar[XB_XSUB(b.x)], 1u);
        const unsigned gen = old / nloc;
        if (old + 1u == (gen + 1u) * nloc) {
            __builtin_amdgcn_fence(__ATOMIC_RELEASE, "agent");
            asm volatile("s_waitcnt vmcnt(0)" ::: "memory");
            const unsigned og = xb_add(&bar[XB_TOP], 1u);
            const unsigned tg = og / nx;
            if (og + 1u == (tg + 1u) * nx) xb_add(&bar[XB_TOPGEN], 1u);
            else XB_SPIN(xb_ld(&bar[XB_TOPGEN]) == tg, bar);
            __builtin_amdgcn_fence(__ATOMIC_ACQUIRE, "agent");
            xb_add(&bar[XB_XGEN(b.x)], 1u);
            asm volatile("s_waitcnt vmcnt(0)" ::: "memory");
        } else {
            XB_SPIN(xb_ld(&bar[XB_XGEN(b.x)]) == gen, bar);
            __builtin_amdgcn_fence(__ATOMIC_ACQUIRE, "agent");
            asm volatile("s_waitcnt vmcnt(0)" ::: "memory");
        }
    }
    __syncthreads();
}

namespace pg8 {
constexpr int BM = 256, BK = 64, HALF = 128, HTB = HALF * BK * 2, STAGE_BYTES = 8 * HTB, NXCD = 8, WGM = 8;
__device__ __forceinline__ int lds_byte(int r, int c) { const int st = (r >> 4) * 2 + (c >> 5), rr = r & 15, cc = c & 31, ob = rr * 64 + cc * 2; return st * 1024 + (ob ^ (((ob >> 9) & 1) << 5)); }
__device__ __forceinline__ void stage_rc(int b, int& R, int& C) { const int st = b / 1024, sb = b % 1024, swz = sb ^ (((sb >> 9) & 1) << 5); R = (st >> 1) * 16 + swz / 64; C = (st & 1) * 32 + (swz % 64) / 2; }
__device__ __forceinline__ int perm32(int rho) { const int n = rho >> 4, i = rho & 15; return 8 * (i >> 2) + 4 * n + (i & 3); }

struct Unit { const char* A; const char* B; int g, pm, pn; };

struct Sched {
    const char* A; const char* B; unsigned lda, ldb; int nt;
    int nM, nN, ngroups; long long a_g, b_g;
    int G, c;
    __device__ __forceinline__ bool next(int i, Unit& u) const {
        const int per = nM * nN, nwg = per * ngroups;
        const long L = (long)i * G + c; if (L >= nwg) return false;
        int wgid = (int)L; { const int q = nwg / NXCD, r = nwg % NXCD, xcd = wgid % NXCD, off = wgid / NXCD; wgid = (xcd < r ? xcd * (q + 1) : r * (q + 1) + (xcd - r) * q) + off; }
        const int g = wgid / per, w = wgid % per;
        const int nig = WGM * nN, gid = w / nig, fm = gid * WGM, gsz = (nM - fm) < WGM ? (nM - fm) : WGM;
        u.g = g; u.pm = fm + ((w % nig) % gsz); u.pn = (w % nig) / gsz;
        u.A = A + (long long)g * a_g + (size_t)u.pm * BM * lda; u.B = B + (long long)g * b_g + (size_t)u.pn * BM * ldb;
        return true;
    }
};

template <class Epi>
__device__ __forceinline__ void gemm_phase(LAS unsigned char* lds, const Sched& S, const Epi& E, int tid_in = -1) {
    const int tid = tid_in >= 0 ? tid_in : (int)threadIdx.x, wid = __builtin_amdgcn_readfirstlane(tid >> 6), lane = tid & 63, wr = wid >> 2, wc = wid & 3, fr = lane & 15, fq = lane >> 4;
    const int nt = S.nt;
    unsigned voffA[2], voffB[2];
#pragma unroll
    for (int i = 0; i < 2; ++i) { int R, C; stage_rc(tid * 16 + i * 8192, R, C); const int Rb = (R & ~31) + perm32(R & 31);
        voffA[i] = (unsigned)R * S.lda + (unsigned)C * 2u; voffB[i] = (unsigned)Rb * S.ldb + (unsigned)C * 2u; }
    const size_t kstep = (size_t)(BK * 2);
    const size_t hA = (size_t)HALF * S.lda, hB = (size_t)HALF * S.ldb;
    const unsigned ldsw = (unsigned)wid * 1024u;
    const int aoff = lds_byte(wr * 64 + fr, fq * 8), boff = lds_byte(wc * 32 + fr, fq * 8);
#define PG8_SA(b, h) (((b) * 2 + (h)) * HTB)
#define PG8_SB(b, h) ((4 + (b) * 2 + (h)) * HTB)
#define PG8_STAGE(bufoff, gbase, voff) do { _Pragma("unroll") for (int _i = 0; _i < 2; ++_i) \
        __builtin_amdgcn_global_load_lds((const unsigned*)((const char*)(gbase) + (voff)[_i]), (LAS unsigned*)(lds + (bufoff) + ldsw + _i * 8192), 16, 0, 0); } while (0)
#define PG8_LDA(dst, b, h) do { _Pragma("unroll") for (int m = 0; m < 4; ++m) _Pragma("unroll") for (int k = 0; k < 2; ++k) dst[m][k] = *(const LAS bf16x8*)(lds + PG8_SA(b, h) + aoff + m * 2048 + k * 1024); } while (0)
#define PG8_LDB(dst, b, h) do { _Pragma("unroll") for (int n = 0; n < 2; ++n) _Pragma("unroll") for (int k = 0; k < 2; ++k) dst[n][k] = *(const LAS bf16x8*)(lds + PG8_SB(b, h) + boff + n * 2048 + k * 1024); } while (0)
#define PG8_MMA(ai, bj, At, Bt) do { __builtin_amdgcn_s_setprio(1); _Pragma("unroll") for (int m = 0; m < 4; ++m) _Pragma("unroll") for (int n = 0; n < 2; ++n) _Pragma("unroll") for (int k = 0; k < 2; ++k) \
        acc[ai][bj][m][n] = __builtin_amdgcn_mfma_f32_16x16x32_bf16(Bt[n][k], At[m][k], acc[ai][bj][m][n], 0, 0, 0); __builtin_amdgcn_s_setprio(0); } while (0)
#define PG8_WAIT_V(n) asm volatile("s_waitcnt vmcnt(" #n ")" ::: "memory")
#define PG8_WAIT_L(n) asm volatile("s_waitcnt lgkmcnt(" #n ")" ::: "memory")
#define PG8_BAR __builtin_amdgcn_s_barrier()
#define PG8_SCHED __builtin_amdgcn_sched_barrier(0)
    Unit cur, nxt; int ui = 0;
    if (!S.next(0, cur)) return;
    f32x4 acc[2][2][4][2];
#pragma unroll
    for (int a = 0; a < 2; ++a)
#pragma unroll
        for (int b = 0; b < 2; ++b)
#pragma unroll
            for (int m = 0; m < 4; ++m)
#pragma unroll
                for (int n = 0; n < 2; ++n) acc[a][b][m][n] = (f32x4){0.f, 0.f, 0.f, 0.f};
    bf16x8 At[4][2], B0[2][2], B1[2][2];
    const char* cA = cur.A; const char* cB = cur.B;
    PG8_STAGE(PG8_SB(0, 0), cB, voffB); PG8_STAGE(PG8_SB(0, 1), cB + hB, voffB); PG8_STAGE(PG8_SA(0, 0), cA, voffA); PG8_STAGE(PG8_SA(0, 1), cA + hA, voffA);
    if (wr == 1) PG8_BAR;
    PG8_WAIT_V(2); PG8_BAR;
    PG8_STAGE(PG8_SB(1, 0), cB + kstep, voffB); PG8_STAGE(PG8_SA(1, 0), cA + kstep, voffA); PG8_STAGE(PG8_SB(1, 1), cB + hB + kstep, voffB);
    PG8_WAIT_V(6); PG8_BAR;
    for (;;) {
        const bool has_next = S.next(ui + 1, nxt);
        const char* nA = has_next ? nxt.A : cA; const char* nB = has_next ? nxt.B : cB;
        for (int t = 0; t < nt; t += 2) {
            const bool last = (t == nt - 2);
            const char* a1 = cA + (size_t)(t + 1) * kstep;
            const char* a2 = last ? nA : cA + (size_t)(t + 2) * kstep; const char* b2 = last ? nB : cB + (size_t)(t + 2) * kstep;
            const char* a3 = a2 + kstep; const char* b3 = b2 + kstep;
            PG8_LDB(B0, 0, 0); PG8_LDB(B1, 0, 1); PG8_SCHED; PG8_LDA(At, 0, 0); PG8_STAGE(PG8_SA(1, 1), a1 + hA, voffA);
            PG8_WAIT_V(8); PG8_WAIT_L(0); PG8_BAR; PG8_MMA(0, 0, At, B0); PG8_MMA(0, 1, At, B1); PG8_BAR; PG8_SCHED;
            PG8_LDA(At, 0, 1); PG8_STAGE(PG8_SB(0, 0), b2, voffB); PG8_STAGE(PG8_SB(0, 1), b2 + hB, voffB); PG8_STAGE(PG8_SA(0, 0), a2, voffA);
            PG8_WAIT_V(8); PG8_WAIT_L(0); PG8_BAR; PG8_MMA(1, 0, At, B0); PG8_MMA(1, 1, At, B1); PG8_BAR; PG8_SCHED;
            PG8_LDB(B0, 1, 0); PG8_LDB(B1, 1, 1); PG8_SCHED; PG8_LDA(At, 1, 0); PG8_STAGE(PG8_SA(0, 1), a2 + hA, voffA);
            PG8_WAIT_V(8); PG8_WAIT_L(0); PG8_BAR; PG8_MMA(0, 0, At, B0); PG8_MMA(0, 1, At, B1); PG8_BAR; PG8_SCHED;
            PG8_LDA(At, 1, 1); PG8_STAGE(PG8_SB(1, 0), b3, voffB); PG8_STAGE(PG8_SB(1, 1), b3 + hB, voffB); PG8_STAGE(PG8_SA(1, 0), a3, voffA);
            PG8_WAIT_V(8); PG8_WAIT_L(0); PG8_BAR; PG8_MMA(1, 0, At, B0); PG8_MMA(1, 1, At, B1); PG8_BAR; PG8_SCHED;
        }
        if (wr == 0) PG8_BAR;
        if constexpr (!Epi::FUSED) E(acc, cur, wr, wc, fr, fq);
        if (!has_next) break;
#pragma unroll
        for (int a = 0; a < 2; ++a)
#pragma unroll
            for (int b = 0; b < 2; ++b)
#pragma unroll
                for (int m = 0; m < 4; ++m)
#pragma unroll
                    for (int n = 0; n < 2; ++n) acc[a][b][m][n] = (f32x4){0.f, 0.f, 0.f, 0.f};
        cur = nxt; cA = nA; cB = nB; ++ui;
        if (wr == 1) PG8_BAR;
    }
    PG8_WAIT_V(0);
    PG8_BAR;
    if constexpr (Epi::FUSED) E.fused(acc, cur, wr, wc, fr, fq, lds, wid, lane, tid);
#undef PG8_SA
#undef PG8_SB
#undef PG8_STAGE
#undef PG8_LDA
#undef PG8_LDB
#undef PG8_MMA
#undef PG8_WAIT_V
#undef PG8_WAIT_L
#undef PG8_BAR
#undef PG8_SCHED
}

struct EpiF32 {
    static constexpr bool FUSED = false;
    float* C; unsigned ldc; const float* colscale; int c_g; size_t slab_g;
    __device__ __forceinline__ void operator()(const f32x4 (&acc)[2][2][4][2], const Unit& u, int wr, int wc, int fr, int fq) const {
        const int row0 = u.pm * BM + wr * 64 + fr, col0 = u.g * c_g + u.pn * BM + wc * 32 + 8 * fq;
        f32x4 sv[2][2];
#pragma unroll
        for (int bj = 0; bj < 2; ++bj)
#pragma unroll
            for (int n = 0; n < 2; ++n) sv[bj][n] = colscale ? *(const f32x4*)(colscale + col0 + bj * HALF + 4 * n) : (f32x4){1.f, 1.f, 1.f, 1.f};
#pragma unroll
        for (int ai = 0; ai < 2; ++ai)
#pragma unroll
            for (int m = 0; m < 4; ++m) { float* rowp = C + (size_t)u.g * slab_g + (size_t)(row0 + ai * HALF + m * 16) * ldc + col0;
#pragma unroll
                for (int bj = 0; bj < 2; ++bj) { *(f32x4*)(rowp + bj * HALF) = acc[ai][bj][m][0] * sv[bj][0]; *(f32x4*)(rowp + bj * HALF + 4) = acc[ai][bj][m][1] * sv[bj][1]; } }
    }
};
struct EpiY {
    static constexpr bool FUSED = false;
    bf16_t* C; unsigned ldc; const float* colscale; int c_g; size_t slab_g;
    __device__ __forceinline__ void operator()(const f32x4 (&acc)[2][2][4][2], const Unit& u, int wr, int wc, int fr, int fq) const {
        const int row0 = u.pm * BM + wr * 64 + fr, col0 = u.g * c_g + u.pn * BM + wc * 32 + 8 * fq;
        f32x4 sv[2][2];
#pragma unroll
        for (int bj = 0; bj < 2; ++bj)
#pragma unroll
            for (int n = 0; n < 2; ++n) sv[bj][n] = colscale ? *(const f32x4*)(colscale + col0 + bj * HALF + 4 * n) : (f32x4){1.f, 1.f, 1.f, 1.f};
#pragma unroll
        for (int ai = 0; ai < 2; ++ai)
#pragma unroll
            for (int m = 0; m < 4; ++m) { bf16_t* rowp = C + (size_t)(row0 + ai * HALF + m * 16) * ldc + col0;
#pragma unroll
                for (int bj = 0; bj < 2; ++bj) { const f32x4 v0 = acc[ai][bj][m][0] * sv[bj][0], v1 = acc[ai][bj][m][1] * sv[bj][1];
                    u32x4 w; w.x = cvt_pk_vis(v0[0], v0[1]); w.y = cvt_pk_vis(v0[2], v0[3]); w.z = cvt_pk_vis(v1[0], v1[1]); w.w = cvt_pk_vis(v1[2], v1[3]);
                    *(u32x4*)(rowp + bj * HALF) = w; } }
    }
};
struct EpiSlab {
    static constexpr bool FUSED = false;
    bf16_t* C; unsigned ldc; size_t slab_g;
    __device__ __forceinline__ void operator()(const f32x4 (&acc)[2][2][4][2], const Unit& u, int wr, int wc, int fr, int fq) const {
        const int row0 = u.pm * BM + wr * 64 + fr, col0 = u.pn * BM + wc * 32 + 8 * fq;
#pragma unroll
        for (int ai = 0; ai < 2; ++ai)
#pragma unroll
            for (int m = 0; m < 4; ++m) { bf16_t* rowp = C + (size_t)u.g * slab_g + (size_t)(row0 + ai * HALF + m * 16) * ldc + col0;
#pragma unroll
                for (int bj = 0; bj < 2; ++bj) { const f32x4 v0 = acc[ai][bj][m][0], v1 = acc[ai][bj][m][1];
                    u32x4 w; w.x = cvt_pk_vis(v0[0], v0[1]); w.y = cvt_pk_vis(v0[2], v0[3]); w.z = cvt_pk_vis(v1[0], v1[1]); w.w = cvt_pk_vis(v1[2], v1[3]);
                    *(u32x4*)(rowp + bj * HALF) = w; } }
    }
};
template <int ACT> struct EpiBf16 {
    static constexpr bool FUSED = false;
    bf16_t* C; unsigned ldc; int row_g;
    __device__ __forceinline__ void operator()(const f32x4 (&acc)[2][2][4][2], const Unit& u, int wr, int wc, int fr, int fq) const {
        const int row0 = u.g * row_g + u.pm * BM + wr * 64 + fr, col0 = u.pn * BM + wc * 32 + 8 * fq;
#pragma unroll
        for (int ai = 0; ai < 2; ++ai)
#pragma unroll
            for (int m = 0; m < 4; ++m) { bf16_t* rowp = C + (size_t)(row0 + ai * HALF + m * 16) * ldc + col0;
#pragma unroll
                for (int bj = 0; bj < 2; ++bj) { f32x4 v0 = acc[ai][bj][m][0], v1 = acc[ai][bj][m][1];
                    if (ACT == 1) {
#pragma unroll
                        for (int e = 0; e < 4; ++e) { const float a = __builtin_amdgcn_fmed3f(v0[e], 0.f, __builtin_inff()), b = __builtin_amdgcn_fmed3f(v1[e], 0.f, __builtin_inff()); v0[e] = a * a; v1[e] = b * b; } }
                    u32x4 w; w.x = cvt_pk_vis(v0[0], v0[1]); w.y = cvt_pk_vis(v0[2], v0[3]); w.z = cvt_pk_vis(v1[0], v1[1]); w.w = cvt_pk_vis(v1[2], v1[3]);
                    *(u32x4*)(rowp + bj * HALF) = w; } }
    }
};
struct EpiFAH {
    static constexpr bool FUSED = false;
    bf16_t* YT; int cs;
    __device__ __forceinline__ void operator()(const f32x4 (&acc)[2][2][4][2], const Unit& u, int wr, int wc, int fr, int fq) const {
        bf16_t* base = YT + (size_t)(u.g * 256) * 16384 + (u.pn >> 3) * 4096 + cs * 2048 + (u.pn & 7) * 256;
        const int row0 = wr * 64 + fr, col0 = wc * 32 + 8 * fq;
#pragma unroll
        for (int ai = 0; ai < 2; ++ai)
#pragma unroll
            for (int m = 0; m < 4; ++m) { bf16_t* rowp = base + (size_t)(row0 + ai * HALF + m * 16) * 16384 + col0;
#pragma unroll
                for (int bj = 0; bj < 2; ++bj) { const f32x4 v0 = acc[ai][bj][m][0], v1 = acc[ai][bj][m][1];
                    u32x4 w; w.x = cvt_pk_vis(v0[0], v0[1]); w.y = cvt_pk_vis(v0[2], v0[3]); w.z = cvt_pk_vis(v1[0], v1[1]); w.w = cvt_pk_vis(v1[2], v1[3]);
                    *(u32x4*)(rowp + bj * HALF) = w; } }
    }
};
struct EpiFA {
    static constexpr bool FUSED = false;
    bf16_t* YT; bf16_t* YTC; int pn_base;
    __device__ __forceinline__ void operator()(const f32x4 (&acc)[2][2][4][2], const Unit& u, int wr, int wc, int fr, int fq) const {
        const int cs = u.pm >> 1, k2b = (u.pm & 1) * 256, pn = u.pn + pn_base;
        bf16_t* base; size_t pitch;
        if (pn < 32) { const int b = pn >> 3; base = YT + (size_t)(u.g * 512 + k2b) * 16384 + b * 4096 + cs * 2048 + (pn & 7) * 256; pitch = 16384; }
        else { const int b = pn - 32; base = YTC + (size_t)(u.g * 512 + k2b) * 2048 + b * 512 + cs * 256; pitch = 2048; }
        const int row0 = wr * 64 + fr, col0 = wc * 32 + 8 * fq;
#pragma unroll
        for (int ai = 0; ai < 2; ++ai)
#pragma unroll
            for (int m = 0; m < 4; ++m) { bf16_t* rowp = base + (size_t)(row0 + ai * HALF + m * 16) * pitch + col0;
#pragma unroll
                for (int bj = 0; bj < 2; ++bj) { const f32x4 v0 = acc[ai][bj][m][0], v1 = acc[ai][bj][m][1];
                    u32x4 w; w.x = cvt_pk_vis(v0[0], v0[1]); w.y = cvt_pk_vis(v0[2], v0[3]); w.z = cvt_pk_vis(v1[0], v1[1]); w.w = cvt_pk_vis(v1[2], v1[3]);
                    *(u32x4*)(rowp + bj * HALF) = w; } }
    }
};
struct EpiQKV {
    static constexpr bool FUSED = false;
    bf16_t* Q; const float* rope;
    int pm_base, pn_base;
    __device__ __forceinline__ void operator()(const f32x4 (&acc)[2][2][4][2], const Unit& u, int wr, int wc, int fr, int fq) const {
        const int pn = u.pn + pn_base, pm = u.pm + pm_base, part = pn >> 3;
        bf16_t* dst = Q + (size_t)part * ((WS_K - WS_Q) / 2);
        const int row0 = pm * BM + wr * 64 + fr, colp = (pn & 7) * BM + wc * 32 + 8 * fq;
        const bool dorope = (part < 2) && (pm < 32);
        const float sc = part == 0 ? QSCALE : 1.f;
#pragma unroll
        for (int ai = 0; ai < 2; ++ai)
#pragma unroll
            for (int m = 0; m < 4; ++m) { const int row = row0 + ai * HALF + m * 16; bf16_t* rowp = dst + (size_t)row * D + colp;
                const int t = row & 2047, prow = t >> 6, pcol = t & 63;
#pragma unroll
                for (int bj = 0; bj < 2; ++bj) { f32x4 v0 = acc[ai][bj][m][0], v1 = acc[ai][bj][m][1];
                    if (dorope) { const int c = colp + bj * HALF, j0 = (c & 63) >> 1, ax = j0 >> 4, f0 = j0 & 15;
                        const float* cs = rope + ((ax ? pcol : prow) * 16 + f0) * 2;
                        const f32x4 cs0 = *(const f32x4*)cs, cs1 = *(const f32x4*)(cs + 4);
                        f32x4 r0, r1;
                        r0[0] = v0[0] * cs0[0] - v0[1] * cs0[1]; r0[1] = v0[0] * cs0[1] + v0[1] * cs0[0];
                        r0[2] = v0[2] * cs0[2] - v0[3] * cs0[3]; r0[3] = v0[2] * cs0[3] + v0[3] * cs0[2];
                        r1[0] = v1[0] * cs1[0] - v1[1] * cs1[1]; r1[1] = v1[0] * cs1[1] + v1[1] * cs1[0];
                        r1[2] = v1[2] * cs1[2] - v1[3] * cs1[3]; r1[3] = v1[2] * cs1[3] + v1[3] * cs1[2];
                        v0 = r0; v1 = r1; }
                    v0 = v0 * sc; v1 = v1 * sc;
                    u32x4 w; w.x = cvt_pk_vis(v0[0], v0[1]); w.y = cvt_pk_vis(v0[2], v0[3]); w.z = cvt_pk_vis(v1[0], v1[1]); w.w = cvt_pk_vis(v1[2], v1[3]);
                    *(u32x4*)(rowp + bj * HALF) = w; } }
    }
};

struct EpiFuse {
    static constexpr bool FUSED = true;
    const float* xin; float* xout; bf16_t* uout;
    const float* gate; const float* g_post;
    const float* g_pre; const float* sc; const float* sh;
    unsigned long long* slots;
    unsigned* cnt; unsigned* tmo;
    __device__ __forceinline__ void operator()(const f32x4 (&)[2][2][4][2], const Unit&, int, int, int, int) const {}
    __device__ __forceinline__ void fused(f32x4 (&acc)[2][2][4][2], const Unit& u, int wr, int wc, int fr, int fq, LAS unsigned char* lds, int wid, int lane, int tid) const {
        LAS float* ta = (LAS float*)lds; LAS float* tg = ta + 256; LAS float* ts = tg + 256;
        LAS f32x4* P4 = (LAS f32x4*)(lds + 4096);
        LAS f32x2* S2 = (LAS f32x2*)(lds + 4096 + 16384);
        const int b = (u.pm * BM) >> 11, colt = u.pn * BM;
#define FZ_BAR() do { asm volatile("s_waitcnt vmcnt(0) lgkmcnt(0)" ::: "memory"); __builtin_amdgcn_s_barrier(); asm volatile("" ::: "memory"); } while (0)
        if (tid < 256) { const int c = colt + tid; ta[tid] = gate[(size_t)b * MODROW + c] * g_post[c];
            if (uout) { tg[tid] = g_pre[c] * (1.0f + sc[(size_t)b * MODROW + c]); ts[tid] = sh[(size_t)b * MODROW + c]; } }
        FZ_BAR();
#pragma unroll
        for (int ai = 0; ai < 2; ++ai)
#pragma unroll
            for (int m = 0; m < 4; ++m) { const int rl = ai * HALF + wr * 64 + m * 16 + fr; const float* xr = xin + (size_t)((u.pm * BM) + rl) * D + colt + wc * 32 + 8 * fq;
                float s1 = 0.f, s2 = 0.f, s3 = 0.f, s4 = 0.f;
#pragma unroll
                for (int bj = 0; bj < 2; ++bj)
#pragma unroll
                    for (int n = 0; n < 2; ++n) { const f32x4 y = acc[ai][bj][m][n], x = *(const f32x4*)(xr + bj * HALF + 4 * n), a = *(const LAS f32x4*)(ta + bj * HALF + wc * 32 + 8 * fq + 4 * n);
                        const f32x4 ay = a * y;
                        s1 += (y[0] * y[0] + y[1] * y[1]) + (y[2] * y[2] + y[3] * y[3]); s2 += (x[0] * x[0] + x[1] * x[1]) + (x[2] * x[2] + x[3] * x[3]);
                        s3 += (x[0] * ay[0] + x[1] * ay[1]) + (x[2] * ay[2] + x[3] * ay[3]); s4 += (ay[0] * ay[0] + ay[1] * ay[1]) + (ay[2] * ay[2] + ay[3] * ay[3]); }
                s1 += __shfl_xor(s1, 16); s1 += __shfl_xor(s1, 32); s2 += __shfl_xor(s2, 16); s2 += __shfl_xor(s2, 32);
                s3 += __shfl_xor(s3, 16); s3 += __shfl_xor(s3, 32); s4 += __shfl_xor(s4, 16); s4 += __shfl_xor(s4, 32);
                if (fq == 0) P4[rl * 4 + wc] = (f32x4){s1, s2, s3, s4};
                asm volatile("" ::: "memory"); }
        FZ_BAR();
        if (tid < 256) { const f32x4 p0 = P4[tid * 4 + 0], p1 = P4[tid * 4 + 1], p2 = P4[tid * 4 + 2], p3 = P4[tid * 4 + 3]; const f32x4 t = (p0 + p1) + (p2 + p3);
            unsigned long long* slot = slots + ((size_t)((u.pm * BM) + tid) * 8 + u.pn) * 2;
            __hip_atomic_store(slot, ((unsigned long long)__float_as_uint(t[1]) << 32) | __float_as_uint(t[0]), __ATOMIC_RELAXED, __HIP_MEMORY_SCOPE_AGENT);
            __hip_atomic_store(slot + 1, ((unsigned long long)__float_as_uint(t[3]) << 32) | __float_as_uint(t[2]), __ATOMIC_RELAXED, __HIP_MEMORY_SCOPE_AGENT); }
        asm volatile("s_waitcnt vmcnt(0)" ::: "memory");
        if (tid < 256 && lane == 0) __hip_atomic_fetch_add(cnt + 64 * u.pm, 1u, __ATOMIC_RELAXED, __HIP_MEMORY_SCOPE_AGENT);
        if (wid == 0) { const unsigned long long t0 = __builtin_amdgcn_s_memrealtime();
            for (;;) { if ((unsigned)__builtin_amdgcn_readfirstlane(__hip_atomic_load(cnt + 64 * u.pm, __ATOMIC_RELAXED, __HIP_MEMORY_SCOPE_AGENT)) >= 32u) break;
                if (__builtin_amdgcn_s_memrealtime() - t0 > 2000000ull) { if (lane == 0) __hip_atomic_store(tmo, 1u, __ATOMIC_RELAXED, __HIP_MEMORY_SCOPE_AGENT); break; }
                __builtin_amdgcn_s_sleep(2); }
            __builtin_amdgcn_fence(__ATOMIC_ACQUIRE, "agent"); }
        FZ_BAR();
        if (tid < 256) { const unsigned long long* slot = slots + (size_t)((u.pm * BM) + tid) * 16; float t1 = 0.f, t2 = 0.f, t3 = 0.f, t4 = 0.f;
#pragma unroll
            for (int t = 0; t < 8; ++t) { const unsigned long long w0 = __hip_atomic_load(slot + 2 * t, __ATOMIC_RELAXED, __HIP_MEMORY_SCOPE_AGENT), w1 = __hip_atomic_load(slot + 2 * t + 1, __ATOMIC_RELAXED, __HIP_MEMORY_SCOPE_AGENT);
                t1 += __uint_as_float((unsigned)w0); t2 += __uint_as_float((unsigned)(w0 >> 32)); t3 += __uint_as_float((unsigned)w1); t4 += __uint_as_float((unsigned)(w1 >> 32)); }
            const float r1 = 1.0f / sqrtf(t1 * (1.0f / D) + NORM_EPS);
            const float q = t2 + 2.0f * r1 * t3 + r1 * r1 * t4;
            S2[tid] = (f32x2){r1, 1.0f / sqrtf(fmaxf(q, 0.f) * (1.0f / D) + NORM_EPS)}; }
        FZ_BAR();
#pragma unroll
        for (int ai = 0; ai < 2; ++ai)
#pragma unroll
            for (int m = 0; m < 4; ++m) { const int rl = ai * HALF + wr * 64 + m * 16 + fr; const size_t off = (size_t)((u.pm * BM) + rl) * D + colt + wc * 32 + 8 * fq; const f32x2 rr = S2[rl];
#pragma unroll
                for (int bj = 0; bj < 2; ++bj) { const int cl = bj * HALF + wc * 32 + 8 * fq;
                    const f32x4 a0 = *(const LAS f32x4*)(ta + cl), a1 = *(const LAS f32x4*)(ta + cl + 4);
                    const f32x4 x0 = *(const f32x4*)(xin + off + bj * HALF) + (a0 * acc[ai][bj][m][0]) * rr[0], x1 = *(const f32x4*)(xin + off + bj * HALF + 4) + (a1 * acc[ai][bj][m][1]) * rr[0];
                    *(f32x4*)(xout + off + bj * HALF) = x0; *(f32x4*)(xout + off + bj * HALF + 4) = x1;
                    if (uout) { const f32x4 g0 = *(const LAS f32x4*)(tg + cl), g1 = *(const LAS f32x4*)(tg + cl + 4), h0 = *(const LAS f32x4*)(ts + cl), h1 = *(const LAS f32x4*)(ts + cl + 4);
                        const f32x4 u0 = (x0 * rr[1]) * g0 + h0, u1 = (x1 * rr[1]) * g1 + h1;
                        u32x4 w; w.x = cvt_pk_vis(u0[0], u0[1]); w.y = cvt_pk_vis(u0[2], u0[3]); w.z = cvt_pk_vis(u1[0], u1[1]); w.w = cvt_pk_vis(u1[2], u1[3]);
                        *(u32x4*)(uout + off + bj * HALF) = w; } }
                asm volatile("" ::: "memory"); }
        FZ_BAR();
#undef FZ_BAR
    }
};
}


namespace att {
__device__ __forceinline__ unsigned off_a(unsigned row, unsigned ch) { return 2048u * (row >> 3) + 512u * (ch >> 2) + 64u * (row & 7) + 16u * ((ch & 3) ^ ((row >> 2) & 3)); }
constexpr int KBUF = 0, VBUF = 32768, QOFF = 65536, WSF_OFF = LDSCTL_OFF + 1024;
constexpr float THR = 6.0f;
struct Args { const bf16_t* Q; const bf16_t* K; const bf16_t* V; bf16_t* O; const float* gsub; float lam, post; };
__device__ __forceinline__ s16x4 vtr(const LAS unsigned char* p) { return __builtin_bit_cast(s16x4, __builtin_amdgcn_ds_read_tr16_b64_v4i16((LAS s16x4*)p)); }
__device__ __forceinline__ float half_max(float v) { auto rr = __builtin_amdgcn_permlane32_swap(__float_as_uint(v), __float_as_uint(v), false, false); return fmaxf(__uint_as_float(rr[0]), __uint_as_float(rr[1])); }
__device__ __forceinline__ float half_sum(float v) { auto rr = __builtin_amdgcn_permlane32_swap(__float_as_uint(v), __float_as_uint(v), false, false); return __uint_as_float(rr[0]) + __uint_as_float(rr[1]); }

__device__ __forceinline__ void glds16(const void* gsrc, unsigned lds_dst) { unsigned keep;
    asm volatile("s_mov_b32 %0, m0\n\ts_mov_b32 m0, %2\n\ts_nop 0\n\tglobal_load_lds_dwordx4 %1, off\n\ts_mov_b32 m0, %0" : "=&s"(keep) : "v"(gsrc), "s"(lds_dst) : "memory"); }
__device__ __forceinline__ float max3f(float a, float b, float c) { float r; asm("v_max3_f32 %0, %1, %2, %3" : "=v"(r) : "v"(a), "v"(b), "v"(c)); return r; }
__device__ __forceinline__ float max2f(float a, float b) { float r; asm("v_max_f32_e32 %0, %1, %2" : "=v"(r) : "v"(a), "v"(b)); return r; }
__device__ __forceinline__ float fsub_s(float a, float b) { float r; asm("v_sub_f32_e32 %0, %1, %2" : "=v"(r) : "v"(a), "v"(b)); return r; }
__device__ __forceinline__ float fadd_s(float a, float b) { float r; asm("v_add_f32_e32 %0, %1, %2" : "=v"(r) : "v"(a), "v"(b)); return r; }
typedef __bf16 bf16x2_t __attribute__((ext_vector_type(2)));
__device__ __forceinline__ unsigned cvtpk_b(float lo, float hi) { const f32x2 v = {lo, hi}; const bf16x2_t b = __builtin_convertvector(v, bf16x2_t); return __builtin_bit_cast(unsigned, b); }
template <bool SAFE>
__device__ __forceinline__ bool unit(LAS unsigned char* lds, const Args& P, int b, int h, int q0, int nlat, int tid) {
    const int lane = tid & 63, r32 = lane & 31, hi = lane >> 5; const int wid = __builtin_amdgcn_readfirstlane(tid >> 6);
    const int nt = nlat + 4;
    if (wid >= 4) __builtin_amdgcn_s_setprio(1);
    LAS unsigned char* Qs = lds + QOFF + wid * 8192;
    LAS float* wsf = (LAS float*)(lds + WSF_OFF + wid * 256);
    {   const bf16_t* qrow = P.Q + (size_t)(q0 + wid * 32 + r32) * D + h * 128 + hi * 8;
#pragma unroll
        for (int c = 0; c < 2; ++c)
#pragma unroll
            for (int d0 = 0; d0 < 4; ++d0) { const u32x4 v = *(const u32x4*)(qrow + c * 64 + d0 * 16); *(LAS u32x4*)(Qs + ((c * 4 + d0) * 2 + hi) * 512 + r32 * 16) = v; } }
    unsigned goff[2];
#pragma unroll
    for (int i = 0; i < 2; ++i) { const unsigned p = 2 * wid + i, rg = p >> 1, chq = (p & 1) * 2 + (lane >> 5), r7 = (lane >> 2) & 7, x = lane & 3, rsw = (r7 >> 2) | ((rg & 1) << 1);
        goff[i] = ((8 * rg + r7) * D + h * 128 + (4 * chq + (x ^ rsw)) * 8) * 2; }
#define ATT_GROW(t) ((t) < nlat ? b * SEQ + 64 * (t) : ML + b * CL + 64 * ((t) - nlat))
#define ATT_DMA(t, buf) do { const size_t g_ = (size_t)ATT_GROW(t) * D * 2; _Pragma("unroll") for (int i_ = 0; i_ < 2; ++i_) { \
        glds16((const char*)P.K + g_ + goff[i_], (unsigned)__builtin_amdgcn_readfirstlane(lds0 + KBUF + (buf) * 16384 + (2 * wid + i_) * 1024)); \
        glds16((const char*)P.V + g_ + goff[i_], (unsigned)__builtin_amdgcn_readfirstlane(lds0 + VBUF + (buf) * 16384 + (2 * wid + i_) * 1024)); } } while (0)
    const unsigned lds0 = (unsigned)(uintptr_t)lds;
    ATT_DMA(0, 0);
    unsigned kb[2];
#pragma unroll
    for (int e = 0; e < 2; ++e) kb[e] = 2048u * (r32 >> 3) + 64u * (r32 & 7) + 16u * ((unsigned)(2 * e + hi) ^ ((r32 >> 2) & 3));
    const unsigned blk = (lane >> 4) & 1, q_ = (lane & 15) >> 2, p_ = lane & 3;
    unsigned vb[2];
#pragma unroll
    for (int t = 0; t < 2; ++t) vb[t] = 2048u * t + 64u * (4 * hi + q_) + 16u * ((2 * blk + (p_ >> 1)) ^ ((2 * t + hi) & 3)) + 8u * (p_ & 1);
    float m0 = -1e30f, m1 = -1e30f, l0 = 0.f, l1 = 0.f;
    f32x16 o[2][4];
#pragma unroll
    for (int c = 0; c < 2; ++c)
#pragma unroll
        for (int d = 0; d < 4; ++d) o[c][d] = f32x16{};
    asm volatile("s_waitcnt vmcnt(0)" ::: "memory");
    __syncthreads();
#define SB() __builtin_amdgcn_sched_barrier(0)
#define ATT_SMB(S0, S1, i, M, SUM, PW) do { const float a_ = (i) < 8 ? S0[2 * ((i) & 7)] : S1[2 * ((i) & 7)], b_ = (i) < 8 ? S0[2 * ((i) & 7) + 1] : S1[2 * ((i) & 7) + 1]; \
        const float ea_ = SAFE ? __builtin_amdgcn_exp2f(fsub_s(a_, M)) : __builtin_amdgcn_exp2f(a_), eb_ = SAFE ? __builtin_amdgcn_exp2f(fsub_s(b_, M)) : __builtin_amdgcn_exp2f(b_); \
        SUM += ea_; SUM += eb_; PW[i] = cvtpk_b(ea_, eb_); asm volatile("" : "+v"(SUM), "+v"(PW[i])); } while (0)
#define ATT_SMA(S0, S1, c, MC, LC) do { asm volatile("s_nop 15\n\ts_nop 7" : "+v"(S0), "+v"(S1)); \
        float a_ = max3f(S0[0], S0[1], S1[0]), b_ = max3f(S0[2], S0[3], S1[1]); a_ = max3f(a_, S1[2], S1[3]); \
        _Pragma("unroll") for (int r_ = 4; r_ < 16; r_ += 4) { a_ = max3f(a_, S0[r_], S0[r_ + 1]); b_ = max3f(b_, S0[r_ + 2], S0[r_ + 3]); a_ = max3f(a_, S1[r_], S1[r_ + 1]); b_ = max3f(b_, S1[r_ + 2], S1[r_ + 3]); } \
        const float mx_ = half_max(max2f(a_, b_)); \
        if (__any(mx_ - MC > THR)) { const float mn_ = fmaxf(MC, mx_), al_ = __builtin_amdgcn_exp2f(MC - mn_); MC = mn_; LC *= al_; if (hi == 0) wsf[r32] = al_; \
            _Pragma("unroll") for (int g4 = 0; g4 < 4; ++g4) { const f32x4 a4 = *(const LAS f32x4*)(wsf + 8 * g4 + 4 * hi); \
                _Pragma("unroll") for (int d = 0; d < 4; ++d) { o[c][d][4 * g4 + 0] *= a4[0]; o[c][d][4 * g4 + 1] *= a4[1]; o[c][d][4 * g4 + 2] *= a4[2]; o[c][d][4 * g4 + 3] *= a4[3]; } } } } while (0)
#define ATT_LDQK(c, d0, QF, K0, K1) do { QF = *(const LAS bf16x8*)(Qs + (((c) * 4 + (d0)) * 2 + hi) * 512 + r32 * 16); \
        K0 = *(const LAS bf16x8*)(Kb + kb[(d0) & 1] + 512 * (2 * (c) + ((d0) >> 1))); K1 = *(const LAS bf16x8*)(Kb + kb[(d0) & 1] + 512 * (2 * (c) + ((d0) >> 1)) + 8192); } while (0)
#define ATT_LDV(i, LO, HH) do { LO = vtr(Vb + vb[0] + 4096 * ((i) >> 2) + 512 * ((i) & 3)); HH = vtr(Vb + vb[1] + 4096 * ((i) >> 2) + 512 * ((i) & 3)); } while (0)
#define ATT_VF(LO, HH) ((bf16x8){LO[0], LO[1], LO[2], LO[3], HH[0], HH[1], HH[2], HH[3]})
#define ATT_PA(PW, ks) ((bf16x8)__builtin_bit_cast(bf16x8, (u32x4){PW[4 * (ks)], PW[4 * (ks) + 1], PW[4 * (ks) + 2], PW[4 * (ks) + 3]}))
#pragma unroll 1
    for (int t = 0; t < nt; ++t) {
        const int buf = t & 1;
        if (t + 1 < nt) ATT_DMA(t + 1, buf ^ 1);
        const LAS unsigned char* Kb = lds + KBUF + buf * 16384; const LAS unsigned char* Vb = lds + VBUF + buf * 16384;
        unsigned pw0[16], pw1[16];
        f32x16 sa = f32x16{}, sb = f32x16{};
        SB();
        {   bf16x8 qfA, k0A, k1A, qfB, k0B, k1B;
            ATT_LDQK(0, 0, qfA, k0A, k1A); ATT_LDQK(0, 1, qfB, k0B, k1B); SB();
            sa = __builtin_amdgcn_mfma_f32_32x32x16_bf16(k0A, qfA, sa, 0, 0, 0); sb = __builtin_amdgcn_mfma_f32_32x32x16_bf16(k1A, qfA, sb, 0, 0, 0); SB();
            ATT_LDQK(0, 2, qfA, k0A, k1A); SB();
            sa = __builtin_amdgcn_mfma_f32_32x32x16_bf16(k0B, qfB, sa, 0, 0, 0); sb = __builtin_amdgcn_mfma_f32_32x32x16_bf16(k1B, qfB, sb, 0, 0, 0); SB();
            ATT_LDQK(0, 3, qfB, k0B, k1B); SB();
            sa = __builtin_amdgcn_mfma_f32_32x32x16_bf16(k0A, qfA, sa, 0, 0, 0); sb = __builtin_amdgcn_mfma_f32_32x32x16_bf16(k1A, qfA, sb, 0, 0, 0); SB();
            sa = __builtin_amdgcn_mfma_f32_32x32x16_bf16(k0B, qfB, sa, 0, 0, 0); sb = __builtin_amdgcn_mfma_f32_32x32x16_bf16(k1B, qfB, sb, 0, 0, 0); }
        SB();
        if constexpr (SAFE) ATT_SMA(sa, sb, 0, m0, l0);
        SB();
        f32x16 ta = f32x16{}, tb = f32x16{};
        {   bf16x8 qf, k0, k1; float sum = 0.f;
            ATT_LDQK(1, 0, qf, k0, k1); SB();
#define ATT_C(d0) do { ta = __builtin_amdgcn_mfma_f32_32x32x16_bf16(k0, qf, ta, 0, 0, 0); SB(); \
            if ((d0) < 3) k0 = *(const LAS bf16x8*)(Kb + kb[((d0) + 1) & 1] + 512 * (2 + (((d0) + 1) >> 1))); \
            ATT_SMB(sa, sb, 4 * (d0) + 0, m0, sum, pw0); ATT_SMB(sa, sb, 4 * (d0) + 1, m0, sum, pw0); SB(); \
            tb = __builtin_amdgcn_mfma_f32_32x32x16_bf16(k1, qf, tb, 0, 0, 0); SB(); \
            if ((d0) < 3) { qf = *(const LAS bf16x8*)(Qs + ((4 + (d0) + 1) * 2 + hi) * 512 + r32 * 16); k1 = *(const LAS bf16x8*)(Kb + kb[((d0) + 1) & 1] + 512 * (2 + (((d0) + 1) >> 1)) + 8192); } \
            ATT_SMB(sa, sb, 4 * (d0) + 2, m0, sum, pw0); ATT_SMB(sa, sb, 4 * (d0) + 3, m0, sum, pw0); SB(); } while (0)
            ATT_C(0); ATT_C(1); ATT_C(2); ATT_C(3);
#undef ATT_C
            l0 += sum; }
        if constexpr (SAFE) ATT_SMA(ta, tb, 1, m1, l1);
        SB();
        {   s16x4 loA, hhA, loB, hhB, loC, hhC; float sum = 0.f;
            ATT_LDV(0, loA, hhA); ATT_LDV(1, loB, hhB); SB();
#define ATT_E(i, LOc, HHc, LOn, HHn) do { if ((i) + 2 < 16) ATT_LDV((i) + 2, LOn, HHn); SB(); \
            o[0][(i) & 3] = __builtin_amdgcn_mfma_f32_32x32x16_bf16(ATT_PA(pw0, (i) >> 2), ATT_VF(LOc, HHc), o[0][(i) & 3], 0, 0, 0); SB(); ATT_SMB(ta, tb, i, m1, sum, pw1); SB(); } while (0)
            ATT_E(0, loA, hhA, loC, hhC); ATT_E(1, loB, hhB, loA, hhA); ATT_E(2, loC, hhC, loB, hhB);
            ATT_E(3, loA, hhA, loC, hhC); ATT_E(4, loB, hhB, loA, hhA); ATT_E(5, loC, hhC, loB, hhB);
            ATT_E(6, loA, hhA, loC, hhC); ATT_E(7, loB, hhB, loA, hhA); ATT_E(8, loC, hhC, loB, hhB);
            ATT_E(9, loA, hhA, loC, hhC); ATT_E(10, loB, hhB, loA, hhA); ATT_E(11, loC, hhC, loB, hhB);
            ATT_E(12, loA, hhA, loC, hhC); ATT_E(13, loB, hhB, loA, hhA); ATT_E(14, loC, hhC, loB, hhB);
            ATT_E(15, loA, hhA, loC, hhC);
#undef ATT_E
            l1 += sum; }
#pragma unroll
        for (int ks = 0; ks < 4; ++ks) {
            s16x4 lo[4], hh[4];
#pragma unroll
            for (int d = 0; d < 4; ++d) ATT_LDV(4 * ks + d, lo[d], hh[d]);
#pragma unroll
            for (int d = 0; d < 4; ++d) o[1][d] = __builtin_amdgcn_mfma_f32_32x32x16_bf16(ATT_PA(pw1, ks), ATT_VF(lo[d], hh[d]), o[1][d], 0, 0, 0);
            SB();
        }
        asm volatile("s_waitcnt vmcnt(0)" ::: "memory");
        __syncthreads();
    }
#undef ATT_SMB
#undef ATT_SMA
#undef ATT_LDQK
#undef ATT_LDV
#undef ATT_VF
#undef ATT_PA
#undef SB
#undef ATT_GROW
#undef ATT_DMA
    l0 = half_sum(l0); l1 = half_sum(l1);
    const bool ok = SAFE || !__any(!(l0 > 7.9e-31f && l0 < 1.26e30f && l1 > 7.9e-31f && l1 < 1.26e30f));
    if (hi == 0) { wsf[r32] = 1.0f / l0; wsf[32 + r32] = P.lam / l1; }
    float ss[16];
#pragma unroll
    for (int r = 0; r < 16; ++r) ss[r] = 0.f;
#pragma unroll
    for (int g4 = 0; g4 < 4; ++g4) { const f32x4 a4 = *(const LAS f32x4*)(wsf + 8 * g4 + 4 * hi), b4 = *(const LAS f32x4*)(wsf + 32 + 8 * g4 + 4 * hi);
#pragma unroll
        for (int d = 0; d < 4; ++d)
#pragma unroll
            for (int e = 0; e < 4; ++e) { const float v = o[0][d][4 * g4 + e] * a4[e] - o[1][d][4 * g4 + e] * b4[e]; o[0][d][4 * g4 + e] = v; ss[4 * g4 + e] += v * v; } }
#pragma unroll
    for (int r = 0; r < 16; ++r) {
        float v = ss[r];
#pragma unroll
        for (int s = 1; s < 32; s <<= 1) v += __shfl_xor(v, s);
        ss[r] = (1.0f / sqrtf(v * (1.0f / 128.0f) + SUBLN_EPS)) * P.post;
    }
    {   int l2; asm volatile("v_mbcnt_lo_u32_b32 %0, -1, 0\n\tv_mbcnt_hi_u32_b32 %0, -1, %0" : "=v"(l2));
        const int c2 = l2 & 31, h2 = l2 >> 5;
        LAS unsigned short* stg = (LAS unsigned short*)(lds + QOFF + wid * 8192) + h2 * 4 * 128 + c2;
#pragma unroll
        for (int d = 0; d < 4; ++d) { const float gs = P.gsub[32 * d + c2];
#pragma unroll
            for (int r = 0; r < 16; ++r) { const float v = o[0][d][r] * ss[r] * gs; stg[((r & 3) + 8 * (r >> 2)) * 128 + 32 * d] = (unsigned short)(cvt_pk_bf16(v, 0.f) & 0xffffu); }
            __builtin_amdgcn_sched_barrier(0); }
        const LAS unsigned char* rd = lds + QOFF + wid * 8192 + (l2 >> 4) * 256 + (l2 & 15) * 16;
        bf16_t* Ow = P.O + (size_t)(q0 + wid * 32 + (l2 >> 4)) * D + h * 128 + (l2 & 15) * 8;
#pragma unroll
        for (int i = 0; i < 8; ++i) { const u32x4 v = *(const LAS u32x4*)(rd + i * 1024); *(u32x4*)(Ow + (size_t)i * 4 * D) = v; } }
    __builtin_amdgcn_s_setprio(0);
    __syncthreads();
    return ok;
}
__device__ __forceinline__ void unit_checked(LAS unsigned char* lds, const Args& P, int b, int h, int q0, int nlat, int tid) {
    volatile LAS unsigned* flag = (volatile LAS unsigned*)(lds + MISC_OFF) + 16;
    const bool ok = unit<false>(lds, P, b, h, q0, nlat, tid);
    if (!ok && (tid & 63) == 0) *flag = 1u;
    __syncthreads();
    const unsigned f = *flag;
    __syncthreads();
    if (f) { if (tid == 0) *flag = 0u; (void)unit<true>(lds, P, b, h, q0, nlat, tid); }
}
}

struct ThinArgs {
    const void* xin_lat; const void* xin_ctx;
    int xin_bf16, xout_bf16;
    const bf16_t* y;
    void* xout_lat; void* xout_ctx;
    const float* g_post; const float* gate;
    bf16_t* uout;
    const float* g_pre; const float* sc; const float* sh;
    const bf16_t* yc; int nslab;
    int nrows; int gb_lo;
};
__device__ __forceinline__ void thin_phase(const ThinArgs& T, LAS unsigned char* lds, int bx, int G, int tid, int wave, int lane) {
    (void)G;
    LAS float* tab0 = (LAS float*)lds; LAS float* tab1 = tab0 + 3 * D;
    f32x4 xvb[2][8]; u32x2 xrb[2][8]; u32x2 yrb[2][8];
#define THIN_LOAD(ctx, row_, XV, XR, YR) do { const size_t xo_ = (ctx) ? (size_t)((row_) - ML) * D : (size_t)(row_) * D; \
        if (T.xin_bf16) { const bf16_t* xr_ = (const bf16_t*)((ctx) ? T.xin_ctx : T.xin_lat) + xo_; _Pragma("unroll") for (int j = 0; j < 8; ++j) XR[j] = *(const u32x2*)(xr_ + 256 * j + 4 * lane); } \
        else { const float* xr_ = (const float*)((ctx) ? T.xin_ctx : T.xin_lat) + xo_; _Pragma("unroll") for (int j = 0; j < 8; ++j) XV[j] = *(const f32x4*)(xr_ + 256 * j + 4 * lane); } \
        if (T.y && !((ctx) && T.nslab > 0)) { const bf16_t* yr_ = T.y + (size_t)(row_) * D; _Pragma("unroll") for (int j = 0; j < 8; ++j) YR[j] = __builtin_nontemporal_load((const u32x2*)(yr_ + 256 * j + 4 * lane)); } } while (0)
#define THIN_TABLES(gb, TB) do { const int c4 = 4 * tid; LAS float* ta = (TB); LAS float* tg = ta + D; LAS float* ts = tg + D;     \
        if (T.y) { const f32x4 g = *(const f32x4*)(T.g_post + c4), a = *(const f32x4*)(T.gate + (size_t)(gb) * MODROW + c4); *(LAS f32x4*)(ta + c4) = a * g; } \
        if (T.uout) { const f32x4 g = *(const f32x4*)(T.g_pre + c4), s = *(const f32x4*)(T.sc + (size_t)(gb) * MODROW + c4), h = *(const f32x4*)(T.sh + (size_t)(gb) * MODROW + c4); \
            *(LAS f32x4*)(tg + c4) = g * (s + 1.0f); *(LAS f32x4*)(ts + c4) = h; } } while (0)
#define THIN_ROW(ctx, row, xv, xraw, yraw, TB) do { const LAS float* ta = (TB); const LAS float* tg = ta + D; const LAS float* ts = tg + D; \
        if (T.xin_bf16) { _Pragma("unroll") for (int j = 0; j < 8; ++j) { const u32x2 v = xraw[j]; xv[j][0] = __uint_as_float(v.x << 16); xv[j][1] = __uint_as_float(v.x & 0xffff0000u); xv[j][2] = __uint_as_float(v.y << 16); xv[j][3] = __uint_as_float(v.y & 0xffff0000u); } } \
        if (T.y) { f32x4 yv[8]; float s = 0.f; \
            if ((ctx) && T.nslab > 0) { const bf16_t* yr = T.yc + (size_t)((row) - ML) * D; \
                _Pragma("unroll") for (int j = 0; j < 8; ++j) { const u32x2 v = __builtin_nontemporal_load((const u32x2*)(yr + 256 * j + 4 * lane)); \
                    yv[j][0] = __uint_as_float(v.x << 16); yv[j][1] = __uint_as_float(v.x & 0xffff0000u); yv[j][2] = __uint_as_float(v.y << 16); yv[j][3] = __uint_as_float(v.y & 0xffff0000u); } \
                _Pragma("unroll 1") for (int sl = 1; sl < T.nslab; ++sl) { yr += (size_t)MC * D; \
                    _Pragma("unroll") for (int j = 0; j < 8; ++j) { const u32x2 v = __builtin_nontemporal_load((const u32x2*)(yr + 256 * j + 4 * lane)); \
                        yv[j][0] += __uint_as_float(v.x << 16); yv[j][1] += __uint_as_float(v.x & 0xffff0000u); yv[j][2] += __uint_as_float(v.y << 16); yv[j][3] += __uint_as_float(v.y & 0xffff0000u); } } \
            } else { _Pragma("unroll") for (int j = 0; j < 8; ++j) { const u32x2 v = yraw[j]; \
                    yv[j][0] = __uint_as_float(v.x << 16); yv[j][1] = __uint_as_float(v.x & 0xffff0000u); yv[j][2] = __uint_as_float(v.y << 16); yv[j][3] = __uint_as_float(v.y & 0xffff0000u); } } \
            _Pragma("unroll") for (int j = 0; j < 8; ++j) s += (yv[j][0] * yv[j][0] + yv[j][1] * yv[j][1]) + (yv[j][2] * yv[j][2] + yv[j][3] * yv[j][3]); \
            const float rs = 1.0f / sqrtf(wave_sum(s) * (1.0f / D) + NORM_EPS); \
            _Pragma("unroll") for (int j = 0; j < 8; ++j) { const f32x4 a = *(const LAS f32x4*)(ta + 256 * j + 4 * lane); xv[j] = xv[j] + a * (yv[j] * rs); } \
            void* xob = (ctx) ? T.xout_ctx : T.xout_lat; const size_t xoo = (ctx) ? (size_t)((row) - ML) * D : (size_t)(row) * D; \
            if (xob) { \
                if (T.xout_bf16) { bf16_t* xo = (bf16_t*)xob + xoo;        \
                    _Pragma("unroll") for (int j = 0; j < 8; ++j) { u32x2 w; w.x = cvt_pk_bf16(xv[j][0], xv[j][1]); w.y = cvt_pk_bf16(xv[j][2], xv[j][3]); __builtin_nontemporal_store(w, (u32x2*)(xo + 256 * j + 4 * lane)); \
                        xv[j][0] = __uint_as_float(w.x << 16); xv[j][1] = __uint_as_float(w.x & 0xffff0000u); xv[j][2] = __uint_as_float(w.y << 16); xv[j][3] = __uint_as_float(w.y & 0xffff0000u); } \
                } else { float* xo = (float*)xob + xoo; _Pragma("unroll") for (int j = 0; j < 8; ++j) *(f32x4*)(xo + 256 * j + 4 * lane) = xv[j]; } } } \
        if (T.uout) { float s = 0.f; \
            _Pragma("unroll") for (int j = 0; j < 8; ++j) s += (xv[j][0] * xv[j][0] + xv[j][1] * xv[j][1]) + (xv[j][2] * xv[j][2] + xv[j][3] * xv[j][3]); \
            const float rs = 1.0f / sqrtf(wave_sum(s) * (1.0f / D) + NORM_EPS); \
            bf16_t* uo = T.uout + (size_t)(row) * D; \
            _Pragma("unroll") for (int j = 0; j < 8; ++j) { const f32x4 g = *(const LAS f32x4*)(tg + 256 * j + 4 * lane), c = *(const LAS f32x4*)(ts + 256 * j + 4 * lane); \
                const f32x4 u = (xv[j] * rs) * g + c; \
                u32x2 w; w.x = cvt_pk_bf16(u[0], u[1]); w.y = cvt_pk_bf16(u[2], u[3]); *(u32x2*)(uo + 256 * j + 4 * lane) = w; } } } while (0)
    const bool has_ctx = T.nrows > ML, my_ctx = has_ctx && wave < 4;
    const int gb = bx >> 6, rbase = gb * SEQ + (bx & 63) * 32 + wave * 4, crow = ML + bx * 4 + (wave & 3);
    if (T.gb_lo == 0) THIN_LOAD(false, rbase, xvb[0], xrb[0], yrb[0]); else if (my_ctx) THIN_LOAD(true, crow, xvb[0], xrb[0], yrb[0]);
    if (T.gb_lo == 0) THIN_TABLES(gb, tab0);
    if (has_ctx) THIN_TABLES(4, tab1);
    __syncthreads();
    if (T.gb_lo == 0) {
#pragma unroll
        for (int i = 0; i < 4; ++i) {
            if (i + 1 < 4) THIN_LOAD(false, rbase + i + 1, xvb[(i + 1) & 1], xrb[(i + 1) & 1], yrb[(i + 1) & 1]);
            else if (my_ctx) THIN_LOAD(true, crow, xvb[0], xrb[0], yrb[0]);
            THIN_ROW(false, rbase + i, xvb[i & 1], xrb[i & 1], yrb[i & 1], tab0);
        }
    }
    if (my_ctx) THIN_ROW(true, crow, xvb[0], xrb[0], yrb[0], tab1);
    __syncthreads();
#undef THIN_LOAD
#undef THIN_TABLES
#undef THIN_ROW
}
template <int W>
__device__ __forceinline__ void pool_sub(const bf16_t* Useq, bf16_t* Dseq, int t0, int Ls) {
    constexpr int H = W / 2, NR = 8 + W - 1;
    u32x2 rows[NR];
#pragma unroll
    for (int k = 0; k < NR; ++k) { const int tt = t0 - H + k; const bool ok = tt >= 0 && tt < Ls; const int tc = tt < 0 ? 0 : (tt >= Ls ? Ls - 1 : tt);
        const u32x2 v = *(const u32x2*)(Useq + (size_t)tc * D); rows[k].x = ok ? v.x : 0u; rows[k].y = ok ? v.y : 0u; }
#pragma unroll
    for (int i = 0; i < 8; ++i) { const int t = t0 + i; int lo = t - H, hi = lo + W; lo = lo < 0 ? 0 : lo; hi = hi > Ls ? Ls : hi;
        f32x4 s = {0.f, 0.f, 0.f, 0.f};
#pragma unroll
        for (int k = 0; k < W; ++k) { const u32x2 v = rows[i + k];
            s[0] += __uint_as_float(v.x << 16); s[1] += __uint_as_float(v.x & 0xffff0000u); s[2] += __uint_as_float(v.y << 16); s[3] += __uint_as_float(v.y & 0xffff0000u); }
        const u32x2 cv = rows[i + H]; const float inv = 1.0f / (float)(hi - lo);
        f32x4 d; d[0] = s[0] * inv - __uint_as_float(cv.x << 16); d[1] = s[1] * inv - __uint_as_float(cv.x & 0xffff0000u); d[2] = s[2] * inv - __uint_as_float(cv.y << 16); d[3] = s[3] * inv - __uint_as_float(cv.y & 0xffff0000u);
        u32x2 o; o.x = cvt_pk_bf16(d[0], d[1]); o.y = cvt_pk_bf16(d[2], d[3]);
        *(u32x2*)(Dseq + (size_t)t * D) = o; }
}
__device__ __forceinline__ void pool_phase(const bf16_t* U, bf16_t* Dm, int nrows, int bx, int wave, int lane) {
    const int coff = 256 * wave + 4 * lane;
    {   const int b = bx >> 6, t00 = (bx & 63) * 32; const bf16_t* Us = U + (size_t)b * SEQ * D + coff; bf16_t* Ds = Dm + (size_t)b * SEQ * D + coff;
#pragma unroll 1
        for (int sb = 0; sb < 4; ++sb) { const int t0 = t00 + 8 * sb;
            switch (wave >> 1) { case 0: pool_sub<2>(Us, Ds, t0, SEQ); break; case 1: pool_sub<4>(Us, Ds, t0, SEQ); break; case 2: pool_sub<8>(Us, Ds, t0, SEQ); break; default: pool_sub<16>(Us, Ds, t0, SEQ); break; } } }
    if (nrows > ML) {
        if (wave < 4) { const int sbi = bx >> 1, j = 4 * (bx & 1) + wave, r0 = sbi * 8, cb = r0 >> 8, t0 = r0 & 255; const int co = 256 * j + 4 * lane;
            const bf16_t* Us = U + (size_t)(ML + cb * CL) * D + co; bf16_t* Ds = Dm + (size_t)(ML + cb * CL) * D + co;
            switch (j >> 1) { case 0: pool_sub<2>(Us, Ds, t0, CL); break; case 1: pool_sub<4>(Us, Ds, t0, CL); break; case 2: pool_sub<8>(Us, Ds, t0, CL); break; default: pool_sub<16>(Us, Ds, t0, CL); break; } } }
}

struct TrDesc { const float* src; bf16_t* dst; int N, K; int perm; };
__device__ __forceinline__ void tr_load(const TrDesc& d, f32x4 (&v)[16], int lane) {
    const int kq = lane >> 4, n4 = lane & 15;
#pragma unroll
    for (int i = 0; i < 16; ++i) v[i] = __builtin_nontemporal_load((const f32x4*)(d.src + (size_t)(4 * i + kq) * d.N + 4 * n4));
}
__device__ __forceinline__ void tr_store(const TrDesc& d, const f32x4 (&v)[16], LAS float* scr, int lane) {
    const int kq = lane >> 4, n4 = lane & 15;
#pragma unroll
    for (int i = 0; i < 16; ++i) { LAS float* s = scr + (4 * i + kq) * 65 + 4 * n4; s[0] = v[i][0]; s[1] = v[i][1]; s[2] = v[i][2]; s[3] = v[i][3]; }
    asm volatile("s_waitcnt lgkmcnt(0)" ::: "memory");
    const int c = lane & 7;
#pragma unroll
    for (int j = 0; j < 8; ++j) { const int n = (lane >> 3) + 8 * j; int sc = n;
        if (d.perm) { const int jj = n >> 1, which = n & 1, ax = jj >> 4, f = jj & 15; sc = ax * 32 + which * 16 + f; }
        const LAS float* s = scr + (8 * c) * 65 + sc;
        u32x4 o; o.x = cvt_pk_bf16(s[0 * 65], s[1 * 65]); o.y = cvt_pk_bf16(s[2 * 65], s[3 * 65]); o.z = cvt_pk_bf16(s[4 * 65], s[5 * 65]); o.w = cvt_pk_bf16(s[6 * 65], s[7 * 65]);
        *(u32x4*)(d.dst + (size_t)n * d.K + 8 * c) = o; }
    asm volatile("s_waitcnt lgkmcnt(0)" ::: "memory");
}

struct Params {
    const float* in[22];
    float* out; unsigned char* ws;
    float lam_init0, lam_init3;
    int ph_lo, ph_hi;
};

template <int PART>
__device__ __forceinline__ void prologue(const Params& P, LAS unsigned char* lds, int tid, int wave, int lane, int vcu, int G) {
    unsigned char* ws = P.ws;
    const float* c_in = P.in[1]; const float* cctx = P.in[3]; const float* w_mod = P.in[4]; const float* b_mod = P.in[5];
    LAS float* sil = (LAS float*)lds;
    LAS float* red = (LAS float*)(lds + 65536);
    for (int i = tid; i < 5 * D; i += NTHR) { const int r = i / D, k = i % D; const float x = r < 4 ? c_in[r * D + k] : cctx[k]; sil[k * 8 + r] = x / (1.0f + __expf(-x)); }
    __syncthreads();
    float* mod = (float*)(ws + WS_MOD);
    for (int item = (PART == 1 ? 192 : 0) + blockIdx.x; item < (PART == 0 ? 192 : 4 * 192); item += G) {
        const int l = item / 192, col = (item % 192) * 64 + lane;
        const float* W = w_mod + (size_t)l * D * MODROW + col;
        float a0 = 0.f, a1 = 0.f, a2 = 0.f, a3 = 0.f, a4 = 0.f;
        const int k0 = wave * 256;
        for (int kk = 0; kk < 256; kk += 32) {
            float w[32];
#pragma unroll
            for (int j = 0; j < 32; ++j) w[j] = __builtin_nontemporal_load(W + (size_t)(k0 + kk + j) * MODROW);
#pragma unroll
            for (int j = 0; j < 32; ++j) { const f32x4 s4 = *(const LAS f32x4*)(sil + (k0 + kk + j) * 8); const float s5 = sil[(k0 + kk + j) * 8 + 4];
                a0 += s4[0] * w[j]; a1 += s4[1] * w[j]; a2 += s4[2] * w[j]; a3 += s4[3] * w[j]; a4 += s5 * w[j]; }
        }
        red[(wave * 5 + 0) * 64 + lane] = a0; red[(wave * 5 + 1) * 64 + lane] = a1; red[(wave * 5 + 2) * 64 + lane] = a2; red[(wave * 5 + 3) * 64 + lane] = a3; red[(wave * 5 + 4) * 64 + lane] = a4;
        __syncthreads();
        if (wave < 5) { float s = b_mod[l * MODROW + col];
#pragma unroll
            for (int w8 = 0; w8 < 8; ++w8) s += red[(w8 * 5 + wave) * 64 + lane];
            mod[((size_t)l * 5 + wave) * MODROW + col] = s; }
        if (l == 0) asm volatile("s_waitcnt vmcnt(0)" ::: "memory");
        __syncthreads();
        if (l == 0 && tid == 0) { __builtin_amdgcn_fence(__ATOMIC_RELEASE, "agent"); asm volatile("s_waitcnt vmcnt(0)" ::: "memory"); xb_add((unsigned*)(ws + WS_CTL) + CW_MOD0, 1u); }
    }
    LAS float* scr = (LAS float*)(lds + wave * 16640);
    const int gw = vcu * NWAVES + wave, NGW = G * NWAVES;
    bf16_t* Wqkv = (bf16_t*)(ws + WS_WQKV); bf16_t* Wo = (bf16_t*)(ws + WS_WO); bf16_t* Wf = (bf16_t*)(ws + WS_WF); bf16_t* Wp = (bf16_t*)(ws + WS_WPOOL);
    bf16_t* W1 = (bf16_t*)(ws + WS_W1); bf16_t* W2 = (bf16_t*)(ws + WS_W2);
    constexpr int I_QKV = (D / 64) * (3 * D / 64), I_O = (D / 64) * (D / 64), I_P = 8 * 8, I_1 = (D / 64) * (FF / 64), I_2 = (FF / 64) * (D / 64);
    constexpr int NITEMS = 2 * I_QKV + 2 * I_O + I_O + 4 * I_P + 4 * I_1 + 4 * I_2;
    auto decode = [&](int it) -> TrDesc {
        int r = it; const float* W; bf16_t* WT; int K, N, perm = 0;
        if (r < 2 * I_QKV) { const int ia = r / I_QKV; r %= I_QKV; W = P.in[10] + (size_t)ia * D * 3 * D; WT = Wqkv + (size_t)ia * 3 * D * D; K = D; N = 3 * D; perm = (r % (3 * D / 64)) < 2 * D / 64; }
        else if ((r -= 2 * I_QKV) < 2 * I_O) { const int ia = r / I_O; r %= I_O; W = P.in[11] + (size_t)ia * D * D; WT = Wo + (size_t)ia * D * D; K = D; N = D; }
        else if ((r -= 2 * I_O) < I_O) { W = P.in[17]; WT = Wf; K = D; N = D; }
        else if ((r -= I_O) < 4 * I_P) { const int g = r / I_P; r %= I_P; W = P.in[18] + (size_t)g * 512 * 512; WT = Wp + (size_t)g * 512 * 512; K = 512; N = 512; }
        else if ((r -= 4 * I_P) < 4 * I_1) { const int l = r / I_1; r %= I_1; W = P.in[20] + (size_t)l * D * FF; WT = W1 + (size_t)l * FF * D; K = D; N = FF; }
        else { r -= 4 * I_1; const int l = r / I_2; r %= I_2; W = P.in[21] + (size_t)l * FF * D; WT = W2 + (size_t)l * D * FF; K = FF; N = D; }
        const int nblk = N / 64, k0 = 64 * (r / nblk), n0 = 64 * (r % nblk);
        TrDesc d; d.src = W + (size_t)k0 * N + n0; d.dst = WT + (size_t)n0 * K + k0; d.N = N; d.K = K; d.perm = perm; return d; };
    {   const int it_end = (PART == 0 ? I_QKV : NITEMS); int it = (PART == 1 ? I_QKV : 0) + gw;
        f32x4 va[16], vb[16]; TrDesc da, db;
        if (it < it_end) { da = decode(it); tr_load(da, va, lane); }
        while (it < it_end) {
            const bool hb = it + NGW < it_end; if (hb) { db = decode(it + NGW); tr_load(db, vb, lane); }
            tr_store(da, va, scr, lane);
            if (!hb) break;
            const bool ha = it + 2 * NGW < it_end; if (ha) { da = decode(it + 2 * NGW); tr_load(da, va, lane); }
            tr_store(db, vb, scr, lane);
            if (!ha) break;
            it += 2 * NGW;
        } }
    if constexpr (PART != 1) {
        const int gt = gw * 64 + lane, NGT = NGW * 64; float* rope = (float*)(ws + WS_ROPE);
        for (int i = gt; i < 64 * 16; i += NGT) { const int pos = i >> 4, f = i & 15; const float inv = 1.0f / powf(10000.0f, (float)f * (1.0f / 16.0f)); const float ang = (float)pos * inv;
            rope[2 * i] = cosf(ang); rope[2 * i + 1] = sinf(ang); }
    }
    if constexpr (PART != 0) {   bf16_t* T1 = (bf16_t*)(ws + WS_T1); bf16_t* A2 = (bf16_t*)(ws + WS_A2); bf16_t* A2C = (bf16_t*)(ws + WS_A2C);
        constexpr int C_T1 = 1024 * 512 / 8, C_A2 = 2048 * 4096 / 8, C_A2C = 256 * 512 / 8;
        const int gt = gw * 64 + lane, NGT = NGW * 64;
        for (int ch = gt; ch < C_T1 + C_A2 + C_A2C; ch += NGT) {
            int r = ch; bf16_t* dst; int row, col0, N, ncol; float scale; bool negsin;
            if (r < C_T1) { row = r / 64; col0 = (r % 64) * 8; dst = T1 + (size_t)row * 512 + col0; N = 512; scale = 0.04419417382415922f; negsin = false;
                const int cs = row >> 9, k2 = row & 511; float vals[8];
#pragma unroll
                for (int e = 0; e < 8; ++e) { const int idx = (k2 * (col0 + e)) & 511; const float a = (float)idx * (1.0f / 256.0f); vals[e] = (cs ? sinpif(a) : cospif(a)) * scale; }
                u32x4 o; o.x = cvt_pk_bf16(vals[0], vals[1]); o.y = cvt_pk_bf16(vals[2], vals[3]); o.z = cvt_pk_bf16(vals[4], vals[5]); o.w = cvt_pk_bf16(vals[6], vals[7]); *(u32x4*)dst = o; continue; }
            r -= C_T1;
            if (r < C_A2) { row = r / 512; col0 = (r % 512) * 8; dst = A2 + (size_t)row * 4096 + col0; N = 2048; scale = 0.022097086912079608f; }
            else { r -= C_A2; row = r / 64; col0 = (r % 64) * 8; dst = A2C + (size_t)row * 512 + col0; N = 256; scale = 0.0625f; }
            (void)ncol; (void)negsin;
            { const int cs = col0 / N, n0 = col0 % N; float vals[8];
#pragma unroll
              for (int e = 0; e < 8; ++e) { const int idx = (row * (n0 + e)) & (N - 1); const float a = (float)idx * (2.0f / (float)N); vals[e] = (cs ? -sinpif(a) : cospif(a)) * scale; }
              u32x4 o; o.x = cvt_pk_bf16(vals[0], vals[1]); o.y = cvt_pk_bf16(vals[2], vals[3]); o.z = cvt_pk_bf16(vals[4], vals[5]); o.w = cvt_pk_bf16(vals[6], vals[7]); *(u32x4*)dst = o; }
        }
    }
}

__device__ __forceinline__ void fourier_y256(const bf16_t* U, const bf16_t* T1, float* Y256, int bx, int wave, int lane) {
    const float sc = bf2f(T1[256 * 512]);
#pragma unroll 1
    for (int rr = 0; rr < 4; ++rr) {
        const int tok = bx * 32 + wave * 4 + rr;
        const bf16_t* up = U + (size_t)tok * D + lane * 32;
        float a = 0.f;
#pragma unroll
        for (int i = 0; i < 4; ++i) { const u32x4 w = *(const u32x4*)(up + 8 * i);
            a += (__uint_as_float(w.x << 16) - __uint_as_float(w.x & 0xffff0000u)) + (__uint_as_float(w.y << 16) - __uint_as_float(w.y & 0xffff0000u))
               + (__uint_as_float(w.z << 16) - __uint_as_float(w.z & 0xffff0000u)) + (__uint_as_float(w.w << 16) - __uint_as_float(w.w & 0xffff0000u)); }
        a += __shfl_xor(a, 1); a += __shfl_xor(a, 2); a += __shfl_xor(a, 4); a += __shfl_xor(a, 8);
        if ((lane & 15) == 0) Y256[(size_t)((tok >> 11) * 4 + (lane >> 4)) * 2048 + (tok & 2047)] = a * sc;
    }
}
__device__ __forceinline__ void fourier_edge1024(const bf16_t* YT, const bf16_t* A2, float* PE, int bx, int wave, int lane) {
#pragma unroll 1
    for (int rr = 0; rr < 2; ++rr) {
        const int idx = bx * 16 + wave * 2 + rr, r = idx >> 2, b = idx & 3;
        const bf16_t* yp = YT + (size_t)r * 16384 + b * 4096; const bf16_t* ap = A2 + (size_t)1024 * 4096;
        float a = 0.f;
#pragma unroll
        for (int i = 0; i < 4; ++i) { const int n1 = (i * 64 + lane) * 8; const u32x4 y = *(const u32x4*)(yp + n1), c = *(const u32x4*)(ap + n1);
            a += __uint_as_float(y.x << 16) * __uint_as_float(c.x << 16) + __uint_as_float(y.x & 0xffff0000u) * __uint_as_float(c.x & 0xffff0000u)
               + __uint_as_float(y.y << 16) * __uint_as_float(c.y << 16) + __uint_as_float(y.y & 0xffff0000u) * __uint_as_float(c.y & 0xffff0000u)
               + __uint_as_float(y.z << 16) * __uint_as_float(c.z << 16) + __uint_as_float(y.z & 0xffff0000u) * __uint_as_float(c.z & 0xffff0000u)
               + __uint_as_float(y.w << 16) * __uint_as_float(c.w << 16) + __uint_as_float(y.w & 0xffff0000u) * __uint_as_float(c.w & 0xffff0000u); }
        a = wave_sum(a);
        if (lane == 0) PE[b * 1024 + r] = a;
    }
}
struct FcBlk { f32x4 lo, hi; };
__device__ __forceinline__ FcBlk fc_unpack(const u32x4 w) { FcBlk r; r.lo = f32x4{__uint_as_float(w.x << 16), __uint_as_float(w.x & 0xffff0000u), __uint_as_float(w.y << 16), __uint_as_float(w.y & 0xffff0000u)};
    r.hi = f32x4{__uint_as_float(w.z << 16), __uint_as_float(w.z & 0xffff0000u), __uint_as_float(w.w << 16), __uint_as_float(w.w & 0xffff0000u)}; return r; }
__device__ __forceinline__ void fc_store_fwd(bf16_t* dst, const FcBlk& v) { u32x4 f; f.x = cvt_pk_vis(v.lo[0], v.lo[1]); f.y = cvt_pk_vis(v.lo[2], v.lo[3]); f.z = cvt_pk_vis(v.hi[0], v.hi[1]); f.w = cvt_pk_vis(v.hi[2], v.hi[3]); *(u32x4*)dst = f; }
__device__ __forceinline__ void fc_store_rev(bf16_t* dst, float e0, const FcBlk& v) { u32x4 f; f.x = cvt_pk_vis(e0, v.hi[3]); f.y = cvt_pk_vis(v.hi[2], v.hi[1]); f.z = cvt_pk_vis(v.hi[0], v.lo[3]); f.w = cvt_pk_vis(v.lo[2], v.lo[1]); *(u32x4*)dst = f; }
__device__ __forceinline__ float fc_nyquist(const bf16_t* A2, LAS float* ys, int k1, int lane) {
    float s0 = 0.f, s1 = 0.f, s2 = 0.f, s3 = 0.f;
#pragma unroll
    for (int i = 0; i < 4; ++i) { const int n1 = (i * 64 + lane) * 8; const FcBlk a = fc_unpack(*(const u32x4*)(A2 + (size_t)k1 * 4096 + n1));
#define FC_DOT(S, G_) { const f32x4 y0 = *(LAS f32x4*)(ys + (G_) * 2048 + n1), y1 = *(LAS f32x4*)(ys + (G_) * 2048 + n1 + 4); \
                        S += a.lo[0] * y0[0] + a.lo[1] * y0[1] + a.lo[2] * y0[2] + a.lo[3] * y0[3] + a.hi[0] * y1[0] + a.hi[1] * y1[1] + a.hi[2] * y1[2] + a.hi[3] * y1[3]; }
        FC_DOT(s0, 0) FC_DOT(s1, 1) FC_DOT(s2, 2) FC_DOT(s3, 3)
#undef FC_DOT
    }
    s0 = wave_sum(s0); s1 = wave_sum(s1); s2 = wave_sum(s2); s3 = wave_sum(s3);
    const int g = lane >> 4;
    return g == 0 ? s0 : (g == 1 ? s1 : (g == 2 ? s2 : s3));
}
__device__ __forceinline__ void fourier_combine(const bf16_t* PQ, const float* PE, const bf16_t* A2, const float* Y256, bf16_t* O, LAS unsigned char* lds, int bx, int tid, int wave, int lane) {
    const int b = bx >> 6, kp0 = (bx & 63) * 16;
    LAS float* ys = (LAS float*)lds;
    for (int i = tid; i < 4 * 2048 / 4; i += NTHR) ((LAS f32x4*)ys)[i] = ((const f32x4*)(Y256 + (size_t)b * 4 * 2048))[i];
    __syncthreads();
    const int g = lane >> 4, j = lane & 15;
    constexpr size_t PART = (size_t)4 * 1024 * 1024;
#pragma unroll 1
    for (int rr = 0; rr < 2; ++rr) {
        const int k1 = kp0 + wave * 2 + rr;
        float sg = fc_nyquist(A2, ys, k1, lane), sg2 = 0.f;
        if (k1 == 0) sg2 = fc_nyquist(A2, ys, 1024, lane);
        asm volatile("" : "+v"(sg), "+v"(sg2)); __builtin_amdgcn_sched_barrier(0);
        const bf16_t* pa = PQ + ((size_t)b * 1024 + k1) * 1024 + g * 256;
        FcBlk P0, P1, Q0, Q1; float pn1, qn1, pn2, qn2;
        const int jn = j == 15 ? 0 : 8 * (j + 17);
        { const FcBlk x0 = fc_unpack(*(const u32x4*)(pa + 8 * j)), x1 = fc_unpack(*(const u32x4*)(pa + PART + 8 * j)); P0.lo = x0.lo + x1.lo; P0.hi = x0.hi + x1.hi; }
        { const FcBlk x0 = fc_unpack(*(const u32x4*)(pa + 8 * (j + 16))), x1 = fc_unpack(*(const u32x4*)(pa + PART + 8 * (j + 16))); P1.lo = x0.lo + x1.lo; P1.hi = x0.hi + x1.hi; }
        { const FcBlk x0 = fc_unpack(*(const u32x4*)(pa + 2 * PART + 8 * j)), x1 = fc_unpack(*(const u32x4*)(pa + 3 * PART + 8 * j)); Q0.lo = x0.lo + x1.lo; Q0.hi = x0.hi + x1.hi; }
        { const FcBlk x0 = fc_unpack(*(const u32x4*)(pa + 2 * PART + 8 * (j + 16))), x1 = fc_unpack(*(const u32x4*)(pa + 3 * PART + 8 * (j + 16))); Q1.lo = x0.lo + x1.lo; Q1.hi = x0.hi + x1.hi; }
        pn1 = bf2f(pa[8 * (j + 1)]) + bf2f(pa[PART + 8 * (j + 1)]); qn1 = bf2f(pa[2 * PART + 8 * (j + 1)]) + bf2f(pa[3 * PART + 8 * (j + 1)]);
        pn2 = bf2f(pa[jn]) + bf2f(pa[PART + jn]);                   qn2 = bf2f(pa[2 * PART + jn]) + bf2f(pa[3 * PART + jn]);
        FcBlk S0, S1, D0, D1; S0.lo = P0.lo + Q0.lo; S0.hi = P0.hi + Q0.hi; S1.lo = P1.lo + Q1.lo; S1.hi = P1.hi + Q1.hi; D0.lo = P0.lo - Q0.lo; D0.hi = P0.hi - Q0.hi; D1.lo = P1.lo - Q1.lo; D1.hi = P1.hi - Q1.hi;
        { bf16_t* orow = O + ((size_t)b * 2048 + k1) * D + g * 512;
          fc_store_fwd(orow + 8 * j, S0); fc_store_fwd(orow + 8 * (j + 16), S1);
          fc_store_rev(orow + 8 * (63 - j), pn1 - qn1, D0); fc_store_rev(orow + 8 * (47 - j), j == 15 ? sg : pn2 - qn2, D1); }
        if (k1 != 0) {
          bf16_t* orow = O + ((size_t)b * 2048 + (2048 - k1)) * D + g * 512;
          fc_store_fwd(orow + 8 * j, D0); fc_store_fwd(orow + 8 * (j + 16), D1);
          fc_store_rev(orow + 8 * (63 - j), pn1 + qn1, S0); fc_store_rev(orow + 8 * (47 - j), j == 15 ? sg : pn2 + qn2, S1);
        } else {
          const float* pe = PE + b * 1024 + g * 256;
          FcBlk E0, E1; E0.lo = *(const f32x4*)(pe + 8 * j); E0.hi = *(const f32x4*)(pe + 8 * j + 4); E1.lo = *(const f32x4*)(pe + 8 * (j + 16)); E1.hi = *(const f32x4*)(pe + 8 * (j + 16) + 4);
          bf16_t* orow = O + ((size_t)b * 2048 + 1024) * D + g * 512;
          fc_store_fwd(orow + 8 * j, E0); fc_store_fwd(orow + 8 * (j + 16), E1);
          fc_store_rev(orow + 8 * (63 - j), pe[8 * (j + 1)], E0); fc_store_rev(orow + 8 * (47 - j), j == 15 ? sg2 : pe[jn], E1);
        }
    }
}

struct Ctx { LAS unsigned char* lds; int tid, lane, wave, G, bx, vcu, gw, NGW; };
#if MK_MULTI
#define GRID_BAR() do { } while (0)
#else
#define GRID_BAR() xcd_barrier(bar)
#endif
#define PH_BEGIN(k) if ((k) >= P.ph_lo && (k) < P.ph_hi) {
#define PH_END(k)   if ((k) + 1 < P.ph_hi) GRID_BAR(); }
#define WSP(T, off) ((T*)(P.ws + (off)))

#ifndef FUSE_T
#define FUSE_T 0
#endif
template <int L> struct LayerCfg {
    static constexpr int kind = L % 3; static constexpr bool lastl = (L == 3);
    static constexpr int NMIX = (kind == 2) ? 1 : (kind == 1 ? 3 : 2);
    static constexpr bool fuse_mid = FUSE_T && kind != 2, fuse_post = FUSE_T;
    static constexpr bool has_tmid = !(fuse_mid && lastl), has_tpost = !(fuse_post && lastl);
    static constexpr int o_mix = NMIX, o_tmid = o_mix + 1, o_w1 = o_tmid + (has_tmid ? 1 : 0), o_w2 = o_w1 + 1, o_tpost = o_w2 + 1, nph = o_tpost + (has_tpost ? 1 : 0);
};
#define GEMM_CALL(S, E) do { int tid_ = C.tid; asm volatile("" : "+v"(tid_)); pg8::gemm_phase(lds, S, E, tid_); } while (0)

template <int L, int PH0>
__device__ __forceinline__ void layer(const Params& P, const Ctx& C, const XcdBarrier& bar) {
    using CF = LayerCfg<L>;
    constexpr int kind = CF::kind; constexpr bool lastl = CF::lastl;
    constexpr int Mact = lastl ? ML : MT;
    LAS unsigned char* lds = C.lds;
    const float* modl = WSP(const float, WS_MOD) + (size_t)L * 5 * MODROW; float* X = WSP(float, WS_X); bf16_t* XB = WSP(bf16_t, WS_X);
    if constexpr (kind == 0) {
        constexpr int ia = L / 3;
        PH_BEGIN(PH0)
        { pg8::Sched S{}; S.A = (const char*)WSP(bf16_t, WS_U); S.B = (const char*)(WSP(bf16_t, WS_WQKV) + (size_t)ia * 3 * D * D); S.lda = D * 2; S.ldb = D * 2; S.nt = D / 64;
          S.nM = (lastl ? ML : MT) / 256; S.nN = 3 * D / 256; S.ngroups = 1; S.a_g = 0; S.b_g = 0; S.G = C.G; S.c = C.bx;
          pg8::EpiQKV E{WSP(bf16_t, WS_Q), WSP(const float, WS_ROPE), 0, 0};
          GEMM_CALL(S, E);
          if constexpr (lastl) {
              pg8::Sched S2 = S; S2.A = (const char*)(WSP(bf16_t, WS_U) + (size_t)ML * D); S2.B = S.B + (size_t)D * D * 2; S2.nM = MC / 256; S2.nN = 2 * D / 256;
              pg8::EpiQKV E2{WSP(bf16_t, WS_Q), WSP(const float, WS_ROPE), ML / 256, D / 256};
              GEMM_CALL(S2, E2); } }
        PH_END(PH0)
        PH_BEGIN(PH0 + 1)
        { const float* lq1 = P.in[12] + ia * 64; const float* lk1 = P.in[13] + ia * 64; const float* lq2 = P.in[14] + ia * 64; const float* lk2 = P.in[15] + ia * 64;
          const float d1 = wave_sum(lq1[C.lane] * lk1[C.lane]), d2 = wave_sum(lq2[C.lane] * lk2[C.lane]);
          const float li = (L == 0) ? P.lam_init0 : P.lam_init3;
          att::Args A{WSP(bf16_t, WS_Q), WSP(bf16_t, WS_K), WSP(bf16_t, WS_V), WSP(bf16_t, WS_O), P.in[16] + ia * 128, expf(d1) - expf(d2) + li, 1.0f - li};
          constexpr int nlat_units = NB * NH * (SEQ / 256);
          const int per = (nlat_units + C.G - 1) / C.G;
#pragma unroll 1
          for (int i = 0; i < per; ++i) { const int uu = C.vcu * per + i; if (uu < nlat_units) { const int bh = uu >> 3, qb = uu & 7; int tid_ = C.tid; asm volatile("" : "+v"(tid_)); att::unit_checked(lds, A, bh >> 4, bh & 15, (bh >> 4) * SEQ + qb * 256, SEQ / 64, tid_); } }
          if constexpr (!lastl) { for (int uc = C.bx; uc < NB * NH; uc += C.G) { const int b = uc >> 4, h = uc & 15; int tid_ = C.tid; asm volatile("" : "+v"(tid_)); att::unit_checked(lds, A, b, h, ML + b * CL, 0, tid_); } } }
        PH_END(PH0 + 1)
    } else if constexpr (kind == 1) {
        PH_BEGIN(PH0)
        { pg8::Sched S{}; S.B = (const char*)WSP(bf16_t, WS_U); S.lda = 512 * 2; S.ldb = D * 2; S.nt = 8; S.nM = 1; S.nN = ML / 256; S.ngroups = 4; S.a_g = 0; S.b_g = 512 * 2; S.G = C.G;
          S.A = (const char*)WSP(bf16_t, WS_T1); S.c = C.bx;
          { pg8::EpiFAH E{WSP(bf16_t, WS_YT), 0}; GEMM_CALL(S, E); }
          S.A = (const char*)(WSP(bf16_t, WS_T1) + 512 * 512); S.c = (C.bx + C.G / 2) % C.G;
          { pg8::EpiFAH E{WSP(bf16_t, WS_YT), 1}; GEMM_CALL(S, E); }
          static_assert(!lastl, "the Fourier layer keeps its context stream");
          pg8::Sched S2{}; S2.A = (const char*)WSP(bf16_t, WS_T1); S2.B = (const char*)(WSP(bf16_t, WS_U) + (size_t)ML * D); S2.lda = 512 * 2; S2.ldb = D * 2; S2.nt = 8; S2.nM = 4; S2.nN = MC / 256; S2.ngroups = 4; S2.a_g = 0; S2.b_g = 512 * 2; S2.G = C.G; S2.c = C.bx;
          pg8::EpiFA E2{WSP(bf16_t, WS_YT), WSP(bf16_t, WS_YTC), 32}; GEMM_CALL(S2, E2);
          fourier_y256(WSP(const bf16_t, WS_U), WSP(const bf16_t, WS_T1), WSP(float, WS_SLOT), C.bx, C.wave, C.lane); }
        PH_END(PH0)
        PH_BEGIN(PH0 + 1)
        { pg8::Sched S{}; S.lda = 4096 * 2; S.ldb = 16384 * 2; S.nt = 16; S.nM = 4; S.nN = 4; S.ngroups = 4; S.a_g = 0; S.b_g = 4096 * 2; S.G = C.G;
          bf16_t* PQ = WSP(bf16_t, WS_YT) + 16 * MiB;
#define FB_CALL(q) { S.A = (const char*)(WSP(bf16_t, WS_A2) + ((q) >> 1) * 2048 + ((q) & 1) * 1024); S.B = (const char*)(WSP(bf16_t, WS_YT) + ((q) >> 1) * 2048 + ((q) & 1) * 1024); \
                     S.c = (C.bx + C.G - (q) * (C.G / 4)) % C.G; pg8::EpiBf16<0> E{PQ + (size_t)(q) * 4 * 1024 * 1024, 1024u, 1024}; GEMM_CALL(S, E); }
          FB_CALL(0) FB_CALL(1) FB_CALL(2) FB_CALL(3)
#undef FB_CALL
          { pg8::Sched S2{}; S2.A = (const char*)WSP(bf16_t, WS_A2C); S2.B = (const char*)WSP(bf16_t, WS_YTC); S2.lda = 512 * 2; S2.ldb = 2048 * 2; S2.nt = 8; S2.nM = 1; S2.nN = 8; S2.ngroups = 4; S2.a_g = 0; S2.b_g = 512 * 2; S2.G = C.G; S2.c = C.bx;
            pg8::EpiBf16<0> E2{WSP(bf16_t, WS_O) + (size_t)ML * D, (unsigned)D, CL};
            GEMM_CALL(S2, E2); }
          fourier_edge1024(WSP(const bf16_t, WS_YT), WSP(const bf16_t, WS_A2), WSP(float, WS_SLOT) + 65536, C.bx, C.wave, C.lane); }
        PH_END(PH0 + 1)
        PH_BEGIN(PH0 + 2)
        fourier_combine(WSP(const bf16_t, WS_YT) + 16 * MiB, WSP(const float, WS_SLOT) + 65536, WSP(const bf16_t, WS_A2), WSP(const float, WS_SLOT), WSP(bf16_t, WS_O), C.lds, C.bx, C.tid, C.wave, C.lane);
        PH_END(PH0 + 2)
    } else {
        PH_BEGIN(PH0) pool_phase(WSP(bf16_t, WS_U), WSP(bf16_t, WS_O), Mact, C.bx, C.wave, C.lane); PH_END(PH0)
    }
    PH_BEGIN(PH0 + CF::o_mix)
    { pg8::Sched S{}; S.A = (const char*)WSP(bf16_t, WS_O); S.lda = D * 2; S.G = C.G; S.c = C.bx;
      if constexpr (kind == 2) { S.B = (const char*)WSP(bf16_t, WS_WPOOL); S.ldb = 512 * 2; S.nt = 8; S.nM = Mact / 256; S.nN = 2; S.ngroups = 4; S.a_g = 512 * 2; S.b_g = 512 * 512 * 2;
          pg8::EpiY E{WSP(bf16_t, WS_Y), (unsigned)D, P.in[19], 512, 0}; GEMM_CALL(S, E); }
      else { S.B = kind == 0 ? (const char*)(WSP(bf16_t, WS_WO) + (size_t)(L / 3) * D * D) : (const char*)WSP(bf16_t, WS_WF); S.ldb = D * 2; S.nt = D / 64; S.nM = ML / 256; S.nN = D / 256; S.ngroups = 1;
          if constexpr (CF::fuse_mid) {
              pg8::EpiFuse E{L == 0 ? P.in[0] : X, X, WSP(bf16_t, WS_U), modl + 2 * D, P.in[7] + L * D, P.in[8] + L * D, modl + 4 * D, modl + 3 * D,
                             WSP(unsigned long long, WS_SLOT), WSP(unsigned, WS_CTL) + CW_FUSE + (2 * L) * 2048, WSP(unsigned, WS_CTL) + CW_TMO};
              GEMM_CALL(S, E);
          } else { pg8::EpiY E{WSP(bf16_t, WS_Y), (unsigned)D, nullptr, 0, 0}; GEMM_CALL(S, E); }
          if constexpr (!lastl) { pg8::Sched S2 = S; S2.A = (const char*)(WSP(bf16_t, WS_O) + (size_t)ML * D); S2.nt = D / 64 / NSPLIT; S2.nM = MC / 256; S2.ngroups = NSPLIT; S2.a_g = (D / NSPLIT) * 2; S2.b_g = (D / NSPLIT) * 2;
              pg8::EpiSlab E2{WSP(bf16_t, WS_YC), (unsigned)D, (size_t)MC * D}; GEMM_CALL(S2, E2); } } }
    PH_END(PH0 + CF::o_mix)
    if constexpr (CF::has_tmid) {
    PH_BEGIN(PH0 + CF::o_tmid)
    { ThinArgs T{}; T.xin_lat = L == 0 ? (const void*)P.in[0] : (const void*)XB; T.xin_ctx = L == 0 ? (const void*)P.in[2] : (const void*)(XB + (size_t)ML * D); T.xin_bf16 = L == 0 ? 0 : 1; T.y = WSP(const bf16_t, WS_Y); T.xout_lat = XB; T.xout_ctx = XB + (size_t)ML * D; T.xout_bf16 = 1;
      T.yc = WSP(const bf16_t, WS_YC); T.nslab = (kind == 2 || lastl) ? 0 : NSPLIT;
      T.g_post = P.in[7] + L * D; T.gate = modl + 2 * D; T.uout = WSP(bf16_t, WS_U); T.g_pre = P.in[8] + L * D; T.sc = modl + 4 * D; T.sh = modl + 3 * D; T.nrows = Mact; T.gb_lo = CF::fuse_mid ? 4 : 0;
      thin_phase(T, C.lds, C.bx, C.G, C.tid, C.wave, C.lane); }
    PH_END(PH0 + CF::o_tmid)
    }
    PH_BEGIN(PH0 + CF::o_w1)
    { pg8::Sched S{}; S.A = (const char*)WSP(bf16_t, WS_U); S.B = (const char*)(WSP(bf16_t, WS_W1) + (size_t)L * FF * D); S.lda = D * 2; S.ldb = D * 2; S.nt = D / 64; S.nM = Mact / 256; S.nN = FF / 256; S.ngroups = 1; S.G = C.G; S.c = C.bx;
      pg8::EpiBf16<1> E{WSP(bf16_t, WS_H), (unsigned)FF, 0}; GEMM_CALL(S, E); }
    PH_END(PH0 + CF::o_w1)
    PH_BEGIN(PH0 + CF::o_w2)
    { pg8::Sched S{}; S.A = (const char*)WSP(bf16_t, WS_H); S.B = (const char*)(WSP(bf16_t, WS_W2) + (size_t)L * D * FF); S.lda = FF * 2; S.ldb = FF * 2; S.nt = FF / 64; S.nM = ML / 256; S.nN = D / 256; S.ngroups = 1; S.G = C.G; S.c = C.bx;
      if constexpr (CF::fuse_post) {
          const float* modn = modl + 5 * MODROW;
          pg8::EpiFuse E{X, lastl ? P.out : X, lastl ? nullptr : WSP(bf16_t, WS_U), modl + 5 * D, P.in[9] + L * D, lastl ? nullptr : P.in[6] + (L + 1) * D, modn + 1 * D, modn + 0 * D,
                         WSP(unsigned long long, WS_SLOT), WSP(unsigned, WS_CTL) + CW_FUSE + (2 * L + 1) * 2048, WSP(unsigned, WS_CTL) + CW_TMO};
          GEMM_CALL(S, E);
      } else { pg8::EpiY E{WSP(bf16_t, WS_Y), (unsigned)D, nullptr, 0, 0}; GEMM_CALL(S, E); }
      if constexpr (!lastl) { pg8::Sched S2 = S; S2.A = (const char*)(WSP(bf16_t, WS_H) + (size_t)ML * FF); S2.nt = FF / 64 / NSPLIT; S2.nM = MC / 256; S2.ngroups = NSPLIT; S2.a_g = (FF / NSPLIT) * 2; S2.b_g = (FF / NSPLIT) * 2;
          pg8::EpiSlab E2{WSP(bf16_t, WS_YC), (unsigned)D, (size_t)MC * D}; GEMM_CALL(S2, E2); } }
    PH_END(PH0 + CF::o_w2)
    if constexpr (CF::has_tpost) {
    PH_BEGIN(PH0 + CF::o_tpost)
    { ThinArgs T{}; T.xin_lat = XB; T.xin_ctx = XB + (size_t)ML * D; T.xin_bf16 = 1; T.y = WSP(const bf16_t, WS_Y); T.xout_lat = lastl ? (void*)P.out : (void*)XB; T.xout_ctx = XB + (size_t)ML * D; T.xout_bf16 = lastl ? 0 : 1;
      T.yc = WSP(const bf16_t, WS_YC); T.nslab = lastl ? 0 : NSPLIT;
      T.g_post = P.in[9] + L * D; T.gate = modl + 5 * D; T.nrows = Mact; T.gb_lo = CF::fuse_post ? 4 : 0;
      if constexpr (!lastl) { const float* modn = modl + 5 * MODROW; T.uout = WSP(bf16_t, WS_U); T.g_pre = P.in[6] + (L + 1) * D; T.sc = modn + 1 * D; T.sh = modn + 0 * D; }
      thin_phase(T, C.lds, C.bx, C.G, C.tid, C.wave, C.lane); }
    PH_END(PH0 + CF::o_tpost)
    }
}
constexpr int PH_L0 = 1, PH_L1 = PH_L0 + LayerCfg<0>::nph, PH_L2 = PH_L1 + LayerCfg<1>::nph, PH_L3 = PH_L2 + LayerCfg<2>::nph, N_PHASES = PH_L3 + LayerCfg<3>::nph;

__global__ void __launch_bounds__(NTHR, 2) fwd_kernel(Params P) {
    extern __shared__ __attribute__((aligned(16))) unsigned char lds_raw[];
    Ctx C; C.lds = (LAS unsigned char*)lds_raw;
    C.tid = threadIdx.x; C.lane = C.tid & 63; C.wave = __builtin_amdgcn_readfirstlane(C.tid >> 6);
    C.G = gridDim.x; C.bx = blockIdx.x; C.vcu = (C.G % 8 == 0) ? (C.bx % 8) * (C.G / 8) + C.bx / 8 : C.bx;
    C.gw = C.vcu * NWAVES + C.wave; C.NGW = C.G * NWAVES;
    for (int u = C.tid; u < (LDS_BYTES - LDSCTL_OFF) / 4; u += NTHR) ((LAS unsigned*)(C.lds + LDSCTL_OFF))[u] = 0u;
    __syncthreads();
#if MK_MULTI
    XcdBarrier bar{};
#else
    XcdBarrier bar = xcd_barrier_post(WSP(unsigned, WS_CTL) + CW_BAR, (volatile LAS unsigned*)(C.lds + MISC_OFF) + 8);
#endif
    PH_BEGIN(0) prologue<2>(P, C.lds, C.tid, C.wave, C.lane, C.vcu, C.G);
    { unsigned* bw = WSP(unsigned, WS_CTL) + CW_BAR; unsigned* ctr = WSP(unsigned, WS_CTL) + CW_MOD0;
      __syncthreads();
      if (C.tid == 0) { XB_SPIN(xb_ld(ctr) < 192u, bw); __builtin_amdgcn_fence(__ATOMIC_ACQUIRE, "agent"); asm volatile("s_waitcnt vmcnt(0)" ::: "memory"); }
      __syncthreads();
      const float* mod = WSP(const float, WS_MOD);
      ThinArgs T{}; T.xin_lat = P.in[0]; T.xin_ctx = P.in[2]; T.y = nullptr; T.uout = WSP(bf16_t, WS_U); T.g_pre = P.in[6]; T.sc = mod + 1 * D; T.sh = mod + 0 * D; T.nrows = MT;
      thin_phase(T, C.lds, C.bx, C.G, C.tid, C.wave, C.lane); }
    PH_END(0)
#if !MK_MULTI
    if (P.ph_lo == 0 && P.ph_hi > 1) {
        volatile LAS unsigned* st = (volatile LAS unsigned*)(C.lds + MISC_OFF) + 8;
        if (C.tid == 0) { unsigned* bw = WSP(unsigned, WS_CTL) + CW_BAR; bool okc = (C.G % 8 == 0);
            for (unsigned j = 0; j < 16; ++j) { const unsigned cnt = xb_ld(&bw[XB_XCNT(j)]); okc = okc && (cnt == (j < 8 ? (unsigned)C.G / 8u : 0u)); }
            st[3] = okc ? st[2] * 8u + bar.x : (unsigned)blockIdx.x; }
        __syncthreads();
        C.bx = (int)st[3]; C.vcu = (C.G % 8 == 0) ? (C.bx % 8) * (C.G / 8) + C.bx / 8 : C.bx; C.gw = C.vcu * NWAVES + C.wave;
    }
#endif
    layer<0, PH_L0>(P, C, bar);
    layer<1, PH_L1>(P, C, bar);
    layer<2, PH_L2>(P, C, bar);
    layer<3, PH_L3>(P, C, bar);
}
#undef PH_BEGIN
#undef PH_END
#undef GRID_BAR

extern "C" void kernel_launch(void* const* d_in, const int* in_sizes, int n_in, void* d_out, int out_size, void* d_ws, size_t ws_size, hipStream_t stream) {
    static int grid = 0;
    if (grid == 0) {
        if (n_in != 22 || out_size != ML * D || ws_size < WS_END) { fprintf(stderr, "kernel_launch: unexpected problem: n_in %d out %d ws %zu (need %zu)\n", n_in, out_size, ws_size, (size_t)WS_END); grid = -1; return; }
        int dev = 0, cus = 0, per_cu = 0;
        if (hipGetDevice(&dev) != hipSuccess || hipDeviceGetAttribute(&cus, hipDeviceAttributeMultiprocessorCount, dev) != hipSuccess) { grid = -1; return; }
        if (hipFuncSetAttribute((const void*)fwd_kernel, hipFuncAttributeMaxDynamicSharedMemorySize, LDS_BYTES) != hipSuccess) { fprintf(stderr, "kernel_launch: hipFuncSetAttribute failed\n"); grid = -1; return; }
        if (hipOccupancyMaxActiveBlocksPerMultiprocessor(&per_cu, (const void*)fwd_kernel, NTHR, LDS_BYTES) != hipSuccess || per_cu < 1) fprintf(stderr, "kernel_launch: occupancy query says %d\n", per_cu);
        (void)hipGetLastError();
        if (cus < 256) { fprintf(stderr, "kernel_launch: %d CUs; this kernel is built for a 256-CU device (one workgroup per CU, fused epilogues pair 8 workgroups per row panel)\n", cus); grid = -1; return; }
        grid = 256;
    }
    if (grid < 0) return;
    (void)in_sizes;
    hipMemsetAsync((char*)d_ws + WS_CTL, 0, CTL_BYTES, stream);
    Params p{};
    for (int i = 0; i < 22; ++i) p.in[i] = (const float*)d_in[i];
    p.out = (float*)d_out; p.ws = (unsigned char*)d_ws;
    p.lam_init0 = (float)(0.8 - 0.6 * exp(-0.3 * 0.0)); p.lam_init3 = (float)(0.8 - 0.6 * exp(-0.3 * 3.0));
#if MK_MULTI
    for (int ph = 0; ph < N_PHASES; ++ph) { p.ph_lo = ph; p.ph_hi = ph + 1; hipLaunchKernelGGL(fwd_kernel, dim3(grid), dim3(NTHR), LDS_BYTES, stream, p); }
#else
    p.ph_lo = 0; p.ph_hi = N_PHASES;
    hipLaunchKernelGGL(fwd_kernel, dim3(grid), dim3(NTHR), LDS_BYTES, stream, p);
#endif
    const hipError_t le = hipPeekAtLastError();
    if (le != hipSuccess) fprintf(stderr, "kernel_launch: launch failed: %s\n", hipGetErrorName(le));
}
```

```cpp
#include <hip/hip_runtime.h>
#include <cstdio>
#include <cstdint>
#include <cmath>

#ifndef MK_MULTI
#define MK_MULTI 0
#endif

#define LAS __attribute__((address_space(3)))
#define GAS __attribute__((address_space(1)))
typedef unsigned short bf16_t;
typedef short bf16x8 __attribute__((ext_vector_type(8)));
typedef short s16x4 __attribute__((ext_vector_type(4)));
typedef float f32x4 __attribute__((ext_vector_type(4)));
typedef float f32x2 __attribute__((ext_vector_type(2)));
typedef float f32x16 __attribute__((ext_vector_type(16)));
typedef unsigned u32x4 __attribute__((ext_vector_type(4)));
typedef unsigned u32x2 __attribute__((ext_vector_type(2)));

constexpr int D = 2048, NB = 4, SEQ = 2048, CL = 256, ML = NB * SEQ, MC = NB * CL, MT = ML + MC, FF = 8192, NH = 16, NMOD = 6, MODROW = NMOD * D;
constexpr int NWAVES = 8, NTHR = 512;
constexpr float NORM_EPS = 1e-6f, SUBLN_EPS = 1e-5f;
constexpr float QSCALE = 0.125f * 1.4426950408889634f;

constexpr size_t MiB = 1u << 20;
constexpr size_t WS_CTL = 0, CTL_BYTES = 1 * MiB;
constexpr size_t WS_MOD = 1 * MiB;
constexpr size_t WS_ROPE = 2 * MiB;
constexpr size_t WS_T1 = 3 * MiB;
constexpr size_t WS_A2C = 4 * MiB;
constexpr size_t WS_A2 = 5 * MiB;
constexpr size_t WS_WQKV = 22 * MiB;
constexpr size_t WS_WO = 70 * MiB;
constexpr size_t WS_WF = 86 * MiB;
constexpr size_t WS_WPOOL = 94 * MiB;
constexpr size_t WS_W1 = 96 * MiB;
constexpr size_t WS_W2 = 224 * MiB;
constexpr size_t WS_X = 352 * MiB;
constexpr size_t WS_Y = 424 * MiB;
constexpr size_t WS_U = 496 * MiB;
constexpr size_t WS_Q = 532 * MiB, WS_K = 568 * MiB, WS_V = 604 * MiB, WS_O = 640 * MiB;
constexpr size_t WS_H = 676 * MiB;
constexpr size_t WS_YT = 820 * MiB;
constexpr size_t WS_YTC = 884 * MiB;
constexpr size_t WS_YC = 892 * MiB;
constexpr size_t WS_SLOT = 956 * MiB;
constexpr size_t WS_END = 958 * MiB;
constexpr int NSPLIT = 8;

constexpr int RING_BYTES = 131072, LDSCTL_OFF = 139264  , MISC_OFF = LDSCTL_OFF + 320, LDS_BYTES = 147456;

__device__ __forceinline__ unsigned cvt_pk_bf16(float lo, float hi) { unsigned r; asm volatile("v_cvt_pk_bf16_f32 %0, %1, %2" : "=v"(r) : "v"(lo), "v"(hi)); return r; }
typedef __bf16 bf16x2v_t __attribute__((ext_vector_type(2)));
__device__ __forceinline__ unsigned cvt_pk_vis(float lo, float hi) { const f32x2 v = {lo, hi}; const bf16x2v_t b = __builtin_convertvector(v, bf16x2v_t); return __builtin_bit_cast(unsigned, b); }
__device__ __forceinline__ float bf2f(unsigned short b) { return __uint_as_float(((unsigned)b) << 16); }
__device__ __forceinline__ float wave_sum(float v) {
#pragma unroll
    for (int o = 1; o < 64; o <<= 1) v += __shfl_xor(v, o);
    return v;
}

#define XB_TMO      128
#define XB_XCNT(j)  (256  + 64 * (j))
#define XB_XSUB(j)  (1280 + 64 * (j))
#define XB_XGEN(j)  (2304 + 64 * (j))
#define XB_TOP      3328
#define XB_TOPGEN   3392
#define XCD_BAR_WORDS 3456
#define XB_SPIN_CAP (1u << 18)
constexpr int CW_BAR = 4096, CW_FUSE = 16384, CW_TMO = 8, CW_MOD0 = 2048;

__device__ __forceinline__ unsigned xb_ld(unsigned* p)              { return __hip_atomic_load(p, __ATOMIC_RELAXED, __HIP_MEMORY_SCOPE_AGENT); }
__device__ __forceinline__ unsigned xb_add(unsigned* p, unsigned v) { return __hip_atomic_fetch_add(p, v, __ATOMIC_RELAXED, __HIP_MEMORY_SCOPE_AGENT); }
__device__ __forceinline__ unsigned xb_xcc_id() { return (unsigned)__builtin_amdgcn_s_getreg((3 << 11) | 20) & 0xFu; }
#define XB_SPIN(cond, bar) do { unsigned _sp = 0; while (cond) { __builtin_amdgcn_s_sleep(1); \
    if ((++_sp & 255u) == 0u) { if (xb_ld(&(bar)[XB_TMO])) break; if (_sp > XB_SPIN_CAP) { atomicAdd(&(bar)[XB_TMO], 1u); break; } } } } while (0)

struct XcdBarrier { unsigned* bar; unsigned x; volatile LAS unsigned* st; };

__device__ __forceinline__ XcdBarrier xcd_barrier_post(unsigned* bar, volatile LAS unsigned* st) {
    XcdBarrier b; b.bar = bar; b.x = xb_xcc_id(); b.st = st;
    if (threadIdx.x == 0) st[2] = xb_add(&bar[XB_XCNT(b.x)], 1u);
    return b;
}
__device__ __forceinline__ void xcd_barrier_complete(unsigned* bar, unsigned x, unsigned& nloc, unsigned& nx) {
    const unsigned G = gridDim.x * gridDim.y * gridDim.z;
    unsigned sum, cnt, mine, sp = 0u;
    for (;;) {
        sum = 0u; cnt = 0u; mine = 0u;
#pragma unroll
        for (unsigned j = 0; j < 16; ++j) { const unsigned c = xb_ld(&bar[XB_XCNT(j)]); sum += c; cnt += (c > 0u) ? 1u : 0u; mine = (j == x) ? c : mine; }
        if (sum == G) break;
        __builtin_amdgcn_s_sleep(1);
        if ((++sp & 255u) == 0u) { if (xb_ld(&bar[XB_TMO])) break; if (sp > XB_SPIN_CAP) { atomicAdd(&bar[XB_TMO], 1u); break; } }
    }
    nloc = mine > 0u ? mine : 1u; nx = cnt > 0u ? cnt : 1u;
}
__device__ __forceinline__ void xcd_barrier(const XcdBarrier& b) {
    asm volatile("s_waitcnt vmcnt(0)" ::: "memory");
    __syncthreads();
    if (threadIdx.x == 0) {
        unsigned* bar = b.bar;
        __builtin_amdgcn_s_waitcnt(0);
        unsigned nloc = b.st[0], nx = b.st[1];
        if (nloc == 0u) { xcd_barrier_complete(bar, b.x, nloc, nx); b.st[0] = nloc; b.st[1] = nx; }
        const unsigned old = xb_add(&bar[XB_XSUB(b.x)], 1u);
        const unsigned gen = old / nloc;
        if (old + 1u == (gen + 1u) * nloc) {
            __builtin_amdgcn_fence(__ATOMIC_RELEASE, "agent");
            asm volatile("s_waitcnt vmcnt(0)" ::: "memory");
            const unsigned og = xb_add(&bar[XB_TOP], 1u);
            const unsigned tg = og / nx;
            if (og + 1u == (tg + 1u) * nx) xb_add(&bar[XB_TOPGEN], 1u);
            else XB_SPIN(xb_ld(&bar[XB_TOPGEN]) == tg, bar);
            __builtin_amdgcn_fence(__ATOMIC_ACQUIRE, "agent");
            xb_add(&bar[XB_XGEN(b.x)], 1u);
            asm volatile("s_waitcnt vmcnt(0)" ::: "memory");
        } else {
            XB_SPIN(xb_ld(&bar[XB_XGEN(b.x)]) == gen, bar);
            __builtin_amdgcn_fence(__ATOMIC_ACQUIRE, "agent");
            asm volatile("s_waitcnt vmcnt(0)" ::: "memory");
        }
    }
    __syncthreads();
}

namespace pg8 {
constexpr int BM = 256, BK = 64, HALF = 128, HTB = HALF * BK * 2, STAGE_BYTES = 8 * HTB, NXCD = 8, WGM = 8;
__device__ __forceinline__ int lds_byte(int r, int c) { const int st = (r >> 4) * 2 + (c >> 5), rr = r & 15, cc = c & 31, ob = rr * 64 + cc * 2; return st * 1024 + (ob ^ (((ob >> 9) & 1) << 5)); }
__device__ __forceinline__ void stage_rc(int b, int& R, int& C) { const int st = b / 1024, sb = b % 1024, swz = sb ^ (((sb >> 9) & 1) << 5); R = (st >> 1) * 16 + swz / 64; C = (st & 1) * 32 + (swz % 64) / 2; }
__device__ __forceinline__ int perm32(int rho) { const int n = rho >> 4, i = rho & 15; return 8 * (i >> 2) + 4 * n + (i & 3); }

struct Unit { const char* A; const char* B; int g, pm, pn; };

struct Sched {
    const char* A; const char* B; unsigned lda, ldb; int nt;
    int nM, nN, ngroups; long long a_g, b_g;
    int G, c;
    __device__ __forceinline__ bool next(int i, Unit& u) const {
        const int per = nM * nN, nwg = per * ngroups;
        const long L = (long)i * G + c; if (L >= nwg) return false;
        int wgid = (int)L; { const int q = nwg / NXCD, r = nwg % NXCD, xcd = wgid % NXCD, off = wgid / NXCD; wgid = (xcd < r ? xcd * (q + 1) : r * (q + 1) + (xcd - r) * q) + off; }
        const int g = wgid / per, w = wgid % per;
        const int nig = WGM * nN, gid = w / nig, fm = gid * WGM, gsz = (nM - fm) < WGM ? (nM - fm) : WGM;
        u.g = g; u.pm = fm + ((w % nig) % gsz); u.pn = (w % nig) / gsz;
        u.A = A + (long long)g * a_g + (size_t)u.pm * BM * lda; u.B = B + (long long)g * b_g + (size_t)u.pn * BM * ldb;
        return true;
    }
};

template <class Epi>
__device__ __forceinline__ void gemm_phase(LAS unsigned char* lds, const Sched& S, const Epi& E, int tid_in = -1) {
    const int tid = tid_in >= 0 ? tid_in : (int)threadIdx.x, wid = __builtin_amdgcn_readfirstlane(tid >> 6), lane = tid & 63, wr = wid >> 2, wc = wid & 3, fr = lane & 15, fq = lane >> 4;
    const int nt = S.nt;
    unsigned voffA[2], voffB[2];
#pragma unroll
    for (int i = 0; i < 2; ++i) { int R, C; stage_rc(tid * 16 + i * 8192, R, C); const int Rb = (R & ~31) + perm32(R & 31);
        voffA[i] = (unsigned)R * S.lda + (unsigned)C * 2u; voffB[i] = (unsigned)Rb * S.ldb + (unsigned)C * 2u; }
    const size_t kstep = (size_t)(BK * 2);
    const size_t hA = (size_t)HALF * S.lda, hB = (size_t)HALF * S.ldb;
    const unsigned ldsw = (unsigned)wid * 1024u;
    const int aoff = lds_byte(wr * 64 + fr, fq * 8), boff = lds_byte(wc * 32 + fr, fq * 8);
#define PG8_SA(b, h) (((b) * 2 + (h)) * HTB)
#define PG8_SB(b, h) ((4 + (b) * 2 + (h)) * HTB)
#define PG8_STAGE(bufoff, gbase, voff) do { _Pragma("unroll") for (int _i = 0; _i < 2; ++_i) \
        __builtin_amdgcn_global_load_lds((const unsigned*)((const char*)(gbase) + (voff)[_i]), (LAS unsigned*)(lds + (bufoff) + ldsw + _i * 8192), 16, 0, 0); } while (0)
#define PG8_LDA(dst, b, h) do { _Pragma("unroll") for (int m = 0; m < 4; ++m) _Pragma("unroll") for (int k = 0; k < 2; ++k) dst[m][k] = *(const LAS bf16x8*)(lds + PG8_SA(b, h) + aoff + m * 2048 + k * 1024); } while (0)
#define PG8_LDB(dst, b, h) do { _Pragma("unroll") for (int n = 0; n < 2; ++n) _Pragma("unroll") for (int k = 0; k < 2; ++k) dst[n][k] = *(const LAS bf16x8*)(lds + PG8_SB(b, h) + boff + n * 2048 + k * 1024); } while (0)
#define PG8_MMA(ai, bj, At, Bt) do { __builtin_amdgcn_s_setprio(1); _Pragma("unroll") for (int m = 0; m < 4; ++m) _Pragma("unroll") for (int n = 0; n < 2; ++n) _Pragma("unroll") for (int k = 0; k < 2; ++k) \
        acc[ai][bj][m][n] = __builtin_amdgcn_mfma_f32_16x16x32_bf16(Bt[n][k], At[m][k], acc[ai][bj][m][n], 0, 0, 0); __builtin_amdgcn_s_setprio(0); } while (0)
#define PG8_WAIT_V(n) asm volatile("s_waitcnt vmcnt(" #n ")" ::: "memory")
#define PG8_WAIT_L(n) asm volatile("s_waitcnt lgkmcnt(" #n ")" ::: "memory")
#define PG8_BAR __builtin_amdgcn_s_barrier()
#define PG8_SCHED __builtin_amdgcn_sched_barrier(0)
    Unit cur, nxt; int ui = 0;
    if (!S.next(0, cur)) return;
    f32x4 acc[2][2][4][2];
#pragma unroll
    for (int a = 0; a < 2; ++a)
#pragma unroll
        for (int b = 0; b < 2; ++b)
#pragma unroll
            for (int m = 0; m < 4; ++m)
#pragma unroll
                for (int n = 0; n < 2; ++n) acc[a][b][m][n] = (f32x4){0.f, 0.f, 0.f, 0.f};
    bf16x8 At[4][2], B0[2][2], B1[2][2];
    const char* cA = cur.A; const char* cB = cur.B;
    PG8_STAGE(PG8_SB(0, 0), cB, voffB); PG8_STAGE(PG8_SB(0, 1), cB + hB, voffB); PG8_STAGE(PG8_SA(0, 0), cA, voffA); PG8_STAGE(PG8_SA(0, 1), cA + hA, voffA);
    if (wr == 1) PG8_BAR;
    PG8_WAIT_V(2); PG8_BAR;
    PG8_STAGE(PG8_SB(1, 0), cB + kstep, voffB); PG8_STAGE(PG8_SA(1, 0), cA + kstep, voffA); PG8_STAGE(PG8_SB(1, 1), cB + hB + kstep, voffB);
    PG8_WAIT_V(6); PG8_BAR;
    for (;;) {
        const bool has_next = S.next(ui + 1, nxt);
        const char* nA = has_next ? nxt.A : cA; const char* nB = has_next ? nxt.B : cB;
        for (int t = 0; t < nt; t += 2) {
            const bool last = (t == nt - 2);
            const char* a1 = cA + (size_t)(t + 1) * kstep;
            const char* a2 = last ? nA : cA + (size_t)(t + 2) * kstep; const char* b2 = last ? nB : cB + (size_t)(t + 2) * kstep;
            const char* a3 = a2 + kstep; const char* b3 = b2 + kstep;
            PG8_LDB(B0, 0, 0); PG8_LDB(B1, 0, 1); PG8_SCHED; PG8_LDA(At, 0, 0); PG8_STAGE(PG8_SA(1, 1), a1 + hA, voffA);
            PG8_WAIT_V(8); PG8_WAIT_L(0); PG8_BAR; PG8_MMA(0, 0, At, B0); PG8_MMA(0, 1, At, B1); PG8_BAR; PG8_SCHED;
            PG8_LDA(At, 0, 1); PG8_STAGE(PG8_SB(0, 0), b2, voffB); PG8_STAGE(PG8_SB(0, 1), b2 + hB, voffB); PG8_STAGE(PG8_SA(0, 0), a2, voffA);
            PG8_WAIT_V(8); PG8_WAIT_L(0); PG8_BAR; PG8_MMA(1, 0, At, B0); PG8_MMA(1, 1, At, B1); PG8_BAR; PG8_SCHED;
            PG8_LDB(B0, 1, 0); PG8_LDB(B1, 1, 1); PG8_SCHED; PG8_LDA(At, 1, 0); PG8_STAGE(PG8_SA(0, 1), a2 + hA, voffA);
            PG8_WAIT_V(8); PG8_WAIT_L(0); PG8_BAR; PG8_MMA(0, 0, At, B0); PG8_MMA(0, 1, At, B1); PG8_BAR; PG8_SCHED;
            PG8_LDA(At, 1, 1); PG8_STAGE(PG8_SB(1, 0), b3, voffB); PG8_STAGE(PG8_SB(1, 1), b3 + hB, voffB); PG8_STAGE(PG8_SA(1, 0), a3, voffA);
            PG8_WAIT_V(8); PG8_WAIT_L(0); PG8_BAR; PG8_MMA(1, 0, At, B0); PG8_MMA(1, 1, At, B1); PG8_BAR; PG8_SCHED;
        }
        if (wr == 0) PG8_BAR;
        if constexpr (!Epi::FUSED) E(acc, cur, wr, wc, fr, fq);
        if (!has_next) break;
#pragma unroll
        for (int a = 0; a < 2; ++a)
#pragma unroll
            for (int b = 0; b < 2; ++b)
#pragma unroll
                for (int m = 0; m < 4; ++m)
#pragma unroll
                    for (int n = 0; n < 2; ++n) acc[a][b][m][n] = (f32x4){0.f, 0.f, 0.f, 0.f};
        cur = nxt; cA = nA; cB = nB; ++ui;
        if (wr == 1) PG8_BAR;
    }
    PG8_WAIT_V(0);
    PG8_BAR;
    if constexpr (Epi::FUSED) E.fused(acc, cur, wr, wc, fr, fq, lds, wid, lane, tid);
#undef PG8_SA
#undef PG8_SB
#undef PG8_STAGE
#undef PG8_LDA
#undef PG8_LDB
#undef PG8_MMA
#undef PG8_WAIT_V
#undef PG8_WAIT_L
#undef PG8_BAR
#undef PG8_SCHED
}

struct EpiF32 {
    static constexpr bool FUSED = false;
    float* C; unsigned ldc; const float* colscale; int c_g; size_t slab_g;
    __device__ __forceinline__ void operator()(const f32x4 (&acc)[2][2][4][2], const Unit& u, int wr, int wc, int fr, int fq) const {
        const int row0 = u.pm * BM + wr * 64 + fr, col0 = u.g * c_g + u.pn * BM + wc * 32 + 8 * fq;
        f32x4 sv[2][2];
#pragma unroll
        for (int bj = 0; bj < 2; ++bj)
#pragma unroll
            for (int n = 0; n < 2; ++n) sv[bj][n] = colscale ? *(const f32x4*)(colscale + col0 + bj * HALF + 4 * n) : (f32x4){1.f, 1.f, 1.f, 1.f};
#pragma unroll
        for (int ai = 0; ai < 2; ++ai)
#pragma unroll
            for (int m = 0; m < 4; ++m) { float* rowp = C + (size_t)u.g * slab_g + (size_t)(row0 + ai * HALF + m * 16) * ldc + col0;
#pragma unroll
                for (int bj = 0; bj < 2; ++bj) { *(f32x4*)(rowp + bj * HALF) = acc[ai][bj][m][0] * sv[bj][0]; *(f32x4*)(rowp + bj * HALF + 4) = acc[ai][bj][m][1] * sv[bj][1]; } }
    }
};
struct EpiY {
    static constexpr bool FUSED = false;
    bf16_t* C; unsigned ldc; const float* colscale; int c_g; size_t slab_g;
    __device__ __forceinline__ void operator()(const f32x4 (&acc)[2][2][4][2], const Unit& u, int wr, int wc, int fr, int fq) const {
        const int row0 = u.pm * BM + wr * 64 + fr, col0 = u.g * c_g + u.pn * BM + wc * 32 + 8 * fq;
        f32x4 sv[2][2];
#pragma unroll
        for (int bj = 0; bj < 2; ++bj)
#pragma unroll
            for (int n = 0; n < 2; ++n) sv[bj][n] = colscale ? *(const f32x4*)(colscale + col0 + bj * HALF + 4 * n) : (f32x4){1.f, 1.f, 1.f, 1.f};
#pragma unroll
        for (int ai = 0; ai < 2; ++ai)
#pragma unroll
            for (int m = 0; m < 4; ++m) { bf16_t* rowp = C + (size_t)(row0 + ai * HALF + m * 16) * ldc + col0;
#pragma unroll
                for (int bj = 0; bj < 2; ++bj) { const f32x4 v0 = acc[ai][bj][m][0] * sv[bj][0], v1 = acc[ai][bj][m][1] * sv[bj][1];
                    u32x4 w; w.x = cvt_pk_vis(v0[0], v0[1]); w.y = cvt_pk_vis(v0[2], v0[3]); w.z = cvt_pk_vis(v1[0], v1[1]); w.w = cvt_pk_vis(v1[2], v1[3]);
                    *(u32x4*)(rowp + bj * HALF) = w; } }
    }
};
struct EpiSlab {
    static constexpr bool FUSED = false;
    bf16_t* C; unsigned ldc; size_t slab_g;
    __device__ __forceinline__ void operator()(const f32x4 (&acc)[2][2][4][2], const Unit& u, int wr, int wc, int fr, int fq) const {
        const int row0 = u.pm * BM + wr * 64 + fr, col0 = u.pn * BM + wc * 32 + 8 * fq;
#pragma unroll
        for (int ai = 0; ai < 2; ++ai)
#pragma unroll
            for (int m = 0; m < 4; ++m) { bf16_t* rowp = C + (size_t)u.g * slab_g + (size_t)(row0 + ai * HALF + m * 16) * ldc + col0;
#pragma unroll
                for (int bj = 0; bj < 2; ++bj) { const f32x4 v0 = acc[ai][bj][m][0], v1 = acc[ai][bj][m][1];
                    u32x4 w; w.x = cvt_pk_vis(v0[0], v0[1]); w.y = cvt_pk_vis(v0[2], v0[3]); w.z = cvt_pk_vis(v1[0], v1[1]); w.w = cvt_pk_vis(v1[2], v1[3]);
                    *(u32x4*)(rowp + bj * HALF) = w; } }
    }
};
template <int ACT> struct EpiBf16 {
    static constexpr bool FUSED = false;
    bf16_t* C; unsigned ldc; int row_g;
    __device__ __forceinline__ void operator()(const f32x4 (&acc)[2][2][4][2], const Unit& u, int wr, int wc, int fr, int fq) const {
        const int row0 = u.g * row_g + u.pm * BM + wr * 64 + fr, col0 = u.pn * BM + wc * 32 + 8 * fq;
#pragma unroll
        for (int ai = 0; ai < 2; ++ai)
#pragma unroll
            for (int m = 0; m < 4; ++m) { bf16_t* rowp = C + (size_t)(row0 + ai * HALF + m * 16) * ldc + col0;
#pragma unroll
                for (int bj = 0; bj < 2; ++bj) { f32x4 v0 = acc[ai][bj][m][0], v1 = acc[ai][bj][m][1];
                    if (ACT == 1) {
#pragma unroll
                        for (int e = 0; e < 4; ++e) { const float a = __builtin_amdgcn_fmed3f(v0[e], 0.f, __builtin_inff()), b = __builtin_amdgcn_fmed3f(v1[e], 0.f, __builtin_inff()); v0[e] = a * a; v1[e] = b * b; } }
                    u32x4 w; w.x = cvt_pk_vis(v0[0], v0[1]); w.y = cvt_pk_vis(v0[2], v0[3]); w.z = cvt_pk_vis(v1[0], v1[1]); w.w = cvt_pk_vis(v1[2], v1[3]);
                    *(u32x4*)(rowp + bj * HALF) = w; } }
    }
};
struct EpiFAH {
    static constexpr bool FUSED = false;
    bf16_t* YT; int cs;
    __device__ __forceinline__ void operator()(const f32x4 (&acc)[2][2][4][2], const Unit& u, int wr, int wc, int fr, int fq) const {
        bf16_t* base = YT + (size_t)(u.g * 256) * 16384 + (u.pn >> 3) * 4096 + cs * 2048 + (u.pn & 7) * 256;
        const int row0 = wr * 64 + fr, col0 = wc * 32 + 8 * fq;
#pragma unroll
        for (int ai = 0; ai < 2; ++ai)
#pragma unroll
            for (int m = 0; m < 4; ++m) { bf16_t* rowp = base + (size_t)(row0 + ai * HALF + m * 16) * 16384 + col0;
#pragma unroll
                for (int bj = 0; bj < 2; ++bj) { const f32x4 v0 = acc[ai][bj][m][0], v1 = acc[ai][bj][m][1];
                    u32x4 w; w.x = cvt_pk_vis(v0[0], v0[1]); w.y = cvt_pk_vis(v0[2], v0[3]); w.z = cvt_pk_vis(v1[0], v1[1]); w.w = cvt_pk_vis(v1[2], v1[3]);
                    *(u32x4*)(rowp + bj * HALF) = w; } }
    }
};
struct EpiFA {
    static constexpr bool FUSED = false;
    bf16_t* YT; bf16_t* YTC; int pn_base;
    __device__ __forceinline__ void operator()(const f32x4 (&acc)[2][2][4][2], const Unit& u, int wr, int wc, int fr, int fq) const {
        const int cs = u.pm >> 1, k2b = (u.pm & 1) * 256, pn = u.pn + pn_base;
        bf16_t* base; size_t pitch;
        if (pn < 32) { const int b = pn >> 3; base = YT + (size_t)(u.g * 512 + k2b) * 16384 + b * 4096 + cs * 2048 + (pn & 7) * 256; pitch = 16384; }
        else { const int b = pn - 32; base = YTC + (size_t)(u.g * 512 + k2b) * 2048 + b * 512 + cs * 256; pitch = 2048; }
        const int row0 = wr * 64 + fr, col0 = wc * 32 + 8 * fq;
#pragma unroll
        for (int ai = 0; ai < 2; ++ai)
#pragma unroll
            for (int m = 0; m < 4; ++m) { bf16_t* rowp = base + (size_t)(row0 + ai * HALF + m * 16) * pitch + col0;
#pragma unroll
                for (int bj = 0; bj < 2; ++bj) { const f32x4 v0 = acc[ai][bj][m][0], v1 = acc[ai][bj][m][1];
                    u32x4 w; w.x = cvt_pk_vis(v0[0], v0[1]); w.y = cvt_pk_vis(v0[2], v0[3]); w.z = cvt_pk_vis(v1[0], v1[1]); w.w = cvt_pk_vis(v1[2], v1[3]);
                    *(u32x4*)(rowp + bj * HALF) = w; } }
    }
};
struct EpiQKV {
    static constexpr bool FUSED = false;
    bf16_t* Q; const float* rope;
    int pm_base, pn_base;
    __device__ __forceinline__ void operator()(const f32x4 (&acc)[2][2][4][2], const Unit& u, int wr, int wc, int fr, int fq) const {
        const int pn = u.pn + pn_base, pm = u.pm + pm_base, part = pn >> 3;
        bf16_t* dst = Q + (size_t)part * ((WS_K - WS_Q) / 2);
        const int row0 = pm * BM + wr * 64 + fr, colp = (pn & 7) * BM + wc * 32 + 8 * fq;
        const bool dorope = (part < 2) && (pm < 32);
        const float sc = part == 0 ? QSCALE : 1.f;
#pragma unroll
        for (int ai = 0; ai < 2; ++ai)
#pragma unroll
            for (int m = 0; m < 4; ++m) { const int row = row0 + ai * HALF + m * 16; bf16_t* rowp = dst + (size_t)row * D + colp;
                const int t = row & 2047, prow = t >> 6, pcol = t & 63;
#pragma unroll
                for (int bj = 0; bj < 2; ++bj) { f32x4 v0 = acc[ai][bj][m][0], v1 = acc[ai][bj][m][1];
                    if (dorope) { const int c = colp + bj * HALF, j0 = (c & 63) >> 1, ax = j0 >> 4, f0 = j0 & 15;
                        const float* cs = rope + ((ax ? pcol : prow) * 16 + f0) * 2;
                        const f32x4 cs0 = *(const f32x4*)cs, cs1 = *(const f32x4*)(cs + 4);
                        f32x4 r0, r1;
                        r0[0] = v0[0] * cs0[0] - v0[1] * cs0[1]; r0[1] = v0[0] * cs0[1] + v0[1] * cs0[0];
                        r0[2] = v0[2] * cs0[2] - v0[3] * cs0[3]; r0[3] = v0[2] * cs0[3] + v0[3] * cs0[2];
                        r1[0] = v1[0] * cs1[0] - v1[1] * cs1[1]; r1[1] = v1[0] * cs1[1] + v1[1] * cs1[0];
                        r1[2] = v1[2] * cs1[2] - v1[3] * cs1[3]; r1[3] = v1[2] * cs1[3] + v1[3] * cs1[2];
                        v0 = r0; v1 = r1; }
                    v0 = v0 * sc; v1 = v1 * sc;
                    u32x4 w; w.x = cvt_pk_vis(v0[0], v0[1]); w.y = cvt_pk_vis(v0[2], v0[3]); w.z = cvt_pk_vis(v1[0], v1[1]); w.w = cvt_pk_vis(v1[2], v1[3]);
                    *(u32x4*)(rowp + bj * HALF) = w; } }
    }
};

struct EpiFuse {
    static constexpr bool FUSED = true;
    const float* xin; float* xout; bf16_t* uout;
    const float* gate; const float* g_post;
    const float* g_pre; const float* sc; const float* sh;
    unsigned long long* slots;
    unsigned* cnt; unsigned* tmo;
    __device__ __forceinline__ void operator()(const f32x4 (&)[2][2][4][2], const Unit&, int, int, int, int) const {}
    __device__ __forceinline__ void fused(f32x4 (&acc)[2][2][4][2], const Unit& u, int wr, int wc, int fr, int fq, LAS unsigned char* lds, int wid, int lane, int tid) const {
        LAS float* ta = (LAS float*)lds; LAS float* tg = ta + 256; LAS float* ts = tg + 256;
        LAS f32x4* P4 = (LAS f32x4*)(lds + 4096);
        LAS f32x2* S2 = (LAS f32x2*)(lds + 4096 + 16384);
        const int b = (u.pm * BM) >> 11, colt = u.pn * BM;
#define FZ_BAR() do { asm volatile("s_waitcnt vmcnt(0) lgkmcnt(0)" ::: "memory"); __builtin_amdgcn_s_barrier(); asm volatile("" ::: "memory"); } while (0)
        if (tid < 256) { const int c = colt + tid; ta[tid] = gate[(size_t)b * MODROW + c] * g_post[c];
            if (uout) { tg[tid] = g_pre[c] * (1.0f + sc[(size_t)b * MODROW + c]); ts[tid] = sh[(size_t)b * MODROW + c]; } }
        FZ_BAR();
#pragma unroll
        for (int ai = 0; ai < 2; ++ai)
#pragma unroll
            for (int m = 0; m < 4; ++m) { const int rl = ai * HALF + wr * 64 + m * 16 + fr; const float* xr = xin + (size_t)((u.pm * BM) + rl) * D + colt + wc * 32 + 8 * fq;
                float s1 = 0.f, s2 = 0.f, s3 = 0.f, s4 = 0.f;
#pragma unroll
                for (int bj = 0; bj < 2; ++bj)
#pragma unroll
                    for (int n = 0; n < 2; ++n) { const f32x4 y = acc[ai][bj][m][n], x = *(const f32x4*)(xr + bj * HALF + 4 * n), a = *(const LAS f32x4*)(ta + bj * HALF + wc * 32 + 8 * fq + 4 * n);
                        const f32x4 ay = a * y;
                        s1 += (y[0] * y[0] + y[1] * y[1]) + (y[2] * y[2] + y[3] * y[3]); s2 += (x[0] * x[0] + x[1] * x[1]) + (x[2] * x[2] + x[3] * x[3]);
                        s3 += (x[0] * ay[0] + x[1] * ay[1]) + (x[2] * ay[2] + x[3] * ay[3]); s4 += (ay[0] * ay[0] + ay[1] * ay[1]) + (ay[2] * ay[2] + ay[3] * ay[3]); }
                s1 += __shfl_xor(s1, 16); s1 += __shfl_xor(s1, 32); s2 += __shfl_xor(s2, 16); s2 += __shfl_xor(s2, 32);
                s3 += __shfl_xor(s3, 16); s3 += __shfl_xor(s3, 32); s4 += __shfl_xor(s4, 16); s4 += __shfl_xor(s4, 32);
                if (fq == 0) P4[rl * 4 + wc] = (f32x4){s1, s2, s3, s4};
                asm volatile("" ::: "memory"); }
        FZ_BAR();
        if (tid < 256) { const f32x4 p0 = P4[tid * 4 + 0], p1 = P4[tid * 4 + 1], p2 = P4[tid * 4 + 2], p3 = P4[tid * 4 + 3]; const f32x4 t = (p0 + p1) + (p2 + p3);
            unsigned long long* slot = slots + ((size_t)((u.pm * BM) + tid) * 8 + u.pn) * 2;
            __hip_atomic_store(slot, ((unsigned long long)__float_as_uint(t[1]) << 32) | __float_as_uint(t[0]), __ATOMIC_RELAXED, __HIP_MEMORY_SCOPE_AGENT);
            __hip_atomic_store(slot + 1, ((unsigned long long)__float_as_uint(t[3]) << 32) | __float_as_uint(t[2]), __ATOMIC_RELAXED, __HIP_MEMORY_SCOPE_AGENT); }
        asm volatile("s_waitcnt vmcnt(0)" ::: "memory");
        if (tid < 256 && lane == 0) __hip_atomic_fetch_add(cnt + 64 * u.pm, 1u, __ATOMIC_RELAXED, __HIP_MEMORY_SCOPE_AGENT);
        if (wid == 0) { const unsigned long long t0 = __builtin_amdgcn_s_memrealtime();
            for (;;) { if ((unsigned)__builtin_amdgcn_readfirstlane(__hip_atomic_load(cnt + 64 * u.pm, __ATOMIC_RELAXED, __HIP_MEMORY_SCOPE_AGENT)) >= 32u) break;
                if (__builtin_amdgcn_s_memrealtime() - t0 > 2000000ull) { if (lane == 0) __hip_atomic_store(tmo, 1u, __ATOMIC_RELAXED, __HIP_MEMORY_SCOPE_AGENT); break; }
                __builtin_amdgcn_s_sleep(2); }
            __builtin_amdgcn_fence(__ATOMIC_ACQUIRE, "agent"); }
        FZ_BAR();
        if (tid < 256) { const unsigned long long* slot = slots + (size_t)((u.pm * BM) + tid) * 16; float t1 = 0.f, t2 = 0.f, t3 = 0.f, t4 = 0.f;
#pragma unroll
            for (int t = 0; t < 8; ++t) { const unsigned long long w0 = __hip_atomic_load(slot + 2 * t, __ATOMIC_RELAXED, __HIP_MEMORY_SCOPE_AGENT), w1 = __hip_atomic_load(slot + 2 * t + 1, __ATOMIC_RELAXED, __HIP_MEMORY_SCOPE_AGENT);
                t1 += __uint_as_float((unsigned)w0); t2 += __uint_as_float((unsigned)(w0 >> 32)); t3 += __uint_as_float((unsigned)w1); t4 += __uint_as_float((unsigned)(w1 >> 32)); }
            const float r1 = 1.0f / sqrtf(t1 * (1.0f / D) + NORM_EPS);
            const float q = t2 + 2.0f * r1 * t3 + r1 * r1 * t4;
            S2[tid] = (f32x2){r1, 1.0f / sqrtf(fmaxf(q, 0.f) * (1.0f / D) + NORM_EPS)}; }
        FZ_BAR();
#pragma unroll
        for (int ai = 0; ai < 2; ++ai)
#pragma unroll
            for (int m = 0; m < 4; ++m) { const int rl = ai * HALF + wr * 64 + m * 16 + fr; const size_t off = (size_t)((u.pm * BM) + rl) * D + colt + wc * 32 + 8 * fq; const f32x2 rr = S2[rl];
#pragma unroll
                for (int bj = 0; bj < 2; ++bj) { const int cl = bj * HALF + wc * 32 + 8 * fq;
                    const f32x4 a0 = *(const LAS f32x4*)(ta + cl), a1 = *(const LAS f32x4*)(ta + cl + 4);
                    const f32x4 x0 = *(const f32x4*)(xin + off + bj * HALF) + (a0 * acc[ai][bj][m][0]) * rr[0], x1 = *(const f32x4*)(xin + off + bj * HALF + 4) + (a1 * acc[ai][bj][m][1]) * rr[0];
                    *(f32x4*)(xout + off + bj * HALF) = x0; *(f32x4*)(xout + off + bj * HALF + 4) = x1;
                    if (uout) { const f32x4 g0 = *(const LAS f32x4*)(tg + cl), g1 = *(const LAS f32x4*)(tg + cl + 4), h0 = *(const LAS f32x4*)(ts + cl), h1 = *(const LAS f32x4*)(ts + cl + 4);
                        const f32x4 u0 = (x0 * rr[1]) * g0 + h0, u1 = (x1 * rr[1]) * g1 + h1;
                        u32x4 w; w.x = cvt_pk_vis(u0[0], u0[1]); w.y = cvt_pk_vis(u0[2], u0[3]); w.z = cvt_pk_vis(u1[0], u1[1]); w.w = cvt_pk_vis(u1[2], u1[3]);
                        *(u32x4*)(uout + off + bj * HALF) = w; } }
                asm volatile("" ::: "memory"); }
        FZ_BAR();
#undef FZ_BAR
    }
};
}


namespace att {
__device__ __forceinline__ unsigned off_a(unsigned row, unsigned ch) { return 2048u * (row >> 3) + 512u * (ch >> 2) + 64u * (row & 7) + 16u * ((ch & 3) ^ ((row >> 2) & 3)); }
constexpr int KBUF = 0, VBUF = 32768, QOFF = 65536, WSF_OFF = LDSCTL_OFF + 1024;
constexpr float THR = 6.0f;
struct Args { const bf16_t* Q; const bf16_t* K; const bf16_t* V; bf16_t* O; const float* gsub; float lam, post; };
__device__ __forceinline__ s16x4 vtr(const LAS unsigned char* p) { return __builtin_bit_cast(s16x4, __builtin_amdgcn_ds_read_tr16_b64_v4i16((LAS s16x4*)p)); }
__device__ __forceinline__ float half_max(float v) { auto rr = __builtin_amdgcn_permlane32_swap(__float_as_uint(v), __float_as_uint(v), false, false); return fmaxf(__uint_as_float(rr[0]), __uint_as_float(rr[1])); }
__device__ __forceinline__ float half_sum(float v) { auto rr = __builtin_amdgcn_permlane32_swap(__float_as_uint(v), __float_as_uint(v), false, false); return __uint_as_float(rr[0]) + __uint_as_float(rr[1]); }

__device__ __forceinline__ void glds16(const void* gsrc, unsigned lds_dst) { unsigned keep;
    asm volatile("s_mov_b32 %0, m0\n\ts_mov_b32 m0, %2\n\ts_nop 0\n\tglobal_load_lds_dwordx4 %1, off\n\ts_mov_b32 m0, %0" : "=&s"(keep) : "v"(gsrc), "s"(lds_dst) : "memory"); }
__device__ __forceinline__ float max3f(float a, float b, float c) { float r; asm("v_max3_f32 %0, %1, %2, %3" : "=v"(r) : "v"(a), "v"(b), "v"(c)); return r; }
__device__ __forceinline__ float max2f(float a, float b) { float r; asm("v_max_f32_e32 %0, %1, %2" : "=v"(r) : "v"(a), "v"(b)); return r; }
__device__ __forceinline__ float fsub_s(float a, float b) { float r; asm("v_sub_f32_e32 %0, %1, %2" : "=v"(r) : "v"(a), "v"(b)); return r; }
__device__ __forceinline__ float fadd_s(float a, float b) { float r; asm("v_add_f32_e32 %0, %1, %2" : "=v"(r) : "v"(a), "v"(b)); return r; }
typedef __bf16 bf16x2_t __attribute__((ext_vector_type(2)));
__device__ __forceinline__ unsigned cvtpk_b(float lo, float hi) { const f32x2 v = {lo, hi}; const bf16x2_t b = __builtin_convertvector(v, bf16x2_t); return __builtin_bit_cast(unsigned, b); }
template <bool SAFE>
__device__ __forceinline__ bool unit(LAS unsigned char* lds, const Args& P, int b, int h, int q0, int nlat, int tid) {
    const int lane = tid & 63, r32 = lane & 31, hi = lane >> 5; const int wid = __builtin_amdgcn_readfirstlane(tid >> 6);
    const int nt = nlat + 4;
    if (wid >= 4) __builtin_amdgcn_s_setprio(1);
    LAS unsigned char* Qs = lds + QOFF + wid * 8192;
    LAS float* wsf = (LAS float*)(lds + WSF_OFF + wid * 256);
    {   const bf16_t* qrow = P.Q + (size_t)(q0 + wid * 32 + r32) * D + h * 128 + hi * 8;
#pragma unroll
        for (int c = 0; c < 2; ++c)
#pragma unroll
            for (int d0 = 0; d0 < 4; ++d0) { const u32x4 v = *(const u32x4*)(qrow + c * 64 + d0 * 16); *(LAS u32x4*)(Qs + ((c * 4 + d0) * 2 + hi) * 512 + r32 * 16) = v; } }
    unsigned goff[2];
#pragma unroll
    for (int i = 0; i < 2; ++i) { const unsigned p = 2 * wid + i, rg = p >> 1, chq = (p & 1) * 2 + (lane >> 5), r7 = (lane >> 2) & 7, x = lane & 3, rsw = (r7 >> 2) | ((rg & 1) << 1);
        goff[i] = ((8 * rg + r7) * D + h * 128 + (4 * chq + (x ^ rsw)) * 8) * 2; }
#define ATT_GROW(t) ((t) < nlat ? b * SEQ + 64 * (t) : ML + b * CL + 64 * ((t) - nlat))
#define ATT_DMA(t, buf) do { const size_t g_ = (size_t)ATT_GROW(t) * D * 2; _Pragma("unroll") for (int i_ = 0; i_ < 2; ++i_) { \
        glds16((const char*)P.K + g_ + goff[i_], (unsigned)__builtin_amdgcn_readfirstlane(lds0 + KBUF + (buf) * 16384 + (2 * wid + i_) * 1024)); \
        glds16((const char*)P.V + g_ + goff[i_], (unsigned)__builtin_amdgcn_readfirstlane(lds0 + VBUF + (buf) * 16384 + (2 * wid + i_) * 1024)); } } while (0)
    const unsigned lds0 = (unsigned)(uintptr_t)lds;
    ATT_DMA(0, 0);
    unsigned kb[2];
#pragma unroll
    for (int e = 0; e < 2; ++e) kb[e] = 2048u * (r32 >> 3) + 64u * (r32 & 7) + 16u * ((unsigned)(2 * e + hi) ^ ((r32 >> 2) & 3));
    const unsigned blk = (lane >> 4) & 1, q_ = (lane & 15) >> 2, p_ = lane & 3;
    unsigned vb[2];
#pragma unroll
    for (int t = 0; t < 2; ++t) vb[t] = 2048u * t + 64u * (4 * hi + q_) + 16u * ((2 * blk + (p_ >> 1)) ^ ((2 * t + hi) & 3)) + 8u * (p_ & 1);
    float m0 = -1e30f, m1 = -1e30f, l0 = 0.f, l1 = 0.f;
    f32x16 o[2][4];
#pragma unroll
    for (int c = 0; c < 2; ++c)
#pragma unroll
        for (int d = 0; d < 4; ++d) o[c][d] = f32x16{};
    asm volatile("s_waitcnt vmcnt(0)" ::: "memory");
    __syncthreads();
#define SB() __builtin_amdgcn_sched_barrier(0)
#define ATT_SMB(S0, S1, i, M, SUM, PW) do { const float a_ = (i) < 8 ? S0[2 * ((i) & 7)] : S1[2 * ((i) & 7)], b_ = (i) < 8 ? S0[2 * ((i) & 7) + 1] : S1[2 * ((i) & 7) + 1]; \
        const float ea_ = SAFE ? __builtin_amdgcn_exp2f(fsub_s(a_, M)) : __builtin_amdgcn_exp2f(a_), eb_ = SAFE ? __builtin_amdgcn_exp2f(fsub_s(b_, M)) : __builtin_amdgcn_exp2f(b_); \
        SUM += ea_; SUM += eb_; PW[i] = cvtpk_b(ea_, eb_); asm volatile("" : "+v"(SUM), "+v"(PW[i])); } while (0)
#define ATT_SMA(S0, S1, c, MC, LC) do { asm volatile("s_nop 15\n\ts_nop 7" : "+v"(S0), "+v"(S1)); \
        float a_ = max3f(S0[0], S0[1], S1[0]), b_ = max3f(S0[2], S0[3], S1[1]); a_ = max3f(a_, S1[2], S1[3]); \
        _Pragma("unroll") for (int r_ = 4; r_ < 16; r_ += 4) { a_ = max3f(a_, S0[r_], S0[r_ + 1]); b_ = max3f(b_, S0[r_ + 2], S0[r_ + 3]); a_ = max3f(a_, S1[r_], S1[r_ + 1]); b_ = max3f(b_, S1[r_ + 2], S1[r_ + 3]); } \
        const float mx_ = half_max(max2f(a_, b_)); \
        if (__any(mx_ - MC > THR)) { const float mn_ = fmaxf(MC, mx_), al_ = __builtin_amdgcn_exp2f(MC - mn_); MC = mn_; LC *= al_; if (hi == 0) wsf[r32] = al_; \
            _Pragma("unroll") for (int g4 = 0; g4 < 4; ++g4) { const f32x4 a4 = *(const LAS f32x4*)(wsf + 8 * g4 + 4 * hi); \
                _Pragma("unroll") for (int d = 0; d < 4; ++d) { o[c][d][4 * g4 + 0] *= a4[0]; o[c][d][4 * g4 + 1] *= a4[1]; o[c][d][4 * g4 + 2] *= a4[2]; o[c][d][4 * g4 + 3] *= a4[3]; } } } } while (0)
#define ATT_LDQK(c, d0, QF, K0, K1) do { QF = *(const LAS bf16x8*)(Qs + (((c) * 4 + (d0)) * 2 + hi) * 512 + r32 * 16); \
        K0 = *(const LAS bf16x8*)(Kb + kb[(d0) & 1] + 512 * (2 * (c) + ((d0) >> 1))); K1 = *(const LAS bf16x8*)(Kb + kb[(d0) & 1] + 512 * (2 * (c) + ((d0) >> 1)) + 8192); } while (0)
#define ATT_LDV(i, LO, HH) do { LO = vtr(Vb + vb[0] + 4096 * ((i) >> 2) + 512 * ((i) & 3)); HH = vtr(Vb + vb[1] + 4096 * ((i) >> 2) + 512 * ((i) & 3)); } while (0)
#define ATT_VF(LO, HH) ((bf16x8){LO[0], LO[1], LO[2], LO[3], HH[0], HH[1], HH[2], HH[3]})
#define ATT_PA(PW, ks) ((bf16x8)__builtin_bit_cast(bf16x8, (u32x4){PW[4 * (ks)], PW[4 * (ks) + 1], PW[4 * (ks) + 2], PW[4 * (ks) + 3]}))
#pragma unroll 1
    for (int t = 0; t < nt; ++t) {
        const int buf = t & 1;
        if (t + 1 < nt) ATT_DMA(t + 1, buf ^ 1);
        const LAS unsigned char* Kb = lds + KBUF + buf * 16384; const LAS unsigned char* Vb = lds + VBUF + buf * 16384;
        unsigned pw0[16], pw1[16];
        f32x16 sa = f32x16{}, sb = f32x16{};
        SB();
        {   bf16x8 qfA, k0A, k1A, qfB, k0B, k1B;
            ATT_LDQK(0, 0, qfA, k0A, k1A); ATT_LDQK(0, 1, qfB, k0B, k1B); SB();
            sa = __builtin_amdgcn_mfma_f32_32x32x16_bf16(k0A, qfA, sa, 0, 0, 0); sb = __builtin_amdgcn_mfma_f32_32x32x16_bf16(k1A, qfA, sb, 0, 0, 0); SB();
            ATT_LDQK(0, 2, qfA, k0A, k1A); SB();
            sa = __builtin_amdgcn_mfma_f32_32x32x16_bf16(k0B, qfB, sa, 0, 0, 0); sb = __builtin_amdgcn_mfma_f32_32x32x16_bf16(k1B, qfB, sb, 0, 0, 0); SB();
            ATT_LDQK(0, 3, qfB, k0B, k1B); SB();
            sa = __builtin_amdgcn_mfma_f32_32x32x16_bf16(k0A, qfA, sa, 0, 0, 0); sb = __builtin_amdgcn_mfma_f32_32x32x16_bf16(k1A, qfA, sb, 0, 0, 0); SB();
            sa = __builtin_amdgcn_mfma_f32_32x32x16_bf16(k0B, qfB, sa, 0, 0, 0); sb = __builtin_amdgcn_mfma_f32_32x32x16_bf16(k1B, qfB, sb, 0, 0, 0); }
        SB();
        if constexpr (SAFE) ATT_SMA(sa, sb, 0, m0, l0);
        SB();
        f32x16 ta = f32x16{}, tb = f32x16{};
        {   bf16x8 qf, k0, k1; float sum = 0.f;
            ATT_LDQK(1, 0, qf, k0, k1); SB();
#define ATT_C(d0) do { ta = __builtin_amdgcn_mfma_f32_32x32x16_bf16(k0, qf, ta, 0, 0, 0); SB(); \
            if ((d0) < 3) k0 = *(const LAS bf16x8*)(Kb + kb[((d0) + 1) & 1] + 512 * (2 + (((d0) + 1) >> 1))); \
            ATT_SMB(sa, sb, 4 * (d0) + 0, m0, sum, pw0); ATT_SMB(sa, sb, 4 * (d0) + 1, m0, sum, pw0); SB(); \
            tb = __builtin_amdgcn_mfma_f32_32x32x16_bf16(k1, qf, tb, 0, 0, 0); SB(); \
            if ((d0) < 3) { qf = *(const LAS bf16x8*)(Qs + ((4 + (d0) + 1) * 2 + hi) * 512 + r32 * 16); k1 = *(const LAS bf16x8*)(Kb + kb[((d0) + 1) & 1] + 512 * (2 + (((d0) + 1) >> 1)) + 8192); } \
            ATT_SMB(sa, sb, 4 * (d0) + 2, m0, sum, pw0); ATT_SMB(sa, sb, 4 * (d0) + 3, m0, sum, pw0); SB(); } while (0)
            ATT_C(0); ATT_C(1); ATT_C(2); ATT_C(3);
#undef ATT_C
            l0 += sum; }
        if constexpr (SAFE) ATT_SMA(ta, tb, 1, m1, l1);
        SB();
        {   s16x4 loA, hhA, loB, hhB, loC, hhC; float sum = 0.f;
            ATT_LDV(0, loA, hhA); ATT_LDV(1, loB, hhB); SB();
#define ATT_E(i, LOc, HHc, LOn, HHn) do { if ((i) + 2 < 16) ATT_LDV((i) + 2, LOn, HHn); SB(); \
            o[0][(i) & 3] = __builtin_amdgcn_mfma_f32_32x32x16_bf16(ATT_PA(pw0, (i) >> 2), ATT_VF(LOc, HHc), o[0][(i) & 3], 0, 0, 0); SB(); ATT_SMB(ta, tb, i, m1, sum, pw1); SB(); } while (0)
            ATT_E(0, loA, hhA, loC, hhC); ATT_E(1, loB, hhB, loA, hhA); ATT_E(2, loC, hhC, loB, hhB);
            ATT_E(3, loA, hhA, loC, hhC); ATT_E(4, loB, hhB, loA, hhA); ATT_E(5, loC, hhC, loB, hhB);
            ATT_E(6, loA, hhA, loC, hhC); ATT_E(7, loB, hhB, loA, hhA); ATT_E(8, loC, hhC, loB, hhB);
            ATT_E(9, loA, hhA, loC, hhC); ATT_E(10, loB, hhB, loA, hhA); ATT_E(11, loC, hhC, loB, hhB);
            ATT_E(12, loA, hhA, loC, hhC); ATT_E(13, loB, hhB, loA, hhA); ATT_E(14, loC, hhC, loB, hhB);
            ATT_E(15, loA, hhA, loC, hhC);
#undef ATT_E
            l1 += sum; }
#pragma unroll
        for (int ks = 0; ks < 4; ++ks) {
            s16x4 lo[4], hh[4];
#pragma unroll
            for (int d = 0; d < 4; ++d) ATT_LDV(4 * ks + d, lo[d], hh[d]);
#pragma unroll
            for (int d = 0; d < 4; ++d) o[1][d] = __builtin_amdgcn_mfma_f32_32x32x16_bf16(ATT_PA(pw1, ks), ATT_VF(lo[d], hh[d]), o[1][d], 0, 0, 0);
            SB();
        }
        asm volatile("s_waitcnt vmcnt(0)" ::: "memory");
        __syncthreads();
    }
#undef ATT_SMB
#undef ATT_SMA
#undef ATT_LDQK
#undef ATT_LDV
#undef ATT_VF
#undef ATT_PA
#undef SB
#undef ATT_GROW
#undef ATT_DMA
    l0 = half_sum(l0); l1 = half_sum(l1);
    const bool ok = SAFE || !__any(!(l0 > 7.9e-31f && l0 < 1.26e30f && l1 > 7.9e-31f && l1 < 1.26e30f));
    if (hi == 0) { wsf[r32] = 1.0f / l0; wsf[32 + r32] = P.lam / l1; }
    float ss[16];
#pragma unroll
    for (int r = 0; r < 16; ++r) ss[r] = 0.f;
#pragma unroll
    for (int g4 = 0; g4 < 4; ++g4) { const f32x4 a4 = *(const LAS f32x4*)(wsf + 8 * g4 + 4 * hi), b4 = *(const LAS f32x4*)(wsf + 32 + 8 * g4 + 4 * hi);
#pragma unroll
        for (int d = 0; d < 4; ++d)
#pragma unroll
            for (int e = 0; e < 4; ++e) { const float v = o[0][d][4 * g4 + e] * a4[e] - o[1][d][4 * g4 + e] * b4[e]; o[0][d][4 * g4 + e] = v; ss[4 * g4 + e] += v * v; } }
#pragma unroll
    for (int r = 0; r < 16; ++r) {
        float v = ss[r];
#pragma unroll
        for (int s = 1; s < 32; s <<= 1) v += __shfl_xor(v, s);
        ss[r] = (1.0f / sqrtf(v * (1.0f / 128.0f) + SUBLN_EPS)) * P.post;
    }
    {   int l2; asm volatile("v_mbcnt_lo_u32_b32 %0, -1, 0\n\tv_mbcnt_hi_u32_b32 %0, -1, %0" : "=v"(l2));
        const int c2 = l2 & 31, h2 = l2 >> 5;
        LAS unsigned short* stg = (LAS unsigned short*)(lds + QOFF + wid * 8192) + h2 * 4 * 128 + c2;
#pragma unroll
        for (int d = 0; d < 4; ++d) { const float gs = P.gsub[32 * d + c2];
#pragma unroll
            for (int r = 0; r < 16; ++r) { const float v = o[0][d][r] * ss[r] * gs; stg[((r & 3) + 8 * (r >> 2)) * 128 + 32 * d] = (unsigned short)(cvt_pk_bf16(v, 0.f) & 0xffffu); }
            __builtin_amdgcn_sched_barrier(0); }
        const LAS unsigned char* rd = lds + QOFF + wid * 8192 + (l2 >> 4) * 256 + (l2 & 15) * 16;
        bf16_t* Ow = P.O + (size_t)(q0 + wid * 32 + (l2 >> 4)) * D + h * 128 + (l2 & 15) * 8;
#pragma unroll
        for (int i = 0; i < 8; ++i) { const u32x4 v = *(const LAS u32x4*)(rd + i * 1024); *(u32x4*)(Ow + (size_t)i * 4 * D) = v; } }
    __builtin_amdgcn_s_setprio(0);
    __syncthreads();
    return ok;
}
__device__ __forceinline__ void unit_checked(LAS unsigned char* lds, const Args& P, int b, int h, int q0, int nlat, int tid) {
    volatile LAS unsigned* flag = (volatile LAS unsigned*)(lds + MISC_OFF) + 16;
    const bool ok = unit<false>(lds, P, b, h, q0, nlat, tid);
    if (!ok && (tid & 63) == 0) *flag = 1u;
    __syncthreads();
    const unsigned f = *flag;
    __syncthreads();
    if (f) { if (tid == 0) *flag = 0u; (void)unit<true>(lds, P, b, h, q0, nlat, tid); }
}
}

struct ThinArgs {
    const void* xin_lat; const void* xin_ctx;
    int xin_bf16, xout_bf16;
    const bf16_t* y;
    void* xout_lat; void* xout_ctx;
    const float* g_post; const float* gate;
    bf16_t* uout;
    const float* g_pre; const float* sc; const float* sh;
    const bf16_t* yc; int nslab;
    int nrows; int gb_lo;
};
__device__ __forceinline__ void thin_phase(const ThinArgs& T, LAS unsigned char* lds, int bx, int G, int tid, int wave, int lane) {
    (void)G;
    LAS float* tab0 = (LAS float*)lds; LAS float* tab1 = tab0 + 3 * D;
    f32x4 xvb[2][8]; u32x2 xrb[2][8]; u32x2 yrb[2][8];
#define THIN_LOAD(ctx, row_, XV, XR, YR) do { const size_t xo_ = (ctx) ? (size_t)((row_) - ML) * D : (size_t)(row_) * D; \
        if (T.xin_bf16) { const bf16_t* xr_ = (const bf16_t*)((ctx) ? T.xin_ctx : T.xin_lat) + xo_; _Pragma("unroll") for (int j = 0; j < 8; ++j) XR[j] = *(const u32x2*)(xr_ + 256 * j + 4 * lane); } \
        else { const float* xr_ = (const float*)((ctx) ? T.xin_ctx : T.xin_lat) + xo_; _Pragma("unroll") for (int j = 0; j < 8; ++j) XV[j] = *(const f32x4*)(xr_ + 256 * j + 4 * lane); } \
        if (T.y && !((ctx) && T.nslab > 0)) { const bf16_t* yr_ = T.y + (size_t)(row_) * D; _Pragma("unroll") for (int j = 0; j < 8; ++j) YR[j] = __builtin_nontemporal_load((const u32x2*)(yr_ + 256 * j + 4 * lane)); } } while (0)
#define THIN_TABLES(gb, TB) do { const int c4 = 4 * tid; LAS float* ta = (TB); LAS float* tg = ta + D; LAS float* ts = tg + D;     \
        if (T.y) { const f32x4 g = *(const f32x4*)(T.g_post + c4), a = *(const f32x4*)(T.gate + (size_t)(gb) * MODROW + c4); *(LAS f32x4*)(ta + c4) = a * g; } \
        if (T.uout) { const f32x4 g = *(const f32x4*)(T.g_pre + c4), s = *(const f32x4*)(T.sc + (size_t)(gb) * MODROW + c4), h = *(const f32x4*)(T.sh + (size_t)(gb) * MODROW + c4); \
            *(LAS f32x4*)(tg + c4) = g * (s + 1.0f); *(LAS f32x4*)(ts + c4) = h; } } while (0)
#define THIN_ROW(ctx, row, xv, xraw, yraw, TB) do { const LAS float* ta = (TB); const LAS float* tg = ta + D; const LAS float* ts = tg + D; \
        if (T.xin_bf16) { _Pragma("unroll") for (int j = 0; j < 8; ++j) { const u32x2 v = xraw[j]; xv[j][0] = __uint_as_float(v.x << 16); xv[j][1] = __uint_as_float(v.x & 0xffff0000u); xv[j][2] = __uint_as_float(v.y << 16); xv[j][3] = __uint_as_float(v.y & 0xffff0000u); } } \
        if (T.y) { f32x4 yv[8]; float s = 0.f; \
            if ((ctx) && T.nslab > 0) { const bf16_t* yr = T.yc + (size_t)((row) - ML) * D; \
                _Pragma("unroll") for (int j = 0; j < 8; ++j) { const u32x2 v = __builtin_nontemporal_load((const u32x2*)(yr + 256 * j + 4 * lane)); \
                    yv[j][0] = __uint_as_float(v.x << 16); yv[j][1] = __uint_as_float(v.x & 0xffff0000u); yv[j][2] = __uint_as_float(v.y << 16); yv[j][3] = __uint_as_float(v.y & 0xffff0000u); } \
                _Pragma("unroll 1") for (int sl = 1; sl < T.nslab; ++sl) { yr += (size_t)MC * D; \
                    _Pragma("unroll") for (int j = 0; j < 8; ++j) { const u32x2 v = __builtin_nontemporal_load((const u32x2*)(yr + 256 * j + 4 * lane)); \
                        yv[j][0] += __uint_as_float(v.x << 16); yv[j][1] += __uint_as_float(v.x & 0xffff0000u); yv[j][2] += __uint_as_float(v.y << 16); yv[j][3] += __uint_as_float(v.y & 0xffff0000u); } } \
            } else { _Pragma("unroll") for (int j = 0; j < 8; ++j) { const u32x2 v = yraw[j]; \
                    yv[j][0] = __uint_as_float(v.x << 16); yv[j][1] = __uint_as_float(v.x & 0xffff0000u); yv[j][2] = __uint_as_float(v.y << 16); yv[j][3] = __uint_as_float(v.y & 0xffff0000u); } } \
            _Pragma("unroll") for (int j = 0; j < 8; ++j) s += (yv[j][0] * yv[j][0] + yv[j][1] * yv[j][1]) + (yv[j][2] * yv[j][2] + yv[j][3] * yv[j][3]); \
            const float rs = 1.0f / sqrtf(wave_sum(s) * (1.0f / D) + NORM_EPS); \
            _Pragma("unroll") for (int j = 0; j < 8; ++j) { const f32x4 a = *(const LAS f32x4*)(ta + 256 * j + 4 * lane); xv[j] = xv[j] + a * (yv[j] * rs); } \
            void* xob = (ctx) ? T.xout_ctx : T.xout_lat; const size_t xoo = (ctx) ? (size_t)((row) - ML) * D : (size_t)(row) * D; \
            if (xob) { \
                if (T.xout_bf16) { bf16_t* xo = (bf16_t*)xob + xoo;        \
                    _Pragma("unroll") for (int j = 0; j < 8; ++j) { u32x2 w; w.x = cvt_pk_bf16(xv[j][0], xv[j][1]); w.y = cvt_pk_bf16(xv[j][2], xv[j][3]); __builtin_nontemporal_store(w, (u32x2*)(xo + 256 * j + 4 * lane)); \
                        xv[j][0] = __uint_as_float(w.x << 16); xv[j][1] = __uint_as_float(w.x & 0xffff0000u); xv[j][2] = __uint_as_float(w.y << 16); xv[j][3] = __uint_as_float(w.y & 0xffff0000u); } \
                } else { float* xo = (float*)xob + xoo; _Pragma("unroll") for (int j = 0; j < 8; ++j) *(f32x4*)(xo + 256 * j + 4 * lane) = xv[j]; } } } \
        if (T.uout) { float s = 0.f; \
            _Pragma("unroll") for (int j = 0; j < 8; ++j) s += (xv[j][0] * xv[j][0] + xv[j][1] * xv[j][1]) + (xv[j][2] * xv[j][2] + xv[j][3] * xv[j][3]); \
            const float rs = 1.0f / sqrtf(wave_sum(s) * (1.0f / D) + NORM_EPS); \
            bf16_t* uo = T.uout + (size_t)(row) * D; \
            _Pragma("unroll") for (int j = 0; j < 8; ++j) { const f32x4 g = *(const LAS f32x4*)(tg + 256 * j + 4 * lane), c = *(const LAS f32x4*)(ts + 256 * j + 4 * lane); \
                const f32x4 u = (xv[j] * rs) * g + c; \
                u32x2 w; w.x = cvt_pk_bf16(u[0], u[1]); w.y = cvt_pk_bf16(u[2], u[3]); *(u32x2*)(uo + 256 * j + 4 * lane) = w; } } } while (0)
    const bool has_ctx = T.nrows > ML, my_ctx = has_ctx && wave < 4;
    const int gb = bx >> 6, rbase = gb * SEQ + (bx & 63) * 32 + wave * 4, crow = ML + bx * 4 + (wave & 3);
    if (T.gb_lo == 0) THIN_LOAD(false, rbase, xvb[0], xrb[0], yrb[0]); else if (my_ctx) THIN_LOAD(true, crow, xvb[0], xrb[0], yrb[0]);
    if (T.gb_lo == 0) THIN_TABLES(gb, tab0);
    if (has_ctx) THIN_TABLES(4, tab1);
    __syncthreads();
    if (T.gb_lo == 0) {
#pragma unroll
        for (int i = 0; i < 4; ++i) {
            if (i + 1 < 4) THIN_LOAD(false, rbase + i + 1, xvb[(i + 1) & 1], xrb[(i + 1) & 1], yrb[(i + 1) & 1]);
            else if (my_ctx) THIN_LOAD(true, crow, xvb[0], xrb[0], yrb[0]);
            THIN_ROW(false, rbase + i, xvb[i & 1], xrb[i & 1], yrb[i & 1], tab0);
        }
    }
    if (my_ctx) THIN_ROW(true, crow, xvb[0], xrb[0], yrb[0], tab1);
    __syncthreads();
#undef THIN_LOAD
#undef THIN_TABLES
#undef THIN_ROW
}
template <int W>
__device__ __forceinline__ void pool_sub(const bf16_t* Useq, bf16_t* Dseq, int t0, int Ls) {
    constexpr int H = W / 2, NR = 8 + W - 1;
    u32x2 rows[NR];
#pragma unroll
    for (int k = 0; k < NR; ++k) { const int tt = t0 - H + k; const bool ok = tt >= 0 && tt < Ls; const int tc = tt < 0 ? 0 : (tt >= Ls ? Ls - 1 : tt);
        const u32x2 v = *(const u32x2*)(Useq + (size_t)tc * D); rows[k].x = ok ? v.x : 0u; rows[k].y = ok ? v.y : 0u; }
#pragma unroll
    for (int i = 0; i < 8; ++i) { const int t = t0 + i; int lo = t - H, hi = lo + W; lo = lo < 0 ? 0 : lo; hi = hi > Ls ? Ls : hi;
        f32x4 s = {0.f, 0.f, 0.f, 0.f};
#pragma unroll
        for (int k = 0; k < W; ++k) { const u32x2 v = rows[i + k];
            s[0] += __uint_as_float(v.x << 16); s[1] += __uint_as_float(v.x & 0xffff0000u); s[2] += __uint_as_float(v.y << 16); s[3] += __uint_as_float(v.y & 0xffff0000u); }
        const u32x2 cv = rows[i + H]; const float inv = 1.0f / (float)(hi - lo);
        f32x4 d; d[0] = s[0] * inv - __uint_as_float(cv.x << 16); d[1] = s[1] * inv - __uint_as_float(cv.x & 0xffff0000u); d[2] = s[2] * inv - __uint_as_float(cv.y << 16); d[3] = s[3] * inv - __uint_as_float(cv.y & 0xffff0000u);
        u32x2 o; o.x = cvt_pk_bf16(d[0], d[1]); o.y = cvt_pk_bf16(d[2], d[3]);
        *(u32x2*)(Dseq + (size_t)t * D) = o; }
}
__device__ __forceinline__ void pool_phase(const bf16_t* U, bf16_t* Dm, int nrows, int bx, int wave, int lane) {
    const int coff = 256 * wave + 4 * lane;
    {   const int b = bx >> 6, t00 = (bx & 63) * 32; const bf16_t* Us = U + (size_t)b * SEQ * D + coff; bf16_t* Ds = Dm + (size_t)b * SEQ * D + coff;
#pragma unroll 1
        for (int sb = 0; sb < 4; ++sb) { const int t0 = t00 + 8 * sb;
            switch (wave >> 1) { case 0: pool_sub<2>(Us, Ds, t0, SEQ); break; case 1: pool_sub<4>(Us, Ds, t0, SEQ); break; case 2: pool_sub<8>(Us, Ds, t0, SEQ); break; default: pool_sub<16>(Us, Ds, t0, SEQ); break; } } }
    if (nrows > ML) {
        if (wave < 4) { const int sbi = bx >> 1, j = 4 * (bx & 1) + wave, r0 = sbi * 8, cb = r0 >> 8, t0 = r0 & 255; const int co = 256 * j + 4 * lane;
            const bf16_t* Us = U + (size_t)(ML + cb * CL) * D + co; bf16_t* Ds = Dm + (size_t)(ML + cb * CL) * D + co;
            switch (j >> 1) { case 0: pool_sub<2>(Us, Ds, t0, CL); break; case 1: pool_sub<4>(Us, Ds, t0, CL); break; case 2: pool_sub<8>(Us, Ds, t0, CL); break; default: pool_sub<16>(Us, Ds, t0, CL); break; } } }
}

struct TrDesc { const float* src; bf16_t* dst; int N, K; int perm; };
__device__ __forceinline__ void tr_load(const TrDesc& d, f32x4 (&v)[16], int lane) {
    const int kq = lane >> 4, n4 = lane & 15;
#pragma unroll
    for (int i = 0; i < 16; ++i) v[i] = __builtin_nontemporal_load((const f32x4*)(d.src + (size_t)(4 * i + kq) * d.N + 4 * n4));
}
__device__ __forceinline__ void tr_store(const TrDesc& d, const f32x4 (&v)[16], LAS float* scr, int lane) {
    const int kq = lane >> 4, n4 = lane & 15;
#pragma unroll
    for (int i = 0; i < 16; ++i) { LAS float* s = scr + (4 * i + kq) * 65 + 4 * n4; s[0] = v[i][0]; s[1] = v[i][1]; s[2] = v[i][2]; s[3] = v[i][3]; }
    asm volatile("s_waitcnt lgkmcnt(0)" ::: "memory");
    const int c = lane & 7;
#pragma unroll
    for (int j = 0; j < 8; ++j) { const int n = (lane >> 3) + 8 * j; int sc = n;
        if (d.perm) { const int jj = n >> 1, which = n & 1, ax = jj >> 4, f = jj & 15; sc = ax * 32 + which * 16 + f; }
        const LAS float* s = scr + (8 * c) * 65 + sc;
        u32x4 o; o.x = cvt_pk_bf16(s[0 * 65], s[1 * 65]); o.y = cvt_pk_bf16(s[2 * 65], s[3 * 65]); o.z = cvt_pk_bf16(s[4 * 65], s[5 * 65]); o.w = cvt_pk_bf16(s[6 * 65], s[7 * 65]);
        *(u32x4*)(d.dst + (size_t)n * d.K + 8 * c) = o; }
    asm volatile("s_waitcnt lgkmcnt(0)" ::: "memory");
}

struct Params {
    const float* in[22];
    float* out; unsigned char* ws;
    float lam_init0, lam_init3;
    int ph_lo, ph_hi;
};

namespace cv {
constexpr int I_QKV = (D / 64) * (3 * D / 64), I_O = (D / 64) * (D / 64), I_P = 4 * 8 * 8, I_1 = (D / 64) * (FF / 64), I_2 = (FF / 64) * (D / 64);
constexpr int SEG_A = I_QKV + I_O + I_1 + I_2, SEG_B = I_O + I_1 + I_2, SEG_C = I_P + I_1 + I_2, SEG_D = I_QKV + I_O + I_1 + I_2;
constexpr int OFF_B = SEG_A, OFF_C = OFF_B + SEG_B, OFF_D = OFF_C + SEG_C, NITEMS = OFF_D + SEG_D;
}
__device__ __forceinline__ TrDesc conv_decode(const Params& P, int it) {
    using namespace cv;
    unsigned char* ws = P.ws;
    bf16_t* Wqkv = (bf16_t*)(ws + WS_WQKV); bf16_t* Wo = (bf16_t*)(ws + WS_WO); bf16_t* Wf = (bf16_t*)(ws + WS_WF); bf16_t* Wp = (bf16_t*)(ws + WS_WPOOL);
    bf16_t* W1 = (bf16_t*)(ws + WS_W1); bf16_t* W2 = (bf16_t*)(ws + WS_W2);
    int r = it; const float* W; bf16_t* WT; int K, N, perm = 0;
    int l, kind;
    if (r < OFF_B) { l = 0; kind = r < I_QKV ? 0 : ((r -= I_QKV) < I_O ? 1 : ((r -= I_O) < I_1 ? 4 : (r -= I_1, 5))); }
    else if (r < OFF_C) { r -= OFF_B; l = 1; kind = r < I_O ? 2 : ((r -= I_O) < I_1 ? 4 : (r -= I_1, 5)); }
    else if (r < OFF_D) { r -= OFF_C; l = 2; kind = r < I_P ? 3 : ((r -= I_P) < I_1 ? 4 : (r -= I_1, 5)); }
    else { r -= OFF_D; l = 3; kind = r < I_QKV ? 0 : ((r -= I_QKV) < I_O ? 1 : ((r -= I_O) < I_1 ? 4 : (r -= I_1, 5))); }
    if (kind == 0) { const int ia = l / 3; W = P.in[10] + (size_t)ia * D * 3 * D; WT = Wqkv + (size_t)ia * 3 * D * D; K = D; N = 3 * D; perm = (r % (3 * D / 64)) < 2 * D / 64; }
    else if (kind == 1) { const int ia = l / 3; W = P.in[11] + (size_t)ia * D * D; WT = Wo + (size_t)ia * D * D; K = D; N = D; }
    else if (kind == 2) { W = P.in[17]; WT = Wf; K = D; N = D; }
    else if (kind == 3) { const int g = r / 64; r %= 64; W = P.in[18] + (size_t)g * 512 * 512; WT = Wp + (size_t)g * 512 * 512; K = 512; N = 512; }
    else if (kind == 4) { W = P.in[20] + (size_t)l * D * FF; WT = W1 + (size_t)l * FF * D; K = D; N = FF; }
    else { W = P.in[21] + (size_t)l * FF * D; WT = W2 + (size_t)l * D * FF; K = FF; N = D; }
    const int nblk = N / 64, k0 = 64 * (r / nblk), n0 = 64 * (r % nblk);
    TrDesc d; d.src = W + (size_t)k0 * N + n0; d.dst = WT + (size_t)n0 * K + k0; d.N = N; d.K = K; d.perm = perm; return d;
}
__device__ __forceinline__ void conv_range(const Params& P, LAS unsigned char* lds, int it0, int it1, int w, int nw, int wave, int lane) {
    LAS float* scr = (LAS float*)(lds + wave * 16640);
    int it = it0 + w;
    f32x4 va[16], vb[16]; TrDesc da, db;
    if (it < it1) { da = conv_decode(P, it); tr_load(da, va, lane); }
    while (it < it1) {
        const bool hb = it + nw < it1; if (hb) { db = conv_decode(P, it + nw); tr_load(db, vb, lane); }
        tr_store(da, va, scr, lane);
        if (!hb) break;
        const bool ha = it + 2 * nw < it1; if (ha) { da = conv_decode(P, it + 2 * nw); tr_load(da, va, lane); }
        tr_store(db, vb, scr, lane);
        if (!ha) break;
        it += 2 * nw;
    }
}
namespace cv {
constexpr int WQ0 = 6500, WM0 = 6500, WFA = 1500, WFB = 1500, WM1 = 6500, WPG = 1500;
constexpr int C_Q0 = 0, C_M0 = C_Q0 + WQ0, C_FA = C_M0 + WM0, C_FB = C_FA + WFA, C_M1 = C_FB + WFB, C_PG = C_M1 + WM1, C_M2 = C_PG + WPG, WM2 = (NITEMS - OFF_B) - C_M2;
static_assert(C_FA >= SEG_B, "layer 1's weights are converted inside layer 0");
static_assert(C_PG >= SEG_B + SEG_C, "layer 2's weights are converted before layer 2");
static_assert(WM2 > 0 && WM2 <= 7000, "the last window takes the rest");
}
#define CONV_WINDOW(first_idle, it0, n) do { if (C.bx >= (first_idle)) { __syncthreads(); conv_range(P, C.lds, (it0), (it0) + (n), (C.bx - (first_idle)) * NWAVES + C.wave, (C.G - (first_idle)) * NWAVES, C.wave, C.lane); } } while (0)

template <int PART>
__device__ __forceinline__ void prologue(const Params& P, LAS unsigned char* lds, int tid, int wave, int lane, int vcu, int G) {
    unsigned char* ws = P.ws;
    const float* c_in = P.in[1]; const float* cctx = P.in[3]; const float* w_mod = P.in[4]; const float* b_mod = P.in[5];
    LAS float* sil = (LAS float*)lds;
    LAS float* red = (LAS float*)(lds + 65536);
    for (int i = tid; i < 5 * D; i += NTHR) { const int r = i / D, k = i % D; const float x = r < 4 ? c_in[r * D + k] : cctx[k]; sil[k * 8 + r] = x / (1.0f + __expf(-x)); }
    __syncthreads();
    float* mod = (float*)(ws + WS_MOD);
    for (int item = (PART == 1 ? 192 : 0) + blockIdx.x; item < (PART == 0 ? 192 : 4 * 192); item += G) {
        const int l = item / 192, col = (item % 192) * 64 + lane;
        const float* W = w_mod + (size_t)l * D * MODROW + col;
        float a0 = 0.f, a1 = 0.f, a2 = 0.f, a3 = 0.f, a4 = 0.f;
        const int k0 = wave * 256;
        for (int kk = 0; kk < 256; kk += 32) {
            float w[32];
#pragma unroll
            for (int j = 0; j < 32; ++j) w[j] = __builtin_nontemporal_load(W + (size_t)(k0 + kk + j) * MODROW);
#pragma unroll
            for (int j = 0; j < 32; ++j) { const f32x4 s4 = *(const LAS f32x4*)(sil + (k0 + kk + j) * 8); const float s5 = sil[(k0 + kk + j) * 8 + 4];
                a0 += s4[0] * w[j]; a1 += s4[1] * w[j]; a2 += s4[2] * w[j]; a3 += s4[3] * w[j]; a4 += s5 * w[j]; }
        }
        red[(wave * 5 + 0) * 64 + lane] = a0; red[(wave * 5 + 1) * 64 + lane] = a1; red[(wave * 5 + 2) * 64 + lane] = a2; red[(wave * 5 + 3) * 64 + lane] = a3; red[(wave * 5 + 4) * 64 + lane] = a4;
        __syncthreads();
        if (wave < 5) { float s = b_mod[l * MODROW + col];
#pragma unroll
            for (int w8 = 0; w8 < 8; ++w8) s += red[(w8 * 5 + wave) * 64 + lane];
            mod[((size_t)l * 5 + wave) * MODROW + col] = s; }
        if (l == 0) asm volatile("s_waitcnt vmcnt(0)" ::: "memory");
        __syncthreads();
        if (l == 0 && tid == 0) { __builtin_amdgcn_fence(__ATOMIC_RELEASE, "agent"); asm volatile("s_waitcnt vmcnt(0)" ::: "memory"); xb_add((unsigned*)(ws + WS_CTL) + CW_MOD0, 1u); }
    }
    const int gw = vcu * NWAVES + wave, NGW = G * NWAVES;
    __syncthreads();
    conv_range(P, lds, 0, cv::SEG_A, gw, NGW, wave, lane);
    if constexpr (PART != 1) {
        const int gt = gw * 64 + lane, NGT = NGW * 64; float* rope = (float*)(ws + WS_ROPE);
        for (int i = gt; i < 64 * 16; i += NGT) { const int pos = i >> 4, f = i & 15; const float inv = 1.0f / powf(10000.0f, (float)f * (1.0f / 16.0f)); const float ang = (float)pos * inv;
            rope[2 * i] = cosf(ang); rope[2 * i + 1] = sinf(ang); }
    }
    if constexpr (PART != 0) {   bf16_t* T1 = (bf16_t*)(ws + WS_T1); bf16_t* A2 = (bf16_t*)(ws + WS_A2); bf16_t* A2C = (bf16_t*)(ws + WS_A2C);
        constexpr int C_T1 = 1024 * 512 / 8, C_A2 = 2048 * 4096 / 8, C_A2C = 256 * 512 / 8;
        const int gt = gw * 64 + lane, NGT = NGW * 64;
        for (int ch = gt; ch < C_T1 + C_A2 + C_A2C; ch += NGT) {
            int r = ch; bf16_t* dst; int row, col0, N, ncol; float scale; bool negsin;
            if (r < C_T1) { row = r / 64; col0 = (r % 64) * 8; dst = T1 + (size_t)row * 512 + col0; N = 512; scale = 0.04419417382415922f; negsin = false;
                const int cs = row >> 9, k2 = row & 511; float vals[8];
#pragma unroll
                for (int e = 0; e < 8; ++e) { const int idx = (k2 * (col0 + e)) & 511; const float a = (float)idx * (1.0f / 256.0f); vals[e] = (cs ? sinpif(a) : cospif(a)) * scale; }
                u32x4 o; o.x = cvt_pk_bf16(vals[0], vals[1]); o.y = cvt_pk_bf16(vals[2], vals[3]); o.z = cvt_pk_bf16(vals[4], vals[5]); o.w = cvt_pk_bf16(vals[6], vals[7]); *(u32x4*)dst = o; continue; }
            r -= C_T1;
            if (r < C_A2) { row = r / 512; col0 = (r % 512) * 8; dst = A2 + (size_t)row * 4096 + col0; N = 2048; scale = 0.022097086912079608f; }
            else { r -= C_A2; row = r / 64; col0 = (r % 64) * 8; dst = A2C + (size_t)row * 512 + col0; N = 256; scale = 0.0625f; }
            (void)ncol; (void)negsin;
            { const int cs = col0 / N, n0 = col0 % N; float vals[8];
#pragma unroll
              for (int e = 0; e < 8; ++e) { const int idx = (row * (n0 + e)) & (N - 1); const float a = (float)idx * (2.0f / (float)N); vals[e] = (cs ? -sinpif(a) : cospif(a)) * scale; }
              u32x4 o; o.x = cvt_pk_bf16(vals[0], vals[1]); o.y = cvt_pk_bf16(vals[2], vals[3]); o.z = cvt_pk_bf16(vals[4], vals[5]); o.w = cvt_pk_bf16(vals[6], vals[7]); *(u32x4*)dst = o; }
        }
    }
}

__device__ __forceinline__ void fourier_y256(const bf16_t* U, const bf16_t* T1, float* Y256, int bx, int wave, int lane) {
    const float sc = bf2f(T1[256 * 512]);
#pragma unroll 1
    for (int rr = 0; rr < 4; ++rr) {
        const int tok = bx * 32 + wave * 4 + rr;
        const bf16_t* up = U + (size_t)tok * D + lane * 32;
        float a = 0.f;
#pragma unroll
        for (int i = 0; i < 4; ++i) { const u32x4 w = *(const u32x4*)(up + 8 * i);
            a += (__uint_as_float(w.x << 16) - __uint_as_float(w.x & 0xffff0000u)) + (__uint_as_float(w.y << 16) - __uint_as_float(w.y & 0xffff0000u))
               + (__uint_as_float(w.z << 16) - __uint_as_float(w.z & 0xffff0000u)) + (__uint_as_float(w.w << 16) - __uint_as_float(w.w & 0xffff0000u)); }
        a += __shfl_xor(a, 1); a += __shfl_xor(a, 2); a += __shfl_xor(a, 4); a += __shfl_xor(a, 8);
        if ((lane & 15) == 0) Y256[(size_t)((tok >> 11) * 4 + (lane >> 4)) * 2048 + (tok & 2047)] = a * sc;
    }
}
__device__ __forceinline__ void fourier_edge1024(const bf16_t* YT, const bf16_t* A2, float* PE, int bx, int wave, int lane) {
#pragma unroll 1
    for (int rr = 0; rr < 2; ++rr) {
        const int idx = bx * 16 + wave * 2 + rr, r = idx >> 2, b = idx & 3;
        const bf16_t* yp = YT + (size_t)r * 16384 + b * 4096; const bf16_t* ap = A2 + (size_t)1024 * 4096;
        float a = 0.f;
#pragma unroll
        for (int i = 0; i < 4; ++i) { const int n1 = (i * 64 + lane) * 8; const u32x4 y = *(const u32x4*)(yp + n1), c = *(const u32x4*)(ap + n1);
            a += __uint_as_float(y.x << 16) * __uint_as_float(c.x << 16) + __uint_as_float(y.x & 0xffff0000u) * __uint_as_float(c.x & 0xffff0000u)
               + __uint_as_float(y.y << 16) * __uint_as_float(c.y << 16) + __uint_as_float(y.y & 0xffff0000u) * __uint_as_float(c.y & 0xffff0000u)
               + __uint_as_float(y.z << 16) * __uint_as_float(c.z << 16) + __uint_as_float(y.z & 0xffff0000u) * __uint_as_float(c.z & 0xffff0000u)
               + __uint_as_float(y.w << 16) * __uint_as_float(c.w << 16) + __uint_as_float(y.w & 0xffff0000u) * __uint_as_float(c.w & 0xffff0000u); }
        a = wave_sum(a);
        if (lane == 0) PE[b * 1024 + r] = a;
    }
}
struct FcBlk { f32x4 lo, hi; };
__device__ __forceinline__ FcBlk fc_unpack(const u32x4 w) { FcBlk r; r.lo = f32x4{__uint_as_float(w.x << 16), __uint_as_float(w.x & 0xffff0000u), __uint_as_float(w.y << 16), __uint_as_float(w.y & 0xffff0000u)};
    r.hi = f32x4{__uint_as_float(w.z << 16), __uint_as_float(w.z & 0xffff0000u), __uint_as_float(w.w << 16), __uint_as_float(w.w & 0xffff0000u)}; return r; }
__device__ __forceinline__ void fc_store_fwd(bf16_t* dst, const FcBlk& v) { u32x4 f; f.x = cvt_pk_vis(v.lo[0], v.lo[1]); f.y = cvt_pk_vis(v.lo[2], v.lo[3]); f.z = cvt_pk_vis(v.hi[0], v.hi[1]); f.w = cvt_pk_vis(v.hi[2], v.hi[3]); *(u32x4*)dst = f; }
__device__ __forceinline__ void fc_store_rev(bf16_t* dst, float e0, const FcBlk& v) { u32x4 f; f.x = cvt_pk_vis(e0, v.hi[3]); f.y = cvt_pk_vis(v.hi[2], v.hi[1]); f.z = cvt_pk_vis(v.hi[0], v.lo[3]); f.w = cvt_pk_vis(v.lo[2], v.lo[1]); *(u32x4*)dst = f; }
__device__ __forceinline__ float fc_nyquist(const bf16_t* A2, LAS float* ys, int k1, int lane) {
    float s0 = 0.f, s1 = 0.f, s2 = 0.f, s3 = 0.f;
#pragma unroll
    for (int i = 0; i < 4; ++i) { const int n1 = (i * 64 + lane) * 8; const FcBlk a = fc_unpack(*(const u32x4*)(A2 + (size_t)k1 * 4096 + n1));
#define FC_DOT(S, G_) { const f32x4 y0 = *(LAS f32x4*)(ys + (G_) * 2048 + n1), y1 = *(LAS f32x4*)(ys + (G_) * 2048 + n1 + 4); \
                        S += a.lo[0] * y0[0] + a.lo[1] * y0[1] + a.lo[2] * y0[2] + a.lo[3] * y0[3] + a.hi[0] * y1[0] + a.hi[1] * y1[1] + a.hi[2] * y1[2] + a.hi[3] * y1[3]; }
        FC_DOT(s0, 0) FC_DOT(s1, 1) FC_DOT(s2, 2) FC_DOT(s3, 3)
#undef FC_DOT
    }
    s0 = wave_sum(s0); s1 = wave_sum(s1); s2 = wave_sum(s2); s3 = wave_sum(s3);
    const int g = lane >> 4;
    return g == 0 ? s0 : (g == 1 ? s1 : (g == 2 ? s2 : s3));
}
__device__ __forceinline__ void fourier_combine(const bf16_t* PQ, const float* PE, const bf16_t* A2, const float* Y256, bf16_t* O, LAS unsigned char* lds, int bx, int tid, int wave, int lane) {
    const int b = bx >> 6, kp0 = (bx & 63) * 16;
    LAS float* ys = (LAS float*)lds;
    for (int i = tid; i < 4 * 2048 / 4; i += NTHR) ((LAS f32x4*)ys)[i] = ((const f32x4*)(Y256 + (size_t)b * 4 * 2048))[i];
    __syncthreads();
    const int g = lane >> 4, j = lane & 15;
    constexpr size_t PART = (size_t)4 * 1024 * 1024;
#pragma unroll 1
    for (int rr = 0; rr < 2; ++rr) {
        const int k1 = kp0 + wave * 2 + rr;
        float sg = fc_nyquist(A2, ys, k1, lane), sg2 = 0.f;
        if (k1 == 0) sg2 = fc_nyquist(A2, ys, 1024, lane);
        asm volatile("" : "+v"(sg), "+v"(sg2)); __builtin_amdgcn_sched_barrier(0);
        const bf16_t* pa = PQ + ((size_t)b * 1024 + k1) * 1024 + g * 256;
        FcBlk P0, P1, Q0, Q1; float pn1, qn1, pn2, qn2;
        const int jn = j == 15 ? 0 : 8 * (j + 17);
        { const FcBlk x0 = fc_unpack(*(const u32x4*)(pa + 8 * j)), x1 = fc_unpack(*(const u32x4*)(pa + PART + 8 * j)); P0.lo = x0.lo + x1.lo; P0.hi = x0.hi + x1.hi; }
        { const FcBlk x0 = fc_unpack(*(const u32x4*)(pa + 8 * (j + 16))), x1 = fc_unpack(*(const u32x4*)(pa + PART + 8 * (j + 16))); P1.lo = x0.lo + x1.lo; P1.hi = x0.hi + x1.hi; }
        { const FcBlk x0 = fc_unpack(*(const u32x4*)(pa + 2 * PART + 8 * j)), x1 = fc_unpack(*(const u32x4*)(pa + 3 * PART + 8 * j)); Q0.lo = x0.lo + x1.lo; Q0.hi = x0.hi + x1.hi; }
        { const FcBlk x0 = fc_unpack(*(const u32x4*)(pa + 2 * PART + 8 * (j + 16))), x1 = fc_unpack(*(const u32x4*)(pa + 3 * PART + 8 * (j + 16))); Q1.lo = x0.lo + x1.lo; Q1.hi = x0.hi + x1.hi; }
        pn1 = bf2f(pa[8 * (j + 1)]) + bf2f(pa[PART + 8 * (j + 1)]); qn1 = bf2f(pa[2 * PART + 8 * (j + 1)]) + bf2f(pa[3 * PART + 8 * (j + 1)]);
        pn2 = bf2f(pa[jn]) + bf2f(pa[PART + jn]);                   qn2 = bf2f(pa[2 * PART + jn]) + bf2f(pa[3 * PART + jn]);
        FcBlk S0, S1, D0, D1; S0.lo = P0.lo + Q0.lo; S0.hi = P0.hi + Q0.hi; S1.lo = P1.lo + Q1.lo; S1.hi = P1.hi + Q1.hi; D0.lo = P0.lo - Q0.lo; D0.hi = P0.hi - Q0.hi; D1.lo = P1.lo - Q1.lo; D1.hi = P1.hi - Q1.hi;
        { bf16_t* orow = O + ((size_t)b * 2048 + k1) * D + g * 512;
          fc_store_fwd(orow + 8 * j, S0); fc_store_fwd(orow + 8 * (j + 16), S1);
          fc_store_rev(orow + 8 * (63 - j), pn1 - qn1, D0); fc_store_rev(orow + 8 * (47 - j), j == 15 ? sg : pn2 - qn2, D1); }
        if (k1 != 0) {
          bf16_t* orow = O + ((size_t)b * 2048 + (2048 - k1)) * D + g * 512;
          fc_store_fwd(orow + 8 * j, D0); fc_store_fwd(orow + 8 * (j + 16), D1);
          fc_store_rev(orow + 8 * (63 - j), pn1 + qn1, S0); fc_store_rev(orow + 8 * (47 - j), j == 15 ? sg : pn2 + qn2, S1);
        } else {
          const float* pe = PE + b * 1024 + g * 256;
          FcBlk E0, E1; E0.lo = *(const f32x4*)(pe + 8 * j); E0.hi = *(const f32x4*)(pe + 8 * j + 4); E1.lo = *(const f32x4*)(pe + 8 * (j + 16)); E1.hi = *(const f32x4*)(pe + 8 * (j + 16) + 4);
          bf16_t* orow = O + ((size_t)b * 2048 + 1024) * D + g * 512;
          fc_store_fwd(orow + 8 * j, E0); fc_store_fwd(orow + 8 * (j + 16), E1);
          fc_store_rev(orow + 8 * (63 - j), pe[8 * (j + 1)], E0); fc_store_rev(orow + 8 * (47 - j), j == 15 ? sg2 : pe[jn], E1);
        }
    }
}

struct Ctx { LAS unsigned char* lds; int tid, lane, wave, G, bx, vcu, gw, NGW; };
#if MK_MULTI
#define GRID_BAR() do { } while (0)
#else
#define GRID_BAR() xcd_barrier(bar)
#endif
#define PH_BEGIN(k) if ((k) >= P.ph_lo && (k) < P.ph_hi) {
#define PH_END(k)   if ((k) + 1 < P.ph_hi) GRID_BAR(); }
#define WSP(T, off) ((T*)(P.ws + (off)))

#ifndef FUSE_T
#define FUSE_T 0
#endif
template <int L> struct LayerCfg {
    static constexpr int kind = L % 3; static constexpr bool lastl = (L == 3);
    static constexpr int NMIX = (kind == 2) ? 1 : (kind == 1 ? 3 : 2);
    static constexpr bool fuse_mid = FUSE_T && kind != 2, fuse_post = FUSE_T;
    static constexpr bool has_tmid = !(fuse_mid && lastl), has_tpost = !(fuse_post && lastl);
    static constexpr int o_mix = NMIX, o_tmid = o_mix + 1, o_w1 = o_tmid + (has_tmid ? 1 : 0), o_w2 = o_w1 + 1, o_tpost = o_w2 + 1, nph = o_tpost + (has_tpost ? 1 : 0);
};
#define GEMM_CALL(S, E) do { int tid_ = C.tid; asm volatile("" : "+v"(tid_)); pg8::gemm_phase(lds, S, E, tid_); } while (0)

template <int L, int PH0>
__device__ __forceinline__ void layer(const Params& P, const Ctx& C, const XcdBarrier& bar) {
    using CF = LayerCfg<L>;
    constexpr int kind = CF::kind; constexpr bool lastl = CF::lastl;
    constexpr int Mact = lastl ? ML : MT;
    LAS unsigned char* lds = C.lds;
    const float* modl = WSP(const float, WS_MOD) + (size_t)L * 5 * MODROW; float* X = WSP(float, WS_X); bf16_t* XB = WSP(bf16_t, WS_X);
    if constexpr (kind == 0) {
        constexpr int ia = L / 3;
        PH_BEGIN(PH0)
        { pg8::Sched S{}; S.A = (const char*)WSP(bf16_t, WS_U); S.B = (const char*)(WSP(bf16_t, WS_WQKV) + (size_t)ia * 3 * D * D); S.lda = D * 2; S.ldb = D * 2; S.nt = D / 64;
          S.nM = (lastl ? ML : MT) / 256; S.nN = 3 * D / 256; S.ngroups = 1; S.a_g = 0; S.b_g = 0; S.G = C.G; S.c = C.bx;
          pg8::EpiQKV E{WSP(bf16_t, WS_Q), WSP(const float, WS_ROPE), 0, 0};
          GEMM_CALL(S, E);
          if constexpr (L == 0) CONV_WINDOW((MT / 256) * (3 * D / 256) % 256, cv::OFF_B + cv::C_Q0, cv::WQ0);
          if constexpr (lastl) {
              pg8::Sched S2 = S; S2.A = (const char*)(WSP(bf16_t, WS_U) + (size_t)ML * D); S2.B = S.B + (size_t)D * D * 2; S2.nM = MC / 256; S2.nN = 2 * D / 256;
              pg8::EpiQKV E2{WSP(bf16_t, WS_Q), WSP(const float, WS_ROPE), ML / 256, D / 256};
              GEMM_CALL(S2, E2); } }
        PH_END(PH0)
        PH_BEGIN(PH0 + 1)
        { const float* lq1 = P.in[12] + ia * 64; const float* lk1 = P.in[13] + ia * 64; const float* lq2 = P.in[14] + ia * 64; const float* lk2 = P.in[15] + ia * 64;
          const float d1 = wave_sum(lq1[C.lane] * lk1[C.lane]), d2 = wave_sum(lq2[C.lane] * lk2[C.lane]);
          const float li = (L == 0) ? P.lam_init0 : P.lam_init3;
          att::Args A{WSP(bf16_t, WS_Q), WSP(bf16_t, WS_K), WSP(bf16_t, WS_V), WSP(bf16_t, WS_O), P.in[16] + ia * 128, expf(d1) - expf(d2) + li, 1.0f - li};
          constexpr int nlat_units = NB * NH * (SEQ / 256);
          const int per = (nlat_units + C.G - 1) / C.G;
#pragma unroll 1
          for (int i = 0; i < per; ++i) { const int uu = C.vcu * per + i; if (uu < nlat_units) { const int bh = uu >> 3, qb = uu & 7; int tid_ = C.tid; asm volatile("" : "+v"(tid_)); att::unit_checked(lds, A, bh >> 4, bh & 15, (bh >> 4) * SEQ + qb * 256, SEQ / 64, tid_); } }
          if constexpr (!lastl) { for (int uc = C.bx; uc < NB * NH; uc += C.G) { const int b = uc >> 4, h = uc & 15; int tid_ = C.tid; asm volatile("" : "+v"(tid_)); att::unit_checked(lds, A, b, h, ML + b * CL, 0, tid_); } } }
        PH_END(PH0 + 1)
    } else if constexpr (kind == 1) {
        PH_BEGIN(PH0)
        { pg8::Sched S{}; S.B = (const char*)WSP(bf16_t, WS_U); S.lda = 512 * 2; S.ldb = D * 2; S.nt = 8; S.nM = 1; S.nN = ML / 256; S.ngroups = 4; S.a_g = 0; S.b_g = 512 * 2; S.G = C.G;
          S.A = (const char*)WSP(bf16_t, WS_T1); S.c = C.bx;
          { pg8::EpiFAH E{WSP(bf16_t, WS_YT), 0}; GEMM_CALL(S, E); }
          S.A = (const char*)(WSP(bf16_t, WS_T1) + 512 * 512); S.c = (C.bx + C.G / 2) % C.G;
          { pg8::EpiFAH E{WSP(bf16_t, WS_YT), 1}; GEMM_CALL(S, E); }
          static_assert(!lastl, "the Fourier layer keeps its context stream");
          pg8::Sched S2{}; S2.A = (const char*)WSP(bf16_t, WS_T1); S2.B = (const char*)(WSP(bf16_t, WS_U) + (size_t)ML * D); S2.lda = 512 * 2; S2.ldb = D * 2; S2.nt = 8; S2.nM = 4; S2.nN = MC / 256; S2.ngroups = 4; S2.a_g = 0; S2.b_g = 512 * 2; S2.G = C.G; S2.c = C.bx;
          pg8::EpiFA E2{WSP(bf16_t, WS_YT), WSP(bf16_t, WS_YTC), 32}; GEMM_CALL(S2, E2);
          fourier_y256(WSP(const bf16_t, WS_U), WSP(const bf16_t, WS_T1), WSP(float, WS_SLOT), C.bx, C.wave, C.lane);
          CONV_WINDOW(64, cv::OFF_B + cv::C_FA, cv::WFA); }
        PH_END(PH0)
        PH_BEGIN(PH0 + 1)
        { pg8::Sched S{}; S.lda = 4096 * 2; S.ldb = 16384 * 2; S.nt = 16; S.nM = 4; S.nN = 4; S.ngroups = 4; S.a_g = 0; S.b_g = 4096 * 2; S.G = C.G;
          bf16_t* PQ = WSP(bf16_t, WS_YT) + 16 * MiB;
#define FB_CALL(q) { S.A = (const char*)(WSP(bf16_t, WS_A2) + ((q) >> 1) * 2048 + ((q) & 1) * 1024); S.B = (const char*)(WSP(bf16_t, WS_YT) + ((q) >> 1) * 2048 + ((q) & 1) * 1024); \
                     S.c = (C.bx + C.G - (q) * (C.G / 4)) % C.G; pg8::EpiBf16<0> E{PQ + (size_t)(q) * 4 * 1024 * 1024, 1024u, 1024}; GEMM_CALL(S, E); }
          FB_CALL(0) FB_CALL(1) FB_CALL(2) FB_CALL(3)
#undef FB_CALL
          { pg8::Sched S2{}; S2.A = (const char*)WSP(bf16_t, WS_A2C); S2.B = (const char*)WSP(bf16_t, WS_YTC); S2.lda = 512 * 2; S2.ldb = 2048 * 2; S2.nt = 8; S2.nM = 1; S2.nN = 8; S2.ngroups = 4; S2.a_g = 0; S2.b_g = 512 * 2; S2.G = C.G; S2.c = C.bx;
            pg8::EpiBf16<0> E2{WSP(bf16_t, WS_O) + (size_t)ML * D, (unsigned)D, CL};
            GEMM_CALL(S2, E2); }
          fourier_edge1024(WSP(const bf16_t, WS_YT), WSP(const bf16_t, WS_A2), WSP(float, WS_SLOT) + 65536, C.bx, C.wave, C.lane);
          CONV_WINDOW(32, cv::OFF_B + cv::C_FB, cv::WFB); }
        PH_END(PH0 + 1)
        PH_BEGIN(PH0 + 2)
        fourier_combine(WSP(const bf16_t, WS_YT) + 16 * MiB, WSP(const float, WS_SLOT) + 65536, WSP(const bf16_t, WS_A2), WSP(const float, WS_SLOT), WSP(bf16_t, WS_O), C.lds, C.bx, C.tid, C.wave, C.lane);
        PH_END(PH0 + 2)
    } else {
        PH_BEGIN(PH0) pool_phase(WSP(bf16_t, WS_U), WSP(bf16_t, WS_O), Mact, C.bx, C.wave, C.lane); PH_END(PH0)
    }
    PH_BEGIN(PH0 + CF::o_mix)
    { pg8::Sched S{}; S.A = (const char*)WSP(bf16_t, WS_O); S.lda = D * 2; S.G = C.G; S.c = C.bx;
      if constexpr (kind == 2) { S.B = (const char*)WSP(bf16_t, WS_WPOOL); S.ldb = 512 * 2; S.nt = 8; S.nM = Mact / 256; S.nN = 2; S.ngroups = 4; S.a_g = 512 * 2; S.b_g = 512 * 512 * 2;
          pg8::EpiY E{WSP(bf16_t, WS_Y), (unsigned)D, P.in[19], 512, 0}; GEMM_CALL(S, E);
          CONV_WINDOW(32, cv::OFF_B + cv::C_PG, cv::WPG); }
      else { S.B = kind == 0 ? (const char*)(WSP(bf16_t, WS_WO) + (size_t)(L / 3) * D * D) : (const char*)WSP(bf16_t, WS_WF); S.ldb = D * 2; S.nt = D / 64; S.nM = ML / 256; S.nN = D / 256; S.ngroups = 1;
          if constexpr (CF::fuse_mid) {
              pg8::EpiFuse E{L == 0 ? P.in[0] : X, X, WSP(bf16_t, WS_U), modl + 2 * D, P.in[7] + L * D, P.in[8] + L * D, modl + 4 * D, modl + 3 * D,
                             WSP(unsigned long long, WS_SLOT), WSP(unsigned, WS_CTL) + CW_FUSE + (2 * L) * 2048, WSP(unsigned, WS_CTL) + CW_TMO};
              GEMM_CALL(S, E);
          } else { pg8::EpiY E{WSP(bf16_t, WS_Y), (unsigned)D, nullptr, 0, 0}; GEMM_CALL(S, E); }
          if constexpr (!lastl) { pg8::Sched S2 = S; S2.A = (const char*)(WSP(bf16_t, WS_O) + (size_t)ML * D); S2.nt = D / 64 / NSPLIT; S2.nM = MC / 256; S2.ngroups = NSPLIT; S2.a_g = (D / NSPLIT) * 2; S2.b_g = (D / NSPLIT) * 2;
              pg8::EpiSlab E2{WSP(bf16_t, WS_YC), (unsigned)D, (size_t)MC * D}; GEMM_CALL(S2, E2); } } }
    PH_END(PH0 + CF::o_mix)
    if constexpr (CF::has_tmid) {
    PH_BEGIN(PH0 + CF::o_tmid)
    { ThinArgs T{}; T.xin_lat = L == 0 ? (const void*)P.in[0] : (const void*)XB; T.xin_ctx = L == 0 ? (const void*)P.in[2] : (const void*)(XB + (size_t)ML * D); T.xin_bf16 = L == 0 ? 0 : 1; T.y = WSP(const bf16_t, WS_Y); T.xout_lat = XB; T.xout_ctx = XB + (size_t)ML * D; T.xout_bf16 = 1;
      T.yc = WSP(const bf16_t, WS_YC); T.nslab = (kind == 2 || lastl) ? 0 : NSPLIT;
      T.g_post = P.in[7] + L * D; T.gate = modl + 2 * D; T.uout = WSP(bf16_t, WS_U); T.g_pre = P.in[8] + L * D; T.sc = modl + 4 * D; T.sh = modl + 3 * D; T.nrows = Mact; T.gb_lo = CF::fuse_mid ? 4 : 0;
      thin_phase(T, C.lds, C.bx, C.G, C.tid, C.wave, C.lane); }
    PH_END(PH0 + CF::o_tmid)
    }
    PH_BEGIN(PH0 + CF::o_w1)
    { pg8::Sched S{}; S.A = (const char*)WSP(bf16_t, WS_U); S.B = (const char*)(WSP(bf16_t, WS_W1) + (size_t)L * FF * D); S.lda = D * 2; S.ldb = D * 2; S.nt = D / 64; S.nM = Mact / 256; S.nN = FF / 256; S.ngroups = 1; S.G = C.G; S.c = C.bx;
      pg8::EpiBf16<1> E{WSP(bf16_t, WS_H), (unsigned)FF, 0}; GEMM_CALL(S, E);
      if constexpr (L == 0) CONV_WINDOW(128, cv::OFF_B + cv::C_M0, cv::WM0);
      if constexpr (L == 1) CONV_WINDOW(128, cv::OFF_B + cv::C_M1, cv::WM1);
      if constexpr (L == 2) CONV_WINDOW(128, cv::OFF_B + cv::C_M2, cv::WM2); }
    PH_END(PH0 + CF::o_w1)
    PH_BEGIN(PH0 + CF::o_w2)
    { pg8::Sched S{}; S.A = (const char*)WSP(bf16_t, WS_H); S.B = (const char*)(WSP(bf16_t, WS_W2) + (size_t)L * D * FF); S.lda = FF * 2; S.ldb = FF * 2; S.nt = FF / 64; S.nM = ML / 256; S.nN = D / 256; S.ngroups = 1; S.G = C.G; S.c = C.bx;
      if constexpr (CF::fuse_post) {
          const float* modn = modl + 5 * MODROW;
          pg8::EpiFuse E{X, lastl ? P.out : X, lastl ? nullptr : WSP(bf16_t, WS_U), modl + 5 * D, P.in[9] + L * D, lastl ? nullptr : P.in[6] + (L + 1) * D, modn + 1 * D, modn + 0 * D,
                         WSP(unsigned long long, WS_SLOT), WSP(unsigned, WS_CTL) + CW_FUSE + (2 * L + 1) * 2048, WSP(unsigned, WS_CTL) + CW_TMO};
          GEMM_CALL(S, E);
      } else { pg8::EpiY E{WSP(bf16_t, WS_Y), (unsigned)D, nullptr, 0, 0}; GEMM_CALL(S, E); }
      if constexpr (!lastl) { pg8::Sched S2 = S; S2.A = (const char*)(WSP(bf16_t, WS_H) + (size_t)ML * FF); S2.nt = FF / 64 / NSPLIT; S2.nM = MC / 256; S2.ngroups = NSPLIT; S2.a_g = (FF / NSPLIT) * 2; S2.b_g = (FF / NSPLIT) * 2;
          pg8::EpiSlab E2{WSP(bf16_t, WS_YC), (unsigned)D, (size_t)MC * D}; GEMM_CALL(S2, E2); } }
    PH_END(PH0 + CF::o_w2)
    if constexpr (CF::has_tpost) {
    PH_BEGIN(PH0 + CF::o_tpost)
    { ThinArgs T{}; T.xin_lat = XB; T.xin_ctx = XB + (size_t)ML * D; T.xin_bf16 = 1; T.y = WSP(const bf16_t, WS_Y); T.xout_lat = lastl ? (void*)P.out : (void*)XB; T.xout_ctx = XB + (size_t)ML * D; T.xout_bf16 = lastl ? 0 : 1;
      T.yc = WSP(const bf16_t, WS_YC); T.nslab = lastl ? 0 : NSPLIT;
      T.g_post = P.in[9] + L * D; T.gate = modl + 5 * D; T.nrows = Mact; T.gb_lo = CF::fuse_post ? 4 : 0;
      if constexpr (!lastl) { const float* modn = modl + 5 * MODROW; T.uout = WSP(bf16_t, WS_U); T.g_pre = P.in[6] + (L + 1) * D; T.sc = modn + 1 * D; T.sh = modn + 0 * D; }
      thin_phase(T, C.lds, C.bx, C.G, C.tid, C.wave, C.lane); }
    PH_END(PH0 + CF::o_tpost)
    }
}
constexpr int PH_L0 = 1, PH_L1 = PH_L0 + LayerCfg<0>::nph, PH_L2 = PH_L1 + LayerCfg<1>::nph, PH_L3 = PH_L2 + LayerCfg<2>::nph, N_PHASES = PH_L3 + LayerCfg<3>::nph;

__global__ void __launch_bounds__(NTHR, 2) fwd_kernel(Params P) {
    extern __shared__ __attribute__((aligned(16))) unsigned char lds_raw[];
    Ctx C; C.lds = (LAS unsigned char*)lds_raw;
    C.tid = threadIdx.x; C.lane = C.tid & 63; C.wave = __builtin_amdgcn_readfirstlane(C.tid >> 6);
    C.G = gridDim.x; C.bx = blockIdx.x; C.vcu = (C.G % 8 == 0) ? (C.bx % 8) * (C.G / 8) + C.bx / 8 : C.bx;
    C.gw = C.vcu * NWAVES + C.wave; C.NGW = C.G * NWAVES;
    for (int u = C.tid; u < (LDS_BYTES - LDSCTL_OFF) / 4; u += NTHR) ((LAS unsigned*)(C.lds + LDSCTL_OFF))[u] = 0u;
    __syncthreads();
#if MK_MULTI
    XcdBarrier bar{};
#else
    XcdBarrier bar = xcd_barrier_post(WSP(unsigned, WS_CTL) + CW_BAR, (volatile LAS unsigned*)(C.lds + MISC_OFF) + 8);
#endif
    PH_BEGIN(0) prologue<2>(P, C.lds, C.tid, C.wave, C.lane, C.vcu, C.G);
    { unsigned* bw = WSP(unsigned, WS_CTL) + CW_BAR; unsigned* ctr = WSP(unsigned, WS_CTL) + CW_MOD0;
      __syncthreads();
      if (C.tid == 0) { XB_SPIN(xb_ld(ctr) < 192u, bw); __builtin_amdgcn_fence(__ATOMIC_ACQUIRE, "agent"); asm volatile("s_waitcnt vmcnt(0)" ::: "memory"); }
      __syncthreads();
      const float* mod = WSP(const float, WS_MOD);
      ThinArgs T{}; T.xin_lat = P.in[0]; T.xin_ctx = P.in[2]; T.y = nullptr; T.uout = WSP(bf16_t, WS_U); T.g_pre = P.in[6]; T.sc = mod + 1 * D; T.sh = mod + 0 * D; T.nrows = MT;
      thin_phase(T, C.lds, C.bx, C.G, C.tid, C.wave, C.lane); }
    PH_END(0)
#if !MK_MULTI
    if (P.ph_lo == 0 && P.ph_hi > 1) {
        volatile LAS unsigned* st = (volatile LAS unsigned*)(C.lds + MISC_OFF) + 8;
        if (C.tid == 0) { unsigned* bw = WSP(unsigned, WS_CTL) + CW_BAR; bool okc = (C.G % 8 == 0);
            for (unsigned j = 0; j < 16; ++j) { const unsigned cnt = xb_ld(&bw[XB_XCNT(j)]); okc = okc && (cnt == (j < 8 ? (unsigned)C.G / 8u : 0u)); }
            st[3] = okc ? st[2] * 8u + bar.x : (unsigned)blockIdx.x; }
        __syncthreads();
        C.bx = (int)st[3]; C.vcu = (C.G % 8 == 0) ? (C.bx % 8) * (C.G / 8) + C.bx / 8 : C.bx; C.gw = C.vcu * NWAVES + C.wave;
    }
#endif
    layer<0, PH_L0>(P, C, bar);
    layer<1, PH_L1>(P, C, bar);
    layer<2, PH_L2>(P, C, bar);
    layer<3, PH_L3>(P, C, bar);
}
#undef PH_BEGIN
#undef PH_END
#undef GRID_BAR

extern "C" void kernel_launch(void* const* d_in, const int* in_sizes, int n_in, void* d_out, int out_size, void* d_ws, size_t ws_size, hipStream_t stream) {
    static int grid = 0;
    if (grid == 0) {
        if (n_in != 22 || out_size != ML * D || ws_size < WS_END) { fprintf(stderr, "kernel_launch: unexpected problem: n_in %d out %d ws %zu (need %zu)\n", n_in, out_size, ws_size, (size_t)WS_END); grid = -1; return; }
        int dev = 0, cus = 0, per_cu = 0;
        if (hipGetDevice(&dev) != hipSuccess || hipDeviceGetAttribute(&cus, hipDeviceAttributeMultiprocessorCount, dev) != hipSuccess) { grid = -1; return; }
        if (hipFuncSetAttribute((const void*)fwd_kernel, hipFuncAttributeMaxDynamicSharedMemorySize, LDS_BYTES) != hipSuccess) { fprintf(stderr, "kernel_launch: hipFuncSetAttribute failed\n"); grid = -1; return; }
        if (hipOccupancyMaxActiveBlocksPerMultiprocessor(&per_cu, (const void*)fwd_kernel, NTHR, LDS_BYTES) != hipSuccess || per_cu < 1) fprintf(stderr, "kernel_launch: occupancy query says %d\n", per_cu);
        (void)hipGetLastError();
        if (cus < 256) { fprintf(stderr, "kernel_launch: %d CUs; this kernel is built for a 256-CU device (one workgroup per CU, fused epilogues pair 8 workgroups per row panel)\n", cus); grid = -1; return; }
        grid = 256;
    }
    if (grid < 0) return;
    (void)in_sizes;
    hipMemsetAsync((char*)d_ws + WS_CTL, 0, CTL_BYTES, stream);
    Params p{};
    for (int i = 0; i < 22; ++i) p.in[i] = (const float*)d_in[i];
    p.out = (float*)d_out; p.ws = (unsigned char*)d_ws;
    p.lam_init0 = (float)(0.8 - 0.6 * exp(-0.3 * 0.0)); p.lam_init3 = (float)(0.8 - 0.6 * exp(-0.3 * 3.0));
#if MK_MULTI
    for (int ph = 0; ph < N_PHASES; ++ph) { p.ph_lo = ph; p.ph_hi = ph + 1; hipLaunchKernelGGL(fwd_kernel, dim3(grid), dim3(NTHR), LDS_BYTES, stream, p); }
#else
    p.ph_lo = 0; p.ph_hi = N_PHASES;
    hipLaunchKernelGGL(fwd_kernel, dim3(grid), dim3(NTHR), LDS_BYTES, stream, p);
#endif
    const hipError_t le = hipPeekAtLastError();
    if (le != hipSuccess) fprintf(stderr, "kernel_launch: launch failed: %s\n", hipGetErrorName(le));
}
```
